# Optimizing an MI355X kernel written in HIP

```python
import math
import jax, jax.numpy as jnp
from jax import lax
import numpy as np

D_MODEL = 1024
BATCH = 8
SEQ = 8192
DEPTH = 2
DEC_BATCH = 32
DEC_SEQ = 2048
PAST_LEN = 128

HEAD_DIM = 64
A_Q_HEADS = 8
A_KV_HEADS = 2
A_GROUP = A_Q_HEADS // A_KV_HEADS
WINDOW = 128
BLOCK = 128
B_HEADS = 4
ATTN_HEADS = A_Q_HEADS + B_HEADS
NUM_BUCKETS = 32
MAX_DISTANCE = 128
C_WIDTH = 512
D_WIDTH = 512
SHORT_CONV = 3
CONF_CONV = 31
FFN_HIDDEN = ((8 * D_MODEL // 3 + 255) // 256) * 256
EPS = 1e-6

A_Q_W = A_Q_HEADS * HEAD_DIM
A_KV_W = A_KV_HEADS * HEAD_DIM
B_QK_W = B_HEADS * 2 * HEAD_DIM
B_V_W = B_HEADS * 2 * HEAD_DIM
ATTN_IN = A_Q_W + 2 * A_KV_W + 2 * B_QK_W + B_V_W
ATTN_OUT = A_Q_W + B_V_W
ATTN_SPLITS = [A_Q_W, A_Q_W + A_KV_W, A_Q_W + 2 * A_KV_W,
               A_Q_W + 2 * A_KV_W + B_QK_W, A_Q_W + 2 * A_KV_W + 2 * B_QK_W]
CONV_IN = 3 * C_WIDTH + 2 * D_WIDTH
CONV_OUT = C_WIDTH + D_WIDTH
N_EVEN = (DEPTH + 1) // 2
N_ODD = DEPTH // 2

kernel_name = "hybrid_bidir_encoder_attn_conv"


def rms_norm(x, g):
    xf = x.astype(jnp.float32)
    y = xf * lax.rsqrt(jnp.mean(xf * xf, axis=-1, keepdims=True) + EPS) * g.astype(jnp.float32)
    return y.astype(x.dtype)


def layer_norm(x, g, b):
    xf = x.astype(jnp.float32)
    mu = jnp.mean(xf, axis=-1, keepdims=True)
    xc = xf - mu
    var = jnp.mean(xc * xc, axis=-1, keepdims=True)
    y = xc * lax.rsqrt(var + EPS) * g.astype(jnp.float32) + b.astype(jnp.float32)
    return y.astype(x.dtype)


def rel_bucket(rel):
    half = NUM_BUCKETS // 2
    max_exact = half // 2
    n = jnp.abs(rel)
    large = max_exact + (jnp.log(jnp.maximum(n, 1).astype(jnp.float32) / max_exact)
                         / math.log(MAX_DISTANCE / max_exact) * (half - max_exact)).astype(jnp.int32)
    large = jnp.minimum(large, half - 1)
    return jnp.where(rel > 0, half, 0) + jnp.where(n < max_exact, n, large)


def depthwise_conv(x, w):
    width, ch = w.shape
    return lax.conv_general_dilated(
        x, w[:, None, :].astype(x.dtype), window_strides=(1,),
        padding=[(width // 2, width // 2)],
        dimension_numbers=('NWC', 'WIO', 'NWC'), feature_group_count=ch)


def windowed_gqa(q, k, v, bias_table, sink):
    bsz, s_len = q.shape[0], q.shape[1]
    nb = s_len // BLOCK
    qb = q.reshape(bsz, nb, BLOCK, A_KV_HEADS, A_GROUP, HEAD_DIM)

    def band(t):
        tp = jnp.pad(t, ((0, 0), (BLOCK, BLOCK), (0, 0), (0, 0)))
        tp = tp.reshape(bsz, nb + 2, BLOCK, A_KV_HEADS, HEAD_DIM)
        return jnp.concatenate([tp[:, :-2], tp[:, 1:-1], tp[:, 2:]], axis=2)

    kb, vb = band(k), band(v)
    rel = (jnp.arange(3 * BLOCK)[None, :] - BLOCK) - jnp.arange(BLOCK)[:, None]
    bias = bias_table[rel_bucket(rel)].astype(jnp.float32)
    bias = bias.transpose(2, 0, 1).reshape(A_KV_HEADS, A_GROUP, BLOCK, 3 * BLOCK)
    key_pos = jnp.arange(nb)[:, None] * BLOCK - BLOCK + jnp.arange(3 * BLOCK)[None, :]
    valid = (key_pos >= 0) & (key_pos < s_len)
    mask = (jnp.abs(rel) <= WINDOW)[None, :, :] & valid[:, None, :]
    s = jnp.einsum('bnqhgd,bnkhd->bnhgqk', qb, kb).astype(jnp.float32) * (HEAD_DIM ** -0.5) + bias
    s = jnp.where(mask[None, :, None, None], s, -1e30)
    sk = sink.astype(jnp.float32).reshape(A_KV_HEADS, A_GROUP)[None, None, :, :, None, None]
    m = jnp.maximum(jnp.max(s, axis=-1, keepdims=True), sk)
    e = jnp.exp(s - m)
    p = e / (jnp.sum(e, axis=-1, keepdims=True) + jnp.exp(sk - m))
    o = jnp.einsum('bnhgqk,bnkhd->bnqhgd', p.astype(v.dtype), vb)
    return o.reshape(bsz, s_len, A_Q_HEADS * HEAD_DIM)


def differential_attention(q, k, v, bias_table, lam, subln_g, layer):
    bsz, s_len = q.shape[0], q.shape[1]
    nb = s_len // BLOCK
    lam_init = 0.8 - 0.6 * math.exp(-0.3 * layer)
    lf = lam.astype(jnp.float32)
    lam_full = jnp.exp(jnp.sum(lf[0] * lf[1])) - jnp.exp(jnp.sum(lf[2] * lf[3])) + lam_init
    k_pos = jnp.arange(s_len)
    qblocks = q.reshape(bsz, nb, BLOCK, B_HEADS, 2, HEAD_DIM).transpose(1, 0, 2, 3, 4, 5)

    def block(args):
        qblk, n = args
        q_pos = n * BLOCK + jnp.arange(BLOCK)
        bias = bias_table[rel_bucket(k_pos[None, :] - q_pos[:, None])].astype(jnp.float32)
        bias = bias.transpose(2, 0, 1)[None, :, None]
        s = jnp.einsum('bqhcd,bkhcd->bhcqk', qblk, k).astype(jnp.float32) * (HEAD_DIM ** -0.5) + bias
        p = jax.nn.softmax(s, axis=-1)
        p = p[:, :, 0] - lam_full * p[:, :, 1]
        return jnp.einsum('bhqk,bkhe->bqhe', p.astype(v.dtype), v)

    o = lax.map(block, (qblocks, jnp.arange(nb)))
    o = o.transpose(1, 0, 2, 3, 4).reshape(bsz, s_len, B_HEADS, 2 * HEAD_DIM)
    o = rms_norm(o, subln_g) * (1.0 - lam_init)
    return o.reshape(bsz, s_len, B_HEADS * 2 * HEAD_DIM)


def attention_mixer(h, w_in, w_out, a_qn, a_kn, a_sink, b_qn, b_kn, b_lam, b_subln, rel_bias, layer):
    bsz, s_len, _ = h.shape
    proj = h @ w_in
    qa, ka, va, qb, kb, vb = jnp.split(proj, ATTN_SPLITS, axis=-1)
    qa = rms_norm(qa.reshape(bsz, s_len, A_Q_HEADS, HEAD_DIM), a_qn)
    ka = rms_norm(ka.reshape(bsz, s_len, A_KV_HEADS, HEAD_DIM), a_kn)
    va = va.reshape(bsz, s_len, A_KV_HEADS, HEAD_DIM)
    ya = windowed_gqa(qa, ka, va, rel_bias[:, :A_Q_HEADS], a_sink)
    qb = rms_norm(qb.reshape(bsz, s_len, B_HEADS, 2, HEAD_DIM), b_qn)
    kb = rms_norm(kb.reshape(bsz, s_len, B_HEADS, 2, HEAD_DIM), b_kn)
    vb = vb.reshape(bsz, s_len, B_HEADS, 2 * HEAD_DIM)
    yb = differential_attention(qb, kb, vb, rel_bias[:, A_Q_HEADS:], b_lam, b_subln, layer)
    return jnp.concatenate([ya, yb], axis=-1) @ w_out


def conv_mixer(h, w_in, w_out, sc_w, dw_w, dw_b, ln_g, ln_b):
    proj = h @ w_in
    gb, gc, xc, conf = jnp.split(proj, [C_WIDTH, 2 * C_WIDTH, 3 * C_WIDTH], axis=-1)
    yc = gb * depthwise_conv(gc * xc, sc_w)
    a, gate = jnp.split(conf, 2, axis=-1)
    u = a * jax.nn.sigmoid(gate)
    u = depthwise_conv(u, dw_w) + dw_b
    u = jax.nn.silu(layer_norm(u, ln_g, ln_b))
    return jnp.concatenate([yc, u], axis=-1) @ w_out


def swiglu(h, w_gate, w_up, w_down):
    return (jax.nn.silu(h @ w_gate) * (h @ w_up)) @ w_down


def encoder_trunk(x, rel_bias, mix_norm, ffn_norm, w_gate, w_up, w_down,
                  attn_w_in, attn_w_out, a_q_norm, a_k_norm, a_sink,
                  b_q_norm, b_k_norm, b_lambda, b_subln,
                  conv_w_in, conv_w_out, short_conv_w, conf_dw_w, conf_dw_b, conf_ln_g, conf_ln_b):
    for l in range(DEPTH):
        i = l // 2
        h = rms_norm(x, mix_norm[l])
        if l % 2 == 0:
            mix = attention_mixer(h, attn_w_in[i], attn_w_out[i], a_q_norm[i], a_k_norm[i], a_sink[i],
                                  b_q_norm[i], b_k_norm[i], b_lambda[i], b_subln[i], rel_bias, l)
        else:
            mix = conv_mixer(h, conv_w_in[i], conv_w_out[i], short_conv_w[i], conf_dw_w[i],
                             conf_dw_b[i], conf_ln_g[i], conf_ln_b[i])
        x = x + mix
        x = x + swiglu(rms_norm(x, ffn_norm[l]), w_gate[l], w_up[l], w_down[l])
    return x


def setup_inputs(seed: int = 0) -> dict:
    key = jax.random.key(seed)
    ks = jax.random.split(key, 24)
    f32 = jnp.float32
    nrm = lambda k, shape, scale: jax.random.normal(k, shape, f32) * scale
    gain = lambda k, shape: 1.0 + 0.05 * jax.random.normal(k, shape, f32)
    return {
        "x_prompt": nrm(ks[0], (BATCH, SEQ, D_MODEL), 1.0),
        "x_sample": nrm(ks[1], (DEC_BATCH, DEC_SEQ, D_MODEL), 1.0),
        "rel_bias": nrm(ks[2], (NUM_BUCKETS, ATTN_HEADS), 0.5),
        "mix_norm": gain(ks[3], (DEPTH, D_MODEL)),
        "ffn_norm": gain(ks[4], (DEPTH, D_MODEL)),
        "w_gate": nrm(ks[5], (DEPTH, D_MODEL, FFN_HIDDEN), D_MODEL ** -0.5),
        "w_up": nrm(ks[6], (DEPTH, D_MODEL, FFN_HIDDEN), D_MODEL ** -0.5),
        "w_down": nrm(ks[7], (DEPTH, FFN_HIDDEN, D_MODEL), FFN_HIDDEN ** -0.5),
        "attn_w_in": nrm(ks[8], (N_EVEN, D_MODEL, ATTN_IN), D_MODEL ** -0.5),
        "attn_w_out": nrm(ks[9], (N_EVEN, ATTN_OUT, D_MODEL), ATTN_OUT ** -0.5),
        "a_q_norm": gain(ks[10], (N_EVEN, HEAD_DIM)),
        "a_k_norm": gain(ks[11], (N_EVEN, HEAD_DIM)),
        "a_sink": nrm(ks[12], (N_EVEN, A_Q_HEADS), 0.5),
        "b_q_norm": gain(ks[13], (N_EVEN, HEAD_DIM)),
        "b_k_norm": gain(ks[14], (N_EVEN, HEAD_DIM)),
        "b_lambda": nrm(ks[15], (N_EVEN, 4, HEAD_DIM), 0.1),
        "b_subln": gain(ks[16], (N_EVEN, 2 * HEAD_DIM)),
        "conv_w_in": nrm(ks[17], (N_ODD, D_MODEL, CONV_IN), D_MODEL ** -0.5),
        "conv_w_out": nrm(ks[18], (N_ODD, CONV_OUT, D_MODEL), CONV_OUT ** -0.5),
        "short_conv_w": nrm(ks[19], (N_ODD, SHORT_CONV, C_WIDTH), SHORT_CONV ** -0.5),
        "conf_dw_w": nrm(ks[20], (N_ODD, CONF_CONV, D_WIDTH), CONF_CONV ** -0.5),
        "conf_dw_b": nrm(ks[21], (N_ODD, D_WIDTH), 0.02),
        "conf_ln_g": gain(ks[22], (N_ODD, D_WIDTH)),
        "conf_ln_b": nrm(ks[23], (N_ODD, D_WIDTH), 0.02),
    }


def reference(x_prompt, x_sample, rel_bias, mix_norm, ffn_norm, w_gate, w_up, w_down,
              attn_w_in, attn_w_out, a_q_norm, a_k_norm, a_sink,
              b_q_norm, b_k_norm, b_lambda, b_subln,
              conv_w_in, conv_w_out, short_conv_w, conf_dw_w, conf_dw_b, conf_ln_g, conf_ln_b):
    y_prompt = encoder_trunk(x_prompt, rel_bias, mix_norm, ffn_norm, w_gate, w_up, w_down,
                             attn_w_in, attn_w_out, a_q_norm, a_k_norm, a_sink,
                             b_q_norm, b_k_norm, b_lambda, b_subln,
                             conv_w_in, conv_w_out, short_conv_w, conf_dw_w, conf_dw_b, conf_ln_g, conf_ln_b)
    y_sample = encoder_trunk(x_sample, rel_bias, mix_norm, ffn_norm, w_gate, w_up, w_down,
                             attn_w_in, attn_w_out, a_q_norm, a_k_norm, a_sink,
                             b_q_norm, b_k_norm, b_lambda, b_subln,
                             conv_w_in, conv_w_out, short_conv_w, conf_dw_w, conf_dw_b, conf_ln_g, conf_ln_b)
    return (y_prompt, y_sample)
```

```cpp
#include <hip/hip_runtime.h>
#include <hip/hip_cooperative_groups.h>
#include <cstdio>
#include <cstdint>
namespace cg = cooperative_groups;
#ifndef PROBE_ATT
#define PROBE_ATT 1
#endif
#ifndef MK_N_LAUNCHES
#define MK_N_LAUNCHES 1
#endif
namespace pg8 {
#define PG8_LAS __attribute__((address_space(3)))
typedef unsigned short bf16_t;
typedef short bf16x8 __attribute__((ext_vector_type(8)));
typedef float f32x4 __attribute__((ext_vector_type(4)));
typedef unsigned u32x4 __attribute__((ext_vector_type(4)));
constexpr int BM = 256, BK = 64, HALF = 128, HTB = HALF * BK * 2  , STAGE_BYTES = 8 * HTB, NXCD = 8, WGM = 8;

__host__ __device__ __forceinline__ int lds_byte(int r, int c) { const int st = (r >> 4) * 2 + (c >> 5), rr = r & 15, cc = c & 31, ob = rr * 64 + cc * 2; return st * 1024 + (ob ^ (((ob >> 9) & 1) << 5)); }
__host__ __device__ __forceinline__ void stage_rc(int b, int& R, int& C) { const int st = b / 1024, sb = b % 1024, swz = sb ^ (((sb >> 9) & 1) << 5); R = (st >> 1) * 16 + swz / 64; C = (st & 1) * 32 + (swz % 64) / 2; }
__host__ __device__ __forceinline__ int perm32(int rho) { const int n = rho >> 4, i = rho & 15; return 8 * (i >> 2) + 4 * n + (i & 3); }

struct Unit { int pm, pn; };
struct Gemm { const bf16_t* A; const bf16_t* Bt; int M, N, K; };

struct StaticOrder {
    int nM, nN, nwg, G, c;
    __host__ __device__ void init(int M, int N, int G_, int c_) { nM = M / BM; nN = N / BM; nwg = nM * nN; G = G_; c = c_; }
    __host__ __device__ bool next(int i, Unit& u) const {
        const long L = (long)i * G + c; if (L >= nwg) return false;
        int wgid = (int)L; { const int q = nwg / NXCD, r = nwg % NXCD, xcd = wgid % NXCD, off = wgid / NXCD; wgid = (xcd < r ? xcd * (q + 1) : r * (q + 1) + (xcd - r) * q) + off; }
        const int nig = WGM * nN, gid = wgid / nig, fm = gid * WGM, gsz = (nM - fm) < WGM ? (nM - fm) : WGM;
        u.pm = fm + ((wgid % nig) % gsz); u.pn = (wgid % nig) / gsz; return true;
    }
    __device__ __forceinline__ void a_ready(const Unit&) const {}
    __device__ __forceinline__ void done(const Unit&) const {}
};

__device__ __forceinline__ unsigned cvt_pk_bf16(float lo, float hi) { unsigned r; asm volatile("v_cvt_pk_bf16_f32 %0, %1, %2" : "=v"(r) : "v"(lo), "v"(hi)); return r; }
typedef float f32x2 __attribute__((ext_vector_type(2)));
typedef unsigned u32x2 __attribute__((ext_vector_type(2)));
__device__ __forceinline__ float bf_lo(unsigned w) { return __uint_as_float(w << 16); }
__device__ __forceinline__ float bf_hi(unsigned w) { return __uint_as_float(w & 0xffff0000u); }
__device__ __forceinline__ float row_rstd(const float* ssq, int row) {
    const f32x4* p = (const f32x4*)(ssq + (size_t)row * 16);
    const f32x4 a = p[0], b = p[1], c = p[2], d = p[3];
    const float s = ((a[0] + a[1]) + (a[2] + a[3])) + ((b[0] + b[1]) + (b[2] + b[3])) + ((c[0] + c[1]) + (c[2] + c[3])) + ((d[0] + d[1]) + (d[2] + d[3]));
    return __builtin_amdgcn_rsqf(s * (1.0f / 1024.0f) + 1e-6f);
}
__device__ __forceinline__ float fast_sigmoid(float x) { return __builtin_amdgcn_rcpf(1.0f + __expf(-x)); }

constexpr int QKW = 1664;
constexpr int VT_PITCH = 131072 + 128;
constexpr float C2Q = 0.125f * 1.4426950408889634f;

struct EpiQKV {
    static constexpr bool PERM = true, AFTER_DRAIN = false;
    bf16_t* QK; bf16_t* VT; const float* ssq; const float* aq; const float* ak; const float* bq; const float* bk; PG8_LAS unsigned char* xlds;
    __device__ __forceinline__ void operator()(const f32x4 (&acc)[2][2][4][2], const Unit& u, int wr, int wc, int fr, int fq) const {
        const int L = u.pn * 256 + wc * 64;
        int kind; const float* gain = nullptr; float scale = 1.f; int ccol = 0, vrow = 0;
        if (L < 512) { kind = 0; gain = aq; scale = C2Q; ccol = L; }
        else if (L < 640) { kind = 0; gain = ak; ccol = L; }
        else if (L < 768) { kind = 1; vrow = L - 640; }
        else if (L < 1280) { kind = 0; gain = bq; scale = C2Q; ccol = L - 128; }
        else if (L < 1792) { kind = 0; gain = bk; ccol = L - 128; }
        else { kind = 1; vrow = L - 1792 + 128; }
        if (kind == 0) {
            f32x4 gv[2][2];
#pragma unroll
            for (int bj = 0; bj < 2; ++bj)
#pragma unroll
                for (int n = 0; n < 2; ++n) gv[bj][n] = *(const f32x4*)(gain + 32 * bj + 8 * fq + 4 * n);
#pragma unroll
            for (int ai = 0; ai < 2; ++ai)
#pragma unroll
                for (int m = 0; m < 4; ++m) {
                    const int row = u.pm * BM + ai * HALF + wr * 64 + m * 16 + fr;
                    const float rs = row_rstd(ssq, row);
                    float ss = 0.f;
#pragma unroll
                    for (int bj = 0; bj < 2; ++bj)
#pragma unroll
                        for (int n = 0; n < 2; ++n) { const f32x4 v = acc[ai][bj][m][n] * rs; ss += (v[0] * v[0] + v[1] * v[1]) + (v[2] * v[2] + v[3] * v[3]); }
                    ss += __shfl_xor(ss, 16); ss += __shfl_xor(ss, 32);
                    const float f = rs * __builtin_amdgcn_rsqf(ss * (1.0f / 64.0f) + 1e-6f) * scale;
                    bf16_t* rowp = QK + ((size_t)((row >> 6) * 26 + (ccol >> 6)) * 64 + (row & 63)) * 64 + 8 * fq;
#pragma unroll
                    for (int bj = 0; bj < 2; ++bj) {
                        const f32x4 v0 = acc[ai][bj][m][0] * f * gv[bj][0], v1 = acc[ai][bj][m][1] * f * gv[bj][1];
                        u32x4 w; w.x = cvt_pk_bf16(v0[0], v0[1]); w.y = cvt_pk_bf16(v0[2], v0[3]); w.z = cvt_pk_bf16(v1[0], v1[1]); w.w = cvt_pk_bf16(v1[2], v1[3]);
                        *(u32x4*)(rowp + 32 * bj) = w;
                    }
                }
        } else {
            PG8_LAS unsigned char* xl = xlds + (wr * 4 + wc) * 2048;
            const int lane = fq * 16 + fr;
#pragma unroll
            for (int ai = 0; ai < 2; ++ai) {
                float rs[4];
#pragma unroll
                for (int m = 0; m < 4; ++m) rs[m] = row_rstd(ssq, u.pm * BM + ai * HALF + wr * 64 + m * 16 + fr);
                const size_t tb = (size_t)(u.pm * 4 + ai * 2 + wr) * 640;
#pragma unroll
                for (int bj = 0; bj < 2; ++bj)
#pragma unroll
                    for (int n = 0; n < 2; ++n) {
#pragma unroll
                        for (int m = 0; m < 4; ++m) {
                            const f32x4 v = acc[ai][bj][m][n] * rs[m];
                            const unsigned w0 = cvt_pk_bf16(v[0], v[1]), w1 = cvt_pk_bf16(v[2], v[3]);
                            PG8_LAS bf16_t* q = (PG8_LAS bf16_t*)(xl + (4 * fq) * 128 + (16 * m + fr) * 2);
                            q[0] = (bf16_t)(w0 & 0xffffu); q[64] = (bf16_t)(w0 >> 16); q[128] = (bf16_t)(w1 & 0xffffu); q[192] = (bf16_t)(w1 >> 16);
                        }
                        asm volatile("s_waitcnt lgkmcnt(0)" ::: "memory");
                        const int c16 = lane >> 2, part = lane & 3;
                        const u32x4 a = *(const PG8_LAS u32x4*)(xl + c16 * 128 + part * 32), b = *(const PG8_LAS u32x4*)(xl + c16 * 128 + part * 32 + 16);
                        bf16_t* gp = VT + (tb + vrow + 32 * bj + 8 * (c16 >> 2) + 4 * n + (c16 & 3)) * 64 + part * 16;
                        *(u32x4*)gp = a; *(u32x4*)(gp + 8) = b;
                        asm volatile("s_waitcnt lgkmcnt(0)" ::: "memory");
                    }
            }
        }
    }
};

template <bool FINAL> struct EpiRes {
    static constexpr bool PERM = true, AFTER_DRAIN = false;
    bf16_t* X; float* out; float* ssq;
    __device__ __forceinline__ void operator()(const f32x4 (&acc)[2][2][4][2], const Unit& u, int wr, int wc, int fr, int fq) const {
        const int col0 = u.pn * BM + wc * 32 + 8 * fq;
#pragma unroll
        for (int ai = 0; ai < 2; ++ai)
#pragma unroll
            for (int m = 0; m < 4; ++m) {
                const int row = u.pm * BM + ai * HALF + wr * 64 + m * 16 + fr;
                float ss = 0.f;
#pragma unroll
                for (int bj = 0; bj < 2; ++bj) {
                    bf16_t* xp = X + (size_t)row * 1024 + col0 + bj * HALF;
                    const u32x4 xv = *(const u32x4*)xp;
                    f32x4 y0 = acc[ai][bj][m][0], y1 = acc[ai][bj][m][1];
                    y0[0] += bf_lo(xv.x); y0[1] += bf_hi(xv.x); y0[2] += bf_lo(xv.y); y0[3] += bf_hi(xv.y);
                    y1[0] += bf_lo(xv.z); y1[1] += bf_hi(xv.z); y1[2] += bf_lo(xv.w); y1[3] += bf_hi(xv.w);
                    if (FINAL) {
                        float* op = out + (size_t)row * 1024 + col0 + bj * HALF;
                        *(f32x4*)op = y0; *(f32x4*)(op + 4) = y1;
                    } else {
                        u32x4 w; w.x = cvt_pk_bf16(y0[0], y0[1]); w.y = cvt_pk_bf16(y0[2], y0[3]); w.z = cvt_pk_bf16(y1[0], y1[1]); w.w = cvt_pk_bf16(y1[2], y1[3]);
                        *(u32x4*)xp = w;
                        ss += (y0[0] * y0[0] + y0[1] * y0[1]) + (y0[2] * y0[2] + y0[3] * y0[3]) + (y1[0] * y1[0] + y1[1] * y1[1]) + (y1[2] * y1[2] + y1[3] * y1[3]);
                    }
                }
                if (!FINAL) {
                    ss += __shfl_xor(ss, 16); ss += __shfl_xor(ss, 32);
                    if (fq == 0) ssq[(size_t)row * 16 + u.pn * 4 + wc] = ss;
                }
            }
    }
};

struct EpiGlu {
    static constexpr bool PERM = true, AFTER_DRAIN = false;
    bf16_t* H; const float* ssq;
    __device__ __forceinline__ void operator()(const f32x4 (&acc)[2][2][4][2], const Unit& u, int wr, int wc, int fr, int fq) const {
        const int col0 = u.pn * HALF + wc * 32 + 8 * fq;
#pragma unroll
        for (int ai = 0; ai < 2; ++ai)
#pragma unroll
            for (int m = 0; m < 4; ++m) {
                const int row = u.pm * BM + ai * HALF + wr * 64 + m * 16 + fr;
                const float rs = row_rstd(ssq, row);
                float h[8];
#pragma unroll
                for (int n = 0; n < 2; ++n)
#pragma unroll
                    for (int i = 0; i < 4; ++i) { const float g = acc[ai][0][m][n][i] * rs, up = acc[ai][1][m][n][i] * rs; h[4 * n + i] = g * up * fast_sigmoid(g); }
                u32x4 w; w.x = cvt_pk_bf16(h[0], h[1]); w.y = cvt_pk_bf16(h[2], h[3]); w.z = cvt_pk_bf16(h[4], h[5]); w.w = cvt_pk_bf16(h[6], h[7]);
                *(u32x4*)(H + (size_t)row * 2816 + col0) = w;
            }
    }
};

struct EpiConvIn {
    static constexpr bool PERM = true, AFTER_DRAIN = false;
    bf16_t* O; const float* ssq;
    __device__ __forceinline__ void operator()(const f32x4 (&acc)[2][2][4][2], const Unit& u, int wr, int wc, int fr, int fq) const {
#pragma unroll
        for (int ai = 0; ai < 2; ++ai)
#pragma unroll
            for (int m = 0; m < 4; ++m) {
                const int row = u.pm * BM + ai * HALF + wr * 64 + m * 16 + fr;
                const float rs = row_rstd(ssq, row);
                bf16_t* rp = O + (size_t)row * 1536 + wc * 32 + 8 * fq;
                if (u.pn < 2) {
#pragma unroll
                    for (int bj = 0; bj < 2; ++bj) {
                        const f32x4 v0 = acc[ai][bj][m][0] * rs, v1 = acc[ai][bj][m][1] * rs;
                        u32x4 w; w.x = cvt_pk_bf16(v0[0], v0[1]); w.y = cvt_pk_bf16(v0[2], v0[3]); w.z = cvt_pk_bf16(v1[0], v1[1]); w.w = cvt_pk_bf16(v1[2], v1[3]);
                        *(u32x4*)(rp + u.pn * BM + bj * HALF) = w;
                    }
                } else {
                    float h[8];
                    const bool glu = u.pn >= 6;
#pragma unroll
                    for (int n = 0; n < 2; ++n)
#pragma unroll
                        for (int i = 0; i < 4; ++i) { const float a = acc[ai][0][m][n][i] * rs, b = acc[ai][1][m][n][i] * rs; h[4 * n + i] = glu ? a * fast_sigmoid(b) : a * b; }
                    u32x4 w; w.x = cvt_pk_bf16(h[0], h[1]); w.y = cvt_pk_bf16(h[2], h[3]); w.z = cvt_pk_bf16(h[4], h[5]); w.w = cvt_pk_bf16(h[6], h[7]);
                    *(u32x4*)(rp + 512 + (u.pn - 2) * HALF) = w;
                }
            }
    }
};

struct EpiPlain {
    static constexpr bool PERM = true, AFTER_DRAIN = false;
    bf16_t* O; int ldc; const float* ssq;
    __device__ __forceinline__ void operator()(const f32x4 (&acc)[2][2][4][2], const Unit& u, int wr, int wc, int fr, int fq) const {
        const int col0 = u.pn * BM + wc * 32 + 8 * fq;
#pragma unroll
        for (int ai = 0; ai < 2; ++ai)
#pragma unroll
            for (int m = 0; m < 4; ++m) {
                const int row = u.pm * BM + ai * HALF + wr * 64 + m * 16 + fr;
                const float rs = row_rstd(ssq, row);
#pragma unroll
                for (int bj = 0; bj < 2; ++bj) {
                    const f32x4 v0 = acc[ai][bj][m][0] * rs, v1 = acc[ai][bj][m][1] * rs;
                    u32x4 w; w.x = cvt_pk_bf16(v0[0], v0[1]); w.y = cvt_pk_bf16(v0[2], v0[3]); w.z = cvt_pk_bf16(v1[0], v1[1]); w.w = cvt_pk_bf16(v1[2], v1[3]);
                    *(u32x4*)(O + (size_t)row * ldc + col0 + bj * HALF) = w;
                }
            }
    }
};

template <class Epi, class Sched, bool ALIGN_EPI = false, bool SP2 = false>
__device__ __forceinline__ void gemm_phase(PG8_LAS unsigned char* lds, const Gemm g, const Sched& S, const Epi& E) {
    const int tid = threadIdx.x, wid = __builtin_amdgcn_readfirstlane(tid >> 6), lane = tid & 63, wr = wid >> 2, wc = wid & 3, fr = lane & 15, fq = lane >> 4;
    const int K = g.K, nt = K / BK;
    unsigned voffA[2], voffB[2];
#pragma unroll
    for (int i = 0; i < 2; ++i) { int R, C; stage_rc(tid * 16 + i * 8192, R, C); const int Rb = Epi::PERM ? ((R & ~31) + perm32(R & 31)) : R;
        voffA[i] = (unsigned)(R * K + C) * 2u; voffB[i] = (unsigned)(Rb * K + C) * 2u; }
    const size_t kstep = (size_t)(BK * 2);
    const size_t hstep = (size_t)HALF * K * 2;
    const size_t tstep = 2 * hstep;
    const unsigned ldsw = (unsigned)wid * 1024u;
    const int aoff = lds_byte(wr * 64 + fr, fq * 8), boff = lds_byte(wc * 32 + fr, fq * 8);
#define PG8_SA(b, h) (((b) * 2 + (h)) * HTB)
#define PG8_SB(b, h) ((4 + (b) * 2 + (h)) * HTB)
#define PG8_STAGE(bufoff, gbase, voff) do { _Pragma("unroll") for (int _i = 0; _i < 2; ++_i) \
        __builtin_amdgcn_global_load_lds((const unsigned*)((const char*)(gbase) + (voff)[_i]), (PG8_LAS unsigned*)(lds + (bufoff) + ldsw + _i * 8192), 16, 0, 0); } while (0)
#define PG8_LDA(dst, b, h) do { _Pragma("unroll") for (int m = 0; m < 4; ++m) _Pragma("unroll") for (int k = 0; k < 2; ++k) dst[m][k] = *(const PG8_LAS bf16x8*)(lds + PG8_SA(b, h) + aoff + m * 2048 + k * 1024); } while (0)
#define PG8_LDB(dst, b, h) do { _Pragma("unroll") for (int n = 0; n < 2; ++n) _Pragma("unroll") for (int k = 0; k < 2; ++k) dst[n][k] = *(const PG8_LAS bf16x8*)(lds + PG8_SB(b, h) + boff + n * 2048 + k * 1024); } while (0)
#define PG8_MMA(ai, bj, At, Bt) do { __builtin_amdgcn_s_setprio(1); _Pragma("unroll") for (int m = 0; m < 4; ++m) _Pragma("unroll") for (int n = 0; n < 2; ++n) _Pragma("unroll") for (int k = 0; k < 2; ++k) \
        acc[ai][bj][m][n] = __builtin_amdgcn_mfma_f32_16x16x32_bf16(Bt[n][k], At[m][k], acc[ai][bj][m][n], 0, 0, 0); __builtin_amdgcn_s_setprio(0); } while (0)
#define PG8_WAIT_V(n) asm volatile("s_waitcnt vmcnt(" #n ")" ::: "memory")
#define PG8_WAIT_L(n) asm volatile("s_waitcnt lgkmcnt(" #n ")" ::: "memory")
#define PG8_BAR __builtin_amdgcn_s_barrier()
#define PG8_SCHED __builtin_amdgcn_sched_barrier(0)
    Unit cur, nxt; int ui = 0;
    if (!S.next(0, cur)) return;
    f32x4 acc[2][2][4][2];
#pragma unroll
    for (int a = 0; a < 2; ++a)
#pragma unroll
        for (int b = 0; b < 2; ++b)
#pragma unroll
            for (int m = 0; m < 4; ++m)
#pragma unroll
                for (int n = 0; n < 2; ++n) acc[a][b][m][n] = (f32x4){0.f, 0.f, 0.f, 0.f};
    bf16x8 At[4][2], B0[2][2], B1[2][2];
    const char* cA = (const char*)g.A + (size_t)cur.pm * tstep; const char* cB = (const char*)g.Bt + (size_t)cur.pn * tstep;
    S.a_ready(cur);
    if constexpr (SP2) {
        PG8_STAGE(PG8_SB(0, 0), cB, voffB); PG8_STAGE(PG8_SB(0, 1), cB + hstep, voffB); PG8_STAGE(PG8_SA(0, 0), cA, voffA); PG8_STAGE(PG8_SA(0, 1), cA + hstep, voffA);
        if (wr == 1) PG8_BAR;
        PG8_WAIT_V(2); PG8_BAR;
        PG8_STAGE(PG8_SB(1, 0), cB + kstep, voffB); PG8_STAGE(PG8_SA(1, 0), cA + kstep, voffA); PG8_STAGE(PG8_SB(1, 1), cB + hstep + kstep, voffB);
        PG8_WAIT_V(6); PG8_BAR;
    } else {
        PG8_STAGE(PG8_SB(0, 0), cB, voffB); PG8_STAGE(PG8_SA(0, 0), cA, voffA); PG8_STAGE(PG8_SB(0, 1), cB + hstep, voffB); PG8_STAGE(PG8_SA(0, 1), cA + hstep, voffA);
        if (wr == 1) PG8_BAR;
        PG8_WAIT_V(4); PG8_BAR;
        PG8_STAGE(PG8_SB(1, 0), cB + kstep, voffB); PG8_STAGE(PG8_SA(1, 0), cA + kstep, voffA); PG8_STAGE(PG8_SB(1, 1), cB + hstep + kstep, voffB);
        PG8_WAIT_V(6); PG8_BAR;
    }
    for (;;) {
        const bool has_next = S.next(ui + 1, nxt);
        const char* nA = has_next ? (const char*)g.A + (size_t)nxt.pm * tstep : cA; const char* nB = has_next ? (const char*)g.Bt + (size_t)nxt.pn * tstep : cB;
        for (int t = 0; t < nt; t += 2) {
            const bool last = (t == nt - 2);
            const char* a1 = cA + (size_t)(t + 1) * kstep;
            const char* a2 = last ? nA : cA + (size_t)(t + 2) * kstep; const char* b2 = last ? nB : cB + (size_t)(t + 2) * kstep;
            const char* a3 = a2 + kstep; const char* b3 = b2 + kstep;
            if (last && has_next) S.a_ready(nxt);
            if constexpr (SP2) {
            PG8_LDB(B0, 0, 0); PG8_LDB(B1, 0, 1); PG8_SCHED; PG8_LDA(At, 0, 0); PG8_STAGE(PG8_SA(1, 1), a1 + hstep, voffA);
            PG8_WAIT_V(8); PG8_WAIT_L(0); PG8_BAR; PG8_MMA(0, 0, At, B0); PG8_MMA(0, 1, At, B1); PG8_BAR; PG8_SCHED;
            PG8_LDA(At, 0, 1); PG8_STAGE(PG8_SB(0, 0), b2, voffB); PG8_STAGE(PG8_SB(0, 1), b2 + hstep, voffB); PG8_STAGE(PG8_SA(0, 0), a2, voffA);
            PG8_WAIT_V(8); PG8_WAIT_L(0); PG8_BAR; PG8_MMA(1, 0, At, B0); PG8_MMA(1, 1, At, B1); PG8_BAR; PG8_SCHED;
            PG8_LDB(B0, 1, 0); PG8_LDB(B1, 1, 1); PG8_SCHED; PG8_LDA(At, 1, 0); PG8_STAGE(PG8_SA(0, 1), a2 + hstep, voffA);
            PG8_WAIT_V(8); PG8_WAIT_L(0); PG8_BAR; PG8_MMA(0, 0, At, B0); PG8_MMA(0, 1, At, B1); PG8_BAR; PG8_SCHED;
            PG8_LDA(At, 1, 1); PG8_STAGE(PG8_SB(1, 0), b3, voffB); PG8_STAGE(PG8_SB(1, 1), b3 + hstep, voffB); PG8_STAGE(PG8_SA(1, 0), a3, voffA);
            PG8_WAIT_V(8); PG8_WAIT_L(0); PG8_BAR; PG8_MMA(1, 0, At, B0); PG8_MMA(1, 1, At, B1); PG8_BAR; PG8_SCHED;
            } else {
            PG8_LDB(B0, 0, 0); PG8_SCHED; PG8_LDA(At, 0, 0); PG8_STAGE(PG8_SA(1, 1), a1 + hstep, voffA);
            PG8_WAIT_L(8); PG8_BAR; PG8_WAIT_L(0); PG8_MMA(0, 0, At, B0); PG8_BAR; PG8_SCHED;
            PG8_LDB(B1, 0, 1); PG8_STAGE(PG8_SB(0, 0), b2, voffB);
            PG8_BAR; PG8_WAIT_L(0); PG8_MMA(0, 1, At, B1); PG8_BAR;
            PG8_LDA(At, 0, 1); PG8_STAGE(PG8_SA(0, 0), a2, voffA);
            PG8_BAR; PG8_WAIT_L(0); PG8_MMA(1, 0, At, B0); PG8_BAR; PG8_SCHED;
            PG8_STAGE(PG8_SB(0, 1), b2 + hstep, voffB);
            PG8_WAIT_V(6); PG8_BAR; PG8_MMA(1, 1, At, B1); PG8_BAR;
            PG8_LDB(B0, 1, 0); PG8_SCHED; PG8_LDA(At, 1, 0); PG8_STAGE(PG8_SA(0, 1), a2 + hstep, voffA);
            PG8_WAIT_L(8); PG8_BAR; PG8_WAIT_L(0); PG8_MMA(0, 0, At, B0); PG8_BAR; PG8_SCHED;
            PG8_LDB(B1, 1, 1); PG8_STAGE(PG8_SB(1, 0), b3, voffB);
            PG8_BAR; PG8_WAIT_L(0); PG8_MMA(0, 1, At, B1); PG8_BAR;
            PG8_LDA(At, 1, 1); PG8_STAGE(PG8_SA(1, 0), a3, voffA);
            PG8_BAR; PG8_WAIT_L(0); PG8_MMA(1, 0, At, B0); PG8_BAR; PG8_SCHED;
            PG8_STAGE(PG8_SB(1, 1), b3 + hstep, voffB);
            PG8_WAIT_V(6); PG8_BAR; PG8_MMA(1, 1, At, B1); PG8_BAR;
            }
        }
        if constexpr (ALIGN_EPI) { if (wr == 0) PG8_BAR; }
        if constexpr (!Epi::AFTER_DRAIN) { E(acc, cur, wr, wc, fr, fq); S.done(cur); }
        if (!has_next) break;
#pragma unroll
        for (int a = 0; a < 2; ++a)
#pragma unroll
            for (int b = 0; b < 2; ++b)
#pragma unroll
                for (int m = 0; m < 4; ++m)
#pragma unroll
                    for (int n = 0; n < 2; ++n) acc[a][b][m][n] = (f32x4){0.f, 0.f, 0.f, 0.f};
        cur = nxt; cA = nA; cB = nB; ++ui;
        if constexpr (ALIGN_EPI) { if (wr == 1) PG8_BAR; }
    }
    PG8_WAIT_V(0);
    if constexpr (!ALIGN_EPI) { if (wr == 0) PG8_BAR; }
    PG8_BAR;
    if constexpr (Epi::AFTER_DRAIN) { E.fused(acc, cur, wr, wc, fr, fq, lds, wid, lane); S.done(cur); }
#undef PG8_SA
#undef PG8_SB
#undef PG8_STAGE
#undef PG8_LDA
#undef PG8_LDB
#undef PG8_MMA
#undef PG8_WAIT_V
#undef PG8_WAIT_L
#undef PG8_BAR
#undef PG8_SCHED
}
}
namespace att {
using pg8::bf16_t; using pg8::bf16x8; using pg8::f32x4; using pg8::u32x4; using pg8::u32x2; using pg8::cvt_pk_bf16; using pg8::QKW; using pg8::VT_PITCH;
typedef float f32x16 __attribute__((ext_vector_type(16)));
#define ALAS __attribute__((address_space(3)))
constexpr int OFF_K0 = 0, OFF_K1 = 8192, OFF_V = 16384, STAGE = 32768, NSTG = 4, OFF_LUT = NSTG * STAGE;
constexpr int ATT_LDS = OFF_LUT + 12 * 260 * 4;
__device__ __forceinline__ int pi32(int r) { return (r & ~12) | ((r & 4) << 1) | ((r & 8) >> 1); }
__device__ __forceinline__ int t5_bucket(int rel) {
    const int n = rel < 0 ? -rel : rel;
    int b = n < 8 ? n : (n < 12 ? 8 : n < 16 ? 9 : n < 23 ? 10 : n < 32 ? 11 : n < 46 ? 12 : n < 64 ? 13 : n < 91 ? 14 : 15);
    return b + (rel > 0 ? 16 : 0);
}

__device__ __forceinline__ void glds16(const void* gsrc, unsigned lds_dst) { unsigned keep;
    asm volatile("s_mov_b32 %0, m0\n\ts_mov_b32 m0, %2\n\ts_nop 0\n\tglobal_load_lds_dwordx4 %1, off\n\ts_mov_b32 m0, %0" : "=&s"(keep) : "v"(gsrc), "s"(lds_dst) : "memory"); }
template <int N> __device__ __forceinline__ void wait_bar() { asm volatile("s_waitcnt vmcnt(%0) lgkmcnt(0)\n\ts_barrier" :: "n"(N) : "memory"); }

template <bool WIN>
__device__ __forceinline__ void attn_unit(ALAS unsigned char* lds, const bf16_t* __restrict__ QK, const bf16_t* __restrict__ VT, bf16_t* __restrict__ Y,
                                          const float* __restrict__ rel_bias, const float* __restrict__ sinkp, const float* __restrict__ subln, float lam,
                                          int seq_base, int S, int q0, int hsel) {
    constexpr float LOG2E = 1.4426950408889634f;
    constexpr int NDB = WIN ? 2 : 4;
    const int tid = threadIdx.x, lane = tid & 63, l31 = lane & 31, hi = lane >> 5;
    const int wid = __builtin_amdgcn_readfirstlane(tid >> 6), half = wid >> 2, wq = wid & 3;
    const int qw = q0 + 32 * wq;
    int qcol, kcol0, kcol1, vrow0, bhead;
    if (WIN) { qcol = (2 * hsel + half) * 64; kcol0 = 512 + (hsel >> 1) * 64; kcol1 = kcol0; vrow0 = (hsel >> 1) * 64; bhead = 2 * hsel; }
    else { qcol = 640 + (2 * hsel + half) * 64; kcol0 = 1152 + (2 * hsel) * 64; kcol1 = kcol0 + 64; vrow0 = 128 + hsel * 128; bhead = 8 + hsel; }
    const ALAS float* lut = (const ALAS float*)(lds + OFF_LUT) + (WIN ? (bhead + half) : bhead) * 260;

    const int t_lo = WIN ? (q0 >= 128 ? (q0 - 128) / 64 : 0) : 0;
    const int t_hi = WIN ? ((q0 + 256) / 64 < S / 64 ? (q0 + 256) / 64 : S / 64) : S / 64;
    const int NT = t_hi - t_lo;
    const unsigned ldsb = (unsigned)(uintptr_t)lds;
    const int drow = 8 * wid + (lane >> 3), dch = (lane & 7) ^ ((4 * wid + (lane >> 4)) & 7);
    const bf16_t* kg = QK + ((size_t)((seq_base >> 6) + t_lo) * 26 * 64 + drow) * 64 + dch * 8 + kcol0 * 64;
    const bf16_t* vg = VT + ((size_t)((seq_base >> 6) + t_lo) * 640 + vrow0 + drow) * 64 + dch * 8;
    const unsigned dk = ldsb + wid * 1024;
#define AT_DMA(tr) do { const unsigned sb_ = (unsigned)__builtin_amdgcn_readfirstlane(dk + (((tr) & (NSTG - 1)) * STAGE)); const size_t ko_ = (size_t)(tr) * 26 * 4096, vo_ = (size_t)(tr) * 640 * 64; \
        glds16(kg + ko_, sb_ + OFF_K0); if (!WIN) glds16(kg + ko_ + 4096, sb_ + OFF_K1); glds16(vg + vo_, sb_ + OFF_V); if (!WIN) glds16(vg + vo_ + 64 * 64, sb_ + OFF_V + 8192); } while (0)
    constexpr int NPW = WIN ? 2 : 4;
    bf16x8 qfr[4];
    { const int qrow = seq_base + qw + l31; const bf16_t* qp = QK + ((size_t)((qrow >> 6) * 26 + (qcol >> 6)) * 64 + (qrow & 63)) * 64 + hi * 8;
#pragma unroll
      for (int ds = 0; ds < 4; ++ds) qfr[ds] = *(const bf16x8*)(qp + ds * 16); }
#define qf(ds) qfr[ds]
    AT_DMA(0); if (NT > 1) AT_DMA(1); if (NT > 2) AT_DMA(2);
    constexpr float THR = 8.0f;
    float m_ref = WIN ? sinkp[2 * hsel + half] * LOG2E : 0.f;
    float l_run = (WIN && hi == 0) ? 1.f : 0.f;
    float cbase = 0.f;
    f32x16 cvec;
#pragma unroll
    for (int r = 0; r < 16; ++r) cvec[r] = cbase - m_ref;
    f32x16 o[NDB];
#pragma unroll
    for (int db = 0; db < NDB; ++db)
#pragma unroll
        for (int r = 0; r < 16; ++r) o[db][r] = 0.f;
    const int krow = pi32(l31), fK = (krow >> 1) & 7, fV = (l31 >> 1) & 7;
    int kx[4], vx[4];
#pragma unroll
    for (int c = 0; c < 4; ++c) { kx[c] = (WIN ? OFF_K0 : (half ? OFF_K1 : OFF_K0)) + krow * 128 + (((2 * c + hi) ^ fK) << 4); vx[c] = OFF_V + l31 * 128 + (((2 * c + hi) ^ fV) << 4); }
    const int qabs = qw + l31;
    const float cfar_lo = __uint_as_float(__builtin_amdgcn_readfirstlane(__float_as_uint(lut[0]))), cfar_hi = __uint_as_float(__builtin_amdgcn_readfirstlane(__float_as_uint(lut[256])));
    asm volatile("" : "+v"(qfr[0]), "+v"(qfr[1]), "+v"(qfr[2]), "+v"(qfr[3]));
#pragma clang loop unroll(disable)
    for (int tr = 0; tr < NT; ++tr) {
        if (tr + 2 < NT) wait_bar<2 * NPW>(); else if (tr + 1 < NT) wait_bar<NPW>(); else wait_bar<0>();
        if (tr + 3 < NT) AT_DMA(tr + 3);
        const int k0 = (t_lo + tr) * 64;
        const bool skip = WIN && (k0 > qw + 31 + 128 || k0 + 63 < qw - 128);
        if (!skip) {
            const bool near = WIN || ((k0 - (qw + 31)) < 128 && (qw - (k0 + 63)) < 128);
            const float cinit = near ? 0.f : (k0 > qw ? cfar_hi : cfar_lo);
            if (cinit != cbase) { cbase = cinit;
#pragma unroll
                for (int r = 0; r < 16; ++r) cvec[r] = cbase - m_ref; }
            f32x16 s0, s1;
            const ALAS unsigned char* sb = lds + (tr & (NSTG - 1)) * STAGE;
            {
                bf16x8 ka[8];
#pragma unroll
                for (int ds = 0; ds < 4; ++ds) { ka[2 * ds] = *(const ALAS bf16x8*)(sb + kx[ds]); ka[2 * ds + 1] = *(const ALAS bf16x8*)(sb + kx[ds] + 4096); }
                __builtin_amdgcn_sched_barrier(0);
                s0 = __builtin_amdgcn_mfma_f32_32x32x16_bf16(ka[0], qf(0), cvec, 0, 0, 0);
                s1 = __builtin_amdgcn_mfma_f32_32x32x16_bf16(ka[1], qf(0), cvec, 0, 0, 0);
#pragma unroll
                for (int ds = 1; ds < 4; ++ds) {
                    s0 = __builtin_amdgcn_mfma_f32_32x32x16_bf16(ka[2 * ds], qf(ds), s0, 0, 0, 0);
                    s1 = __builtin_amdgcn_mfma_f32_32x32x16_bf16(ka[2 * ds + 1], qf(ds), s1, 0, 0, 0);
                }
            }
            bf16x8 va[2 * NDB], vc[2 * NDB];
#pragma unroll
            for (int kk = 0; kk < 2; ++kk)
#pragma unroll
                for (int db = 0; db < NDB; ++db) va[kk * NDB + db] = *(const ALAS bf16x8*)(sb + vx[kk] + db * 4096);
            __builtin_amdgcn_sched_barrier(0);
            if (near) {
#pragma unroll
                for (int r = 0; r < 16; ++r) {
                    const int rel = k0 + 16 * (r >> 3) + 8 * hi + (r & 7) - qabs;
                    const int i0 = (rel < -128 ? -128 : (rel > 128 ? 128 : rel)) + 128;
                    const int rel1 = rel + 32;
                    const int i1 = (rel1 < -128 ? -128 : (rel1 > 128 ? 128 : rel1)) + 128;
                    s0[r] += lut[i0]; s1[r] += lut[i1];
                    if (WIN) { if (rel < -128 || rel > 128) s0[r] = -1e30f; if (rel1 < -128 || rel1 > 128) s1[r] = -1e30f; }
                    if ((r & 3) == 3) __builtin_amdgcn_sched_barrier(0);
                }
            }
            float mx = fmaxf(fmaxf(s0[0], s1[0]), fmaxf(s0[1], s1[1]));
#pragma unroll
            for (int r = 2; r < 16; r += 2) mx = fmaxf(mx, fmaxf(fmaxf(s0[r], s1[r]), fmaxf(s0[r + 1], s1[r + 1])));
            if (__any(mx > THR)) {
                mx = fmaxf(mx, __shfl_xor(mx, 32));
                const float dl = fmaxf(mx, 0.f);
                m_ref += dl;
                const float f = __builtin_amdgcn_exp2f(-dl);
                l_run *= f;
#pragma unroll
                for (int db = 0; db < NDB; ++db)
#pragma unroll
                    for (int r = 0; r < 16; ++r) o[db][r] *= f;
#pragma unroll
                for (int r = 0; r < 16; ++r) { s0[r] -= dl; s1[r] -= dl; cvec[r] = cbase - m_ref; }
            }
            float ls0 = 0.f, ls1 = 0.f;
#define AT_EXP(SS, B, PF) do { \
                const float e0 = __builtin_amdgcn_exp2f(SS[B + 0]), e1 = __builtin_amdgcn_exp2f(SS[B + 1]), e2 = __builtin_amdgcn_exp2f(SS[B + 2]), e3 = __builtin_amdgcn_exp2f(SS[B + 3]); \
                const float e4 = __builtin_amdgcn_exp2f(SS[B + 4]), e5 = __builtin_amdgcn_exp2f(SS[B + 5]), e6 = __builtin_amdgcn_exp2f(SS[B + 6]), e7 = __builtin_amdgcn_exp2f(SS[B + 7]); \
                ls0 += (e0 + e1) + (e2 + e3); ls1 += (e4 + e5) + (e6 + e7); \
                PF.u.x = cvt_pk_bf16(e0, e1); PF.u.y = cvt_pk_bf16(e2, e3); PF.u.z = cvt_pk_bf16(e4, e5); PF.u.w = cvt_pk_bf16(e6, e7); } while (0)
            union PFU { u32x4 u; bf16x8 b; };
            PFU p0, p1, p2, p3;
            AT_EXP(s0, 0, p0);
#pragma unroll
            for (int kk = 0; kk < 2; ++kk)
#pragma unroll
                for (int db = 0; db < NDB; ++db) vc[kk * NDB + db] = *(const ALAS bf16x8*)(sb + vx[kk + 2] + db * 4096);
            __builtin_amdgcn_sched_barrier(0);
#pragma unroll
            for (int db = 0; db < NDB; ++db) o[db] = __builtin_amdgcn_mfma_f32_32x32x16_bf16(va[db], p0.b, o[db], 0, 0, 0);
            AT_EXP(s0, 8, p1);
            __builtin_amdgcn_sched_barrier(0);
#pragma unroll
            for (int db = 0; db < NDB; ++db) o[db] = __builtin_amdgcn_mfma_f32_32x32x16_bf16(va[NDB + db], p1.b, o[db], 0, 0, 0);
            AT_EXP(s1, 0, p2);
            __builtin_amdgcn_sched_barrier(0);
#pragma unroll
            for (int db = 0; db < NDB; ++db) o[db] = __builtin_amdgcn_mfma_f32_32x32x16_bf16(vc[db], p2.b, o[db], 0, 0, 0);
            AT_EXP(s1, 8, p3);
            __builtin_amdgcn_sched_barrier(0);
#pragma unroll
            for (int db = 0; db < NDB; ++db) o[db] = __builtin_amdgcn_mfma_f32_32x32x16_bf16(vc[NDB + db], p3.b, o[db], 0, 0, 0);
            __builtin_amdgcn_sched_barrier(0);
#undef AT_EXP
            l_run += ls0 + ls1;
        }
    }
    asm volatile("s_waitcnt lgkmcnt(0)\n\ts_barrier" ::: "memory");
#undef qf
#undef AT_DMA
    const float l_tot = l_run + __shfl_xor(l_run, 32);
    const float inv = 1.0f / l_tot;
    const size_t orow = (size_t)(seq_base + qw + l31) * 1024;
    if (WIN) {
        bf16_t* yp = Y + orow + (2 * hsel + half) * 64 + 4 * hi;
#pragma unroll
        for (int db = 0; db < NDB; ++db)
#pragma unroll
            for (int g = 0; g < 4; ++g) {
                u32x2 w; w.x = cvt_pk_bf16(o[db][4 * g] * inv, o[db][4 * g + 1] * inv); w.y = cvt_pk_bf16(o[db][4 * g + 2] * inv, o[db][4 * g + 3] * inv);
                *(u32x2*)(yp + 32 * db + 8 * g) = w;
            }
    } else {
        ALAS f32x4* xch = (ALAS f32x4*)lds + (size_t)wq * 1024 + l31;
        if (half == 1) {
#pragma unroll
            for (int db = 0; db < NDB; ++db)
#pragma unroll
                for (int g = 0; g < 4; ++g) { f32x4 v; v[0] = o[db][4 * g] * inv; v[1] = o[db][4 * g + 1] * inv; v[2] = o[db][4 * g + 2] * inv; v[3] = o[db][4 * g + 3] * inv;
                    xch[(8 * db + 2 * g + hi) * 32] = v; }
        }
        __syncthreads();
        if (half == 0) {
            float ss = 0.f;
#pragma unroll
            for (int db = 0; db < NDB; ++db)
#pragma unroll
                for (int g = 0; g < 4; ++g) { const f32x4 v = xch[(8 * db + 2 * g + hi) * 32];
#pragma unroll
                    for (int i = 0; i < 4; ++i) { const float x = o[db][4 * g + i] * inv - lam * v[i]; o[db][4 * g + i] = x; ss += x * x; } }
            ss += __shfl_xor(ss, 32);
            const float rn = __builtin_amdgcn_rsqf(ss * (1.0f / 128.0f) + 1e-6f) * 0.8f;
            bf16_t* yp = Y + orow + 512 + hsel * 128 + 4 * hi;
#pragma unroll
            for (int db = 0; db < NDB; ++db)
#pragma unroll
                for (int g = 0; g < 4; ++g) { const f32x4 gsc = *(const f32x4*)(subln + 32 * db + 8 * g + 4 * hi);
                    u32x2 w; w.x = cvt_pk_bf16(o[db][4 * g] * rn * gsc[0], o[db][4 * g + 1] * rn * gsc[1]); w.y = cvt_pk_bf16(o[db][4 * g + 2] * rn * gsc[2], o[db][4 * g + 3] * rn * gsc[3]);
                    *(u32x2*)(yp + 32 * db + 8 * g) = w; }
        }
        __syncthreads();
    }
}

__device__ __forceinline__ void attn_phase(ALAS unsigned char* lds, const bf16_t* QK, const bf16_t* VT, bf16_t* Y, const float* rel_bias, const float* sinkp, const float* subln, const float* blam) {
    float lam;
    { const int lane = threadIdx.x & 63; float a = blam[lane] * blam[64 + lane], b = blam[128 + lane] * blam[192 + lane];
#pragma unroll
      for (int o = 1; o < 64; o <<= 1) { a += __shfl_xor(a, o); b += __shfl_xor(b, o); }
      lam = __expf(a) - __expf(b) + 0.2f; }
    { constexpr float LOG2E = 1.4426950408889634f; ALAS float* lutw = (ALAS float*)(lds + OFF_LUT);
      for (int i = threadIdx.x; i < 12 * 257; i += 512) { const int hh = i / 257, ri = i - hh * 257; lutw[hh * 260 + ri] = rel_bias[t5_bucket(ri - 128) * 12 + hh] * LOG2E; }
      __syncthreads(); }
    const int G = gridDim.x, bx = blockIdx.x;
    for (int u = bx; u < 2048; u += G) { const int qb = u & 63, bh = u >> 6; attn_unit<false>(lds, QK, VT, Y, rel_bias, sinkp, subln, lam, (bh >> 2) * 8192, 8192, qb * 128, bh & 3); }
    for (int u = bx; u < 2048; u += G) { const int qb = u & 15, bh = u >> 4; attn_unit<false>(lds, QK, VT, Y, rel_bias, sinkp, subln, lam, 65536 + (bh >> 2) * 2048, 2048, qb * 128, bh & 3); }
    for (int u = bx; u < 4096; u += G) { const int hp = u & 3, qb = u >> 2;
        const int row0 = qb * 128; int seq_base, S;
        if (row0 < 65536) { seq_base = row0 & ~8191; S = 8192; } else { seq_base = row0 & ~2047; S = 2048; }
        attn_unit<true>(lds, QK, VT, Y, rel_bias, sinkp, subln, lam, seq_base, S, row0 - seq_base, hp); }
}
}

namespace cv {
using pg8::bf16_t; using pg8::f32x4; using pg8::u32x4; using pg8::cvt_pk_bf16; using pg8::bf_lo; using pg8::bf_hi; using pg8::fast_sigmoid;
#define CLAS __attribute__((address_space(3)))
constexpr int T = 32, HALO = 15, ROWS = T + 2 * HALO;
constexpr int OFF_U0 = 0, OFF_U1 = 64 * 1024;
constexpr int CONV_LDS = OFF_U1 + T * 512 * 4;
__device__ __forceinline__ void conv_unit(CLAS unsigned char* lds, const bf16_t* __restrict__ PC, bf16_t* __restrict__ YC, const float* __restrict__ w3, const float* __restrict__ w31,
                                          const float* __restrict__ dwb, const float* __restrict__ lng, const float* __restrict__ lnb, int seq_base, int S, int t0) {
    const int tid = threadIdx.x;
    for (int idx = tid; idx < ROWS * 64; idx += 512) {
        const int j = idx >> 6, v = idx & 63, tok = t0 - HALO + j;
        u32x4 w = (u32x4){0u, 0u, 0u, 0u};
        if (tok >= 0 && tok < S) w = *(const u32x4*)(PC + (size_t)(seq_base + tok) * 1536 + 1024 + v * 8);
        *(CLAS u32x4*)(lds + OFF_U0 + j * 1024 + v * 16) = w;
    }
    __syncthreads();
    const int cp = tid & 255, th = tid >> 8;
    {
        const float wa0 = w3[2 * cp], wa1 = w3[512 + 2 * cp], wa2 = w3[1024 + 2 * cp];
        const float wb0 = w3[2 * cp + 1], wb1 = w3[512 + 2 * cp + 1], wb2 = w3[1024 + 2 * cp + 1];
        const int tb = t0 + 16 * th;
        float p0a = 0.f, p0b = 0.f, p1a, p1b, p2a, p2b;
#define CV_PROD(tok, A, B) do { A = 0.f; B = 0.f; if ((tok) >= 0 && (tok) < S) { const unsigned pp_ = *(const unsigned*)(PC + (size_t)(seq_base + (tok)) * 1536 + 512 + 2 * cp); A = bf_lo(pp_); B = bf_hi(pp_); } } while (0)
        CV_PROD(tb - 1, p0a, p0b); CV_PROD(tb, p1a, p1b);
        for (int i = 0; i < 16; ++i) {
            const int tok = tb + i;
            CV_PROD(tok + 1, p2a, p2b);
            const unsigned gb = *(const unsigned*)(PC + (size_t)(seq_base + tok) * 1536 + 2 * cp);
            const float ya = bf_lo(gb) * (wa0 * p0a + wa1 * p1a + wa2 * p2a), yb = bf_hi(gb) * (wb0 * p0b + wb1 * p1b + wb2 * p2b);
            *(unsigned*)(YC + (size_t)(seq_base + tok) * 1024 + 2 * cp) = cvt_pk_bf16(ya, yb);
            p0a = p1a; p0b = p1b; p1a = p2a; p1b = p2b;
        }
#undef CV_PROD
    }
    {
        float wa[31], wb[31];
#pragma unroll
        for (int j = 0; j < 31; ++j) { wa[j] = w31[j * 512 + 2 * cp]; wb[j] = w31[j * 512 + 2 * cp + 1]; }
        const float ba = dwb[2 * cp], bb = dwb[2 * cp + 1];
        for (int g4 = 0; g4 < 4; ++g4) {
            const int tt = 16 * th + 4 * g4;
            float aa[4], ab[4];
#pragma unroll
            for (int k = 0; k < 4; ++k) { aa[k] = ba; ab[k] = bb; }
            const CLAS unsigned char* up = lds + OFF_U0 + tt * 1024 + cp * 4;
#pragma unroll
            for (int rr = 0; rr < 34; ++rr) {
                const unsigned w = *(const CLAS unsigned*)(up + rr * 1024);
                const float xa = bf_lo(w), xb = bf_hi(w);
#pragma unroll
                for (int k = 0; k < 4; ++k) { const int j = rr - k; if (j >= 0 && j < 31) { aa[k] += wa[j] * xa; ab[k] += wb[j] * xb; } }
            }
#pragma unroll
            for (int k = 0; k < 4; ++k) { typedef float f32x2 __attribute__((ext_vector_type(2))); *(CLAS f32x2*)(lds + OFF_U1 + (tt + k) * 2048 + cp * 8) = (f32x2){aa[k], ab[k]}; }
        }
    }
    __syncthreads();
    {
        const int lane = tid & 63, wid = tid >> 6;
        const f32x4 g0 = *(const f32x4*)(lng + 8 * lane), g1 = *(const f32x4*)(lng + 8 * lane + 4), b0 = *(const f32x4*)(lnb + 8 * lane), b1 = *(const f32x4*)(lnb + 8 * lane + 4);
        for (int k = 0; k < 4; ++k) {
            const int tt = 4 * wid + k;
            const f32x4 x0 = *(const CLAS f32x4*)(lds + OFF_U1 + tt * 2048 + lane * 32), x1 = *(const CLAS f32x4*)(lds + OFF_U1 + tt * 2048 + lane * 32 + 16);
            float s = ((x0[0] + x0[1]) + (x0[2] + x0[3])) + ((x1[0] + x1[1]) + (x1[2] + x1[3]));
#pragma unroll
            for (int o = 1; o < 64; o <<= 1) s += __shfl_xor(s, o);
            const float mean = s * (1.0f / 512.0f);
            const f32x4 d0 = x0 - mean, d1 = x1 - mean;
            float q = ((d0[0] * d0[0] + d0[1] * d0[1]) + (d0[2] * d0[2] + d0[3] * d0[3])) + ((d1[0] * d1[0] + d1[1] * d1[1]) + (d1[2] * d1[2] + d1[3] * d1[3]));
#pragma unroll
            for (int o = 1; o < 64; o <<= 1) q += __shfl_xor(q, o);
            const float rstd = __builtin_amdgcn_rsqf(q * (1.0f / 512.0f) + 1e-6f);
            f32x4 y0 = d0 * rstd * g0 + b0, y1 = d1 * rstd * g1 + b1;
#pragma unroll
            for (int i = 0; i < 4; ++i) { y0[i] = y0[i] * fast_sigmoid(y0[i]); y1[i] = y1[i] * fast_sigmoid(y1[i]); }
            u32x4 w; w.x = cvt_pk_bf16(y0[0], y0[1]); w.y = cvt_pk_bf16(y0[2], y0[3]); w.z = cvt_pk_bf16(y1[0], y1[1]); w.w = cvt_pk_bf16(y1[2], y1[3]);
            *(u32x4*)(YC + (size_t)(seq_base + t0 + tt) * 1024 + 512 + 8 * lane) = w;
        }
    }
    __syncthreads();
}
__device__ __forceinline__ void conv_phase(CLAS unsigned char* lds, const bf16_t* PC, bf16_t* YC, const float* w3, const float* w31, const float* dwb, const float* lng, const float* lnb) {
    for (int u = blockIdx.x; u < 131072 / T; u += gridDim.x) {
        const int row0 = u * T; int seq_base, S;
        if (row0 < 65536) { seq_base = row0 & ~8191; S = 8192; } else { seq_base = row0 & ~2047; S = 2048; }
        conv_unit(lds, PC, YC, w3, w31, dwb, lng, lnb, seq_base, S, row0 - seq_base);
    }
}
}

namespace mk {
using pg8::bf16_t; using pg8::f32x4; using pg8::u32x4; using pg8::u32x2; using pg8::cvt_pk_bf16;
#define MLAS __attribute__((address_space(3)))
constexpr int M = 131072, D = 1024, FF = 2816, NQKV = 2304, NCI = 2560;
constexpr size_t MiB = 1u << 20;
constexpr size_t WS_X = 0;
constexpr size_t WS_BIG = 256 * MiB;
constexpr size_t WS_VT = WS_BIG + (size_t)M * pg8::QKW * 2;
constexpr size_t WS_W = 960 * MiB;
constexpr size_t WS_WQKV = WS_W, WS_WO = WS_WQKV + (size_t)NQKV * D * 2, WS_WGU0 = WS_WO + (size_t)D * D * 2, WS_WGU1 = WS_WGU0 + (size_t)2 * FF * D * 2,
                 WS_WD0 = WS_WGU1 + (size_t)2 * FF * D * 2, WS_WD1 = WS_WD0 + (size_t)D * FF * 2, WS_WCI = WS_WD1 + (size_t)D * FF * 2, WS_WCO = WS_WCI + (size_t)NCI * D * 2;
constexpr size_t WS_SSQ = 1008 * MiB;
constexpr size_t WS_END = 1016 * MiB;
static_assert(WS_VT + (size_t)640 * pg8::VT_PITCH * 2 <= WS_W && WS_BIG + (size_t)M * FF * 2 <= WS_W && WS_WCO + (size_t)D * D * 2 <= WS_SSQ, "ws map");
constexpr int LDS_BYTES = 147456;
static_assert(att::ATT_LDS <= LDS_BYTES && cv::CONV_LDS <= LDS_BYTES && pg8::STAGE_BYTES <= LDS_BYTES, "lds map");

struct Params { const float* in[24]; float* out; unsigned char* ws; int ph_lo, ph_hi; };

__device__ __forceinline__ void tr_item(const float* __restrict__ W, int ldw, int srccol0, const float* __restrict__ gain, bf16_t* __restrict__ WT, int K, int destrow0, int k0, MLAS float* scr, int lane) {
#pragma unroll 8
    for (int i = 0; i < 32; ++i) { const int kk = 2 * i + (lane >> 5); const float g = gain ? gain[k0 + kk] : 1.0f; scr[kk * 33 + (lane & 31)] = W[(size_t)(k0 + kk) * ldw + srccol0 + (lane & 31)] * g; }
    asm volatile("s_waitcnt lgkmcnt(0)" ::: "memory");
    const int c = lane & 7;
#pragma unroll
    for (int j = 0; j < 4; ++j) { const int n = (lane >> 3) + 8 * j; const MLAS float* s = scr + (8 * c) * 33 + n;
        u32x4 o; o.x = cvt_pk_bf16(s[0 * 33], s[1 * 33]); o.y = cvt_pk_bf16(s[2 * 33], s[3 * 33]); o.z = cvt_pk_bf16(s[4 * 33], s[5 * 33]); o.w = cvt_pk_bf16(s[6 * 33], s[7 * 33]);
        *(u32x4*)(WT + (size_t)(destrow0 + n) * K + k0 + 8 * c) = o; }
    asm volatile("s_waitcnt lgkmcnt(0)" ::: "memory");
}

__device__ __forceinline__ void prologue(const Params& p, MLAS unsigned char* lds) {
    const int tid = threadIdx.x, lane = tid & 63, wave = tid >> 6;
    MLAS float* scr = (MLAS float*)(lds + wave * 16384);
    const int gw = blockIdx.x * 8 + wave, NGW = gridDim.x * 8;
    unsigned char* ws = p.ws;
    constexpr int I_QKV = (NQKV / 32) * (D / 64), I_O = (D / 32) * (D / 64), I_GU = (2 * FF / 32) * (D / 64), I_D = (D / 32) * (FF / 64), I_CI = (NCI / 32) * (D / 64);
    constexpr int NIT = I_QKV + I_O + 2 * I_GU + 2 * I_D + I_CI + I_O;
    for (int it = gw; it < NIT; it += NGW) {
        int r = it;
        if (r < I_QKV) { const int kb = r / (NQKV / 32), nb = r % (NQKV / 32); const int n0 = nb * 32, pn = n0 >> 8, within = n0 & 255, bj = within >> 7, wc = (within & 127) >> 5;
            tr_item(p.in[8], NQKV, 256 * pn + 64 * wc + 32 * bj, p.in[3], (bf16_t*)(ws + WS_WQKV), D, n0, kb * 64, scr, lane); continue; }
        r -= I_QKV;
        if (r < I_O) { const int kb = r / (D / 32), nb = r % (D / 32); tr_item(p.in[9], D, nb * 32, nullptr, (bf16_t*)(ws + WS_WO), D, nb * 32, kb * 64, scr, lane); continue; }
        r -= I_O;
        if (r < 2 * I_GU) { const int l = r / I_GU; r -= l * I_GU; const int kb = r / (2 * FF / 32), nb = r % (2 * FF / 32); const int n0 = nb * 32, pn = n0 >> 8, within = n0 & 255, bj = within >> 7, j = within & 127;
            const float* src = (bj ? p.in[6] : p.in[5]) + (size_t)l * D * FF;
            tr_item(src, FF, 128 * pn + j, p.in[4] + l * D, (bf16_t*)(ws + (l ? WS_WGU1 : WS_WGU0)), D, n0, kb * 64, scr, lane); continue; }
        r -= 2 * I_GU;
        if (r < 2 * I_D) { const int l = r / I_D; r -= l * I_D; const int kb = r / (D / 32), nb = r % (D / 32);
            tr_item(p.in[7] + (size_t)l * FF * D, D, nb * 32, nullptr, (bf16_t*)(ws + (l ? WS_WD1 : WS_WD0)), FF, nb * 32, kb * 64, scr, lane); continue; }
        r -= 2 * I_D;
        if (r < I_CI) { const int kb = r / (NCI / 32), nb = r % (NCI / 32); const int n0 = nb * 32, pn = n0 >> 8, within = n0 & 255, bj = within >> 7, j = within & 127;
            const int src = pn < 2 ? n0 : (pn < 6 ? (bj ? 1024 : 512) + 128 * (pn - 2) + j : (bj ? 2048 : 1536) + 128 * (pn - 6) + j);
            tr_item(p.in[17], NCI, src, p.in[3] + D, (bf16_t*)(ws + WS_WCI), D, n0, kb * 64, scr, lane); continue; }
        r -= I_CI;
        { const int kb = r / (D / 32), nb = r % (D / 32); tr_item(p.in[18], D, nb * 32, nullptr, (bf16_t*)(ws + WS_WCO), D, nb * 32, kb * 64, scr, lane); }
    }
    bf16_t* X = (bf16_t*)(ws + WS_X); float* ssq = (float*)(ws + WS_SSQ);
    for (int m0 = gw; m0 < M; m0 += 4 * NGW) {
        f32x4 v[4][4];
#pragma unroll
        for (int r = 0; r < 4; ++r) { const int m = m0 + r * NGW; if (m < M) { const float* xrow = (m < 65536) ? p.in[0] + (size_t)m * D : p.in[1] + (size_t)(m - 65536) * D; const f32x4* xr = (const f32x4*)xrow + lane;
#pragma unroll
            for (int j = 0; j < 4; ++j) v[r][j] = xr[64 * j]; } }
#pragma unroll
        for (int r = 0; r < 4; ++r) { const int m = m0 + r * NGW; if (m < M) {
            float s = 0.f;
#pragma unroll
            for (int j = 0; j < 4; ++j) s += (v[r][j][0] * v[r][j][0] + v[r][j][1] * v[r][j][1]) + (v[r][j][2] * v[r][j][2] + v[r][j][3] * v[r][j][3]);
#pragma unroll
            for (int o = 1; o < 64; o <<= 1) s += __shfl_xor(s, o);
            u32x2* o8 = (u32x2*)(X + (size_t)m * D) + lane;
#pragma unroll
            for (int j = 0; j < 4; ++j) { u32x2 w; w.x = cvt_pk_bf16(v[r][j][0], v[r][j][1]); w.y = cvt_pk_bf16(v[r][j][2], v[r][j][3]); o8[64 * j] = w; }
            if (lane < 16) ssq[(size_t)m * 16 + lane] = (lane == 0) ? s : 0.f; } }
    }
}

__global__ void __launch_bounds__(512, 2) fwd_kernel(Params p) {
    extern __shared__ __attribute__((aligned(16))) unsigned char lds_raw[];
    MLAS unsigned char* lds = (MLAS unsigned char*)lds_raw;
    cg::grid_group grid = cg::this_grid();
    unsigned char* ws = p.ws;
    bf16_t* X = (bf16_t*)(ws + WS_X); bf16_t* BIG = (bf16_t*)(ws + WS_BIG); bf16_t* VT = (bf16_t*)(ws + WS_VT); float* ssq = (float*)(ws + WS_SSQ);
    bf16_t* Y = (bf16_t*)p.out;
    const int lo = p.ph_lo, hi = p.ph_hi, G = gridDim.x, bx = blockIdx.x;
#ifndef PH_MASK
#define PH_MASK 0x7ff
#endif
#define IN(k) (((PH_MASK >> (k)) & 1) && lo <= (k) && (k) < hi)
#define SEAM(k) do { if (IN(k) && IN((k) + 1)) grid.sync(); } while (0)
    if (IN(0)) { prologue(p, lds); __syncthreads(); }
    SEAM(0);
    if (IN(1)) { pg8::Gemm g{X, (const bf16_t*)(ws + WS_WQKV), M, NQKV, D}; pg8::StaticOrder S; S.init(M, NQKV, G, bx);
        pg8::EpiQKV E{BIG, VT, ssq, p.in[10], p.in[11], p.in[13], p.in[14], lds + pg8::STAGE_BYTES};
        pg8::gemm_phase<pg8::EpiQKV, pg8::StaticOrder, true, true>(lds, g, S, E); }
    SEAM(1);
    if (IN(2)) { for (int rep = 0; rep < PROBE_ATT; ++rep) att::attn_phase(lds, BIG, VT, Y, p.in[2], p.in[12], p.in[16], p.in[15]); }
    SEAM(2);
    if (IN(3)) { pg8::Gemm g{Y, (const bf16_t*)(ws + WS_WO), M, D, D}; pg8::StaticOrder S; S.init(M, D, G, bx);
        pg8::EpiRes<false> E{X, nullptr, ssq};
        pg8::gemm_phase<pg8::EpiRes<false>, pg8::StaticOrder, true, true>(lds, g, S, E); }
    SEAM(3);
    if (IN(4)) { pg8::Gemm g{X, (const bf16_t*)(ws + WS_WGU0), M, 2 * FF, D}; pg8::StaticOrder S; S.init(M, 2 * FF, G, bx);
        pg8::EpiGlu E{BIG, ssq};
        pg8::gemm_phase<pg8::EpiGlu, pg8::StaticOrder, true, true>(lds, g, S, E); }
    SEAM(4);
    if (IN(5)) { pg8::Gemm g{BIG, (const bf16_t*)(ws + WS_WD0), M, D, FF}; pg8::StaticOrder S; S.init(M, D, G, bx);
        pg8::EpiRes<false> E{X, nullptr, ssq};
        pg8::gemm_phase<pg8::EpiRes<false>, pg8::StaticOrder, true, true>(lds, g, S, E); }
    SEAM(5);
    if (IN(6)) { pg8::Gemm g{X, (const bf16_t*)(ws + WS_WCI), M, NCI, D}; pg8::StaticOrder S; S.init(M, NCI, G, bx);
        pg8::EpiConvIn E{BIG, ssq};
        pg8::gemm_phase<pg8::EpiConvIn, pg8::StaticOrder, true, true>(lds, g, S, E); }
    SEAM(6);
    if (IN(7)) { cv::conv_phase(lds, BIG, Y, p.in[19], p.in[20], p.in[21], p.in[22], p.in[23]); }
    SEAM(7);
    if (IN(8)) { pg8::Gemm g{Y, (const bf16_t*)(ws + WS_WCO), M, D, D}; pg8::StaticOrder S; S.init(M, D, G, bx);
        pg8::EpiRes<false> E{X, nullptr, ssq};
        pg8::gemm_phase<pg8::EpiRes<false>, pg8::StaticOrder, true, true>(lds, g, S, E); }
    SEAM(8);
    if (IN(9)) { pg8::Gemm g{X, (const bf16_t*)(ws + WS_WGU1), M, 2 * FF, D}; pg8::StaticOrder S; S.init(M, 2 * FF, G, bx);
        pg8::EpiGlu E{BIG, ssq};
        pg8::gemm_phase<pg8::EpiGlu, pg8::StaticOrder, true, true>(lds, g, S, E); }
    SEAM(9);
    if (IN(10)) { pg8::Gemm g{BIG, (const bf16_t*)(ws + WS_WD1), M, D, FF}; pg8::StaticOrder S; S.init(M, D, G, bx);
        pg8::EpiRes<true> E{X, p.out, ssq};
        pg8::gemm_phase<pg8::EpiRes<true>, pg8::StaticOrder, true, true>(lds, g, S, E); }
#undef IN
#undef SEAM
}
}

#ifndef MK_N_LAUNCHES_X
#define MK_N_LAUNCHES 1
#endif
extern "C" void kernel_launch(void* const* d_in, const int* in_sizes, int n_in, void* d_out, int out_size, void* d_ws, size_t ws_size, hipStream_t stream) {
    static int grid = 0;
    if (grid == 0) {
        if (n_in != 24 || out_size != mk::M * mk::D || ws_size < mk::WS_END) { fprintf(stderr, "kernel_launch: unexpected shapes (n_in %d out %d ws %zu)\n", n_in, out_size, ws_size); grid = -1; return; }
        int dev = 0, cus = 0, per_cu = 0;
        (void)hipGetDevice(&dev); (void)hipDeviceGetAttribute(&cus, hipDeviceAttributeMultiprocessorCount, dev);
        (void)hipFuncSetAttribute((const void*)mk::fwd_kernel, hipFuncAttributeMaxDynamicSharedMemorySize, mk::LDS_BYTES);
        (void)hipOccupancyMaxActiveBlocksPerMultiprocessor(&per_cu, (const void*)mk::fwd_kernel, 512, mk::LDS_BYTES);
        if (per_cu < 1) per_cu = 1;
        (void)hipGetLastError();
        grid = cus * per_cu;
    }
    if (grid < 0) return;
    mk::Params p{};
    for (int i = 0; i < 24; ++i) p.in[i] = (const float*)d_in[i];
    p.out = (float*)d_out; p.ws = (unsigned char*)d_ws;
#if MK_N_LAUNCHES == 1
    p.ph_lo = 0; p.ph_hi = 11;
    void* args[] = {&p};
    hipError_t e = hipLaunchCooperativeKernel((const void*)mk::fwd_kernel, dim3(grid), dim3(512), args, mk::LDS_BYTES, stream);
    if (e != hipSuccess) fprintf(stderr, "cooperative launch failed: %s (grid %d)\n", hipGetErrorString(e), grid);
#else
    for (int ph = 0; ph < 11; ++ph) { p.ph_lo = ph; p.ph_hi = ph + 1; hipLaunchKernelGGL(mk::fwd_kernel, dim3(grid), dim3(512), mk::LDS_BYTES, stream, p); }
#endif
}
```

```cpp
#include <hip/hip_runtime.h>
#include <hip/hip_cooperative_groups.h>
#include <cstdio>
#include <cstdint>
namespace cg = cooperative_groups;
#ifndef PROBE_ATT
#define PROBE_ATT 1
#endif
#ifndef MK_N_LAUNCHES
#define MK_N_LAUNCHES 1
#endif
namespace pg8 {
#define PG8_LAS __attribute__((address_space(3)))
typedef unsigned short bf16_t;
typedef short bf16x8 __attribute__((ext_vector_type(8)));
typedef float f32x4 __attribute__((ext_vector_type(4)));
typedef unsigned u32x4 __attribute__((ext_vector_type(4)));
constexpr int BM = 256, BK = 64, HALF = 128, HTB = HALF * BK * 2  , STAGE_BYTES = 8 * HTB, NXCD = 8, WGM = 8;

__host__ __device__ __forceinline__ int lds_byte(int r, int c) { const int st = (r >> 4) * 2 + (c >> 5), rr = r & 15, cc = c & 31, ob = rr * 64 + cc * 2; return st * 1024 + (ob ^ (((ob >> 9) & 1) << 5)); }
__host__ __device__ __forceinline__ void stage_rc(int b, int& R, int& C) { const int st = b / 1024, sb = b % 1024, swz = sb ^ (((sb >> 9) & 1) << 5); R = (st >> 1) * 16 + swz / 64; C = (st & 1) * 32 + (swz % 64) / 2; }
__host__ __device__ __forceinline__ int perm32(int rho) { const int n = rho >> 4, i = rho & 15; return 8 * (i >> 2) + 4 * n + (i & 3); }

struct Unit { int pm, pn; };
struct Gemm { const bf16_t* A; const bf16_t* Bt; int M, N, K; };

struct StaticOrder {
    int nM, nN, nwg, G, c;
    __host__ __device__ void init(int M, int N, int G_, int c_) { nM = M / BM; nN = N / BM; nwg = nM * nN; G = G_; c = c_; }
    __host__ __device__ bool next(int i, Unit& u) const {
        const long L = (long)i * G + c; if (L >= nwg) return false;
        int wgid = (int)L; { const int q = nwg / NXCD, r = nwg % NXCD, xcd = wgid % NXCD, off = wgid / NXCD; wgid = (xcd < r ? xcd * (q + 1) : r * (q + 1) + (xcd - r) * q) + off; }
        const int nig = WGM * nN, gid = wgid / nig, fm = gid * WGM, gsz = (nM - fm) < WGM ? (nM - fm) : WGM;
        u.pm = fm + ((wgid % nig) % gsz); u.pn = (wgid % nig) / gsz; return true;
    }
    __device__ __forceinline__ void a_ready(const Unit&) const {}
    __device__ __forceinline__ void done(const Unit&) const {}
};

__device__ __forceinline__ unsigned cvt_pk_bf16(float lo, float hi) { unsigned r; asm volatile("v_cvt_pk_bf16_f32 %0, %1, %2" : "=v"(r) : "v"(lo), "v"(hi)); return r; }
typedef float f32x2 __attribute__((ext_vector_type(2)));
typedef unsigned u32x2 __attribute__((ext_vector_type(2)));
__device__ __forceinline__ float bf_lo(unsigned w) { return __uint_as_float(w << 16); }
__device__ __forceinline__ float bf_hi(unsigned w) { return __uint_as_float(w & 0xffff0000u); }
__device__ __forceinline__ float row_rstd(const float* ssq, int row) {
    const f32x4* p = (const f32x4*)(ssq + (size_t)row * 16);
    const f32x4 a = p[0], b = p[1], c = p[2], d = p[3];
    const float s = ((a[0] + a[1]) + (a[2] + a[3])) + ((b[0] + b[1]) + (b[2] + b[3])) + ((c[0] + c[1]) + (c[2] + c[3])) + ((d[0] + d[1]) + (d[2] + d[3]));
    return __builtin_amdgcn_rsqf(s * (1.0f / 1024.0f) + 1e-6f);
}
__device__ __forceinline__ float fast_sigmoid(float x) { return __builtin_amdgcn_rcpf(1.0f + __expf(-x)); }

constexpr int QKW = 1664;
constexpr int VT_PITCH = 131072 + 128;
constexpr float C2Q = 0.125f * 1.4426950408889634f;

struct EpiQKV {
    static constexpr bool PERM = true, AFTER_DRAIN = false;
    bf16_t* QK; bf16_t* VT; const float* ssq; const float* aq; const float* ak; const float* bq; const float* bk; PG8_LAS unsigned char* xlds;
    __device__ __forceinline__ void operator()(const f32x4 (&acc)[2][2][4][2], const Unit& u, int wr, int wc, int fr, int fq) const {
        const int L = u.pn * 256 + wc * 64;
        int kind; const float* gain = nullptr; float scale = 1.f; int ccol = 0, vrow = 0;
        if (L < 512) { kind = 0; gain = aq; scale = C2Q; ccol = L; }
        else if (L < 640) { kind = 0; gain = ak; ccol = L; }
        else if (L < 768) { kind = 1; vrow = L - 640; }
        else if (L < 1280) { kind = 0; gain = bq; scale = C2Q; ccol = L - 128; }
        else if (L < 1792) { kind = 0; gain = bk; ccol = L - 128; }
        else { kind = 1; vrow = L - 1792 + 128; }
        if (kind == 0) {
            f32x4 gv[2][2];
#pragma unroll
            for (int bj = 0; bj < 2; ++bj)
#pragma unroll
                for (int n = 0; n < 2; ++n) gv[bj][n] = *(const f32x4*)(gain + 32 * bj + 8 * fq + 4 * n);
#pragma unroll
            for (int ai = 0; ai < 2; ++ai)
#pragma unroll
                for (int m = 0; m < 4; ++m) {
                    const int row = u.pm * BM + ai * HALF + wr * 64 + m * 16 + fr;
                    const float rs = row_rstd(ssq, row);
                    float ss = 0.f;
#pragma unroll
                    for (int bj = 0; bj < 2; ++bj)
#pragma unroll
                        for (int n = 0; n < 2; ++n) { const f32x4 v = acc[ai][bj][m][n] * rs; ss += (v[0] * v[0] + v[1] * v[1]) + (v[2] * v[2] + v[3] * v[3]); }
                    ss += __shfl_xor(ss, 16); ss += __shfl_xor(ss, 32);
                    const float f = rs * __builtin_amdgcn_rsqf(ss * (1.0f / 64.0f) + 1e-6f) * scale;
                    bf16_t* rowp = QK + ((size_t)((row >> 6) * 26 + (ccol >> 6)) * 64 + (row & 63)) * 64 + 8 * fq;
#pragma unroll
                    for (int bj = 0; bj < 2; ++bj) {
                        const f32x4 v0 = acc[ai][bj][m][0] * f * gv[bj][0], v1 = acc[ai][bj][m][1] * f * gv[bj][1];
                        u32x4 w; w.x = cvt_pk_bf16(v0[0], v0[1]); w.y = cvt_pk_bf16(v0[2], v0[3]); w.z = cvt_pk_bf16(v1[0], v1[1]); w.w = cvt_pk_bf16(v1[2], v1[3]);
                        *(u32x4*)(rowp + 32 * bj) = w;
                    }
                }
        } else {
            PG8_LAS unsigned char* xl = xlds + (wr * 4 + wc) * 2048;
            const int lane = fq * 16 + fr;
#pragma unroll
            for (int ai = 0; ai < 2; ++ai) {
                float rs[4];
#pragma unroll
                for (int m = 0; m < 4; ++m) rs[m] = row_rstd(ssq, u.pm * BM + ai * HALF + wr * 64 + m * 16 + fr);
                const size_t tb = (size_t)(u.pm * 4 + ai * 2 + wr) * 640;
#pragma unroll
                for (int bj = 0; bj < 2; ++bj)
#pragma unroll
                    for (int n = 0; n < 2; ++n) {
#pragma unroll
                        for (int m = 0; m < 4; ++m) {
                            const f32x4 v = acc[ai][bj][m][n] * rs[m];
                            const unsigned w0 = cvt_pk_bf16(v[0], v[1]), w1 = cvt_pk_bf16(v[2], v[3]);
                            PG8_LAS bf16_t* q = (PG8_LAS bf16_t*)(xl + (4 * fq) * 128 + (16 * m + fr) * 2);
                            q[0] = (bf16_t)(w0 & 0xffffu); q[64] = (bf16_t)(w0 >> 16); q[128] = (bf16_t)(w1 & 0xffffu); q[192] = (bf16_t)(w1 >> 16);
                        }
                        asm volatile("s_waitcnt lgkmcnt(0)" ::: "memory");
                        const int c16 = lane >> 2, part = lane & 3;
                        const u32x4 a = *(const PG8_LAS u32x4*)(xl + c16 * 128 + part * 32), b = *(const PG8_LAS u32x4*)(xl + c16 * 128 + part * 32 + 16);
                        bf16_t* gp = VT + (tb + vrow + 32 * bj + 8 * (c16 >> 2) + 4 * n + (c16 & 3)) * 64 + part * 16;
                        *(u32x4*)gp = a; *(u32x4*)(gp + 8) = b;
                        asm volatile("s_waitcnt lgkmcnt(0)" ::: "memory");
                    }
            }
        }
    }
};

template <bool FINAL> struct EpiRes {
    static constexpr bool PERM = true, AFTER_DRAIN = false;
    bf16_t* X; float* out; float* ssq;
    __device__ __forceinline__ void operator()(const f32x4 (&acc)[2][2][4][2], const Unit& u, int wr, int wc, int fr, int fq) const {
        const int col0 = u.pn * BM + wc * 32 + 8 * fq;
#pragma unroll
        for (int ai = 0; ai < 2; ++ai)
#pragma unroll
            for (int m = 0; m < 4; ++m) {
                const int row = u.pm * BM + ai * HALF + wr * 64 + m * 16 + fr;
                float ss = 0.f;
#pragma unroll
                for (int bj = 0; bj < 2; ++bj) {
                    bf16_t* xp = X + (size_t)row * 1024 + col0 + bj * HALF;
                    const u32x4 xv = *(const u32x4*)xp;
                    f32x4 y0 = acc[ai][bj][m][0], y1 = acc[ai][bj][m][1];
                    y0[0] += bf_lo(xv.x); y0[1] += bf_hi(xv.x); y0[2] += bf_lo(xv.y); y0[3] += bf_hi(xv.y);
                    y1[0] += bf_lo(xv.z); y1[1] += bf_hi(xv.z); y1[2] += bf_lo(xv.w); y1[3] += bf_hi(xv.w);
                    if (FINAL) {
                        float* op = out + (size_t)row * 1024 + col0 + bj * HALF;
                        *(f32x4*)op = y0; *(f32x4*)(op + 4) = y1;
                    } else {
                        u32x4 w; w.x = cvt_pk_bf16(y0[0], y0[1]); w.y = cvt_pk_bf16(y0[2], y0[3]); w.z = cvt_pk_bf16(y1[0], y1[1]); w.w = cvt_pk_bf16(y1[2], y1[3]);
                        *(u32x4*)xp = w;
                        ss += (y0[0] * y0[0] + y0[1] * y0[1]) + (y0[2] * y0[2] + y0[3] * y0[3]) + (y1[0] * y1[0] + y1[1] * y1[1]) + (y1[2] * y1[2] + y1[3] * y1[3]);
                    }
                }
                if (!FINAL) {
                    ss += __shfl_xor(ss, 16); ss += __shfl_xor(ss, 32);
                    if (fq == 0) ssq[(size_t)row * 16 + u.pn * 4 + wc] = ss;
                }
            }
    }
};

struct EpiGlu {
    static constexpr bool PERM = true, AFTER_DRAIN = false;
    bf16_t* H; const float* ssq;
    __device__ __forceinline__ void operator()(const f32x4 (&acc)[2][2][4][2], const Unit& u, int wr, int wc, int fr, int fq) const {
        const int col0 = u.pn * HALF + wc * 32 + 8 * fq;
#pragma unroll
        for (int ai = 0; ai < 2; ++ai)
#pragma unroll
            for (int m = 0; m < 4; ++m) {
                const int row = u.pm * BM + ai * HALF + wr * 64 + m * 16 + fr;
                const float rs = row_rstd(ssq, row);
                float h[8];
#pragma unroll
                for (int n = 0; n < 2; ++n)
#pragma unroll
                    for (int i = 0; i < 4; ++i) { const float g = acc[ai][0][m][n][i] * rs, up = acc[ai][1][m][n][i] * rs; h[4 * n + i] = g * up * fast_sigmoid(g); }
                u32x4 w; w.x = cvt_pk_bf16(h[0], h[1]); w.y = cvt_pk_bf16(h[2], h[3]); w.z = cvt_pk_bf16(h[4], h[5]); w.w = cvt_pk_bf16(h[6], h[7]);
                *(u32x4*)(H + (size_t)row * 2816 + col0) = w;
            }
    }
};

struct EpiConvIn {
    static constexpr bool PERM = true, AFTER_DRAIN = false;
    bf16_t* O; const float* ssq;
    __device__ __forceinline__ void operator()(const f32x4 (&acc)[2][2][4][2], const Unit& u, int wr, int wc, int fr, int fq) const {
#pragma unroll
        for (int ai = 0; ai < 2; ++ai)
#pragma unroll
            for (int m = 0; m < 4; ++m) {
                const int row = u.pm * BM + ai * HALF + wr * 64 + m * 16 + fr;
                const float rs = row_rstd(ssq, row);
                bf16_t* rp = O + (size_t)row * 1536 + wc * 32 + 8 * fq;
                if (u.pn < 2) {
#pragma unroll
                    for (int bj = 0; bj < 2; ++bj) {
                        const f32x4 v0 = acc[ai][bj][m][0] * rs, v1 = acc[ai][bj][m][1] * rs;
                        u32x4 w; w.x = cvt_pk_bf16(v0[0], v0[1]); w.y = cvt_pk_bf16(v0[2], v0[3]); w.z = cvt_pk_bf16(v1[0], v1[1]); w.w = cvt_pk_bf16(v1[2], v1[3]);
                        *(u32x4*)(rp + u.pn * BM + bj * HALF) = w;
                    }
                } else {
                    float h[8];
                    const bool glu = u.pn >= 6;
#pragma unroll
                    for (int n = 0; n < 2; ++n)
#pragma unroll
                        for (int i = 0; i < 4; ++i) { const float a = acc[ai][0][m][n][i] * rs, b = acc[ai][1][m][n][i] * rs; h[4 * n + i] = glu ? a * fast_sigmoid(b) : a * b; }
                    u32x4 w; w.x = cvt_pk_bf16(h[0], h[1]); w.y = cvt_pk_bf16(h[2], h[3]); w.z = cvt_pk_bf16(h[4], h[5]); w.w = cvt_pk_bf16(h[6], h[7]);
                    *(u32x4*)(rp + 512 + (u.pn - 2) * HALF) = w;
                }
            }
    }
};

struct EpiPlain {
    static constexpr bool PERM = true, AFTER_DRAIN = false;
    bf16_t* O; int ldc; const float* ssq;
    __device__ __forceinline__ void operator()(const f32x4 (&acc)[2][2][4][2], const Unit& u, int wr, int wc, int fr, int fq) const {
        const int col0 = u.pn * BM + wc * 32 + 8 * fq;
#pragma unroll
        for (int ai = 0; ai < 2; ++ai)
#pragma unroll
            for (int m = 0; m < 4; ++m) {
                const int row = u.pm * BM + ai * HALF + wr * 64 + m * 16 + fr;
                const float rs = row_rstd(ssq, row);
#pragma unroll
                for (int bj = 0; bj < 2; ++bj) {
                    const f32x4 v0 = acc[ai][bj][m][0] * rs, v1 = acc[ai][bj][m][1] * rs;
                    u32x4 w; w.x = cvt_pk_bf16(v0[0], v0[1]); w.y = cvt_pk_bf16(v0[2], v0[3]); w.z = cvt_pk_bf16(v1[0], v1[1]); w.w = cvt_pk_bf16(v1[2], v1[3]);
                    *(u32x4*)(O + (size_t)row * ldc + col0 + bj * HALF) = w;
                }
            }
    }
};

template <class Epi, class Sched, bool ALIGN_EPI = false, bool SP2 = false>
__device__ __forceinline__ void gemm_phase(PG8_LAS unsigned char* lds, const Gemm g, const Sched& S, const Epi& E) {
    const int tid = threadIdx.x, wid = __builtin_amdgcn_readfirstlane(tid >> 6), lane = tid & 63, wr = wid >> 2, wc = wid & 3, fr = lane & 15, fq = lane >> 4;
    const int K = g.K, nt = K / BK;
    unsigned voffA[2], voffB[2];
#pragma unroll
    for (int i = 0; i < 2; ++i) { int R, C; stage_rc(tid * 16 + i * 8192, R, C); const int Rb = Epi::PERM ? ((R & ~31) + perm32(R & 31)) : R;
        voffA[i] = (unsigned)(R * K + C) * 2u; voffB[i] = (unsigned)(Rb * K + C) * 2u; }
    const size_t kstep = (size_t)(BK * 2);
    const size_t hstep = (size_t)HALF * K * 2;
    const size_t tstep = 2 * hstep;
    const unsigned ldsw = (unsigned)wid * 1024u;
    const int aoff = lds_byte(wr * 64 + fr, fq * 8), boff = lds_byte(wc * 32 + fr, fq * 8);
#define PG8_SA(b, h) (((b) * 2 + (h)) * HTB)
#define PG8_SB(b, h) ((4 + (b) * 2 + (h)) * HTB)
#define PG8_STAGE(bufoff, gbase, voff) do { _Pragma("unroll") for (int _i = 0; _i < 2; ++_i) \
        __builtin_amdgcn_global_load_lds((const unsigned*)((const char*)(gbase) + (voff)[_i]), (PG8_LAS unsigned*)(lds + (bufoff) + ldsw + _i * 8192), 16, 0, 0); } while (0)
#define PG8_LDA(dst, b, h) do { _Pragma("unroll") for (int m = 0; m < 4; ++m) _Pragma("unroll") for (int k = 0; k < 2; ++k) dst[m][k] = *(const PG8_LAS bf16x8*)(lds + PG8_SA(b, h) + aoff + m * 2048 + k * 1024); } while (0)
#define PG8_LDB(dst, b, h) do { _Pragma("unroll") for (int n = 0; n < 2; ++n) _Pragma("unroll") for (int k = 0; k < 2; ++k) dst[n][k] = *(const PG8_LAS bf16x8*)(lds + PG8_SB(b, h) + boff + n * 2048 + k * 1024); } while (0)
#define PG8_MMA(ai, bj, At, Bt) do { __builtin_amdgcn_s_setprio(1); _Pragma("unroll") for (int m = 0; m < 4; ++m) _Pragma("unroll") for (int n = 0; n < 2; ++n) _Pragma("unroll") for (int k = 0; k < 2; ++k) \
        acc[ai][bj][m][n] = __builtin_amdgcn_mfma_f32_16x16x32_bf16(Bt[n][k], At[m][k], acc[ai][bj][m][n], 0, 0, 0); __builtin_amdgcn_s_setprio(0); } while (0)
#define PG8_WAIT_V(n) asm volatile("s_waitcnt vmcnt(" #n ")" ::: "memory")
#define PG8_WAIT_L(n) asm volatile("s_waitcnt lgkmcnt(" #n ")" ::: "memory")
#define PG8_BAR __builtin_amdgcn_s_barrier()
#define PG8_SCHED __builtin_amdgcn_sched_barrier(0)
    Unit cur, nxt; int ui = 0;
    if (!S.next(0, cur)) return;
    f32x4 acc[2][2][4][2];
#pragma unroll
    for (int a = 0; a < 2; ++a)
#pragma unroll
        for (int b = 0; b < 2; ++b)
#pragma unroll
            for (int m = 0; m < 4; ++m)
#pragma unroll
                for (int n = 0; n < 2; ++n) acc[a][b][m][n] = (f32x4){0.f, 0.f, 0.f, 0.f};
    bf16x8 At[4][2], B0[2][2], B1[2][2];
    const char* cA = (const char*)g.A + (size_t)cur.pm * tstep; const char* cB = (const char*)g.Bt + (size_t)cur.pn * tstep;
    S.a_ready(cur);
    if constexpr (SP2) {
        PG8_STAGE(PG8_SB(0, 0), cB, voffB); PG8_STAGE(PG8_SB(0, 1), cB + hstep, voffB); PG8_STAGE(PG8_SA(0, 0), cA, voffA); PG8_STAGE(PG8_SA(0, 1), cA + hstep, voffA);
        if (wr == 1) PG8_BAR;
        PG8_WAIT_V(2); PG8_BAR;
        PG8_STAGE(PG8_SB(1, 0), cB + kstep, voffB); PG8_STAGE(PG8_SA(1, 0), cA + kstep, voffA); PG8_STAGE(PG8_SB(1, 1), cB + hstep + kstep, voffB);
        PG8_WAIT_V(6); PG8_BAR;
    } else {
        PG8_STAGE(PG8_SB(0, 0), cB, voffB); PG8_STAGE(PG8_SA(0, 0), cA, voffA); PG8_STAGE(PG8_SB(0, 1), cB + hstep, voffB); PG8_STAGE(PG8_SA(0, 1), cA + hstep, voffA);
        if (wr == 1) PG8_BAR;
        PG8_WAIT_V(4); PG8_BAR;
        PG8_STAGE(PG8_SB(1, 0), cB + kstep, voffB); PG8_STAGE(PG8_SA(1, 0), cA + kstep, voffA); PG8_STAGE(PG8_SB(1, 1), cB + hstep + kstep, voffB);
        PG8_WAIT_V(6); PG8_BAR;
    }
    for (;;) {
        const bool has_next = S.next(ui + 1, nxt);
        const char* nA = has_next ? (const char*)g.A + (size_t)nxt.pm * tstep : cA; const char* nB = has_next ? (const char*)g.Bt + (size_t)nxt.pn * tstep : cB;
        for (int t = 0; t < nt; t += 2) {
            const bool last = (t == nt - 2);
            const char* a1 = cA + (size_t)(t + 1) * kstep;
            const char* a2 = last ? nA : cA + (size_t)(t + 2) * kstep; const char* b2 = last ? nB : cB + (size_t)(t + 2) * kstep;
            const char* a3 = a2 + kstep; const char* b3 = b2 + kstep;
            if (last && has_next) S.a_ready(nxt);
            if constexpr (SP2) {
            PG8_LDB(B0, 0, 0); PG8_LDB(B1, 0, 1); PG8_SCHED; PG8_LDA(At, 0, 0); PG8_STAGE(PG8_SA(1, 1), a1 + hstep, voffA);
            PG8_WAIT_V(8); PG8_WAIT_L(0); PG8_BAR; PG8_MMA(0, 0, At, B0); PG8_MMA(0, 1, At, B1); PG8_BAR; PG8_SCHED;
            PG8_LDA(At, 0, 1); PG8_STAGE(PG8_SB(0, 0), b2, voffB); PG8_STAGE(PG8_SB(0, 1), b2 + hstep, voffB); PG8_STAGE(PG8_SA(0, 0), a2, voffA);
            PG8_WAIT_V(8); PG8_WAIT_L(0); PG8_BAR; PG8_MMA(1, 0, At, B0); PG8_MMA(1, 1, At, B1); PG8_BAR; PG8_SCHED;
            PG8_LDB(B0, 1, 0); PG8_LDB(B1, 1, 1); PG8_SCHED; PG8_LDA(At, 1, 0); PG8_STAGE(PG8_SA(0, 1), a2 + hstep, voffA);
            PG8_WAIT_V(8); PG8_WAIT_L(0); PG8_BAR; PG8_MMA(0, 0, At, B0); PG8_MMA(0, 1, At, B1); PG8_BAR; PG8_SCHED;
            PG8_LDA(At, 1, 1); PG8_STAGE(PG8_SB(1, 0), b3, voffB); PG8_STAGE(PG8_SB(1, 1), b3 + hstep, voffB); PG8_STAGE(PG8_SA(1, 0), a3, voffA);
            PG8_WAIT_V(8); PG8_WAIT_L(0); PG8_BAR; PG8_MMA(1, 0, At, B0); PG8_MMA(1, 1, At, B1); PG8_BAR; PG8_SCHED;
            } else {
            PG8_LDB(B0, 0, 0); PG8_SCHED; PG8_LDA(At, 0, 0); PG8_STAGE(PG8_SA(1, 1), a1 + hstep, voffA);
            PG8_WAIT_L(8); PG8_BAR; PG8_WAIT_L(0); PG8_MMA(0, 0, At, B0); PG8_BAR; PG8_SCHED;
            PG8_LDB(B1, 0, 1); PG8_STAGE(PG8_SB(0, 0), b2, voffB);
            PG8_BAR; PG8_WAIT_L(0); PG8_MMA(0, 1, At, B1); PG8_BAR;
            PG8_LDA(At, 0, 1); PG8_STAGE(PG8_SA(0, 0), a2, voffA);
            PG8_BAR; PG8_WAIT_L(0); PG8_MMA(1, 0, At, B0); PG8_BAR; PG8_SCHED;
            PG8_STAGE(PG8_SB(0, 1), b2 + hstep, voffB);
            PG8_WAIT_V(6); PG8_BAR; PG8_MMA(1, 1, At, B1); PG8_BAR;
            PG8_LDB(B0, 1, 0); PG8_SCHED; PG8_LDA(At, 1, 0); PG8_STAGE(PG8_SA(0, 1), a2 + hstep, voffA);
            PG8_WAIT_L(8); PG8_BAR; PG8_WAIT_L(0); PG8_MMA(0, 0, At, B0); PG8_BAR; PG8_SCHED;
            PG8_LDB(B1, 1, 1); PG8_STAGE(PG8_SB(1, 0), b3, voffB);
            PG8_BAR; PG8_WAIT_L(0); PG8_MMA(0, 1, At, B1); PG8_BAR;
            PG8_LDA(At, 1, 1); PG8_STAGE(PG8_SA(1, 0), a3, voffA);
            PG8_BAR; PG8_WAIT_L(0); PG8_MMA(1, 0, At, B0); PG8_BAR; PG8_SCHED;
            PG8_STAGE(PG8_SB(1, 1), b3 + hstep, voffB);
            PG8_WAIT_V(6); PG8_BAR; PG8_MMA(1, 1, At, B1); PG8_BAR;
            }
        }
        if constexpr (ALIGN_EPI) { if (wr == 0) PG8_BAR; }
        if constexpr (!Epi::AFTER_DRAIN) { E(acc, cur, wr, wc, fr, fq); S.done(cur); }
        if (!has_next) break;
#pragma unroll
        for (int a = 0; a < 2; ++a)
#pragma unroll
            for (int b = 0; b < 2; ++b)
#pragma unroll
                for (int m = 0; m < 4; ++m)
#pragma unroll
                    for (int n = 0; n < 2; ++n) acc[a][b][m][n] = (f32x4){0.f, 0.f, 0.f, 0.f};
        cur = nxt; cA = nA; cB = nB; ++ui;
        if constexpr (ALIGN_EPI) { if (wr == 1) PG8_BAR; }
    }
    PG8_WAIT_V(0);
    if constexpr (!ALIGN_EPI) { if (wr == 0) PG8_BAR; }
    PG8_BAR;
    if constexpr (Epi::AFTER_DRAIN) { E.fused(acc, cur, wr, wc, fr, fq, lds, wid, lane); S.done(cur); }
#undef PG8_SA
#undef PG8_SB
#undef PG8_STAGE
#undef PG8_LDA
#undef PG8_LDB
#undef PG8_MMA
#undef PG8_WAIT_V
#undef PG8_WAIT_L
#undef PG8_BAR
#undef PG8_SCHED
}
}
namespace att {
using pg8::bf16_t; using pg8::bf16x8; using pg8::f32x4; using pg8::u32x4; using pg8::u32x2; using pg8::cvt_pk_bf16; using pg8::QKW; using pg8::VT_PITCH;
typedef float f32x16 __attribute__((ext_vector_type(16)));
#define ALAS __attribute__((address_space(3)))
constexpr int OFF_K0 = 0, OFF_K1 = 8192, OFF_V = 16384, STAGE = 32768, NSTG = 4, OFF_LUT = NSTG * STAGE;
constexpr int ATT_LDS = OFF_LUT + 12 * 260 * 4;
__device__ __forceinline__ int pi32(int r) { return (r & ~12) | ((r & 4) << 1) | ((r & 8) >> 1); }
__device__ __forceinline__ int t5_bucket(int rel) {
    const int n = rel < 0 ? -rel : rel;
    int b = n < 8 ? n : (n < 12 ? 8 : n < 16 ? 9 : n < 23 ? 10 : n < 32 ? 11 : n < 46 ? 12 : n < 64 ? 13 : n < 91 ? 14 : 15);
    return b + (rel > 0 ? 16 : 0);
}

__device__ __forceinline__ void glds16(const void* gsrc, unsigned lds_dst) { unsigned keep;
    asm volatile("s_mov_b32 %0, m0\n\ts_mov_b32 m0, %2\n\ts_nop 0\n\tglobal_load_lds_dwordx4 %1, off\n\ts_mov_b32 m0, %0" : "=&s"(keep) : "v"(gsrc), "s"(lds_dst) : "memory"); }
__device__ __forceinline__ float fadd_s(float a, float b) { float r; asm("v_add_f32_e32 %0, %1, %2" : "=v"(r) : "v"(a), "v"(b)); return r; }
__device__ __forceinline__ float max3_s(float a, float b, float c) { float r; asm("v_max3_f32 %0, %1, %2, %3" : "=v"(r) : "v"(a), "v"(b), "v"(c)); return r; }
template <int N> __device__ __forceinline__ void wait_bar() { asm volatile("s_waitcnt vmcnt(%0) lgkmcnt(0)\n\ts_barrier" :: "n"(N) : "memory"); }

template <bool WIN>
__device__ __forceinline__ void attn_unit(ALAS unsigned char* lds, const bf16_t* __restrict__ QK, const bf16_t* __restrict__ VT, bf16_t* __restrict__ Y,
                                          const float* __restrict__ rel_bias, const float* __restrict__ sinkp, const float* __restrict__ subln, float lam,
                                          int seq_base, int S, int q0, int hsel) {
    constexpr float LOG2E = 1.4426950408889634f;
    constexpr int NDB = WIN ? 2 : 4;
    const int tid = threadIdx.x, lane = tid & 63, l31 = lane & 31, hi = lane >> 5;
    const int wid = __builtin_amdgcn_readfirstlane(tid >> 6), half = wid >> 2, wq = wid & 3;
    const int qw = q0 + 32 * wq;
    int qcol, kcol0, kcol1, vrow0, bhead;
    if (WIN) { qcol = (2 * hsel + half) * 64; kcol0 = 512 + (hsel >> 1) * 64; kcol1 = kcol0; vrow0 = (hsel >> 1) * 64; bhead = 2 * hsel; }
    else { qcol = 640 + (2 * hsel + half) * 64; kcol0 = 1152 + (2 * hsel) * 64; kcol1 = kcol0 + 64; vrow0 = 128 + hsel * 128; bhead = 8 + hsel; }
    const ALAS float* lut = (const ALAS float*)(lds + OFF_LUT) + (WIN ? (bhead + half) : bhead) * 260;

    const int t_lo = WIN ? (q0 >= 128 ? (q0 - 128) / 64 : 0) : 0;
    const int t_hi = WIN ? ((q0 + 256) / 64 < S / 64 ? (q0 + 256) / 64 : S / 64) : S / 64;
    const int NT = t_hi - t_lo;
    const unsigned ldsb = (unsigned)(uintptr_t)lds;
    const int drow = 8 * wid + (lane >> 3), dch = (lane & 7) ^ ((4 * wid + (lane >> 4)) & 7);
    const bf16_t* kg = QK + ((size_t)((seq_base >> 6) + t_lo) * 26 * 64 + drow) * 64 + dch * 8 + kcol0 * 64;
    const bf16_t* vg = VT + ((size_t)((seq_base >> 6) + t_lo) * 640 + vrow0 + drow) * 64 + dch * 8;
    const unsigned dk = ldsb + wid * 1024;
#define AT_DMA(tr) do { const unsigned sb_ = (unsigned)__builtin_amdgcn_readfirstlane(dk + (((tr) & (NSTG - 1)) * STAGE)); const size_t ko_ = (size_t)(tr) * 26 * 4096, vo_ = (size_t)(tr) * 640 * 64; \
        glds16(kg + ko_, sb_ + OFF_K0); if (!WIN) glds16(kg + ko_ + 4096, sb_ + OFF_K1); glds16(vg + vo_, sb_ + OFF_V); if (!WIN) glds16(vg + vo_ + 64 * 64, sb_ + OFF_V + 8192); } while (0)
    constexpr int NPW = WIN ? 2 : 4;
    bf16x8 qfr[4];
    { const int qrow = seq_base + qw + l31; const bf16_t* qp = QK + ((size_t)((qrow >> 6) * 26 + (qcol >> 6)) * 64 + (qrow & 63)) * 64 + hi * 8;
#pragma unroll
      for (int ds = 0; ds < 4; ++ds) qfr[ds] = *(const bf16x8*)(qp + ds * 16); }
#define qf(ds) qfr[ds]
    AT_DMA(0); if (NT > 1) AT_DMA(1); if (NT > 2) AT_DMA(2);
    constexpr float THR = 8.0f;
    float m_ref = WIN ? sinkp[2 * hsel + half] * LOG2E : 0.f;
    float l_run = (WIN && hi == 0) ? 1.f : 0.f;
    float cbase = 0.f;
    f32x16 cvec;
#pragma unroll
    for (int r = 0; r < 16; ++r) cvec[r] = cbase - m_ref;
    f32x16 o[NDB];
#pragma unroll
    for (int db = 0; db < NDB; ++db)
#pragma unroll
        for (int r = 0; r < 16; ++r) o[db][r] = 0.f;
    const int krow = pi32(l31), fK = (krow >> 1) & 7, fV = (l31 >> 1) & 7;
    int kx[4], vx[4];
#pragma unroll
    for (int c = 0; c < 4; ++c) { kx[c] = (WIN ? OFF_K0 : (half ? OFF_K1 : OFF_K0)) + krow * 128 + (((2 * c + hi) ^ fK) << 4); vx[c] = OFF_V + l31 * 128 + (((2 * c + hi) ^ fV) << 4); }
    const int qabs = qw + l31;
    const float cfar_lo = __uint_as_float(__builtin_amdgcn_readfirstlane(__float_as_uint(lut[0]))), cfar_hi = __uint_as_float(__builtin_amdgcn_readfirstlane(__float_as_uint(lut[256])));
    asm volatile("" : "+v"(qfr[0]), "+v"(qfr[1]), "+v"(qfr[2]), "+v"(qfr[3]));
#pragma clang loop unroll(disable)
    for (int tr = 0; tr < NT; ++tr) {
        if (tr + 2 < NT) wait_bar<2 * NPW>(); else if (tr + 1 < NT) wait_bar<NPW>(); else wait_bar<0>();
        if (tr + 3 < NT) AT_DMA(tr + 3);
        const int k0 = (t_lo + tr) * 64;
        const bool skip = WIN && (k0 > qw + 31 + 128 || k0 + 63 < qw - 128);
        if (!skip) {
            const bool near = WIN || ((k0 - (qw + 31)) < 128 && (qw - (k0 + 63)) < 128);
            const float cinit = near ? 0.f : (k0 > qw ? cfar_hi : cfar_lo);
            if (__builtin_expect(cinit != cbase, 0)) { cbase = cinit; asm volatile("" ::: "memory");
#pragma unroll
                for (int r = 0; r < 16; ++r) cvec[r] = cbase - m_ref; }
            f32x16 s0, s1;
            const ALAS unsigned char* sb = lds + (tr & (NSTG - 1)) * STAGE;
            {
                bf16x8 ka[8];
#pragma unroll
                for (int ds = 0; ds < 4; ++ds) { ka[2 * ds] = *(const ALAS bf16x8*)(sb + kx[ds]); ka[2 * ds + 1] = *(const ALAS bf16x8*)(sb + kx[ds] + 4096); }
                __builtin_amdgcn_sched_barrier(0);
                s0 = __builtin_amdgcn_mfma_f32_32x32x16_bf16(ka[0], qf(0), cvec, 0, 0, 0);
                s1 = __builtin_amdgcn_mfma_f32_32x32x16_bf16(ka[1], qf(0), cvec, 0, 0, 0);
#pragma unroll
                for (int ds = 1; ds < 4; ++ds) {
                    s0 = __builtin_amdgcn_mfma_f32_32x32x16_bf16(ka[2 * ds], qf(ds), s0, 0, 0, 0);
                    s1 = __builtin_amdgcn_mfma_f32_32x32x16_bf16(ka[2 * ds + 1], qf(ds), s1, 0, 0, 0);
                }
            }
            bf16x8 va[2 * NDB], vc[2 * NDB];
#pragma unroll
            for (int kk = 0; kk < 2; ++kk)
#pragma unroll
                for (int db = 0; db < NDB; ++db) va[kk * NDB + db] = *(const ALAS bf16x8*)(sb + vx[kk] + db * 4096);
            __builtin_amdgcn_sched_barrier(0);
            if (near) {
#pragma unroll
                for (int r = 0; r < 16; ++r) {
                    const int rel = k0 + 16 * (r >> 3) + 8 * hi + (r & 7) - qabs;
                    const int i0 = (rel < -128 ? -128 : (rel > 128 ? 128 : rel)) + 128;
                    const int rel1 = rel + 32;
                    const int i1 = (rel1 < -128 ? -128 : (rel1 > 128 ? 128 : rel1)) + 128;
                    s0[r] += lut[i0]; s1[r] += lut[i1];
                    if (WIN) { if (rel < -128 || rel > 128) s0[r] = -1e30f; if (rel1 < -128 || rel1 > 128) s1[r] = -1e30f; }
                    if ((r & 3) == 3) __builtin_amdgcn_sched_barrier(0);
                }
            }
            float mxa = max3_s(s0[0], s0[1], s1[0]), mxb = max3_s(s0[2], s0[3], s1[1]);
            mxa = max3_s(mxa, s1[2], s1[3]);
#pragma unroll
            for (int r = 4; r < 16; r += 4) { mxa = max3_s(mxa, s0[r], s0[r + 1]); mxb = max3_s(mxb, s0[r + 2], s0[r + 3]); mxa = max3_s(mxa, s1[r], s1[r + 1]); mxb = max3_s(mxb, s1[r + 2], s1[r + 3]); }
            float mx = fmaxf(mxa, mxb);
            if (__any(mx > THR)) {
                mx = fmaxf(mx, __shfl_xor(mx, 32));
                const float dl = fmaxf(mx, 0.f);
                m_ref += dl;
                const float f = __builtin_amdgcn_exp2f(-dl);
                l_run *= f;
#pragma unroll
                for (int db = 0; db < NDB; ++db)
#pragma unroll
                    for (int r = 0; r < 16; ++r) o[db][r] *= f;
#pragma unroll
                for (int r = 0; r < 16; ++r) { s0[r] -= dl; s1[r] -= dl; cvec[r] = cbase - m_ref; }
            }
            float ls0 = 0.f, ls1 = 0.f;
#define AT_EXP(SS, B, PF) do { \
                const float e0 = __builtin_amdgcn_exp2f(SS[B + 0]), e1 = __builtin_amdgcn_exp2f(SS[B + 1]), e2 = __builtin_amdgcn_exp2f(SS[B + 2]), e3 = __builtin_amdgcn_exp2f(SS[B + 3]); \
                const float e4 = __builtin_amdgcn_exp2f(SS[B + 4]), e5 = __builtin_amdgcn_exp2f(SS[B + 5]), e6 = __builtin_amdgcn_exp2f(SS[B + 6]), e7 = __builtin_amdgcn_exp2f(SS[B + 7]); \
                ls0 = fadd_s(fadd_s(ls0, e0), e1); ls1 = fadd_s(fadd_s(ls1, e4), e5); ls0 = fadd_s(fadd_s(ls0, e2), e3); ls1 = fadd_s(fadd_s(ls1, e6), e7); \
                PF.u.x = cvt_pk_bf16(e0, e1); PF.u.y = cvt_pk_bf16(e2, e3); PF.u.z = cvt_pk_bf16(e4, e5); PF.u.w = cvt_pk_bf16(e6, e7); } while (0)
            union PFU { u32x4 u; bf16x8 b; };
            PFU p0, p1, p2, p3;
            AT_EXP(s0, 0, p0);
#pragma unroll
            for (int kk = 0; kk < 2; ++kk)
#pragma unroll
                for (int db = 0; db < NDB; ++db) vc[kk * NDB + db] = *(const ALAS bf16x8*)(sb + vx[kk + 2] + db * 4096);
            __builtin_amdgcn_sched_barrier(0);
#pragma unroll
            for (int db = 0; db < NDB; ++db) o[db] = __builtin_amdgcn_mfma_f32_32x32x16_bf16(va[db], p0.b, o[db], 0, 0, 0);
            AT_EXP(s0, 8, p1);
            __builtin_amdgcn_sched_barrier(0);
#pragma unroll
            for (int db = 0; db < NDB; ++db) o[db] = __builtin_amdgcn_mfma_f32_32x32x16_bf16(va[NDB + db], p1.b, o[db], 0, 0, 0);
            AT_EXP(s1, 0, p2);
            __builtin_amdgcn_sched_barrier(0);
#pragma unroll
            for (int db = 0; db < NDB; ++db) o[db] = __builtin_amdgcn_mfma_f32_32x32x16_bf16(vc[db], p2.b, o[db], 0, 0, 0);
            AT_EXP(s1, 8, p3);
            __builtin_amdgcn_sched_barrier(0);
#pragma unroll
            for (int db = 0; db < NDB; ++db) o[db] = __builtin_amdgcn_mfma_f32_32x32x16_bf16(vc[NDB + db], p3.b, o[db], 0, 0, 0);
            __builtin_amdgcn_sched_barrier(0);
#undef AT_EXP
            l_run += ls0 + ls1;
        }
    }
    asm volatile("s_waitcnt lgkmcnt(0)\n\ts_barrier" ::: "memory");
#undef qf
#undef AT_DMA
    const float l_tot = l_run + __shfl_xor(l_run, 32);
    const float inv = 1.0f / l_tot;
    const size_t orow = (size_t)(seq_base + qw + l31) * 1024;
    if (WIN) {
        bf16_t* yp = Y + orow + (2 * hsel + half) * 64 + 4 * hi;
#pragma unroll
        for (int db = 0; db < NDB; ++db)
#pragma unroll
            for (int g = 0; g < 4; ++g) {
                u32x2 w; w.x = cvt_pk_bf16(o[db][4 * g] * inv, o[db][4 * g + 1] * inv); w.y = cvt_pk_bf16(o[db][4 * g + 2] * inv, o[db][4 * g + 3] * inv);
                *(u32x2*)(yp + 32 * db + 8 * g) = w;
            }
    } else {
        ALAS f32x4* xch = (ALAS f32x4*)lds + (size_t)wq * 1024 + l31;
        if (half == 1) {
#pragma unroll
            for (int db = 0; db < NDB; ++db)
#pragma unroll
                for (int g = 0; g < 4; ++g) { f32x4 v; v[0] = o[db][4 * g] * inv; v[1] = o[db][4 * g + 1] * inv; v[2] = o[db][4 * g + 2] * inv; v[3] = o[db][4 * g + 3] * inv;
                    xch[(8 * db + 2 * g + hi) * 32] = v; }
        }
        __syncthreads();
        if (half == 0) {
            float ss = 0.f;
#pragma unroll
            for (int db = 0; db < NDB; ++db)
#pragma unroll
                for (int g = 0; g < 4; ++g) { const f32x4 v = xch[(8 * db + 2 * g + hi) * 32];
#pragma unroll
                    for (int i = 0; i < 4; ++i) { const float x = o[db][4 * g + i] * inv - lam * v[i]; o[db][4 * g + i] = x; ss += x * x; } }
            ss += __shfl_xor(ss, 32);
            const float rn = __builtin_amdgcn_rsqf(ss * (1.0f / 128.0f) + 1e-6f) * 0.8f;
            bf16_t* yp = Y + orow + 512 + hsel * 128 + 4 * hi;
#pragma unroll
            for (int db = 0; db < NDB; ++db)
#pragma unroll
                for (int g = 0; g < 4; ++g) { const f32x4 gsc = *(const f32x4*)(subln + 32 * db + 8 * g + 4 * hi);
                    u32x2 w; w.x = cvt_pk_bf16(o[db][4 * g] * rn * gsc[0], o[db][4 * g + 1] * rn * gsc[1]); w.y = cvt_pk_bf16(o[db][4 * g + 2] * rn * gsc[2], o[db][4 * g + 3] * rn * gsc[3]);
                    *(u32x2*)(yp + 32 * db + 8 * g) = w; }
        }
        __syncthreads();
    }
}

__device__ __forceinline__ void attn_phase(ALAS unsigned char* lds, const bf16_t* QK, const bf16_t* VT, bf16_t* Y, const float* rel_bias, const float* sinkp, const float* subln, const float* blam) {
    float lam;
    { const int lane = threadIdx.x & 63; float a = blam[lane] * blam[64 + lane], b = blam[128 + lane] * blam[192 + lane];
#pragma unroll
      for (int o = 1; o < 64; o <<= 1) { a += __shfl_xor(a, o); b += __shfl_xor(b, o); }
      lam = __expf(a) - __expf(b) + 0.2f; }
    { constexpr float LOG2E = 1.4426950408889634f; ALAS float* lutw = (ALAS float*)(lds + OFF_LUT);
      for (int i = threadIdx.x; i < 12 * 257; i += 512) { const int hh = i / 257, ri = i - hh * 257; lutw[hh * 260 + ri] = rel_bias[t5_bucket(ri - 128) * 12 + hh] * LOG2E; }
      __syncthreads(); }
    const int G = gridDim.x, bx = blockIdx.x;
    for (int u = bx; u < 2048; u += G) { const int qb = u & 63, bh = u >> 6; attn_unit<false>(lds, QK, VT, Y, rel_bias, sinkp, subln, lam, (bh >> 2) * 8192, 8192, qb * 128, bh & 3); }
    for (int u = bx; u < 2048; u += G) { const int qb = u & 15, bh = u >> 4; attn_unit<false>(lds, QK, VT, Y, rel_bias, sinkp, subln, lam, 65536 + (bh >> 2) * 2048, 2048, qb * 128, bh & 3); }
    for (int u = bx; u < 4096; u += G) { const int hp = u & 3, qb = u >> 2;
        const int row0 = qb * 128; int seq_base, S;
        if (row0 < 65536) { seq_base = row0 & ~8191; S = 8192; } else { seq_base = row0 & ~2047; S = 2048; }
        attn_unit<true>(lds, QK, VT, Y, rel_bias, sinkp, subln, lam, seq_base, S, row0 - seq_base, hp); }
}
}

namespace cv {
using pg8::bf16_t; using pg8::f32x4; using pg8::u32x4; using pg8::cvt_pk_bf16; using pg8::bf_lo; using pg8::bf_hi; using pg8::fast_sigmoid;
#define CLAS __attribute__((address_space(3)))
constexpr int T = 32, HALO = 15, ROWS = T + 2 * HALO;
constexpr int OFF_U0 = 0, OFF_U1 = 64 * 1024;
constexpr int CONV_LDS = OFF_U1 + T * 512 * 4;
__device__ __forceinline__ void conv_unit(CLAS unsigned char* lds, const bf16_t* __restrict__ PC, bf16_t* __restrict__ YC, const float* __restrict__ w3, const float* __restrict__ w31,
                                          const float* __restrict__ dwb, const float* __restrict__ lng, const float* __restrict__ lnb, int seq_base, int S, int t0) {
    const int tid = threadIdx.x;
    for (int idx = tid; idx < ROWS * 64; idx += 512) {
        const int j = idx >> 6, v = idx & 63, tok = t0 - HALO + j;
        u32x4 w = (u32x4){0u, 0u, 0u, 0u};
        if (tok >= 0 && tok < S) w = *(const u32x4*)(PC + (size_t)(seq_base + tok) * 1536 + 1024 + v * 8);
        *(CLAS u32x4*)(lds + OFF_U0 + j * 1024 + v * 16) = w;
    }
    __syncthreads();
    const int cp = tid & 255, th = tid >> 8;
    {
        const float wa0 = w3[2 * cp], wa1 = w3[512 + 2 * cp], wa2 = w3[1024 + 2 * cp];
        const float wb0 = w3[2 * cp + 1], wb1 = w3[512 + 2 * cp + 1], wb2 = w3[1024 + 2 * cp + 1];
        const int tb = t0 + 16 * th;
        float p0a = 0.f, p0b = 0.f, p1a, p1b, p2a, p2b;
#define CV_PROD(tok, A, B) do { A = 0.f; B = 0.f; if ((tok) >= 0 && (tok) < S) { const unsigned pp_ = *(const unsigned*)(PC + (size_t)(seq_base + (tok)) * 1536 + 512 + 2 * cp); A = bf_lo(pp_); B = bf_hi(pp_); } } while (0)
        CV_PROD(tb - 1, p0a, p0b); CV_PROD(tb, p1a, p1b);
        for (int i = 0; i < 16; ++i) {
            const int tok = tb + i;
            CV_PROD(tok + 1, p2a, p2b);
            const unsigned gb = *(const unsigned*)(PC + (size_t)(seq_base + tok) * 1536 + 2 * cp);
            const float ya = bf_lo(gb) * (wa0 * p0a + wa1 * p1a + wa2 * p2a), yb = bf_hi(gb) * (wb0 * p0b + wb1 * p1b + wb2 * p2b);
            *(unsigned*)(YC + (size_t)(seq_base + tok) * 1024 + 2 * cp) = cvt_pk_bf16(ya, yb);
            p0a = p1a; p0b = p1b; p1a = p2a; p1b = p2b;
        }
#undef CV_PROD
    }
    {
        float wa[31], wb[31];
#pragma unroll
        for (int j = 0; j < 31; ++j) { wa[j] = w31[j * 512 + 2 * cp]; wb[j] = w31[j * 512 + 2 * cp + 1]; }
        const float ba = dwb[2 * cp], bb = dwb[2 * cp + 1];
        for (int g4 = 0; g4 < 4; ++g4) {
            const int tt = 16 * th + 4 * g4;
            float aa[4], ab[4];
#pragma unroll
            for (int k = 0; k < 4; ++k) { aa[k] = ba; ab[k] = bb; }
            const CLAS unsigned char* up = lds + OFF_U0 + tt * 1024 + cp * 4;
#pragma unroll
            for (int rr = 0; rr < 34; ++rr) {
                const unsigned w = *(const CLAS unsigned*)(up + rr * 1024);
                const float xa = bf_lo(w), xb = bf_hi(w);
#pragma unroll
                for (int k = 0; k < 4; ++k) { const int j = rr - k; if (j >= 0 && j < 31) { aa[k] += wa[j] * xa; ab[k] += wb[j] * xb; } }
            }
#pragma unroll
            for (int k = 0; k < 4; ++k) { typedef float f32x2 __attribute__((ext_vector_type(2))); *(CLAS f32x2*)(lds + OFF_U1 + (tt + k) * 2048 + cp * 8) = (f32x2){aa[k], ab[k]}; }
        }
    }
    __syncthreads();
    {
        const int lane = tid & 63, wid = tid >> 6;
        const f32x4 g0 = *(const f32x4*)(lng + 8 * lane), g1 = *(const f32x4*)(lng + 8 * lane + 4), b0 = *(const f32x4*)(lnb + 8 * lane), b1 = *(const f32x4*)(lnb + 8 * lane + 4);
        for (int k = 0; k < 4; ++k) {
            const int tt = 4 * wid + k;
            const f32x4 x0 = *(const CLAS f32x4*)(lds + OFF_U1 + tt * 2048 + lane * 32), x1 = *(const CLAS f32x4*)(lds + OFF_U1 + tt * 2048 + lane * 32 + 16);
            float s = ((x0[0] + x0[1]) + (x0[2] + x0[3])) + ((x1[0] + x1[1]) + (x1[2] + x1[3]));
#pragma unroll
            for (int o = 1; o < 64; o <<= 1) s += __shfl_xor(s, o);
            const float mean = s * (1.0f / 512.0f);
            const f32x4 d0 = x0 - mean, d1 = x1 - mean;
            float q = ((d0[0] * d0[0] + d0[1] * d0[1]) + (d0[2] * d0[2] + d0[3] * d0[3])) + ((d1[0] * d1[0] + d1[1] * d1[1]) + (d1[2] * d1[2] + d1[3] * d1[3]));
#pragma unroll
            for (int o = 1; o < 64; o <<= 1) q += __shfl_xor(q, o);
            const float rstd = __builtin_amdgcn_rsqf(q * (1.0f / 512.0f) + 1e-6f);
            f32x4 y0 = d0 * rstd * g0 + b0, y1 = d1 * rstd * g1 + b1;
#pragma unroll
            for (int i = 0; i < 4; ++i) { y0[i] = y0[i] * fast_sigmoid(y0[i]); y1[i] = y1[i] * fast_sigmoid(y1[i]); }
            u32x4 w; w.x = cvt_pk_bf16(y0[0], y0[1]); w.y = cvt_pk_bf16(y0[2], y0[3]); w.z = cvt_pk_bf16(y1[0], y1[1]); w.w = cvt_pk_bf16(y1[2], y1[3]);
            *(u32x4*)(YC + (size_t)(seq_base + t0 + tt) * 1024 + 512 + 8 * lane) = w;
        }
    }
    __syncthreads();
}
__device__ __forceinline__ void conv_phase(CLAS unsigned char* lds, const bf16_t* PC, bf16_t* YC, const float* w3, const float* w31, const float* dwb, const float* lng, const float* lnb) {
    for (int u = blockIdx.x; u < 131072 / T; u += gridDim.x) {
        const int row0 = u * T; int seq_base, S;
        if (row0 < 65536) { seq_base = row0 & ~8191; S = 8192; } else { seq_base = row0 & ~2047; S = 2048; }
        conv_unit(lds, PC, YC, w3, w31, dwb, lng, lnb, seq_base, S, row0 - seq_base);
    }
}
}

namespace mk {
using pg8::bf16_t; using pg8::f32x4; using pg8::u32x4; using pg8::u32x2; using pg8::cvt_pk_bf16;
#define MLAS __attribute__((address_space(3)))
constexpr int M = 131072, D = 1024, FF = 2816, NQKV = 2304, NCI = 2560;
constexpr size_t MiB = 1u << 20;
constexpr size_t WS_X = 0;
constexpr size_t WS_BIG = 256 * MiB;
constexpr size_t WS_VT = WS_BIG + (size_t)M * pg8::QKW * 2;
constexpr size_t WS_W = 960 * MiB;
constexpr size_t WS_WQKV = WS_W, WS_WO = WS_WQKV + (size_t)NQKV * D * 2, WS_WGU0 = WS_WO + (size_t)D * D * 2, WS_WGU1 = WS_WGU0 + (size_t)2 * FF * D * 2,
                 WS_WD0 = WS_WGU1 + (size_t)2 * FF * D * 2, WS_WD1 = WS_WD0 + (size_t)D * FF * 2, WS_WCI = WS_WD1 + (size_t)D * FF * 2, WS_WCO = WS_WCI + (size_t)NCI * D * 2;
constexpr size_t WS_SSQ = 1008 * MiB;
constexpr size_t WS_CTL = 1016 * MiB, CTL_BYTES = 16384;
constexpr size_t WS_END = WS_CTL + 65536;
static_assert(WS_VT + (size_t)640 * pg8::VT_PITCH * 2 <= WS_W && WS_BIG + (size_t)M * FF * 2 <= WS_W && WS_WCO + (size_t)D * D * 2 <= WS_SSQ, "ws map");
constexpr int MISC_OFF = 147456, LDS_BYTES = MISC_OFF + 256;
static_assert(att::ATT_LDS <= MISC_OFF && cv::CONV_LDS <= MISC_OFF && pg8::STAGE_BYTES + 16384 <= MISC_OFF, "lds map");

#define XB_TMO      128
#define XB_XCNT(j)  (256  + 64 * (j))
#define XB_XSUB(j)  (1280 + 64 * (j))
#define XB_XGEN(j)  (2304 + 64 * (j))
#define XB_TOP      3328
#define XB_TOPGEN   3392
#define XCD_BAR_WORDS 3456
#define XB_SPIN_CAP (1u << 18)

__device__ __forceinline__ unsigned xb_ld(unsigned* p)              { return __hip_atomic_load(p, __ATOMIC_RELAXED, __HIP_MEMORY_SCOPE_AGENT); }
__device__ __forceinline__ unsigned xb_add(unsigned* p, unsigned v) { return __hip_atomic_fetch_add(p, v, __ATOMIC_RELAXED, __HIP_MEMORY_SCOPE_AGENT); }
__device__ __forceinline__ unsigned xb_xcc_id() { return (unsigned)__builtin_amdgcn_s_getreg((3 << 11) | 20) & 0xFu; }
#define XB_SPIN(cond, bar) do { unsigned _sp = 0; while (cond) { __builtin_amdgcn_s_sleep(1); \
    if ((++_sp & 255u) == 0u) { if (xb_ld(&(bar)[XB_TMO])) break; if (_sp > XB_SPIN_CAP) { atomicAdd(&(bar)[XB_TMO], 1u); break; } } } } while (0)

struct XcdBarrier {
    unsigned* bar; unsigned x;
    volatile MLAS unsigned* st;
};

__device__ __forceinline__ XcdBarrier xcd_barrier_post(unsigned* bar, volatile MLAS unsigned* st) {
    XcdBarrier b; b.bar = bar; b.x = xb_xcc_id(); b.st = st;
    if (threadIdx.x == 0) (void)xb_add(&bar[XB_XCNT(b.x)], 1u);
    return b;
}
__device__ __forceinline__ void xcd_barrier_complete(unsigned* bar, unsigned x, unsigned& nloc, unsigned& nx) {
    const unsigned G = gridDim.x * gridDim.y * gridDim.z;
    unsigned sum, cnt, mine, sp = 0u;
    for (;;) {
        sum = 0u; cnt = 0u; mine = 0u;
#pragma unroll
        for (unsigned j = 0; j < 16; ++j) { const unsigned c = xb_ld(&bar[XB_XCNT(j)]); sum += c; cnt += (c > 0u) ? 1u : 0u; mine = (j == x) ? c : mine; }
        if (sum == G) break;
        __builtin_amdgcn_s_sleep(1);
        if ((++sp & 255u) == 0u) { if (xb_ld(&bar[XB_TMO])) break; if (sp > XB_SPIN_CAP) { atomicAdd(&bar[XB_TMO], 1u); break; } }
    }
    nloc = mine > 0u ? mine : 1u; nx = cnt > 0u ? cnt : 1u;
}

__device__ __forceinline__ void xcd_barrier(const XcdBarrier& b) {
    asm volatile("s_waitcnt vmcnt(0)" ::: "memory");
    __syncthreads();
    if (threadIdx.x == 0) {
        unsigned* bar = b.bar;
        __builtin_amdgcn_s_waitcnt(0);
        unsigned nloc = b.st[0], nx = b.st[1];
        if (nloc == 0u) { xcd_barrier_complete(bar, b.x, nloc, nx); b.st[0] = nloc; b.st[1] = nx; }
        const unsigned old = xb_add(&bar[XB_XSUB(b.x)], 1u);
        const unsigned gen = old / nloc;
        if (old + 1u == (gen + 1u) * nloc) {
            __builtin_amdgcn_fence(__ATOMIC_RELEASE, "agent");
            asm volatile("s_waitcnt vmcnt(0)" ::: "memory");
            const unsigned og = xb_add(&bar[XB_TOP], 1u);
            const unsigned tg = og / nx;
            if (og + 1u == (tg + 1u) * nx) xb_add(&bar[XB_TOPGEN], 1u);
            else XB_SPIN(xb_ld(&bar[XB_TOPGEN]) == tg, bar);
            __builtin_amdgcn_fence(__ATOMIC_ACQUIRE, "agent");
            xb_add(&bar[XB_XGEN(b.x)], 1u);
            asm volatile("s_waitcnt vmcnt(0)" ::: "memory");
        } else {
            XB_SPIN(xb_ld(&bar[XB_XGEN(b.x)]) == gen, bar);
            __builtin_amdgcn_fence(__ATOMIC_ACQUIRE, "agent");
            asm volatile("s_waitcnt vmcnt(0)" ::: "memory");
        }
    }
    __syncthreads();
}

static_assert(XCD_BAR_WORDS * 4 <= CTL_BYTES, "barrier words");
struct Params { const float* in[24]; float* out; unsigned char* ws; int ph_lo, ph_hi; };

__device__ __forceinline__ void tr_item(const float* __restrict__ W, int ldw, int srccol0, const float* __restrict__ gain, bf16_t* __restrict__ WT, int K, int destrow0, int k0, MLAS float* scr, int lane) {
#pragma unroll 8
    for (int i = 0; i < 32; ++i) { const int kk = 2 * i + (lane >> 5); const float g = gain ? gain[k0 + kk] : 1.0f; scr[kk * 33 + (lane & 31)] = W[(size_t)(k0 + kk) * ldw + srccol0 + (lane & 31)] * g; }
    asm volatile("s_waitcnt lgkmcnt(0)" ::: "memory");
    const int c = lane & 7;
#pragma unroll
    for (int j = 0; j < 4; ++j) { const int n = (lane >> 3) + 8 * j; const MLAS float* s = scr + (8 * c) * 33 + n;
        u32x4 o; o.x = cvt_pk_bf16(s[0 * 33], s[1 * 33]); o.y = cvt_pk_bf16(s[2 * 33], s[3 * 33]); o.z = cvt_pk_bf16(s[4 * 33], s[5 * 33]); o.w = cvt_pk_bf16(s[6 * 33], s[7 * 33]);
        *(u32x4*)(WT + (size_t)(destrow0 + n) * K + k0 + 8 * c) = o; }
    asm volatile("s_waitcnt lgkmcnt(0)" ::: "memory");
}

__device__ __forceinline__ void prologue(const Params& p, MLAS unsigned char* lds) {
    const int tid = threadIdx.x, lane = tid & 63, wave = tid >> 6;
    MLAS float* scr = (MLAS float*)(lds + wave * 16384);
    const int gw = blockIdx.x * 8 + wave, NGW = gridDim.x * 8;
    unsigned char* ws = p.ws;
    constexpr int I_QKV = (NQKV / 32) * (D / 64), I_O = (D / 32) * (D / 64), I_GU = (2 * FF / 32) * (D / 64), I_D = (D / 32) * (FF / 64), I_CI = (NCI / 32) * (D / 64);
    constexpr int NIT = I_QKV + I_O + 2 * I_GU + 2 * I_D + I_CI + I_O;
    for (int it = gw; it < NIT; it += NGW) {
        int r = it;
        if (r < I_QKV) { const int kb = r / (NQKV / 32), nb = r % (NQKV / 32); const int n0 = nb * 32, pn = n0 >> 8, within = n0 & 255, bj = within >> 7, wc = (within & 127) >> 5;
            tr_item(p.in[8], NQKV, 256 * pn + 64 * wc + 32 * bj, p.in[3], (bf16_t*)(ws + WS_WQKV), D, n0, kb * 64, scr, lane); continue; }
        r -= I_QKV;
        if (r < I_O) { const int kb = r / (D / 32), nb = r % (D / 32); tr_item(p.in[9], D, nb * 32, nullptr, (bf16_t*)(ws + WS_WO), D, nb * 32, kb * 64, scr, lane); continue; }
        r -= I_O;
        if (r < 2 * I_GU) { const int l = r / I_GU; r -= l * I_GU; const int kb = r / (2 * FF / 32), nb = r % (2 * FF / 32); const int n0 = nb * 32, pn = n0 >> 8, within = n0 & 255, bj = within >> 7, j = within & 127;
            const float* src = (bj ? p.in[6] : p.in[5]) + (size_t)l * D * FF;
            tr_item(src, FF, 128 * pn + j, p.in[4] + l * D, (bf16_t*)(ws + (l ? WS_WGU1 : WS_WGU0)), D, n0, kb * 64, scr, lane); continue; }
        r -= 2 * I_GU;
        if (r < 2 * I_D) { const int l = r / I_D; r -= l * I_D; const int kb = r / (D / 32), nb = r % (D / 32);
            tr_item(p.in[7] + (size_t)l * FF * D, D, nb * 32, nullptr, (bf16_t*)(ws + (l ? WS_WD1 : WS_WD0)), FF, nb * 32, kb * 64, scr, lane); continue; }
        r -= 2 * I_D;
        if (r < I_CI) { const int kb = r / (NCI / 32), nb = r % (NCI / 32); const int n0 = nb * 32, pn = n0 >> 8, within = n0 & 255, bj = within >> 7, j = within & 127;
            const int src = pn < 2 ? n0 : (pn < 6 ? (bj ? 1024 : 512) + 128 * (pn - 2) + j : (bj ? 2048 : 1536) + 128 * (pn - 6) + j);
            tr_item(p.in[17], NCI, src, p.in[3] + D, (bf16_t*)(ws + WS_WCI), D, n0, kb * 64, scr, lane); continue; }
        r -= I_CI;
        { const int kb = r / (D / 32), nb = r % (D / 32); tr_item(p.in[18], D, nb * 32, nullptr, (bf16_t*)(ws + WS_WCO), D, nb * 32, kb * 64, scr, lane); }
    }
    bf16_t* X = (bf16_t*)(ws + WS_X); float* ssq = (float*)(ws + WS_SSQ);
    for (int m0 = gw; m0 < M; m0 += 4 * NGW) {
        f32x4 v[4][4];
#pragma unroll
        for (int r = 0; r < 4; ++r) { const int m = m0 + r * NGW; if (m < M) { const float* xrow = (m < 65536) ? p.in[0] + (size_t)m * D : p.in[1] + (size_t)(m - 65536) * D; const f32x4* xr = (const f32x4*)xrow + lane;
#pragma unroll
            for (int j = 0; j < 4; ++j) v[r][j] = xr[64 * j]; } }
#pragma unroll
        for (int r = 0; r < 4; ++r) { const int m = m0 + r * NGW; if (m < M) {
            float s = 0.f;
#pragma unroll
            for (int j = 0; j < 4; ++j) s += (v[r][j][0] * v[r][j][0] + v[r][j][1] * v[r][j][1]) + (v[r][j][2] * v[r][j][2] + v[r][j][3] * v[r][j][3]);
#pragma unroll
            for (int o = 1; o < 64; o <<= 1) s += __shfl_xor(s, o);
            u32x2* o8 = (u32x2*)(X + (size_t)m * D) + lane;
#pragma unroll
            for (int j = 0; j < 4; ++j) { u32x2 w; w.x = cvt_pk_bf16(v[r][j][0], v[r][j][1]); w.y = cvt_pk_bf16(v[r][j][2], v[r][j][3]); o8[64 * j] = w; }
            if (lane < 16) ssq[(size_t)m * 16 + lane] = (lane == 0) ? s : 0.f; } }
    }
}

__global__ void __launch_bounds__(512, 2) fwd_kernel(Params p) {
    extern __shared__ __attribute__((aligned(16))) unsigned char lds_raw[];
    MLAS unsigned char* lds = (MLAS unsigned char*)lds_raw;
    cg::grid_group grid = cg::this_grid();
    unsigned char* ws = p.ws;
    bf16_t* X = (bf16_t*)(ws + WS_X); bf16_t* BIG = (bf16_t*)(ws + WS_BIG); bf16_t* VT = (bf16_t*)(ws + WS_VT); float* ssq = (float*)(ws + WS_SSQ);
    bf16_t* Y = (bf16_t*)p.out;
    const int lo = p.ph_lo, hi = p.ph_hi, G = gridDim.x, bx = blockIdx.x;
    volatile MLAS unsigned* misc = (volatile MLAS unsigned*)(lds + MISC_OFF);
    if (threadIdx.x < 2) misc[threadIdx.x] = 0u;
    __syncthreads();
    const XcdBarrier xbar = xcd_barrier_post((unsigned*)(ws + WS_CTL), misc);
#ifndef PH_MASK
#define PH_MASK 0x7ff
#endif
#define IN(k) (((PH_MASK >> (k)) & 1) && lo <= (k) && (k) < hi)
#define SEAM(k) do { if (IN(k) && IN((k) + 1)) { if ((k) == 0) grid.sync(); else xcd_barrier(xbar); } } while (0)
    if (IN(0)) { prologue(p, lds); __syncthreads(); }
    SEAM(0);
    if (IN(1)) { pg8::Gemm g{X, (const bf16_t*)(ws + WS_WQKV), M, NQKV, D}; pg8::StaticOrder S; S.init(M, NQKV, G, bx);
        pg8::EpiQKV E{BIG, VT, ssq, p.in[10], p.in[11], p.in[13], p.in[14], lds + pg8::STAGE_BYTES};
        pg8::gemm_phase<pg8::EpiQKV, pg8::StaticOrder, true, true>(lds, g, S, E); }
    SEAM(1);
    if (IN(2)) { for (int rep = 0; rep < PROBE_ATT; ++rep) att::attn_phase(lds, BIG, VT, Y, p.in[2], p.in[12], p.in[16], p.in[15]); }
    SEAM(2);
    if (IN(3)) { pg8::Gemm g{Y, (const bf16_t*)(ws + WS_WO), M, D, D}; pg8::StaticOrder S; S.init(M, D, G, bx);
        pg8::EpiRes<false> E{X, nullptr, ssq};
        pg8::gemm_phase<pg8::EpiRes<false>, pg8::StaticOrder, true, true>(lds, g, S, E); }
    SEAM(3);
    if (IN(4)) { pg8::Gemm g{X, (const bf16_t*)(ws + WS_WGU0), M, 2 * FF, D}; pg8::StaticOrder S; S.init(M, 2 * FF, G, bx);
        pg8::EpiGlu E{BIG, ssq};
        pg8::gemm_phase<pg8::EpiGlu, pg8::StaticOrder, true, true>(lds, g, S, E); }
    SEAM(4);
    if (IN(5)) { pg8::Gemm g{BIG, (const bf16_t*)(ws + WS_WD0), M, D, FF}; pg8::StaticOrder S; S.init(M, D, G, bx);
        pg8::EpiRes<false> E{X, nullptr, ssq};
        pg8::gemm_phase<pg8::EpiRes<false>, pg8::StaticOrder, true, true>(lds, g, S, E); }
    SEAM(5);
    if (IN(6)) { pg8::Gemm g{X, (const bf16_t*)(ws + WS_WCI), M, NCI, D}; pg8::StaticOrder S; S.init(M, NCI, G, bx);
        pg8::EpiConvIn E{BIG, ssq};
        pg8::gemm_phase<pg8::EpiConvIn, pg8::StaticOrder, true, true>(lds, g, S, E); }
    SEAM(6);
    if (IN(7)) { cv::conv_phase(lds, BIG, Y, p.in[19], p.in[20], p.in[21], p.in[22], p.in[23]); }
    SEAM(7);
    if (IN(8)) { pg8::Gemm g{Y, (const bf16_t*)(ws + WS_WCO), M, D, D}; pg8::StaticOrder S; S.init(M, D, G, bx);
        pg8::EpiRes<false> E{X, nullptr, ssq};
        pg8::gemm_phase<pg8::EpiRes<false>, pg8::StaticOrder, true, true>(lds, g, S, E); }
    SEAM(8);
    if (IN(9)) { pg8::Gemm g{X, (const bf16_t*)(ws + WS_WGU1), M, 2 * FF, D}; pg8::StaticOrder S; S.init(M, 2 * FF, G, bx);
        pg8::EpiGlu E{BIG, ssq};
        pg8::gemm_phase<pg8::EpiGlu, pg8::StaticOrder, true, true>(lds, g, S, E); }
    SEAM(9);
    if (IN(10)) { pg8::Gemm g{BIG, (const bf16_t*)(ws + WS_WD1), M, D, FF}; pg8::StaticOrder S; S.init(M, D, G, bx);
        pg8::EpiRes<true> E{X, p.out, ssq};
        pg8::gemm_phase<pg8::EpiRes<true>, pg8::StaticOrder, true, true>(lds, g, S, E); }
#undef IN
#undef SEAM
}
}

#ifndef MK_N_LAUNCHES_X
#define MK_N_LAUNCHES 1
#endif
extern "C" void kernel_launch(void* const* d_in, const int* in_sizes, int n_in, void* d_out, int out_size, void* d_ws, size_t ws_size, hipStream_t stream) {
    static int grid = 0;
    if (grid == 0) {
        if (n_in != 24 || out_size != mk::M * mk::D || ws_size < mk::WS_END) { fprintf(stderr, "kernel_launch: unexpected shapes (n_in %d out %d ws %zu)\n", n_in, out_size, ws_size); grid = -1; return; }
        int dev = 0, cus = 0, per_cu = 0;
        (void)hipGetDevice(&dev); (void)hipDeviceGetAttribute(&cus, hipDeviceAttributeMultiprocessorCount, dev);
        (void)hipFuncSetAttribute((const void*)mk::fwd_kernel, hipFuncAttributeMaxDynamicSharedMemorySize, mk::LDS_BYTES);
        (void)hipOccupancyMaxActiveBlocksPerMultiprocessor(&per_cu, (const void*)mk::fwd_kernel, 512, mk::LDS_BYTES);
        if (per_cu < 1) per_cu = 1;
        (void)hipGetLastError();
        grid = cus * per_cu;
    }
    if (grid < 0) return;
    if (hipMemsetAsync((char*)d_ws + mk::WS_CTL, 0, mk::CTL_BYTES, stream) != hipSuccess) { fprintf(stderr, "kernel_launch: memset of the barrier words failed\n"); return; }
    mk::Params p{};
    for (int i = 0; i < 24; ++i) p.in[i] = (const float*)d_in[i];
    p.out = (float*)d_out; p.ws = (unsigned char*)d_ws;
#if MK_N_LAUNCHES == 1
    p.ph_lo = 0; p.ph_hi = 11;
    void* args[] = {&p};
    hipError_t e = hipLaunchCooperativeKernel((const void*)mk::fwd_kernel, dim3(grid), dim3(512), args, mk::LDS_BYTES, stream);
    if (e != hipSuccess) fprintf(stderr, "cooperative launch failed: %s (grid %d)\n", hipGetErrorString(e), grid);
#else
    for (int ph = 0; ph < 11; ++ph) { p.ph_lo = ph; p.ph_hi = ph + 1; hipLaunchKernelGGL(mk::fwd_kernel, dim3(grid), dim3(512), mk::LDS_BYTES, stream, p); }
#endif
}
```

```cpp
#include <hip/hip_runtime.h>
#include <hip/hip_cooperative_groups.h>
#include <cstdio>
#include <cstdint>
namespace cg = cooperative_groups;
#ifndef PROBE_ATT
#define PROBE_ATT 1
#endif
#ifndef MK_N_LAUNCHES
#define MK_N_LAUNCHES 1
#endif
namespace pg8 {
#define PG8_LAS __attribute__((address_space(3)))
typedef unsigned short bf16_t;
typedef short bf16x8 __attribute__((ext_vector_type(8)));
typedef float f32x4 __attribute__((ext_vector_type(4)));
typedef unsigned u32x4 __attribute__((ext_vector_type(4)));
constexpr int BM = 256, BK = 64, HALF = 128, HTB = HALF * BK * 2  , STAGE_BYTES = 8 * HTB, NXCD = 8, WGM = 8;

__host__ __device__ __forceinline__ int lds_byte(int r, int c) { const int st = (r >> 4) * 2 + (c >> 5), rr = r & 15, cc = c & 31, ob = rr * 64 + cc * 2; return st * 1024 + (ob ^ (((ob >> 9) & 1) << 5)); }
__host__ __device__ __forceinline__ void stage_rc(int b, int& R, int& C) { const int st = b / 1024, sb = b % 1024, swz = sb ^ (((sb >> 9) & 1) << 5); R = (st >> 1) * 16 + swz / 64; C = (st & 1) * 32 + (swz % 64) / 2; }
__host__ __device__ __forceinline__ int perm32(int rho) { const int n = rho >> 4, i = rho & 15; return 8 * (i >> 2) + 4 * n + (i & 3); }

struct Unit { int pm, pn; };
struct Gemm { const bf16_t* A; const bf16_t* Bt; int M, N, K; };

struct StaticOrder {
    int nM, nN, nwg, G, c;
    __host__ __device__ void init(int M, int N, int G_, int c_) { nM = M / BM; nN = N / BM; nwg = nM * nN; G = G_; c = c_; }
    __host__ __device__ bool next(int i, Unit& u) const {
        const long L = (long)i * G + c; if (L >= nwg) return false;
        int wgid = (int)L; { const int q = nwg / NXCD, r = nwg % NXCD, xcd = wgid % NXCD, off = wgid / NXCD; wgid = (xcd < r ? xcd * (q + 1) : r * (q + 1) + (xcd - r) * q) + off; }
        const int nig = WGM * nN, gid = wgid / nig, fm = gid * WGM, gsz = (nM - fm) < WGM ? (nM - fm) : WGM;
        u.pm = fm + ((wgid % nig) % gsz); u.pn = (wgid % nig) / gsz; return true;
    }
    __device__ __forceinline__ void a_ready(const Unit&) const {}
    __device__ __forceinline__ void done(const Unit&) const {}
};

__device__ __forceinline__ unsigned cvt_pk_bf16(float lo, float hi) { unsigned r; asm volatile("v_cvt_pk_bf16_f32 %0, %1, %2" : "=v"(r) : "v"(lo), "v"(hi)); return r; }
typedef float f32x2 __attribute__((ext_vector_type(2)));
typedef unsigned u32x2 __attribute__((ext_vector_type(2)));
__device__ __forceinline__ float bf_lo(unsigned w) { return __uint_as_float(w << 16); }
__device__ __forceinline__ float bf_hi(unsigned w) { return __uint_as_float(w & 0xffff0000u); }
__device__ __forceinline__ float row_rstd(const float* ssq, int row) {
    const f32x4* p = (const f32x4*)(ssq + (size_t)row * 16);
    const f32x4 a = p[0], b = p[1], c = p[2], d = p[3];
    const float s = ((a[0] + a[1]) + (a[2] + a[3])) + ((b[0] + b[1]) + (b[2] + b[3])) + ((c[0] + c[1]) + (c[2] + c[3])) + ((d[0] + d[1]) + (d[2] + d[3]));
    return __builtin_amdgcn_rsqf(s * (1.0f / 1024.0f) + 1e-6f);
}
__device__ __forceinline__ void rows_rstd(const float* ssq, int row0, int fq, float (&rs)[2][4]) {
    f32x4 pr[2][4];
#pragma unroll
    for (int ai = 0; ai < 2; ++ai)
#pragma unroll
        for (int m = 0; m < 4; ++m) pr[ai][m] = *(const f32x4*)(ssq + (size_t)(row0 + ai * HALF + m * 16) * 16 + 4 * fq);
#pragma unroll
    for (int ai = 0; ai < 2; ++ai)
#pragma unroll
        for (int m = 0; m < 4; ++m) { float t = (pr[ai][m][0] + pr[ai][m][1]) + (pr[ai][m][2] + pr[ai][m][3]); t += __shfl_xor(t, 16); t += __shfl_xor(t, 32); rs[ai][m] = __builtin_amdgcn_rsqf(t * (1.0f / 1024.0f) + 1e-6f); }
}
__device__ __forceinline__ float fast_sigmoid(float x) { return __builtin_amdgcn_rcpf(1.0f + __expf(-x)); }

constexpr int QKW = 1664;
constexpr int VT_PITCH = 131072 + 128;
constexpr float C2Q = 0.125f * 1.4426950408889634f;

struct EpiQKV {
    static constexpr bool PERM = true, AFTER_DRAIN = false;
    bf16_t* QK; bf16_t* VT; const float* ssq; const float* aq; const float* ak; const float* bq; const float* bk; PG8_LAS unsigned char* xlds;
    __device__ __forceinline__ void operator()(const f32x4 (&acc)[2][2][4][2], const Unit& u, int wr, int wc, int fr, int fq) const {
        const int L = u.pn * 256 + wc * 64;
        int kind; const float* gain = nullptr; float scale = 1.f; int ccol = 0, vrow = 0;
        if (L < 512) { kind = 0; gain = aq; scale = C2Q; ccol = L; }
        else if (L < 640) { kind = 0; gain = ak; ccol = L; }
        else if (L < 768) { kind = 1; vrow = L - 640; }
        else if (L < 1280) { kind = 0; gain = bq; scale = C2Q; ccol = L - 128; }
        else if (L < 1792) { kind = 0; gain = bk; ccol = L - 128; }
        else { kind = 1; vrow = L - 1792 + 128; }
        if (kind == 0) {
            f32x4 gv[2][2];
#pragma unroll
            for (int bj = 0; bj < 2; ++bj)
#pragma unroll
                for (int n = 0; n < 2; ++n) gv[bj][n] = *(const f32x4*)(gain + 32 * bj + 8 * fq + 4 * n);
            float rsv[2][4]; rows_rstd(ssq, u.pm * BM + wr * 64 + fr, fq, rsv);
#pragma unroll
            for (int ai = 0; ai < 2; ++ai)
#pragma unroll
                for (int m = 0; m < 4; ++m) {
                    const int row = u.pm * BM + ai * HALF + wr * 64 + m * 16 + fr;
                    const float rs = rsv[ai][m];
                    float ss = 0.f;
#pragma unroll
                    for (int bj = 0; bj < 2; ++bj)
#pragma unroll
                        for (int n = 0; n < 2; ++n) { const f32x4 v = acc[ai][bj][m][n] * rs; ss += (v[0] * v[0] + v[1] * v[1]) + (v[2] * v[2] + v[3] * v[3]); }
                    ss += __shfl_xor(ss, 16); ss += __shfl_xor(ss, 32);
                    const float f = rs * __builtin_amdgcn_rsqf(ss * (1.0f / 64.0f) + 1e-6f) * scale;
                    bf16_t* rowp = QK + ((size_t)((row >> 6) * 26 + (ccol >> 6)) * 64 + (row & 63)) * 64 + 8 * fq;
#pragma unroll
                    for (int bj = 0; bj < 2; ++bj) {
                        const f32x4 v0 = acc[ai][bj][m][0] * f * gv[bj][0], v1 = acc[ai][bj][m][1] * f * gv[bj][1];
                        u32x4 w; w.x = cvt_pk_bf16(v0[0], v0[1]); w.y = cvt_pk_bf16(v0[2], v0[3]); w.z = cvt_pk_bf16(v1[0], v1[1]); w.w = cvt_pk_bf16(v1[2], v1[3]);
                        *(u32x4*)(rowp + 32 * bj) = w;
                    }
                }
        } else {
            PG8_LAS unsigned char* xl = xlds + (wr * 4 + wc) * 2048;
            const int lane = fq * 16 + fr;
            float rsv[2][4]; rows_rstd(ssq, u.pm * BM + wr * 64 + fr, fq, rsv);
#pragma unroll
            for (int ai = 0; ai < 2; ++ai) {
                float rs[4];
#pragma unroll
                for (int m = 0; m < 4; ++m) rs[m] = rsv[ai][m];
                const size_t tb = (size_t)(u.pm * 4 + ai * 2 + wr) * 640;
#pragma unroll
                for (int bj = 0; bj < 2; ++bj)
#pragma unroll
                    for (int n = 0; n < 2; ++n) {
#pragma unroll
                        for (int m = 0; m < 4; ++m) {
                            const f32x4 v = acc[ai][bj][m][n] * rs[m];
                            const unsigned w0 = cvt_pk_bf16(v[0], v[1]), w1 = cvt_pk_bf16(v[2], v[3]);
                            PG8_LAS bf16_t* q = (PG8_LAS bf16_t*)(xl + (4 * fq) * 128 + (16 * m + fr) * 2);
                            q[0] = (bf16_t)(w0 & 0xffffu); q[64] = (bf16_t)(w0 >> 16); q[128] = (bf16_t)(w1 & 0xffffu); q[192] = (bf16_t)(w1 >> 16);
                        }
                        asm volatile("s_waitcnt lgkmcnt(0)" ::: "memory");
                        const int c16 = lane >> 2, part = lane & 3;
                        const u32x4 a = *(const PG8_LAS u32x4*)(xl + c16 * 128 + part * 32), b = *(const PG8_LAS u32x4*)(xl + c16 * 128 + part * 32 + 16);
                        bf16_t* gp = VT + (tb + vrow + 32 * bj + 8 * (c16 >> 2) + 4 * n + (c16 & 3)) * 64 + part * 16;
                        *(u32x4*)gp = a; *(u32x4*)(gp + 8) = b;
                        asm volatile("s_waitcnt lgkmcnt(0)" ::: "memory");
                    }
            }
        }
    }
};

template <bool FINAL> struct EpiRes {
    static constexpr bool PERM = true, AFTER_DRAIN = false;
    bf16_t* X; float* out; float* ssq;
    __device__ __forceinline__ void operator()(const f32x4 (&acc)[2][2][4][2], const Unit& u, int wr, int wc, int fr, int fq) const {
        const int col0 = u.pn * BM + wc * 32 + 8 * fq;
        u32x4 xin[2][4][2];
#pragma unroll
        for (int ai = 0; ai < 2; ++ai)
#pragma unroll
            for (int m = 0; m < 4; ++m)
#pragma unroll
                for (int bj = 0; bj < 2; ++bj) xin[ai][m][bj] = *(const u32x4*)(X + (size_t)(u.pm * BM + ai * HALF + wr * 64 + m * 16 + fr) * 1024 + col0 + bj * HALF);
#pragma unroll
        for (int ai = 0; ai < 2; ++ai)
#pragma unroll
            for (int m = 0; m < 4; ++m) {
                const int row = u.pm * BM + ai * HALF + wr * 64 + m * 16 + fr;
                float ss = 0.f;
#pragma unroll
                for (int bj = 0; bj < 2; ++bj) {
                    bf16_t* xp = X + (size_t)row * 1024 + col0 + bj * HALF;
                    const u32x4 xv = xin[ai][m][bj];
                    f32x4 y0 = acc[ai][bj][m][0], y1 = acc[ai][bj][m][1];
                    y0[0] += bf_lo(xv.x); y0[1] += bf_hi(xv.x); y0[2] += bf_lo(xv.y); y0[3] += bf_hi(xv.y);
                    y1[0] += bf_lo(xv.z); y1[1] += bf_hi(xv.z); y1[2] += bf_lo(xv.w); y1[3] += bf_hi(xv.w);
                    if (FINAL) {
                        float* op = out + (size_t)row * 1024 + col0 + bj * HALF;
                        *(f32x4*)op = y0; *(f32x4*)(op + 4) = y1;
                    } else {
                        u32x4 w; w.x = cvt_pk_bf16(y0[0], y0[1]); w.y = cvt_pk_bf16(y0[2], y0[3]); w.z = cvt_pk_bf16(y1[0], y1[1]); w.w = cvt_pk_bf16(y1[2], y1[3]);
                        *(u32x4*)xp = w;
                        ss += (y0[0] * y0[0] + y0[1] * y0[1]) + (y0[2] * y0[2] + y0[3] * y0[3]) + (y1[0] * y1[0] + y1[1] * y1[1]) + (y1[2] * y1[2] + y1[3] * y1[3]);
                    }
                }
                if (!FINAL) {
                    ss += __shfl_xor(ss, 16); ss += __shfl_xor(ss, 32);
                    if (fq == 0) ssq[(size_t)row * 16 + u.pn * 4 + wc] = ss;
                }
            }
    }
};

struct EpiGlu {
    static constexpr bool PERM = true, AFTER_DRAIN = false;
    bf16_t* H; const float* ssq;
    __device__ __forceinline__ void operator()(const f32x4 (&acc)[2][2][4][2], const Unit& u, int wr, int wc, int fr, int fq) const {
        const int col0 = u.pn * HALF + wc * 32 + 8 * fq;
        float rsv[2][4]; rows_rstd(ssq, u.pm * BM + wr * 64 + fr, fq, rsv);
#pragma unroll
        for (int ai = 0; ai < 2; ++ai)
#pragma unroll
            for (int m = 0; m < 4; ++m) {
                const int row = u.pm * BM + ai * HALF + wr * 64 + m * 16 + fr;
                const float rs = rsv[ai][m];
                float h[8];
#pragma unroll
                for (int n = 0; n < 2; ++n)
#pragma unroll
                    for (int i = 0; i < 4; ++i) { const float g = acc[ai][0][m][n][i] * rs, up = acc[ai][1][m][n][i] * rs; h[4 * n + i] = g * up * fast_sigmoid(g); }
                u32x4 w; w.x = cvt_pk_bf16(h[0], h[1]); w.y = cvt_pk_bf16(h[2], h[3]); w.z = cvt_pk_bf16(h[4], h[5]); w.w = cvt_pk_bf16(h[6], h[7]);
                *(u32x4*)(H + (size_t)row * 2816 + col0) = w;
            }
    }
};

struct EpiConvIn {
    static constexpr bool PERM = true, AFTER_DRAIN = false;
    bf16_t* O; const float* ssq;
    __device__ __forceinline__ void operator()(const f32x4 (&acc)[2][2][4][2], const Unit& u, int wr, int wc, int fr, int fq) const {
        float rsv[2][4]; rows_rstd(ssq, u.pm * BM + wr * 64 + fr, fq, rsv);
#pragma unroll
        for (int ai = 0; ai < 2; ++ai)
#pragma unroll
            for (int m = 0; m < 4; ++m) {
                const int row = u.pm * BM + ai * HALF + wr * 64 + m * 16 + fr;
                const float rs = rsv[ai][m];
                bf16_t* rp = O + (size_t)row * 1536 + wc * 32 + 8 * fq;
                if (u.pn < 2) {
#pragma unroll
                    for (int bj = 0; bj < 2; ++bj) {
                        const f32x4 v0 = acc[ai][bj][m][0] * rs, v1 = acc[ai][bj][m][1] * rs;
                        u32x4 w; w.x = cvt_pk_bf16(v0[0], v0[1]); w.y = cvt_pk_bf16(v0[2], v0[3]); w.z = cvt_pk_bf16(v1[0], v1[1]); w.w = cvt_pk_bf16(v1[2], v1[3]);
                        *(u32x4*)(rp + u.pn * BM + bj * HALF) = w;
                    }
                } else {
                    float h[8];
                    const bool glu = u.pn >= 6;
#pragma unroll
                    for (int n = 0; n < 2; ++n)
#pragma unroll
                        for (int i = 0; i < 4; ++i) { const float a = acc[ai][0][m][n][i] * rs, b = acc[ai][1][m][n][i] * rs; h[4 * n + i] = glu ? a * fast_sigmoid(b) : a * b; }
                    u32x4 w; w.x = cvt_pk_bf16(h[0], h[1]); w.y = cvt_pk_bf16(h[2], h[3]); w.z = cvt_pk_bf16(h[4], h[5]); w.w = cvt_pk_bf16(h[6], h[7]);
                    *(u32x4*)(rp + 512 + (u.pn - 2) * HALF) = w;
                }
            }
    }
};

struct EpiPlain {
    static constexpr bool PERM = true, AFTER_DRAIN = false;
    bf16_t* O; int ldc; const float* ssq;
    __device__ __forceinline__ void operator()(const f32x4 (&acc)[2][2][4][2], const Unit& u, int wr, int wc, int fr, int fq) const {
        const int col0 = u.pn * BM + wc * 32 + 8 * fq;
#pragma unroll
        for (int ai = 0; ai < 2; ++ai)
#pragma unroll
            for (int m = 0; m < 4; ++m) {
                const int row = u.pm * BM + ai * HALF + wr * 64 + m * 16 + fr;
                const float rs = row_rstd(ssq, row);
#pragma unroll
                for (int bj = 0; bj < 2; ++bj) {
                    const f32x4 v0 = acc[ai][bj][m][0] * rs, v1 = acc[ai][bj][m][1] * rs;
                    u32x4 w; w.x = cvt_pk_bf16(v0[0], v0[1]); w.y = cvt_pk_bf16(v0[2], v0[3]); w.z = cvt_pk_bf16(v1[0], v1[1]); w.w = cvt_pk_bf16(v1[2], v1[3]);
                    *(u32x4*)(O + (size_t)row * ldc + col0 + bj * HALF) = w;
                }
            }
    }
};

template <class Epi, class Sched, bool ALIGN_EPI = false, bool SP2 = false>
__device__ __forceinline__ void gemm_phase(PG8_LAS unsigned char* lds, const Gemm g, const Sched& S, const Epi& E) {
    const int tid = threadIdx.x, wid = __builtin_amdgcn_readfirstlane(tid >> 6), lane = tid & 63, wr = wid >> 2, wc = wid & 3, fr = lane & 15, fq = lane >> 4;
    const int K = g.K, nt = K / BK;
    unsigned voffA[2], voffB[2];
#pragma unroll
    for (int i = 0; i < 2; ++i) { int R, C; stage_rc(tid * 16 + i * 8192, R, C); const int Rb = Epi::PERM ? ((R & ~31) + perm32(R & 31)) : R;
        voffA[i] = (unsigned)(R * K + C) * 2u; voffB[i] = (unsigned)(Rb * K + C) * 2u; }
    const size_t kstep = (size_t)(BK * 2);
    const size_t hstep = (size_t)HALF * K * 2;
    const size_t tstep = 2 * hstep;
    const unsigned ldsw = (unsigned)wid * 1024u;
    const int aoff = lds_byte(wr * 64 + fr, fq * 8), boff = lds_byte(wc * 32 + fr, fq * 8);
#define PG8_SA(b, h) (((b) * 2 + (h)) * HTB)
#define PG8_SB(b, h) ((4 + (b) * 2 + (h)) * HTB)
#define PG8_STAGE(bufoff, gbase, voff) do { _Pragma("unroll") for (int _i = 0; _i < 2; ++_i) \
        __builtin_amdgcn_global_load_lds((const unsigned*)((const char*)(gbase) + (voff)[_i]), (PG8_LAS unsigned*)(lds + (bufoff) + ldsw + _i * 8192), 16, 0, 0); } while (0)
#define PG8_LDA(dst, b, h) do { _Pragma("unroll") for (int m = 0; m < 4; ++m) _Pragma("unroll") for (int k = 0; k < 2; ++k) dst[m][k] = *(const PG8_LAS bf16x8*)(lds + PG8_SA(b, h) + aoff + m * 2048 + k * 1024); } while (0)
#define PG8_LDB(dst, b, h) do { _Pragma("unroll") for (int n = 0; n < 2; ++n) _Pragma("unroll") for (int k = 0; k < 2; ++k) dst[n][k] = *(const PG8_LAS bf16x8*)(lds + PG8_SB(b, h) + boff + n * 2048 + k * 1024); } while (0)
#define PG8_MMA(ai, bj, At, Bt) do { __builtin_amdgcn_s_setprio(1); _Pragma("unroll") for (int m = 0; m < 4; ++m) _Pragma("unroll") for (int n = 0; n < 2; ++n) _Pragma("unroll") for (int k = 0; k < 2; ++k) \
        acc[ai][bj][m][n] = __builtin_amdgcn_mfma_f32_16x16x32_bf16(Bt[n][k], At[m][k], acc[ai][bj][m][n], 0, 0, 0); __builtin_amdgcn_s_setprio(0); } while (0)
#define PG8_WAIT_V(n) asm volatile("s_waitcnt vmcnt(" #n ")" ::: "memory")
#define PG8_WAIT_L(n) asm volatile("s_waitcnt lgkmcnt(" #n ")" ::: "memory")
#define PG8_BAR __builtin_amdgcn_s_barrier()
#define PG8_SCHED __builtin_amdgcn_sched_barrier(0)
    Unit cur, nxt; int ui = 0;
    if (!S.next(0, cur)) return;
    f32x4 acc[2][2][4][2];
#pragma unroll
    for (int a = 0; a < 2; ++a)
#pragma unroll
        for (int b = 0; b < 2; ++b)
#pragma unroll
            for (int m = 0; m < 4; ++m)
#pragma unroll
                for (int n = 0; n < 2; ++n) acc[a][b][m][n] = (f32x4){0.f, 0.f, 0.f, 0.f};
    bf16x8 At[4][2], B0[2][2], B1[2][2];
    const char* cA = (const char*)g.A + (size_t)cur.pm * tstep; const char* cB = (const char*)g.Bt + (size_t)cur.pn * tstep;
    S.a_ready(cur);
    if constexpr (SP2) {
        PG8_STAGE(PG8_SB(0, 0), cB, voffB); PG8_STAGE(PG8_SB(0, 1), cB + hstep, voffB); PG8_STAGE(PG8_SA(0, 0), cA, voffA); PG8_STAGE(PG8_SA(0, 1), cA + hstep, voffA);
        if (wr == 1) PG8_BAR;
        PG8_WAIT_V(2); PG8_BAR;
        PG8_STAGE(PG8_SB(1, 0), cB + kstep, voffB); PG8_STAGE(PG8_SA(1, 0), cA + kstep, voffA); PG8_STAGE(PG8_SB(1, 1), cB + hstep + kstep, voffB);
        PG8_WAIT_V(6); PG8_BAR;
    } else {
        PG8_STAGE(PG8_SB(0, 0), cB, voffB); PG8_STAGE(PG8_SA(0, 0), cA, voffA); PG8_STAGE(PG8_SB(0, 1), cB + hstep, voffB); PG8_STAGE(PG8_SA(0, 1), cA + hstep, voffA);
        if (wr == 1) PG8_BAR;
        PG8_WAIT_V(4); PG8_BAR;
        PG8_STAGE(PG8_SB(1, 0), cB + kstep, voffB); PG8_STAGE(PG8_SA(1, 0), cA + kstep, voffA); PG8_STAGE(PG8_SB(1, 1), cB + hstep + kstep, voffB);
        PG8_WAIT_V(6); PG8_BAR;
    }
    for (;;) {
        const bool has_next = S.next(ui + 1, nxt);
        const char* nA = has_next ? (const char*)g.A + (size_t)nxt.pm * tstep : cA; const char* nB = has_next ? (const char*)g.Bt + (size_t)nxt.pn * tstep : cB;
        for (int t = 0; t < nt; t += 2) {
            const bool last = (t == nt - 2);
            const char* a1 = cA + (size_t)(t + 1) * kstep;
            const char* a2 = last ? nA : cA + (size_t)(t + 2) * kstep; const char* b2 = last ? nB : cB + (size_t)(t + 2) * kstep;
            const char* a3 = a2 + kstep; const char* b3 = b2 + kstep;
            if (last && has_next) S.a_ready(nxt);
            if constexpr (SP2) {
            PG8_LDB(B0, 0, 0); PG8_LDB(B1, 0, 1); PG8_SCHED; PG8_LDA(At, 0, 0); PG8_STAGE(PG8_SA(1, 1), a1 + hstep, voffA);
            PG8_WAIT_V(8); PG8_WAIT_L(0); PG8_BAR; PG8_MMA(0, 0, At, B0); PG8_MMA(0, 1, At, B1); PG8_BAR; PG8_SCHED;
            PG8_LDA(At, 0, 1); PG8_STAGE(PG8_SB(0, 0), b2, voffB); PG8_STAGE(PG8_SB(0, 1), b2 + hstep, voffB); PG8_STAGE(PG8_SA(0, 0), a2, voffA);
            PG8_WAIT_V(8); PG8_WAIT_L(0); PG8_BAR; PG8_MMA(1, 0, At, B0); PG8_MMA(1, 1, At, B1); PG8_BAR; PG8_SCHED;
            PG8_LDB(B0, 1, 0); PG8_LDB(B1, 1, 1); PG8_SCHED; PG8_LDA(At, 1, 0); PG8_STAGE(PG8_SA(0, 1), a2 + hstep, voffA);
            PG8_WAIT_V(8); PG8_WAIT_L(0); PG8_BAR; PG8_MMA(0, 0, At, B0); PG8_MMA(0, 1, At, B1); PG8_BAR; PG8_SCHED;
            PG8_LDA(At, 1, 1); PG8_STAGE(PG8_SB(1, 0), b3, voffB); PG8_STAGE(PG8_SB(1, 1), b3 + hstep, voffB); PG8_STAGE(PG8_SA(1, 0), a3, voffA);
            PG8_WAIT_V(8); PG8_WAIT_L(0); PG8_BAR; PG8_MMA(1, 0, At, B0); PG8_MMA(1, 1, At, B1); PG8_BAR; PG8_SCHED;
            } else {
            PG8_LDB(B0, 0, 0); PG8_SCHED; PG8_LDA(At, 0, 0); PG8_STAGE(PG8_SA(1, 1), a1 + hstep, voffA);
            PG8_WAIT_L(8); PG8_BAR; PG8_WAIT_L(0); PG8_MMA(0, 0, At, B0); PG8_BAR; PG8_SCHED;
            PG8_LDB(B1, 0, 1); PG8_STAGE(PG8_SB(0, 0), b2, voffB);
            PG8_BAR; PG8_WAIT_L(0); PG8_MMA(0, 1, At, B1); PG8_BAR;
            PG8_LDA(At, 0, 1); PG8_STAGE(PG8_SA(0, 0), a2, voffA);
            PG8_BAR; PG8_WAIT_L(0); PG8_MMA(1, 0, At, B0); PG8_BAR; PG8_SCHED;
            PG8_STAGE(PG8_SB(0, 1), b2 + hstep, voffB);
            PG8_WAIT_V(6); PG8_BAR; PG8_MMA(1, 1, At, B1); PG8_BAR;
            PG8_LDB(B0, 1, 0); PG8_SCHED; PG8_LDA(At, 1, 0); PG8_STAGE(PG8_SA(0, 1), a2 + hstep, voffA);
            PG8_WAIT_L(8); PG8_BAR; PG8_WAIT_L(0); PG8_MMA(0, 0, At, B0); PG8_BAR; PG8_SCHED;
            PG8_LDB(B1, 1, 1); PG8_STAGE(PG8_SB(1, 0), b3, voffB);
            PG8_BAR; PG8_WAIT_L(0); PG8_MMA(0, 1, At, B1); PG8_BAR;
            PG8_LDA(At, 1, 1); PG8_STAGE(PG8_SA(1, 0), a3, voffA);
            PG8_BAR; PG8_WAIT_L(0); PG8_MMA(1, 0, At, B0); PG8_BAR; PG8_SCHED;
            PG8_STAGE(PG8_SB(1, 1), b3 + hstep, voffB);
            PG8_WAIT_V(6); PG8_BAR; PG8_MMA(1, 1, At, B1); PG8_BAR;
            }
        }
        if constexpr (ALIGN_EPI) { if (wr == 0) PG8_BAR; }
        if constexpr (!Epi::AFTER_DRAIN) { E(acc, cur, wr, wc, fr, fq); S.done(cur); }
        if (!has_next) break;
#pragma unroll
        for (int a = 0; a < 2; ++a)
#pragma unroll
            for (int b = 0; b < 2; ++b)
#pragma unroll
                for (int m = 0; m < 4; ++m)
#pragma unroll
                    for (int n = 0; n < 2; ++n) acc[a][b][m][n] = (f32x4){0.f, 0.f, 0.f, 0.f};
        cur = nxt; cA = nA; cB = nB; ++ui;
        if constexpr (ALIGN_EPI) { if (wr == 1) PG8_BAR; }
    }
    PG8_WAIT_V(0);
    if constexpr (!ALIGN_EPI) { if (wr == 0) PG8_BAR; }
    PG8_BAR;
    if constexpr (Epi::AFTER_DRAIN) { E.fused(acc, cur, wr, wc, fr, fq, lds, wid, lane); S.done(cur); }
#undef PG8_SA
#undef PG8_SB
#undef PG8_STAGE
#undef PG8_LDA
#undef PG8_LDB
#undef PG8_MMA
#undef PG8_WAIT_V
#undef PG8_WAIT_L
#undef PG8_BAR
#undef PG8_SCHED
}
}
namespace att {
using pg8::bf16_t; using pg8::bf16x8; using pg8::f32x4; using pg8::u32x4; using pg8::u32x2; using pg8::cvt_pk_bf16; using pg8::QKW; using pg8::VT_PITCH;
typedef float f32x16 __attribute__((ext_vector_type(16)));
#define ALAS __attribute__((address_space(3)))
constexpr int OFF_K0 = 0, OFF_K1 = 8192, OFF_V = 16384, STAGE = 32768, NSTG = 4, OFF_LUT = NSTG * STAGE;
constexpr int OFF_SUB = OFF_LUT + 12 * 260 * 4;
constexpr int ATT_LDS = OFF_SUB + 512;
__device__ __forceinline__ int pi32(int r) { return (r & ~12) | ((r & 4) << 1) | ((r & 8) >> 1); }
__device__ __forceinline__ int t5_bucket(int rel) {
    const int n = rel < 0 ? -rel : rel;
    int b = n < 8 ? n : (n < 12 ? 8 : n < 16 ? 9 : n < 23 ? 10 : n < 32 ? 11 : n < 46 ? 12 : n < 64 ? 13 : n < 91 ? 14 : 15);
    return b + (rel > 0 ? 16 : 0);
}

__device__ __forceinline__ void glds16(const void* gsrc, unsigned lds_dst) { unsigned keep;
    asm volatile("s_mov_b32 %0, m0\n\ts_mov_b32 m0, %2\n\ts_nop 0\n\tglobal_load_lds_dwordx4 %1, off\n\ts_mov_b32 m0, %0" : "=&s"(keep) : "v"(gsrc), "s"(lds_dst) : "memory"); }
__device__ __forceinline__ float fadd_s(float a, float b) { float r; asm("v_add_f32_e32 %0, %1, %2" : "=v"(r) : "v"(a), "v"(b)); return r; }
__device__ __forceinline__ float max3_s(float a, float b, float c) { float r; asm("v_max3_f32 %0, %1, %2, %3" : "=v"(r) : "v"(a), "v"(b), "v"(c)); return r; }
template <int N> __device__ __forceinline__ void wait_bar() { asm volatile("s_waitcnt vmcnt(%0) lgkmcnt(0)\n\ts_barrier" :: "n"(N) : "memory"); }

template <bool WIN>
__device__ __forceinline__ void attn_unit(ALAS unsigned char* lds, const bf16_t* __restrict__ QK, const bf16_t* __restrict__ VT, bf16_t* __restrict__ Y,
                                          const float* __restrict__ rel_bias, const float* __restrict__ sinkp, const float* __restrict__ subln, float lam,
                                          int seq_base, int S, int q0, int hsel) {
    constexpr float LOG2E = 1.4426950408889634f;
    constexpr int NDB = WIN ? 2 : 4;
    const int tid = threadIdx.x, lane = tid & 63, l31 = lane & 31, hi = lane >> 5;
    const int wid = __builtin_amdgcn_readfirstlane(tid >> 6), half = wid >> 2, wq = wid & 3;
    const int qw = q0 + 32 * wq;
    int qcol, kcol0, kcol1, vrow0, bhead;
    if (WIN) { qcol = (2 * hsel + half) * 64; kcol0 = 512 + (hsel >> 1) * 64; kcol1 = kcol0; vrow0 = (hsel >> 1) * 64; bhead = 2 * hsel; }
    else { qcol = 640 + (2 * hsel + half) * 64; kcol0 = 1152 + (2 * hsel) * 64; kcol1 = kcol0 + 64; vrow0 = 128 + hsel * 128; bhead = 8 + hsel; }
    const ALAS float* lut = (const ALAS float*)(lds + OFF_LUT) + (WIN ? (bhead + half) : bhead) * 260;

    const int t_lo = WIN ? (q0 >= 128 ? (q0 - 128) / 64 : 0) : 0;
    const int t_hi = WIN ? ((q0 + 256) / 64 < S / 64 ? (q0 + 256) / 64 : S / 64) : S / 64;
    const int NT = t_hi - t_lo;
    const unsigned ldsb = (unsigned)(uintptr_t)lds;
    const int drow = 8 * wid + (lane >> 3), dch = (lane & 7) ^ ((4 * wid + (lane >> 4)) & 7);
    const bf16_t* kg = QK + ((size_t)((seq_base >> 6) + t_lo) * 26 * 64 + drow) * 64 + dch * 8 + kcol0 * 64;
    const bf16_t* vg = VT + ((size_t)((seq_base >> 6) + t_lo) * 640 + vrow0 + drow) * 64 + dch * 8;
    const unsigned dk = ldsb + wid * 1024;
#define AT_DMA(tr) do { const unsigned sb_ = (unsigned)__builtin_amdgcn_readfirstlane(dk + (((tr) & (NSTG - 1)) * STAGE)); const size_t ko_ = (size_t)(tr) * 26 * 4096, vo_ = (size_t)(tr) * 640 * 64; \
        glds16(kg + ko_, sb_ + OFF_K0); if (!WIN) glds16(kg + ko_ + 4096, sb_ + OFF_K1); glds16(vg + vo_, sb_ + OFF_V); if (!WIN) glds16(vg + vo_ + 64 * 64, sb_ + OFF_V + 8192); } while (0)
    constexpr int NPW = WIN ? 2 : 4;
    bf16x8 qfr[4];
    { const int qrow = seq_base + qw + l31; const bf16_t* qp = QK + ((size_t)((qrow >> 6) * 26 + (qcol >> 6)) * 64 + (qrow & 63)) * 64 + hi * 8;
#pragma unroll
      for (int ds = 0; ds < 4; ++ds) qfr[ds] = *(const bf16x8*)(qp + ds * 16); }
#define qf(ds) qfr[ds]
    AT_DMA(0); if (NT > 1) AT_DMA(1); if (NT > 2) AT_DMA(2);
    constexpr float THR = 8.0f;
    float m_ref = WIN ? sinkp[2 * hsel + half] * LOG2E : 0.f;
    float l_run = (WIN && hi == 0) ? 1.f : 0.f;
    float cbase = 0.f;
    f32x16 cvec;
#pragma unroll
    for (int r = 0; r < 16; ++r) cvec[r] = cbase - m_ref;
    f32x16 o[NDB];
#pragma unroll
    for (int db = 0; db < NDB; ++db)
#pragma unroll
        for (int r = 0; r < 16; ++r) o[db][r] = 0.f;
    const int krow = pi32(l31), fK = (krow >> 1) & 7, fV = (l31 >> 1) & 7;
    int kx[4], vx[4];
#pragma unroll
    for (int c = 0; c < 4; ++c) { kx[c] = (WIN ? OFF_K0 : (half ? OFF_K1 : OFF_K0)) + krow * 128 + (((2 * c + hi) ^ fK) << 4); vx[c] = OFF_V + l31 * 128 + (((2 * c + hi) ^ fV) << 4); }
    const int qabs = qw + l31;
    const float cfar_lo = __uint_as_float(__builtin_amdgcn_readfirstlane(__float_as_uint(lut[0]))), cfar_hi = __uint_as_float(__builtin_amdgcn_readfirstlane(__float_as_uint(lut[256])));
    asm volatile("" : "+v"(qfr[0]), "+v"(qfr[1]), "+v"(qfr[2]), "+v"(qfr[3]));
#pragma clang loop unroll(disable)
    for (int tr = 0; tr < NT; ++tr) {
        if (tr + 2 < NT) wait_bar<2 * NPW>(); else if (tr + 1 < NT) wait_bar<NPW>(); else wait_bar<0>();
        if (tr + 3 < NT) AT_DMA(tr + 3);
        const int k0 = (t_lo + tr) * 64;
        const bool skip = WIN && (k0 > qw + 31 + 128 || k0 + 63 < qw - 128);
        if (!skip) {
            const bool near = WIN || ((k0 - (qw + 31)) < 128 && (qw - (k0 + 63)) < 128);
            const float cinit = near ? 0.f : (k0 > qw ? cfar_hi : cfar_lo);
            if (__builtin_expect(cinit != cbase, 0)) { cbase = cinit; asm volatile("" ::: "memory");
#pragma unroll
                for (int r = 0; r < 16; ++r) cvec[r] = cbase - m_ref; }
            f32x16 s0, s1;
            const ALAS unsigned char* sb = lds + (tr & (NSTG - 1)) * STAGE;
            {
                bf16x8 ka[8];
#pragma unroll
                for (int ds = 0; ds < 4; ++ds) { ka[2 * ds] = *(const ALAS bf16x8*)(sb + kx[ds]); ka[2 * ds + 1] = *(const ALAS bf16x8*)(sb + kx[ds] + 4096); }
                __builtin_amdgcn_sched_barrier(0);
                s0 = __builtin_amdgcn_mfma_f32_32x32x16_bf16(ka[0], qf(0), cvec, 0, 0, 0);
                s1 = __builtin_amdgcn_mfma_f32_32x32x16_bf16(ka[1], qf(0), cvec, 0, 0, 0);
#pragma unroll
                for (int ds = 1; ds < 4; ++ds) {
                    s0 = __builtin_amdgcn_mfma_f32_32x32x16_bf16(ka[2 * ds], qf(ds), s0, 0, 0, 0);
                    s1 = __builtin_amdgcn_mfma_f32_32x32x16_bf16(ka[2 * ds + 1], qf(ds), s1, 0, 0, 0);
                }
            }
            bf16x8 va[2 * NDB], vc[2 * NDB];
#pragma unroll
            for (int kk = 0; kk < 2; ++kk)
#pragma unroll
                for (int db = 0; db < NDB; ++db) va[kk * NDB + db] = *(const ALAS bf16x8*)(sb + vx[kk] + db * 4096);
            __builtin_amdgcn_sched_barrier(0);
            if (near) {
#pragma unroll
                for (int r = 0; r < 16; ++r) {
                    const int rel = k0 + 16 * (r >> 3) + 8 * hi + (r & 7) - qabs;
                    const int i0 = (rel < -128 ? -128 : (rel > 128 ? 128 : rel)) + 128;
                    const int rel1 = rel + 32;
                    const int i1 = (rel1 < -128 ? -128 : (rel1 > 128 ? 128 : rel1)) + 128;
                    s0[r] += lut[i0]; s1[r] += lut[i1];
                    if (WIN) { if (rel < -128 || rel > 128) s0[r] = -1e30f; if (rel1 < -128 || rel1 > 128) s1[r] = -1e30f; }
                    if ((r & 3) == 3) __builtin_amdgcn_sched_barrier(0);
                }
            }
            float mxa = max3_s(s0[0], s0[1], s1[0]), mxb = max3_s(s0[2], s0[3], s1[1]);
            mxa = max3_s(mxa, s1[2], s1[3]);
#pragma unroll
            for (int r = 4; r < 16; r += 4) { mxa = max3_s(mxa, s0[r], s0[r + 1]); mxb = max3_s(mxb, s0[r + 2], s0[r + 3]); mxa = max3_s(mxa, s1[r], s1[r + 1]); mxb = max3_s(mxb, s1[r + 2], s1[r + 3]); }
            float mx = fmaxf(mxa, mxb);
            if (__any(mx > THR)) {
                mx = fmaxf(mx, __shfl_xor(mx, 32));
                const float dl = fmaxf(mx, 0.f);
                m_ref += dl;
                const float f = __builtin_amdgcn_exp2f(-dl);
                l_run *= f;
#pragma unroll
                for (int db = 0; db < NDB; ++db)
#pragma unroll
                    for (int r = 0; r < 16; ++r) o[db][r] *= f;
#pragma unroll
                for (int r = 0; r < 16; ++r) { s0[r] -= dl; s1[r] -= dl; cvec[r] = cbase - m_ref; }
            }
            float ls0 = 0.f, ls1 = 0.f;
#define AT_EXP(SS, B, PF) do { \
                const float e0 = __builtin_amdgcn_exp2f(SS[B + 0]), e1 = __builtin_amdgcn_exp2f(SS[B + 1]), e2 = __builtin_amdgcn_exp2f(SS[B + 2]), e3 = __builtin_amdgcn_exp2f(SS[B + 3]); \
                const float e4 = __builtin_amdgcn_exp2f(SS[B + 4]), e5 = __builtin_amdgcn_exp2f(SS[B + 5]), e6 = __builtin_amdgcn_exp2f(SS[B + 6]), e7 = __builtin_amdgcn_exp2f(SS[B + 7]); \
                ls0 = fadd_s(fadd_s(ls0, e0), e1); ls1 = fadd_s(fadd_s(ls1, e4), e5); ls0 = fadd_s(fadd_s(ls0, e2), e3); ls1 = fadd_s(fadd_s(ls1, e6), e7); \
                PF.u.x = cvt_pk_bf16(e0, e1); PF.u.y = cvt_pk_bf16(e2, e3); PF.u.z = cvt_pk_bf16(e4, e5); PF.u.w = cvt_pk_bf16(e6, e7); } while (0)
            union PFU { u32x4 u; bf16x8 b; };
            PFU p0, p1, p2, p3;
            AT_EXP(s0, 0, p0);
#pragma unroll
            for (int kk = 0; kk < 2; ++kk)
#pragma unroll
                for (int db = 0; db < NDB; ++db) vc[kk * NDB + db] = *(const ALAS bf16x8*)(sb + vx[kk + 2] + db * 4096);
            __builtin_amdgcn_sched_barrier(0);
#pragma unroll
            for (int db = 0; db < NDB; ++db) o[db] = __builtin_amdgcn_mfma_f32_32x32x16_bf16(va[db], p0.b, o[db], 0, 0, 0);
            AT_EXP(s0, 8, p1);
            __builtin_amdgcn_sched_barrier(0);
#pragma unroll
            for (int db = 0; db < NDB; ++db) o[db] = __builtin_amdgcn_mfma_f32_32x32x16_bf16(va[NDB + db], p1.b, o[db], 0, 0, 0);
            AT_EXP(s1, 0, p2);
            __builtin_amdgcn_sched_barrier(0);
#pragma unroll
            for (int db = 0; db < NDB; ++db) o[db] = __builtin_amdgcn_mfma_f32_32x32x16_bf16(vc[db], p2.b, o[db], 0, 0, 0);
            AT_EXP(s1, 8, p3);
            __builtin_amdgcn_sched_barrier(0);
#pragma unroll
            for (int db = 0; db < NDB; ++db) o[db] = __builtin_amdgcn_mfma_f32_32x32x16_bf16(vc[NDB + db], p3.b, o[db], 0, 0, 0);
            __builtin_amdgcn_sched_barrier(0);
#undef AT_EXP
            l_run += ls0 + ls1;
        }
    }
    asm volatile("s_waitcnt lgkmcnt(0)\n\ts_barrier" ::: "memory");
#undef qf
#undef AT_DMA
    const float l_tot = l_run + __shfl_xor(l_run, 32);
    const float inv = 1.0f / l_tot;
    const size_t orow = (size_t)(seq_base + qw + l31) * 1024;
    if (WIN) {
        bf16_t* yp = Y + orow + (2 * hsel + half) * 64 + 4 * hi;
#pragma unroll
        for (int db = 0; db < NDB; ++db)
#pragma unroll
            for (int g = 0; g < 4; ++g) {
                u32x2 w; w.x = cvt_pk_bf16(o[db][4 * g] * inv, o[db][4 * g + 1] * inv); w.y = cvt_pk_bf16(o[db][4 * g + 2] * inv, o[db][4 * g + 3] * inv);
                *(u32x2*)(yp + 32 * db + 8 * g) = w;
            }
    } else {
        ALAS f32x4* xch = (ALAS f32x4*)lds + (size_t)wq * 1024 + l31;
        if (half == 1) {
#pragma unroll
            for (int db = 0; db < NDB; ++db)
#pragma unroll
                for (int g = 0; g < 4; ++g) { f32x4 v; v[0] = o[db][4 * g] * inv; v[1] = o[db][4 * g + 1] * inv; v[2] = o[db][4 * g + 2] * inv; v[3] = o[db][4 * g + 3] * inv;
                    xch[(8 * db + 2 * g + hi) * 32] = v; }
        }
        __syncthreads();
        if (half == 0) {
            float ss = 0.f;
#pragma unroll
            for (int db = 0; db < NDB; ++db)
#pragma unroll
                for (int g = 0; g < 4; ++g) { const f32x4 v = xch[(8 * db + 2 * g + hi) * 32];
#pragma unroll
                    for (int i = 0; i < 4; ++i) { const float x = o[db][4 * g + i] * inv - lam * v[i]; o[db][4 * g + i] = x; ss += x * x; } }
            ss += __shfl_xor(ss, 32);
            const float rn = __builtin_amdgcn_rsqf(ss * (1.0f / 128.0f) + 1e-6f) * 0.8f;
            bf16_t* yp = Y + orow + 512 + hsel * 128 + 4 * hi;
#pragma unroll
            for (int db = 0; db < NDB; ++db)
#pragma unroll
                for (int g = 0; g < 4; ++g) { const f32x4 gsc = *(const ALAS f32x4*)(lds + OFF_SUB + (32 * db + 8 * g + 4 * hi) * 4);
                    u32x2 w; w.x = cvt_pk_bf16(o[db][4 * g] * rn * gsc[0], o[db][4 * g + 1] * rn * gsc[1]); w.y = cvt_pk_bf16(o[db][4 * g + 2] * rn * gsc[2], o[db][4 * g + 3] * rn * gsc[3]);
                    *(u32x2*)(yp + 32 * db + 8 * g) = w; }
        }
        __syncthreads();
    }
}

__device__ __forceinline__ void attn_phase(ALAS unsigned char* lds, const bf16_t* QK, const bf16_t* VT, bf16_t* Y, const float* rel_bias, const float* sinkp, const float* subln, const float* blam) {
    float lam;
    { const int lane = threadIdx.x & 63; float a = blam[lane] * blam[64 + lane], b = blam[128 + lane] * blam[192 + lane];
#pragma unroll
      for (int o = 1; o < 64; o <<= 1) { a += __shfl_xor(a, o); b += __shfl_xor(b, o); }
      lam = __expf(a) - __expf(b) + 0.2f; }
    { constexpr float LOG2E = 1.4426950408889634f; ALAS float* lutw = (ALAS float*)(lds + OFF_LUT);
      for (int i = threadIdx.x; i < 12 * 257; i += 512) { const int hh = i / 257, ri = i - hh * 257; lutw[hh * 260 + ri] = rel_bias[t5_bucket(ri - 128) * 12 + hh] * LOG2E; }
      if (threadIdx.x < 128) ((ALAS float*)(lds + OFF_SUB))[threadIdx.x] = subln[threadIdx.x];
      __syncthreads(); }
    const int G = gridDim.x, bx = blockIdx.x;
    for (int u = bx; u < 2048; u += G) { const int qb = u & 63, bh = u >> 6; attn_unit<false>(lds, QK, VT, Y, rel_bias, sinkp, subln, lam, (bh >> 2) * 8192, 8192, qb * 128, bh & 3); }
    for (int u = bx; u < 2048; u += G) { const int qb = u & 15, bh = u >> 4; attn_unit<false>(lds, QK, VT, Y, rel_bias, sinkp, subln, lam, 65536 + (bh >> 2) * 2048, 2048, qb * 128, bh & 3); }
    for (int u = bx; u < 4096; u += G) { const int hp = u & 3, qb = u >> 2;
        const int row0 = qb * 128; int seq_base, S;
        if (row0 < 65536) { seq_base = row0 & ~8191; S = 8192; } else { seq_base = row0 & ~2047; S = 2048; }
        attn_unit<true>(lds, QK, VT, Y, rel_bias, sinkp, subln, lam, seq_base, S, row0 - seq_base, hp); }
}
}

namespace cv {
using pg8::bf16_t; using pg8::f32x4; using pg8::u32x4; using pg8::cvt_pk_bf16; using pg8::bf_lo; using pg8::bf_hi; using pg8::fast_sigmoid;
#define CLAS __attribute__((address_space(3)))
constexpr int T = 32, HALO = 15, ROWS = T + 2 * HALO;
constexpr int OFF_U0 = 0, OFF_U1 = 64 * 1024;
constexpr int CONV_LDS = OFF_U1 + T * 512 * 4;
__device__ __forceinline__ void conv_unit(CLAS unsigned char* lds, const bf16_t* __restrict__ PC, bf16_t* __restrict__ YC, const float* __restrict__ w3, const float* __restrict__ w31,
                                          const float* __restrict__ dwb, const float* __restrict__ lng, const float* __restrict__ lnb, int seq_base, int S, int t0) {
    const int tid = threadIdx.x;
    {
        u32x4 w8[8];
#pragma unroll
        for (int it = 0; it < 8; ++it) { const int idx = tid + 512 * it, j = idx >> 6, v = idx & 63, tok = t0 - HALO + j;
            w8[it] = (u32x4){0u, 0u, 0u, 0u};
            if (idx < ROWS * 64 && tok >= 0 && tok < S) w8[it] = *(const u32x4*)(PC + (size_t)(seq_base + tok) * 1536 + 1024 + v * 8); }
#pragma unroll
        for (int it = 0; it < 8; ++it) { const int idx = tid + 512 * it, j = idx >> 6, v = idx & 63;
            if (idx < ROWS * 64) *(CLAS u32x4*)(lds + OFF_U0 + j * 1024 + v * 16) = w8[it]; }
    }
    __syncthreads();
    const int cp = tid & 255, th = tid >> 8;
    {
        const float wa0 = w3[2 * cp], wa1 = w3[512 + 2 * cp], wa2 = w3[1024 + 2 * cp];
        const float wb0 = w3[2 * cp + 1], wb1 = w3[512 + 2 * cp + 1], wb2 = w3[1024 + 2 * cp + 1];
        const int tb = t0 + 16 * th;
        unsigned pw[18], gw[16];
#pragma unroll
        for (int i = 0; i < 18; ++i) { const int tok = tb - 1 + i; pw[i] = 0u; if (tok >= 0 && tok < S) pw[i] = *(const unsigned*)(PC + (size_t)(seq_base + tok) * 1536 + 512 + 2 * cp); }
#pragma unroll
        for (int i = 0; i < 16; ++i) gw[i] = *(const unsigned*)(PC + (size_t)(seq_base + tb + i) * 1536 + 2 * cp);
#pragma unroll
        for (int i = 0; i < 16; ++i) {
            const float ya = bf_lo(gw[i]) * (wa0 * bf_lo(pw[i]) + wa1 * bf_lo(pw[i + 1]) + wa2 * bf_lo(pw[i + 2]));
            const float yb = bf_hi(gw[i]) * (wb0 * bf_hi(pw[i]) + wb1 * bf_hi(pw[i + 1]) + wb2 * bf_hi(pw[i + 2]));
            *(unsigned*)(YC + (size_t)(seq_base + tb + i) * 1024 + 2 * cp) = cvt_pk_bf16(ya, yb);
        }
    }
    {
        float wa[31], wb[31];
#pragma unroll
        for (int j = 0; j < 31; ++j) { wa[j] = w31[j * 512 + 2 * cp]; wb[j] = w31[j * 512 + 2 * cp + 1]; }
        const float ba = dwb[2 * cp], bb = dwb[2 * cp + 1];
        for (int g4 = 0; g4 < 4; ++g4) {
            const int tt = 16 * th + 4 * g4;
            float aa[4], ab[4];
#pragma unroll
            for (int k = 0; k < 4; ++k) { aa[k] = ba; ab[k] = bb; }
            const CLAS unsigned char* up = lds + OFF_U0 + tt * 1024 + cp * 4;
#pragma unroll
            for (int rr = 0; rr < 34; ++rr) {
                const unsigned w = *(const CLAS unsigned*)(up + rr * 1024);
                const float xa = bf_lo(w), xb = bf_hi(w);
#pragma unroll
                for (int k = 0; k < 4; ++k) { const int j = rr - k; if (j >= 0 && j < 31) { aa[k] += wa[j] * xa; ab[k] += wb[j] * xb; } }
            }
#pragma unroll
            for (int k = 0; k < 4; ++k) { typedef float f32x2 __attribute__((ext_vector_type(2))); *(CLAS f32x2*)(lds + OFF_U1 + (tt + k) * 2048 + cp * 8) = (f32x2){aa[k], ab[k]}; }
        }
    }
    __syncthreads();
    {
        const int lane = tid & 63, wid = tid >> 6;
        const f32x4 g0 = *(const f32x4*)(lng + 8 * lane), g1 = *(const f32x4*)(lng + 8 * lane + 4), b0 = *(const f32x4*)(lnb + 8 * lane), b1 = *(const f32x4*)(lnb + 8 * lane + 4);
        for (int k = 0; k < 4; ++k) {
            const int tt = 4 * wid + k;
            const f32x4 x0 = *(const CLAS f32x4*)(lds + OFF_U1 + tt * 2048 + lane * 32), x1 = *(const CLAS f32x4*)(lds + OFF_U1 + tt * 2048 + lane * 32 + 16);
            float s = ((x0[0] + x0[1]) + (x0[2] + x0[3])) + ((x1[0] + x1[1]) + (x1[2] + x1[3]));
#pragma unroll
            for (int o = 1; o < 64; o <<= 1) s += __shfl_xor(s, o);
            const float mean = s * (1.0f / 512.0f);
            const f32x4 d0 = x0 - mean, d1 = x1 - mean;
            float q = ((d0[0] * d0[0] + d0[1] * d0[1]) + (d0[2] * d0[2] + d0[3] * d0[3])) + ((d1[0] * d1[0] + d1[1] * d1[1]) + (d1[2] * d1[2] + d1[3] * d1[3]));
#pragma unroll
            for (int o = 1; o < 64; o <<= 1) q += __shfl_xor(q, o);
            const float rstd = __builtin_amdgcn_rsqf(q * (1.0f / 512.0f) + 1e-6f);
            f32x4 y0 = d0 * rstd * g0 + b0, y1 = d1 * rstd * g1 + b1;
#pragma unroll
            for (int i = 0; i < 4; ++i) { y0[i] = y0[i] * fast_sigmoid(y0[i]); y1[i] = y1[i] * fast_sigmoid(y1[i]); }
            u32x4 w; w.x = cvt_pk_bf16(y0[0], y0[1]); w.y = cvt_pk_bf16(y0[2], y0[3]); w.z = cvt_pk_bf16(y1[0], y1[1]); w.w = cvt_pk_bf16(y1[2], y1[3]);
            *(u32x4*)(YC + (size_t)(seq_base + t0 + tt) * 1024 + 512 + 8 * lane) = w;
        }
    }
    __syncthreads();
}
__device__ __forceinline__ void conv_phase(CLAS unsigned char* lds, const bf16_t* PC, bf16_t* YC, const float* w3, const float* w31, const float* dwb, const float* lng, const float* lnb) {
    for (int u = blockIdx.x; u < 131072 / T; u += gridDim.x) {
        const int row0 = u * T; int seq_base, S;
        if (row0 < 65536) { seq_base = row0 & ~8191; S = 8192; } else { seq_base = row0 & ~2047; S = 2048; }
        conv_unit(lds, PC, YC, w3, w31, dwb, lng, lnb, seq_base, S, row0 - seq_base);
    }
}
}

namespace mk {
using pg8::bf16_t; using pg8::f32x4; using pg8::u32x4; using pg8::u32x2; using pg8::cvt_pk_bf16;
#define MLAS __attribute__((address_space(3)))
constexpr int M = 131072, D = 1024, FF = 2816, NQKV = 2304, NCI = 2560;
constexpr size_t MiB = 1u << 20;
constexpr size_t WS_X = 0;
constexpr size_t WS_BIG = 256 * MiB;
constexpr size_t WS_VT = WS_BIG + (size_t)M * pg8::QKW * 2;
constexpr size_t WS_W = 960 * MiB;
constexpr size_t WS_WQKV = WS_W, WS_WO = WS_WQKV + (size_t)NQKV * D * 2, WS_WGU0 = WS_WO + (size_t)D * D * 2, WS_WGU1 = WS_WGU0 + (size_t)2 * FF * D * 2,
                 WS_WD0 = WS_WGU1 + (size_t)2 * FF * D * 2, WS_WD1 = WS_WD0 + (size_t)D * FF * 2, WS_WCI = WS_WD1 + (size_t)D * FF * 2, WS_WCO = WS_WCI + (size_t)NCI * D * 2;
constexpr size_t WS_SSQ = 1008 * MiB;
constexpr size_t WS_CTL = 1016 * MiB, CTL_BYTES = 16384;
constexpr size_t WS_END = WS_CTL + 65536;
static_assert(WS_VT + (size_t)640 * pg8::VT_PITCH * 2 <= WS_W && WS_BIG + (size_t)M * FF * 2 <= WS_W && WS_WCO + (size_t)D * D * 2 <= WS_SSQ, "ws map");
constexpr int MISC_OFF = 147456, LDS_BYTES = MISC_OFF + 256;
static_assert(att::ATT_LDS <= MISC_OFF && cv::CONV_LDS <= MISC_OFF && pg8::STAGE_BYTES + 16384 <= MISC_OFF, "lds map");

#define XB_TMO      128
#define XB_XCNT(j)  (256  + 64 * (j))
#define XB_XSUB(j)  (1280 + 64 * (j))
#define XB_XGEN(j)  (2304 + 64 * (j))
#define XB_TOP      3328
#define XB_TOPGEN   3392
#define XCD_BAR_WORDS 3456
#define XB_SPIN_CAP (1u << 18)

__device__ __forceinline__ unsigned xb_ld(unsigned* p)              { return __hip_atomic_load(p, __ATOMIC_RELAXED, __HIP_MEMORY_SCOPE_AGENT); }
__device__ __forceinline__ unsigned xb_add(unsigned* p, unsigned v) { return __hip_atomic_fetch_add(p, v, __ATOMIC_RELAXED, __HIP_MEMORY_SCOPE_AGENT); }
__device__ __forceinline__ unsigned xb_xcc_id() { return (unsigned)__builtin_amdgcn_s_getreg((3 << 11) | 20) & 0xFu; }
#define XB_SPIN(cond, bar) do { unsigned _sp = 0; while (cond) { __builtin_amdgcn_s_sleep(1); \
    if ((++_sp & 255u) == 0u) { if (xb_ld(&(bar)[XB_TMO])) break; if (_sp > XB_SPIN_CAP) { atomicAdd(&(bar)[XB_TMO], 1u); break; } } } } while (0)

struct XcdBarrier {
    unsigned* bar; unsigned x;
    volatile MLAS unsigned* st;
};

__device__ __forceinline__ XcdBarrier xcd_barrier_post(unsigned* bar, volatile MLAS unsigned* st) {
    XcdBarrier b; b.bar = bar; b.x = xb_xcc_id(); b.st = st;
    if (threadIdx.x == 0) (void)xb_add(&bar[XB_XCNT(b.x)], 1u);
    return b;
}
__device__ __forceinline__ void xcd_barrier_complete(unsigned* bar, unsigned x, unsigned& nloc, unsigned& nx) {
    const unsigned G = gridDim.x * gridDim.y * gridDim.z;
    unsigned sum, cnt, mine, sp = 0u;
    for (;;) {
        sum = 0u; cnt = 0u; mine = 0u;
#pragma unroll
        for (unsigned j = 0; j < 16; ++j) { const unsigned c = xb_ld(&bar[XB_XCNT(j)]); sum += c; cnt += (c > 0u) ? 1u : 0u; mine = (j == x) ? c : mine; }
        if (sum == G) break;
        __builtin_amdgcn_s_sleep(1);
        if ((++sp & 255u) == 0u) { if (xb_ld(&bar[XB_TMO])) break; if (sp > XB_SPIN_CAP) { atomicAdd(&bar[XB_TMO], 1u); break; } }
    }
    nloc = mine > 0u ? mine : 1u; nx = cnt > 0u ? cnt : 1u;
}

__device__ __forceinline__ void xcd_barrier(const XcdBarrier& b) {
    asm volatile("s_waitcnt vmcnt(0)" ::: "memory");
    __syncthreads();
    if (threadIdx.x == 0) {
        unsigned* bar = b.bar;
        __builtin_amdgcn_s_waitcnt(0);
        unsigned nloc = b.st[0], nx = b.st[1];
        if (nloc == 0u) { xcd_barrier_complete(bar, b.x, nloc, nx); b.st[0] = nloc; b.st[1] = nx; }
        const unsigned old = xb_add(&bar[XB_XSUB(b.x)], 1u);
        const unsigned gen = old / nloc;
        if (old + 1u == (gen + 1u) * nloc) {
            __builtin_amdgcn_fence(__ATOMIC_RELEASE, "agent");
            asm volatile("s_waitcnt vmcnt(0)" ::: "memory");
            const unsigned og = xb_add(&bar[XB_TOP], 1u);
            const unsigned tg = og / nx;
            if (og + 1u == (tg + 1u) * nx) xb_add(&bar[XB_TOPGEN], 1u);
            else XB_SPIN(xb_ld(&bar[XB_TOPGEN]) == tg, bar);
            __builtin_amdgcn_fence(__ATOMIC_ACQUIRE, "agent");
            xb_add(&bar[XB_XGEN(b.x)], 1u);
            asm volatile("s_waitcnt vmcnt(0)" ::: "memory");
        } else {
            XB_SPIN(xb_ld(&bar[XB_XGEN(b.x)]) == gen, bar);
            __builtin_amdgcn_fence(__ATOMIC_ACQUIRE, "agent");
            asm volatile("s_waitcnt vmcnt(0)" ::: "memory");
        }
    }
    __syncthreads();
}

static_assert(XCD_BAR_WORDS * 4 <= CTL_BYTES, "barrier words");
struct Params { const float* in[24]; float* out; unsigned char* ws; int ph_lo, ph_hi; };

__device__ __forceinline__ void tr_item(const float* __restrict__ W, int ldw, int srccol0, const float* __restrict__ gain, bf16_t* __restrict__ WT, int K, int destrow0, int k0, MLAS float* scr, int lane) {
    float wv[32];
#pragma unroll
    for (int i = 0; i < 32; ++i) { const int kk = 2 * i + (lane >> 5); wv[i] = W[(size_t)(k0 + kk) * ldw + srccol0 + (lane & 31)]; }
    const float g0 = gain ? gain[k0 + (lane & 31) * 2] : 1.0f, g1 = gain ? gain[k0 + (lane & 31) * 2 + 1] : 1.0f;
#pragma unroll
    for (int i = 0; i < 32; ++i) { const int kk = 2 * i + (lane >> 5); const float ga = __shfl(g0, i), gb = __shfl(g1, i); scr[kk * 33 + (lane & 31)] = wv[i] * ((lane >> 5) ? gb : ga); }
    asm volatile("s_waitcnt lgkmcnt(0)" ::: "memory");
    const int c = lane & 7;
#pragma unroll
    for (int j = 0; j < 4; ++j) { const int n = (lane >> 3) + 8 * j; const MLAS float* s = scr + (8 * c) * 33 + n;
        u32x4 o; o.x = cvt_pk_bf16(s[0 * 33], s[1 * 33]); o.y = cvt_pk_bf16(s[2 * 33], s[3 * 33]); o.z = cvt_pk_bf16(s[4 * 33], s[5 * 33]); o.w = cvt_pk_bf16(s[6 * 33], s[7 * 33]);
        *(u32x4*)(WT + (size_t)(destrow0 + n) * K + k0 + 8 * c) = o; }
    asm volatile("s_waitcnt lgkmcnt(0)" ::: "memory");
}

__device__ __forceinline__ void prologue(const Params& p, MLAS unsigned char* lds) {
    const int tid = threadIdx.x, lane = tid & 63, wave = tid >> 6;
    MLAS float* scr = (MLAS float*)(lds + wave * 16384);
    const int gw = blockIdx.x * 8 + wave, NGW = gridDim.x * 8;
    unsigned char* ws = p.ws;
    constexpr int I_QKV = (NQKV / 32) * (D / 64), I_O = (D / 32) * (D / 64), I_GU = (2 * FF / 32) * (D / 64), I_D = (D / 32) * (FF / 64), I_CI = (NCI / 32) * (D / 64);
    constexpr int NIT = I_QKV + I_O + 2 * I_GU + 2 * I_D + I_CI + I_O;
    for (int it = gw; it < NIT; it += NGW) {
        int r = it;
        if (r < I_QKV) { const int kb = r / (NQKV / 32), nb = r % (NQKV / 32); const int n0 = nb * 32, pn = n0 >> 8, within = n0 & 255, bj = within >> 7, wc = (within & 127) >> 5;
            tr_item(p.in[8], NQKV, 256 * pn + 64 * wc + 32 * bj, p.in[3], (bf16_t*)(ws + WS_WQKV), D, n0, kb * 64, scr, lane); continue; }
        r -= I_QKV;
        if (r < I_O) { const int kb = r / (D / 32), nb = r % (D / 32); tr_item(p.in[9], D, nb * 32, nullptr, (bf16_t*)(ws + WS_WO), D, nb * 32, kb * 64, scr, lane); continue; }
        r -= I_O;
        if (r < 2 * I_GU) { const int l = r / I_GU; r -= l * I_GU; const int kb = r / (2 * FF / 32), nb = r % (2 * FF / 32); const int n0 = nb * 32, pn = n0 >> 8, within = n0 & 255, bj = within >> 7, j = within & 127;
            const float* src = (bj ? p.in[6] : p.in[5]) + (size_t)l * D * FF;
            tr_item(src, FF, 128 * pn + j, p.in[4] + l * D, (bf16_t*)(ws + (l ? WS_WGU1 : WS_WGU0)), D, n0, kb * 64, scr, lane); continue; }
        r -= 2 * I_GU;
        if (r < 2 * I_D) { const int l = r / I_D; r -= l * I_D; const int kb = r / (D / 32), nb = r % (D / 32);
            tr_item(p.in[7] + (size_t)l * FF * D, D, nb * 32, nullptr, (bf16_t*)(ws + (l ? WS_WD1 : WS_WD0)), FF, nb * 32, kb * 64, scr, lane); continue; }
        r -= 2 * I_D;
        if (r < I_CI) { const int kb = r / (NCI / 32), nb = r % (NCI / 32); const int n0 = nb * 32, pn = n0 >> 8, within = n0 & 255, bj = within >> 7, j = within & 127;
            const int src = pn < 2 ? n0 : (pn < 6 ? (bj ? 1024 : 512) + 128 * (pn - 2) + j : (bj ? 2048 : 1536) + 128 * (pn - 6) + j);
            tr_item(p.in[17], NCI, src, p.in[3] + D, (bf16_t*)(ws + WS_WCI), D, n0, kb * 64, scr, lane); continue; }
        r -= I_CI;
        { const int kb = r / (D / 32), nb = r % (D / 32); tr_item(p.in[18], D, nb * 32, nullptr, (bf16_t*)(ws + WS_WCO), D, nb * 32, kb * 64, scr, lane); }
    }
    bf16_t* X = (bf16_t*)(ws + WS_X); float* ssq = (float*)(ws + WS_SSQ);
    for (int m0 = gw; m0 < M; m0 += 4 * NGW) {
        f32x4 v[4][4];
#pragma unroll
        for (int r = 0; r < 4; ++r) { const int m = m0 + r * NGW; if (m < M) { const float* xrow = (m < 65536) ? p.in[0] + (size_t)m * D : p.in[1] + (size_t)(m - 65536) * D; const f32x4* xr = (const f32x4*)xrow + lane;
#pragma unroll
            for (int j = 0; j < 4; ++j) v[r][j] = xr[64 * j]; } }
#pragma unroll
        for (int r = 0; r < 4; ++r) { const int m = m0 + r * NGW; if (m < M) {
            float s = 0.f;
#pragma unroll
            for (int j = 0; j < 4; ++j) s += (v[r][j][0] * v[r][j][0] + v[r][j][1] * v[r][j][1]) + (v[r][j][2] * v[r][j][2] + v[r][j][3] * v[r][j][3]);
#pragma unroll
            for (int o = 1; o < 64; o <<= 1) s += __shfl_xor(s, o);
            u32x2* o8 = (u32x2*)(X + (size_t)m * D) + lane;
#pragma unroll
            for (int j = 0; j < 4; ++j) { u32x2 w; w.x = cvt_pk_bf16(v[r][j][0], v[r][j][1]); w.y = cvt_pk_bf16(v[r][j][2], v[r][j][3]); o8[64 * j] = w; }
            if (lane < 16) ssq[(size_t)m * 16 + lane] = (lane == 0) ? s : 0.f; } }
    }
}

__global__ void __launch_bounds__(512, 2) fwd_kernel(Params p) {
    extern __shared__ __attribute__((aligned(16))) unsigned char lds_raw[];
    MLAS unsigned char* lds = (MLAS unsigned char*)lds_raw;
    cg::grid_group grid = cg::this_grid();
    unsigned char* ws = p.ws;
    bf16_t* X = (bf16_t*)(ws + WS_X); bf16_t* BIG = (bf16_t*)(ws + WS_BIG); bf16_t* VT = (bf16_t*)(ws + WS_VT); float* ssq = (float*)(ws + WS_SSQ);
    bf16_t* Y = (bf16_t*)p.out;
    const int lo = p.ph_lo, hi = p.ph_hi, G = gridDim.x, bx = blockIdx.x;
    volatile MLAS unsigned* misc = (volatile MLAS unsigned*)(lds + MISC_OFF);
    if (threadIdx.x < 2) misc[threadIdx.x] = 0u;
    __syncthreads();
    const XcdBarrier xbar = xcd_barrier_post((unsigned*)(ws + WS_CTL), misc);
#ifndef PH_MASK
#define PH_MASK 0x7ff
#endif
#define IN(k) (((PH_MASK >> (k)) & 1) && lo <= (k) && (k) < hi)
#define SEAM(k) do { if (IN(k) && IN((k) + 1)) { if ((k) == 0) grid.sync(); else xcd_barrier(xbar); } } while (0)
    if (IN(0)) { prologue(p, lds); __syncthreads(); }
    SEAM(0);
    if (IN(1)) { pg8::Gemm g{X, (const bf16_t*)(ws + WS_WQKV), M, NQKV, D}; pg8::StaticOrder S; S.init(M, NQKV, G, bx);
        pg8::EpiQKV E{BIG, VT, ssq, p.in[10], p.in[11], p.in[13], p.in[14], lds + pg8::STAGE_BYTES};
        pg8::gemm_phase<pg8::EpiQKV, pg8::StaticOrder, true, true>(lds, g, S, E); }
    SEAM(1);
    if (IN(2)) { for (int rep = 0; rep < PROBE_ATT; ++rep) att::attn_phase(lds, BIG, VT, Y, p.in[2], p.in[12], p.in[16], p.in[15]); }
    SEAM(2);
    if (IN(3)) { pg8::Gemm g{Y, (const bf16_t*)(ws + WS_WO), M, D, D}; pg8::StaticOrder S; S.init(M, D, G, bx);
        pg8::EpiRes<false> E{X, nullptr, ssq};
        pg8::gemm_phase<pg8::EpiRes<false>, pg8::StaticOrder, true, true>(lds, g, S, E); }
    SEAM(3);
    if (IN(4)) { pg8::Gemm g{X, (const bf16_t*)(ws + WS_WGU0), M, 2 * FF, D}; pg8::StaticOrder S; S.init(M, 2 * FF, G, bx);
        pg8::EpiGlu E{BIG, ssq};
        pg8::gemm_phase<pg8::EpiGlu, pg8::StaticOrder, true, true>(lds, g, S, E); }
    SEAM(4);
    if (IN(5)) { pg8::Gemm g{BIG, (const bf16_t*)(ws + WS_WD0), M, D, FF}; pg8::StaticOrder S; S.init(M, D, G, bx);
        pg8::EpiRes<false> E{X, nullptr, ssq};
        pg8::gemm_phase<pg8::EpiRes<false>, pg8::StaticOrder, true, true>(lds, g, S, E); }
    SEAM(5);
    if (IN(6)) { pg8::Gemm g{X, (const bf16_t*)(ws + WS_WCI), M, NCI, D}; pg8::StaticOrder S; S.init(M, NCI, G, bx);
        pg8::EpiConvIn E{BIG, ssq};
        pg8::gemm_phase<pg8::EpiConvIn, pg8::StaticOrder, true, true>(lds, g, S, E); }
    SEAM(6);
    if (IN(7)) { cv::conv_phase(lds, BIG, Y, p.in[19], p.in[20], p.in[21], p.in[22], p.in[23]); }
    SEAM(7);
    if (IN(8)) { pg8::Gemm g{Y, (const bf16_t*)(ws + WS_WCO), M, D, D}; pg8::StaticOrder S; S.init(M, D, G, bx);
        pg8::EpiRes<false> E{X, nullptr, ssq};
        pg8::gemm_phase<pg8::EpiRes<false>, pg8::StaticOrder, true, true>(lds, g, S, E); }
    SEAM(8);
    if (IN(9)) { pg8::Gemm g{X, (const bf16_t*)(ws + WS_WGU1), M, 2 * FF, D}; pg8::StaticOrder S; S.init(M, 2 * FF, G, bx);
        pg8::EpiGlu E{BIG, ssq};
        pg8::gemm_phase<pg8::EpiGlu, pg8::StaticOrder, true, true>(lds, g, S, E); }
    SEAM(9);
    if (IN(10)) { pg8::Gemm g{BIG, (const bf16_t*)(ws + WS_WD1), M, D, FF}; pg8::StaticOrder S; S.init(M, D, G, bx);
        pg8::EpiRes<true> E{X, p.out, ssq};
        pg8::gemm_phase<pg8::EpiRes<true>, pg8::StaticOrder, true, true>(lds, g, S, E); }
#undef IN
#undef SEAM
}
}

#ifndef MK_N_LAUNCHES_X
#define MK_N_LAUNCHES 1
#endif
extern "C" void kernel_launch(void* const* d_in, const int* in_sizes, int n_in, void* d_out, int out_size, void* d_ws, size_t ws_size, hipStream_t stream) {
    static int grid = 0;
    if (grid == 0) {
        if (n_in != 24 || out_size != mk::M * mk::D || ws_size < mk::WS_END) { fprintf(stderr, "kernel_launch: unexpected shapes (n_in %d out %d ws %zu)\n", n_in, out_size, ws_size); grid = -1; return; }
        int dev = 0, cus = 0, per_cu = 0;
        (void)hipGetDevice(&dev); (void)hipDeviceGetAttribute(&cus, hipDeviceAttributeMultiprocessorCount, dev);
        (void)hipFuncSetAttribute((const void*)mk::fwd_kernel, hipFuncAttributeMaxDynamicSharedMemorySize, mk::LDS_BYTES);
        (void)hipOccupancyMaxActiveBlocksPerMultiprocessor(&per_cu, (const void*)mk::fwd_kernel, 512, mk::LDS_BYTES);
        if (per_cu < 1) per_cu = 1;
        (void)hipGetLastError();
        grid = cus * per_cu;
    }
    if (grid < 0) return;
    if (hipMemsetAsync((char*)d_ws + mk::WS_CTL, 0, mk::CTL_BYTES, stream) != hipSuccess) { fprintf(stderr, "kernel_launch: memset of the barrier words failed\n"); return; }
    mk::Params p{};
    for (int i = 0; i < 24; ++i) p.in[i] = (const float*)d_in[i];
    p.out = (float*)d_out; p.ws = (unsigned char*)d_ws;
#if MK_N_LAUNCHES == 1
    p.ph_lo = 0; p.ph_hi = 11;
    void* args[] = {&p};
    hipError_t e = hipLaunchCooperativeKernel((const void*)mk::fwd_kernel, dim3(grid), dim3(512), args, mk::LDS_BYTES, stream);
    if (e != hipSuccess) fprintf(stderr, "cooperative launch failed: %s (grid %d)\n", hipGetErrorString(e), grid);
#else
    for (int ph = 0; ph < 11; ++ph) { p.ph_lo = ph; p.ph_hi = ph + 1; hipLaunchKernelGGL(mk::fwd_kernel, dim3(grid), dim3(512), mk::LDS_BYTES, stream, p); }
#endif
}
```

```cpp
#include <hip/hip_runtime.h>
#include <hip/hip_cooperative_groups.h>
#include <cstdio>
#include <cstdint>
namespace cg = cooperative_groups;
#ifndef PROBE_ATT
#define PROBE_ATT 1
#endif
#ifndef MK_N_LAUNCHES
#define MK_N_LAUNCHES 1
#endif
namespace pg8 {
#define PG8_LAS __attribute__((address_space(3)))
typedef unsigned short bf16_t;
typedef short bf16x8 __attribute__((ext_vector_type(8)));
typedef float f32x4 __attribute__((ext_vector_type(4)));
typedef unsigned u32x4 __attribute__((ext_vector_type(4)));
constexpr int BM = 256, BK = 64, HALF = 128, HTB = HALF * BK * 2  , STAGE_BYTES = 8 * HTB, NXCD = 8, WGM = 8;

__host__ __device__ __forceinline__ int lds_byte(int r, int c) { const int st = (r >> 4) * 2 + (c >> 5), rr = r & 15, cc = c & 31, ob = rr * 64 + cc * 2; return st * 1024 + (ob ^ (((ob >> 9) & 1) << 5)); }
__host__ __device__ __forceinline__ void stage_rc(int b, int& R, int& C) { const int st = b / 1024, sb = b % 1024, swz = sb ^ (((sb >> 9) & 1) << 5); R = (st >> 1) * 16 + swz / 64; C = (st & 1) * 32 + (swz % 64) / 2; }
__host__ __device__ __forceinline__ int perm32(int rho) { const int n = rho >> 4, i = rho & 15; return 8 * (i >> 2) + 4 * n + (i & 3); }

struct Unit { int pm, pn; };
struct Gemm { const bf16_t* A; const bf16_t* Bt; int M, N, K; };

struct StaticOrder {
    int nM, nN, nwg, G, c;
    __host__ __device__ void init(int M, int N, int G_, int c_) { nM = M / BM; nN = N / BM; nwg = nM * nN; G = G_; c = c_; }
    __host__ __device__ bool next(int i, Unit& u) const {
        const long L = (long)i * G + c; if (L >= nwg) return false;
        int wgid = (int)L; { const int q = nwg / NXCD, r = nwg % NXCD, xcd = wgid % NXCD, off = wgid / NXCD; wgid = (xcd < r ? xcd * (q + 1) : r * (q + 1) + (xcd - r) * q) + off; }
        const int nig = WGM * nN, gid = wgid / nig, fm = gid * WGM, gsz = (nM - fm) < WGM ? (nM - fm) : WGM;
        u.pm = fm + ((wgid % nig) % gsz); u.pn = (wgid % nig) / gsz; return true;
    }
    __device__ __forceinline__ void a_ready(const Unit&) const {}
    __device__ __forceinline__ void done(const Unit&) const {}
};

__device__ __forceinline__ unsigned cvt_pk_bf16(float lo, float hi) { unsigned r; asm volatile("v_cvt_pk_bf16_f32 %0, %1, %2" : "=v"(r) : "v"(lo), "v"(hi)); return r; }
typedef float f32x2 __attribute__((ext_vector_type(2)));
typedef unsigned u32x2 __attribute__((ext_vector_type(2)));
__device__ __forceinline__ float bf_lo(unsigned w) { return __uint_as_float(w << 16); }
__device__ __forceinline__ float bf_hi(unsigned w) { return __uint_as_float(w & 0xffff0000u); }
__device__ __forceinline__ float row_rstd(const float* ssq, int row) {
    const f32x4* p = (const f32x4*)(ssq + (size_t)row * 16);
    const f32x4 a = p[0], b = p[1], c = p[2], d = p[3];
    const float s = ((a[0] + a[1]) + (a[2] + a[3])) + ((b[0] + b[1]) + (b[2] + b[3])) + ((c[0] + c[1]) + (c[2] + c[3])) + ((d[0] + d[1]) + (d[2] + d[3]));
    return __builtin_amdgcn_rsqf(s * (1.0f / 1024.0f) + 1e-6f);
}
__device__ __forceinline__ void rows_rstd(const float* ssq, int row0, int fq, float (&rs)[2][4]) {
    f32x4 pr[2][4];
#pragma unroll
    for (int ai = 0; ai < 2; ++ai)
#pragma unroll
        for (int m = 0; m < 4; ++m) pr[ai][m] = *(const f32x4*)(ssq + (size_t)(row0 + ai * HALF + m * 16) * 16 + 4 * fq);
#pragma unroll
    for (int ai = 0; ai < 2; ++ai)
#pragma unroll
        for (int m = 0; m < 4; ++m) { float t = (pr[ai][m][0] + pr[ai][m][1]) + (pr[ai][m][2] + pr[ai][m][3]); t += __shfl_xor(t, 16); t += __shfl_xor(t, 32); rs[ai][m] = __builtin_amdgcn_rsqf(t * (1.0f / 1024.0f) + 1e-6f); }
}
__device__ __forceinline__ float fast_sigmoid(float x) { return __builtin_amdgcn_rcpf(1.0f + __expf(-x)); }

constexpr int QKW = 1664;
constexpr int VT_PITCH = 131072 + 128;
constexpr float C2Q = 0.125f * 1.4426950408889634f;

struct EpiQKV {
    static constexpr bool PERM = true, AFTER_DRAIN = false;
    bf16_t* QK; bf16_t* VT; const float* ssq; const float* aq; const float* ak; const float* bq; const float* bk; PG8_LAS unsigned char* xlds;
    __device__ __forceinline__ void operator()(const f32x4 (&acc)[2][2][4][2], const Unit& u, int wr, int wc, int fr, int fq) const {
        const int L = u.pn * 256 + wc * 64;
        int kind; const float* gain = nullptr; float scale = 1.f; int ccol = 0, vrow = 0;
        if (L < 512) { kind = 0; gain = aq; scale = C2Q; ccol = L; }
        else if (L < 640) { kind = 0; gain = ak; ccol = L; }
        else if (L < 768) { kind = 1; vrow = L - 640; }
        else if (L < 1280) { kind = 0; gain = bq; scale = C2Q; ccol = L - 128; }
        else if (L < 1792) { kind = 0; gain = bk; ccol = L - 128; }
        else { kind = 1; vrow = L - 1792 + 128; }
        if (kind == 0) {
            f32x4 gv[2][2];
#pragma unroll
            for (int bj = 0; bj < 2; ++bj)
#pragma unroll
                for (int n = 0; n < 2; ++n) gv[bj][n] = *(const f32x4*)(gain + 32 * bj + 8 * fq + 4 * n);
            float rsv[2][4]; rows_rstd(ssq, u.pm * BM + wr * 64 + fr, fq, rsv);
#pragma unroll
            for (int ai = 0; ai < 2; ++ai)
#pragma unroll
                for (int m = 0; m < 4; ++m) {
                    const int row = u.pm * BM + ai * HALF + wr * 64 + m * 16 + fr;
                    const float rs = rsv[ai][m];
                    float ss = 0.f;
#pragma unroll
                    for (int bj = 0; bj < 2; ++bj)
#pragma unroll
                        for (int n = 0; n < 2; ++n) { const f32x4 v = acc[ai][bj][m][n] * rs; ss += (v[0] * v[0] + v[1] * v[1]) + (v[2] * v[2] + v[3] * v[3]); }
                    ss += __shfl_xor(ss, 16); ss += __shfl_xor(ss, 32);
                    const float f = rs * __builtin_amdgcn_rsqf(ss * (1.0f / 64.0f) + 1e-6f) * scale;
                    bf16_t* rowp = QK + ((size_t)((row >> 6) * 26 + (ccol >> 6)) * 64 + (row & 63)) * 64 + 8 * fq;
#pragma unroll
                    for (int bj = 0; bj < 2; ++bj) {
                        const f32x4 v0 = acc[ai][bj][m][0] * f * gv[bj][0], v1 = acc[ai][bj][m][1] * f * gv[bj][1];
                        u32x4 w; w.x = cvt_pk_bf16(v0[0], v0[1]); w.y = cvt_pk_bf16(v0[2], v0[3]); w.z = cvt_pk_bf16(v1[0], v1[1]); w.w = cvt_pk_bf16(v1[2], v1[3]);
                        *(u32x4*)(rowp + 32 * bj) = w;
                    }
                }
        } else {
            PG8_LAS unsigned char* xl = xlds + (wr * 4 + wc) * 2048;
            const int lane = fq * 16 + fr;
            float rsv[2][4]; rows_rstd(ssq, u.pm * BM + wr * 64 + fr, fq, rsv);
#pragma unroll
            for (int ai = 0; ai < 2; ++ai) {
                float rs[4];
#pragma unroll
                for (int m = 0; m < 4; ++m) rs[m] = rsv[ai][m];
                const size_t tb = (size_t)(u.pm * 4 + ai * 2 + wr) * 640;
#pragma unroll
                for (int bj = 0; bj < 2; ++bj)
#pragma unroll
                    for (int n = 0; n < 2; ++n) {
#pragma unroll
                        for (int m = 0; m < 4; ++m) {
                            const f32x4 v = acc[ai][bj][m][n] * rs[m];
                            const unsigned w0 = cvt_pk_bf16(v[0], v[1]), w1 = cvt_pk_bf16(v[2], v[3]);
                            PG8_LAS bf16_t* q = (PG8_LAS bf16_t*)(xl + (4 * fq) * 128 + (16 * m + fr) * 2);
                            q[0] = (bf16_t)(w0 & 0xffffu); q[64] = (bf16_t)(w0 >> 16); q[128] = (bf16_t)(w1 & 0xffffu); q[192] = (bf16_t)(w1 >> 16);
                        }
                        asm volatile("s_waitcnt lgkmcnt(0)" ::: "memory");
                        const int c16 = lane >> 2, part = lane & 3;
                        const u32x4 a = *(const PG8_LAS u32x4*)(xl + c16 * 128 + part * 32), b = *(const PG8_LAS u32x4*)(xl + c16 * 128 + part * 32 + 16);
                        bf16_t* gp = VT + (tb + vrow + 32 * bj + 8 * (c16 >> 2) + 4 * n + (c16 & 3)) * 64 + part * 16;
                        *(u32x4*)gp = a; *(u32x4*)(gp + 8) = b;
                        asm volatile("s_waitcnt lgkmcnt(0)" ::: "memory");
                    }
            }
        }
    }
};

template <bool FINAL> struct EpiRes {
    static constexpr bool PERM = true, AFTER_DRAIN = false;
    bf16_t* X; float* out; float* ssq;
    __device__ __forceinline__ void operator()(const f32x4 (&acc)[2][2][4][2], const Unit& u, int wr, int wc, int fr, int fq) const {
        const int col0 = u.pn * BM + wc * 32 + 8 * fq;
        u32x4 xin[2][4][2];
#pragma unroll
        for (int ai = 0; ai < 2; ++ai)
#pragma unroll
            for (int m = 0; m < 4; ++m)
#pragma unroll
                for (int bj = 0; bj < 2; ++bj) xin[ai][m][bj] = *(const u32x4*)(X + (size_t)(u.pm * BM + ai * HALF + wr * 64 + m * 16 + fr) * 1024 + col0 + bj * HALF);
#pragma unroll
        for (int ai = 0; ai < 2; ++ai)
#pragma unroll
            for (int m = 0; m < 4; ++m) {
                const int row = u.pm * BM + ai * HALF + wr * 64 + m * 16 + fr;
                float ss = 0.f;
#pragma unroll
                for (int bj = 0; bj < 2; ++bj) {
                    bf16_t* xp = X + (size_t)row * 1024 + col0 + bj * HALF;
                    const u32x4 xv = xin[ai][m][bj];
                    f32x4 y0 = acc[ai][bj][m][0], y1 = acc[ai][bj][m][1];
                    y0[0] += bf_lo(xv.x); y0[1] += bf_hi(xv.x); y0[2] += bf_lo(xv.y); y0[3] += bf_hi(xv.y);
                    y1[0] += bf_lo(xv.z); y1[1] += bf_hi(xv.z); y1[2] += bf_lo(xv.w); y1[3] += bf_hi(xv.w);
                    if (FINAL) {
                        float* op = out + (size_t)row * 1024 + col0 + bj * HALF;
                        *(f32x4*)op = y0; *(f32x4*)(op + 4) = y1;
                    } else {
                        u32x4 w; w.x = cvt_pk_bf16(y0[0], y0[1]); w.y = cvt_pk_bf16(y0[2], y0[3]); w.z = cvt_pk_bf16(y1[0], y1[1]); w.w = cvt_pk_bf16(y1[2], y1[3]);
                        *(u32x4*)xp = w;
                        ss += (y0[0] * y0[0] + y0[1] * y0[1]) + (y0[2] * y0[2] + y0[3] * y0[3]) + (y1[0] * y1[0] + y1[1] * y1[1]) + (y1[2] * y1[2] + y1[3] * y1[3]);
                    }
                }
                if (!FINAL) {
                    ss += __shfl_xor(ss, 16); ss += __shfl_xor(ss, 32);
                    if (fq == 0) ssq[(size_t)row * 16 + u.pn * 4 + wc] = ss;
                }
            }
    }
};

struct EpiGlu {
    static constexpr bool PERM = true, AFTER_DRAIN = false;
    bf16_t* H; const float* ssq;
    __device__ __forceinline__ void operator()(const f32x4 (&acc)[2][2][4][2], const Unit& u, int wr, int wc, int fr, int fq) const {
        const int col0 = u.pn * HALF + wc * 32 + 8 * fq;
        float rsv[2][4]; rows_rstd(ssq, u.pm * BM + wr * 64 + fr, fq, rsv);
#pragma unroll
        for (int ai = 0; ai < 2; ++ai)
#pragma unroll
            for (int m = 0; m < 4; ++m) {
                const int row = u.pm * BM + ai * HALF + wr * 64 + m * 16 + fr;
                const float rs = rsv[ai][m];
                float h[8];
#pragma unroll
                for (int n = 0; n < 2; ++n)
#pragma unroll
                    for (int i = 0; i < 4; ++i) { const float g = acc[ai][0][m][n][i] * rs, up = acc[ai][1][m][n][i] * rs; h[4 * n + i] = g * up * fast_sigmoid(g); }
                u32x4 w; w.x = cvt_pk_bf16(h[0], h[1]); w.y = cvt_pk_bf16(h[2], h[3]); w.z = cvt_pk_bf16(h[4], h[5]); w.w = cvt_pk_bf16(h[6], h[7]);
                *(u32x4*)(H + (size_t)row * 2816 + col0) = w;
            }
    }
};

struct EpiConvIn {
    static constexpr bool PERM = true, AFTER_DRAIN = false;
    bf16_t* O; const float* ssq;
    __device__ __forceinline__ void operator()(const f32x4 (&acc)[2][2][4][2], const Unit& u, int wr, int wc, int fr, int fq) const {
        float rsv[2][4]; rows_rstd(ssq, u.pm * BM + wr * 64 + fr, fq, rsv);
#pragma unroll
        for (int ai = 0; ai < 2; ++ai)
#pragma unroll
            for (int m = 0; m < 4; ++m) {
                const int row = u.pm * BM + ai * HALF + wr * 64 + m * 16 + fr;
                const float rs = rsv[ai][m];
                bf16_t* rp = O + (size_t)row * 1536 + wc * 32 + 8 * fq;
                if (u.pn < 2) {
#pragma unroll
                    for (int bj = 0; bj < 2; ++bj) {
                        const f32x4 v0 = acc[ai][bj][m][0] * rs, v1 = acc[ai][bj][m][1] * rs;
                        u32x4 w; w.x = cvt_pk_bf16(v0[0], v0[1]); w.y = cvt_pk_bf16(v0[2], v0[3]); w.z = cvt_pk_bf16(v1[0], v1[1]); w.w = cvt_pk_bf16(v1[2], v1[3]);
                        *(u32x4*)(rp + u.pn * BM + bj * HALF) = w;
                    }
                } else {
                    float h[8];
                    const bool glu = u.pn >= 6;
#pragma unroll
                    for (int n = 0; n < 2; ++n)
#pragma unroll
                        for (int i = 0; i < 4; ++i) { const float a = acc[ai][0][m][n][i] * rs, b = acc[ai][1][m][n][i] * rs; h[4 * n + i] = glu ? a * fast_sigmoid(b) : a * b; }
                    u32x4 w; w.x = cvt_pk_bf16(h[0], h[1]); w.y = cvt_pk_bf16(h[2], h[3]); w.z = cvt_pk_bf16(h[4], h[5]); w.w = cvt_pk_bf16(h[6], h[7]);
                    *(u32x4*)(rp + 512 + (u.pn - 2) * HALF) = w;
                }
            }
    }
};

struct EpiPlain {
    static constexpr bool PERM = true, AFTER_DRAIN = false;
    bf16_t* O; int ldc; const float* ssq;
    __device__ __forceinline__ void operator()(const f32x4 (&acc)[2][2][4][2], const Unit& u, int wr, int wc, int fr, int fq) const {
        const int col0 = u.pn * BM + wc * 32 + 8 * fq;
#pragma unroll
        for (int ai = 0; ai < 2; ++ai)
#pragma unroll
            for (int m = 0; m < 4; ++m) {
                const int row = u.pm * BM + ai * HALF + wr * 64 + m * 16 + fr;
                const float rs = row_rstd(ssq, row);
#pragma unroll
                for (int bj = 0; bj < 2; ++bj) {
                    const f32x4 v0 = acc[ai][bj][m][0] * rs, v1 = acc[ai][bj][m][1] * rs;
                    u32x4 w; w.x = cvt_pk_bf16(v0[0], v0[1]); w.y = cvt_pk_bf16(v0[2], v0[3]); w.z = cvt_pk_bf16(v1[0], v1[1]); w.w = cvt_pk_bf16(v1[2], v1[3]);
                    *(u32x4*)(O + (size_t)row * ldc + col0 + bj * HALF) = w;
                }
            }
    }
};

template <class Epi, class Sched, bool ALIGN_EPI = false, bool SP2 = false>
__device__ __forceinline__ void gemm_phase(PG8_LAS unsigned char* lds, const Gemm g, const Sched& S, const Epi& E) {
    const int tid = threadIdx.x, wid = __builtin_amdgcn_readfirstlane(tid >> 6), lane = tid & 63, wr = wid >> 2, wc = wid & 3, fr = lane & 15, fq = lane >> 4;
    const int K = g.K, nt = K / BK;
    unsigned voffA[2], voffB[2];
#pragma unroll
    for (int i = 0; i < 2; ++i) { int R, C; stage_rc(tid * 16 + i * 8192, R, C); const int Rb = Epi::PERM ? ((R & ~31) + perm32(R & 31)) : R;
        voffA[i] = (unsigned)(R * K + C) * 2u; voffB[i] = (unsigned)(Rb * K + C) * 2u; }
    const size_t kstep = (size_t)(BK * 2);
    const size_t hstep = (size_t)HALF * K * 2;
    const size_t tstep = 2 * hstep;
    const unsigned ldsw = (unsigned)wid * 1024u;
    const int aoff = lds_byte(wr * 64 + fr, fq * 8), boff = lds_byte(wc * 32 + fr, fq * 8);
#define PG8_SA(b, h) (((b) * 2 + (h)) * HTB)
#define PG8_SB(b, h) ((4 + (b) * 2 + (h)) * HTB)
#define PG8_STAGE(bufoff, gbase, voff) do { _Pragma("unroll") for (int _i = 0; _i < 2; ++_i) \
        __builtin_amdgcn_global_load_lds((const unsigned*)((const char*)(gbase) + (voff)[_i]), (PG8_LAS unsigned*)(lds + (bufoff) + ldsw + _i * 8192), 16, 0, 0); } while (0)
#define PG8_LDA(dst, b, h) do { _Pragma("unroll") for (int m = 0; m < 4; ++m) _Pragma("unroll") for (int k = 0; k < 2; ++k) dst[m][k] = *(const PG8_LAS bf16x8*)(lds + PG8_SA(b, h) + aoff + m * 2048 + k * 1024); } while (0)
#define PG8_LDB(dst, b, h) do { _Pragma("unroll") for (int n = 0; n < 2; ++n) _Pragma("unroll") for (int k = 0; k < 2; ++k) dst[n][k] = *(const PG8_LAS bf16x8*)(lds + PG8_SB(b, h) + boff + n * 2048 + k * 1024); } while (0)
#define PG8_MMA(ai, bj, At, Bt) do { __builtin_amdgcn_s_setprio(1); _Pragma("unroll") for (int m = 0; m < 4; ++m) _Pragma("unroll") for (int n = 0; n < 2; ++n) _Pragma("unroll") for (int k = 0; k < 2; ++k) \
        acc[ai][bj][m][n] = __builtin_amdgcn_mfma_f32_16x16x32_bf16(Bt[n][k], At[m][k], acc[ai][bj][m][n], 0, 0, 0); __builtin_amdgcn_s_setprio(0); } while (0)
#define PG8_WAIT_V(n) asm volatile("s_waitcnt vmcnt(" #n ")" ::: "memory")
#define PG8_WAIT_L(n) asm volatile("s_waitcnt lgkmcnt(" #n ")" ::: "memory")
#define PG8_BAR __builtin_amdgcn_s_barrier()
#define PG8_SCHED __builtin_amdgcn_sched_barrier(0)
    Unit cur, nxt; int ui = 0;
    if (!S.next(0, cur)) return;
    f32x4 acc[2][2][4][2];
#pragma unroll
    for (int a = 0; a < 2; ++a)
#pragma unroll
        for (int b = 0; b < 2; ++b)
#pragma unroll
            for (int m = 0; m < 4; ++m)
#pragma unroll
                for (int n = 0; n < 2; ++n) acc[a][b][m][n] = (f32x4){0.f, 0.f, 0.f, 0.f};
    bf16x8 At[4][2], B0[2][2], B1[2][2];
    const char* cA = (const char*)g.A + (size_t)cur.pm * tstep; const char* cB = (const char*)g.Bt + (size_t)cur.pn * tstep;
    S.a_ready(cur);
    if constexpr (SP2) {
        PG8_STAGE(PG8_SB(0, 0), cB, voffB); PG8_STAGE(PG8_SB(0, 1), cB + hstep, voffB); PG8_STAGE(PG8_SA(0, 0), cA, voffA); PG8_STAGE(PG8_SA(0, 1), cA + hstep, voffA);
        if (wr == 1) PG8_BAR;
        PG8_WAIT_V(2); PG8_BAR;
        PG8_STAGE(PG8_SB(1, 0), cB + kstep, voffB); PG8_STAGE(PG8_SA(1, 0), cA + kstep, voffA); PG8_STAGE(PG8_SB(1, 1), cB + hstep + kstep, voffB);
        PG8_WAIT_V(6); PG8_BAR;
    } else {
        PG8_STAGE(PG8_SB(0, 0), cB, voffB); PG8_STAGE(PG8_SA(0, 0), cA, voffA); PG8_STAGE(PG8_SB(0, 1), cB + hstep, voffB); PG8_STAGE(PG8_SA(0, 1), cA + hstep, voffA);
        if (wr == 1) PG8_BAR;
        PG8_WAIT_V(4); PG8_BAR;
        PG8_STAGE(PG8_SB(1, 0), cB + kstep, voffB); PG8_STAGE(PG8_SA(1, 0), cA + kstep, voffA); PG8_STAGE(PG8_SB(1, 1), cB + hstep + kstep, voffB);
        PG8_WAIT_V(6); PG8_BAR;
    }
    for (;;) {
        const bool has_next = S.next(ui + 1, nxt);
        const char* nA = has_next ? (const char*)g.A + (size_t)nxt.pm * tstep : cA; const char* nB = has_next ? (const char*)g.Bt + (size_t)nxt.pn * tstep : cB;
        for (int t = 0; t < nt; t += 2) {
            const bool last = (t == nt - 2);
            const char* a1 = cA + (size_t)(t + 1) * kstep;
            const char* a2 = last ? nA : cA + (size_t)(t + 2) * kstep; const char* b2 = last ? nB : cB + (size_t)(t + 2) * kstep;
            const char* a3 = a2 + kstep; const char* b3 = b2 + kstep;
            if (last && has_next) S.a_ready(nxt);
            if constexpr (SP2) {
            PG8_LDB(B0, 0, 0); PG8_LDB(B1, 0, 1); PG8_SCHED; PG8_LDA(At, 0, 0); PG8_STAGE(PG8_SA(1, 1), a1 + hstep, voffA);
            PG8_WAIT_V(8); PG8_WAIT_L(0); PG8_BAR; PG8_MMA(0, 0, At, B0); PG8_MMA(0, 1, At, B1); PG8_BAR; PG8_SCHED;
            PG8_LDA(At, 0, 1); PG8_STAGE(PG8_SB(0, 0), b2, voffB); PG8_STAGE(PG8_SB(0, 1), b2 + hstep, voffB); PG8_STAGE(PG8_SA(0, 0), a2, voffA);
            PG8_WAIT_V(8); PG8_WAIT_L(0); PG8_BAR; PG8_MMA(1, 0, At, B0); PG8_MMA(1, 1, At, B1); PG8_BAR; PG8_SCHED;
            PG8_LDB(B0, 1, 0); PG8_LDB(B1, 1, 1); PG8_SCHED; PG8_LDA(At, 1, 0); PG8_STAGE(PG8_SA(0, 1), a2 + hstep, voffA);
            PG8_WAIT_V(8); PG8_WAIT_L(0); PG8_BAR; PG8_MMA(0, 0, At, B0); PG8_MMA(0, 1, At, B1); PG8_BAR; PG8_SCHED;
            PG8_LDA(At, 1, 1); PG8_STAGE(PG8_SB(1, 0), b3, voffB); PG8_STAGE(PG8_SB(1, 1), b3 + hstep, voffB); PG8_STAGE(PG8_SA(1, 0), a3, voffA);
            PG8_WAIT_V(8); PG8_WAIT_L(0); PG8_BAR; PG8_MMA(1, 0, At, B0); PG8_MMA(1, 1, At, B1); PG8_BAR; PG8_SCHED;
            } else {
            PG8_LDB(B0, 0, 0); PG8_SCHED; PG8_LDA(At, 0, 0); PG8_STAGE(PG8_SA(1, 1), a1 + hstep, voffA);
            PG8_WAIT_L(8); PG8_BAR; PG8_WAIT_L(0); PG8_MMA(0, 0, At, B0); PG8_BAR; PG8_SCHED;
            PG8_LDB(B1, 0, 1); PG8_STAGE(PG8_SB(0, 0), b2, voffB);
            PG8_BAR; PG8_WAIT_L(0); PG8_MMA(0, 1, At, B1); PG8_BAR;
            PG8_LDA(At, 0, 1); PG8_STAGE(PG8_SA(0, 0), a2, voffA);
            PG8_BAR; PG8_WAIT_L(0); PG8_MMA(1, 0, At, B0); PG8_BAR; PG8_SCHED;
            PG8_STAGE(PG8_SB(0, 1), b2 + hstep, voffB);
            PG8_WAIT_V(6); PG8_BAR; PG8_MMA(1, 1, At, B1); PG8_BAR;
            PG8_LDB(B0, 1, 0); PG8_SCHED; PG8_LDA(At, 1, 0); PG8_STAGE(PG8_SA(0, 1), a2 + hstep, voffA);
            PG8_WAIT_L(8); PG8_BAR; PG8_WAIT_L(0); PG8_MMA(0, 0, At, B0); PG8_BAR; PG8_SCHED;
            PG8_LDB(B1, 1, 1); PG8_STAGE(PG8_SB(1, 0), b3, voffB);
            PG8_BAR; PG8_WAIT_L(0); PG8_MMA(0, 1, At, B1); PG8_BAR;
            PG8_LDA(At, 1, 1); PG8_STAGE(PG8_SA(1, 0), a3, voffA);
            PG8_BAR; PG8_WAIT_L(0); PG8_MMA(1, 0, At, B0); PG8_BAR; PG8_SCHED;
            PG8_STAGE(PG8_SB(1, 1), b3 + hstep, voffB);
            PG8_WAIT_V(6); PG8_BAR; PG8_MMA(1, 1, At, B1); PG8_BAR;
            }
        }
        if constexpr (ALIGN_EPI) { if (wr == 0) PG8_BAR; }
        if constexpr (!Epi::AFTER_DRAIN) { E(acc, cur, wr, wc, fr, fq); S.done(cur); }
        if (!has_next) break;
#pragma unroll
        for (int a = 0; a < 2; ++a)
#pragma unroll
            for (int b = 0; b < 2; ++b)
#pragma unroll
                for (int m = 0; m < 4; ++m)
#pragma unroll
                    for (int n = 0; n < 2; ++n) acc[a][b][m][n] = (f32x4){0.f, 0.f, 0.f, 0.f};
        cur = nxt; cA = nA; cB = nB; ++ui;
        if constexpr (ALIGN_EPI) { if (wr == 1) PG8_BAR; }
    }
    PG8_WAIT_V(0);
    if constexpr (!ALIGN_EPI) { if (wr == 0) PG8_BAR; }
    PG8_BAR;
    if constexpr (Epi::AFTER_DRAIN) { E.fused(acc, cur, wr, wc, fr, fq, lds, wid, lane); S.done(cur); }
#undef PG8_SA
#undef PG8_SB
#undef PG8_STAGE
#undef PG8_LDA
#undef PG8_LDB
#undef PG8_MMA
#undef PG8_WAIT_V
#undef PG8_WAIT_L
#undef PG8_BAR
#undef PG8_SCHED
}
}
namespace att {
using pg8::bf16_t; using pg8::bf16x8; using pg8::f32x4; using pg8::u32x4; using pg8::u32x2; using pg8::cvt_pk_bf16; using pg8::QKW; using pg8::VT_PITCH;
typedef float f32x16 __attribute__((ext_vector_type(16)));
#define ALAS __attribute__((address_space(3)))
constexpr int OFF_K0 = 0, OFF_K1 = 8192, OFF_V = 16384, STAGE = 32768, NSTG = 4, OFF_LUT = NSTG * STAGE;
constexpr int OFF_SUB = OFF_LUT + 12 * 260 * 4;
constexpr int ATT_LDS = OFF_SUB + 512;
__device__ __forceinline__ int pi32(int r) { return (r & ~12) | ((r & 4) << 1) | ((r & 8) >> 1); }
__device__ __forceinline__ int t5_bucket(int rel) {
    const int n = rel < 0 ? -rel : rel;
    int b = n < 8 ? n : (n < 12 ? 8 : n < 16 ? 9 : n < 23 ? 10 : n < 32 ? 11 : n < 46 ? 12 : n < 64 ? 13 : n < 91 ? 14 : 15);
    return b + (rel > 0 ? 16 : 0);
}

__device__ __forceinline__ void glds16(const void* gsrc, unsigned lds_dst) { unsigned keep;
    asm volatile("s_mov_b32 %0, m0\n\ts_mov_b32 m0, %2\n\ts_nop 0\n\tglobal_load_lds_dwordx4 %1, off\n\ts_mov_b32 m0, %0" : "=&s"(keep) : "v"(gsrc), "s"(lds_dst) : "memory"); }
typedef float f32x2_t __attribute__((ext_vector_type(2))); typedef __bf16 bf16x2_t __attribute__((ext_vector_type(2)));
__device__ __forceinline__ unsigned cvtpk_s(float lo, float hi) { f32x2_t v = {lo, hi}; bf16x2_t b = __builtin_convertvector(v, bf16x2_t); return __builtin_bit_cast(unsigned, b); }
template <int N> __device__ __forceinline__ void wait_bar() { asm volatile("s_waitcnt vmcnt(%0) lgkmcnt(0)\n\ts_barrier" :: "n"(N) : "memory"); }

template <bool WIN>
__device__ __forceinline__ void attn_unit(ALAS unsigned char* lds, const bf16_t* __restrict__ QK, const bf16_t* __restrict__ VT, bf16_t* __restrict__ Y,
                                          const float* __restrict__ rel_bias, const float* __restrict__ sinkp, const float* __restrict__ subln, float lam,
                                          int seq_base, int S, int q0, int hsel) {
    constexpr float LOG2E = 1.4426950408889634f;
    constexpr int NDB = WIN ? 2 : 4;
    const int tid = threadIdx.x, lane = tid & 63, l31 = lane & 31, hi = lane >> 5;
    const int wid = __builtin_amdgcn_readfirstlane(tid >> 6), half = wid >> 2, wq = wid & 3;
    const int qw = q0 + 32 * wq;
    int qcol, kcol0, kcol1, vrow0, bhead;
    if (WIN) { qcol = (2 * hsel + half) * 64; kcol0 = 512 + (hsel >> 1) * 64; kcol1 = kcol0; vrow0 = (hsel >> 1) * 64; bhead = 2 * hsel; }
    else { qcol = 640 + (2 * hsel + half) * 64; kcol0 = 1152 + (2 * hsel) * 64; kcol1 = kcol0 + 64; vrow0 = 128 + hsel * 128; bhead = 8 + hsel; }
    const ALAS float* lut = (const ALAS float*)(lds + OFF_LUT) + (WIN ? (bhead + half) : bhead) * 260;

    const int t_lo = WIN ? (q0 >= 128 ? (q0 - 128) / 64 : 0) : 0;
    const int t_hi = WIN ? ((q0 + 256) / 64 < S / 64 ? (q0 + 256) / 64 : S / 64) : S / 64;
    const int NT = t_hi - t_lo;
    const unsigned ldsb = (unsigned)(uintptr_t)lds;
    const int drow = 8 * wid + (lane >> 3), dch = (lane & 7) ^ ((4 * wid + (lane >> 4)) & 7);
    const bf16_t* kg = QK + ((size_t)((seq_base >> 6) + t_lo) * 26 * 64 + drow) * 64 + dch * 8 + kcol0 * 64;
    const bf16_t* vg = VT + ((size_t)((seq_base >> 6) + t_lo) * 640 + vrow0 + drow) * 64 + dch * 8;
    const unsigned dk = ldsb + wid * 1024;
#define AT_DMA(tr) do { const unsigned sb_ = (unsigned)__builtin_amdgcn_readfirstlane(dk + (((tr) & (NSTG - 1)) * STAGE)); const size_t ko_ = (size_t)(tr) * 26 * 4096, vo_ = (size_t)(tr) * 640 * 64; \
        glds16(kg + ko_, sb_ + OFF_K0); if (!WIN) glds16(kg + ko_ + 4096, sb_ + OFF_K1); glds16(vg + vo_, sb_ + OFF_V); if (!WIN) glds16(vg + vo_ + 64 * 64, sb_ + OFF_V + 8192); } while (0)
    constexpr int NPW = WIN ? 2 : 4;
    bf16x8 qfr[4];
    { const int qrow = seq_base + qw + l31; const bf16_t* qp = QK + ((size_t)((qrow >> 6) * 26 + (qcol >> 6)) * 64 + (qrow & 63)) * 64 + hi * 8;
#pragma unroll
      for (int ds = 0; ds < 4; ++ds) qfr[ds] = *(const bf16x8*)(qp + ds * 16); }
#define qf(ds) qfr[ds]
    AT_DMA(0); if (NT > 1) AT_DMA(1); if (NT > 2) AT_DMA(2);
    constexpr float THR = 8.0f;
    float m_ref = WIN ? sinkp[2 * hsel + half] * LOG2E : 0.f;
    float l_run = (WIN && hi == 0) ? 1.f : 0.f;
    float cbase = 0.f;
    f32x16 cvec;
#pragma unroll
    for (int r = 0; r < 16; ++r) cvec[r] = cbase - m_ref;
    f32x16 o[NDB];
#pragma unroll
    for (int db = 0; db < NDB; ++db)
#pragma unroll
        for (int r = 0; r < 16; ++r) o[db][r] = 0.f;
    const int krow = pi32(l31), fK = (krow >> 1) & 7, fV = (l31 >> 1) & 7;
    int kx[4], vx[4];
#pragma unroll
    for (int c = 0; c < 4; ++c) { kx[c] = (WIN ? OFF_K0 : (half ? OFF_K1 : OFF_K0)) + krow * 128 + (((2 * c + hi) ^ fK) << 4); vx[c] = OFF_V + l31 * 128 + (((2 * c + hi) ^ fV) << 4); }
    const int qabs = qw + l31;
    const float cfar_lo = __uint_as_float(__builtin_amdgcn_readfirstlane(__float_as_uint(lut[0]))), cfar_hi = __uint_as_float(__builtin_amdgcn_readfirstlane(__float_as_uint(lut[256])));
    asm volatile("" : "+v"(qfr[0]), "+v"(qfr[1]), "+v"(qfr[2]), "+v"(qfr[3]));
#pragma clang loop unroll(disable)
    for (int tr = 0; tr < NT; ++tr) {
        if (tr + 2 < NT) wait_bar<2 * NPW>(); else if (tr + 1 < NT) wait_bar<NPW>(); else wait_bar<0>();
        if (tr + 3 < NT) AT_DMA(tr + 3);
        const int k0 = (t_lo + tr) * 64;
        const bool skip = WIN && (k0 > qw + 31 + 128 || k0 + 63 < qw - 128);
        if (!skip) {
            const bool near = WIN || ((k0 - (qw + 31)) < 128 && (qw - (k0 + 63)) < 128);
            const float cinit = near ? 0.f : (k0 > qw ? cfar_hi : cfar_lo);
            if (__builtin_expect(cinit != cbase, 0)) { cbase = cinit; asm volatile("" ::: "memory");
#pragma unroll
                for (int r = 0; r < 16; ++r) cvec[r] = cbase - m_ref; }
            f32x16 s0, s1;
            const ALAS unsigned char* sb = lds + (tr & (NSTG - 1)) * STAGE;
            {
                bf16x8 ka[8];
#pragma unroll
                for (int ds = 0; ds < 4; ++ds) { ka[2 * ds] = *(const ALAS bf16x8*)(sb + kx[ds]); ka[2 * ds + 1] = *(const ALAS bf16x8*)(sb + kx[ds] + 4096); }
                __builtin_amdgcn_sched_barrier(0);
                s0 = __builtin_amdgcn_mfma_f32_32x32x16_bf16(ka[0], qf(0), cvec, 0, 0, 0);
                s1 = __builtin_amdgcn_mfma_f32_32x32x16_bf16(ka[1], qf(0), cvec, 0, 0, 0);
#pragma unroll
                for (int ds = 1; ds < 4; ++ds) {
                    s0 = __builtin_amdgcn_mfma_f32_32x32x16_bf16(ka[2 * ds], qf(ds), s0, 0, 0, 0);
                    s1 = __builtin_amdgcn_mfma_f32_32x32x16_bf16(ka[2 * ds + 1], qf(ds), s1, 0, 0, 0);
                }
            }
            bf16x8 va[2 * NDB], vc[2 * NDB];
#pragma unroll
            for (int kk = 0; kk < 2; ++kk)
#pragma unroll
                for (int db = 0; db < NDB; ++db) va[kk * NDB + db] = *(const ALAS bf16x8*)(sb + vx[kk] + db * 4096);
            __builtin_amdgcn_sched_barrier(0);
            if (near) {
#pragma unroll
                for (int r = 0; r < 16; ++r) {
                    const int rel = k0 + 16 * (r >> 3) + 8 * hi + (r & 7) - qabs;
                    const int i0 = (rel < -128 ? -128 : (rel > 128 ? 128 : rel)) + 128;
                    const int rel1 = rel + 32;
                    const int i1 = (rel1 < -128 ? -128 : (rel1 > 128 ? 128 : rel1)) + 128;
                    s0[r] += lut[i0]; s1[r] += lut[i1];
                    if (WIN) { if (rel < -128 || rel > 128) s0[r] = -1e30f; if (rel1 < -128 || rel1 > 128) s1[r] = -1e30f; }
                    if ((r & 3) == 3) __builtin_amdgcn_sched_barrier(0);
                }
            }
#define MX3(a, b, c) __builtin_fmaxf(__builtin_fmaxf((a), (b)), (c))
            float mxa = MX3(s0[0], s0[1], s1[0]), mxb = MX3(s0[2], s0[3], s1[1]);
            mxa = MX3(mxa, s1[2], s1[3]);
#pragma unroll
            for (int r = 4; r < 16; r += 4) { mxa = MX3(mxa, s0[r], s0[r + 1]); mxb = MX3(mxb, s0[r + 2], s0[r + 3]); mxa = MX3(mxa, s1[r], s1[r + 1]); mxb = MX3(mxb, s1[r + 2], s1[r + 3]); }
#undef MX3
            float mx = fmaxf(mxa, mxb);
            if (__any(mx > THR)) {
                mx = fmaxf(mx, __shfl_xor(mx, 32));
                const float dl = fmaxf(mx, 0.f);
                m_ref += dl;
                const float f = __builtin_amdgcn_exp2f(-dl);
                l_run *= f;
#pragma unroll
                for (int db = 0; db < NDB; ++db)
#pragma unroll
                    for (int r = 0; r < 16; ++r) o[db][r] *= f;
#pragma unroll
                for (int r = 0; r < 16; ++r) { s0[r] -= dl; s1[r] -= dl; cvec[r] = cbase - m_ref; }
            }
            float ls0 = 0.f, ls1 = 0.f;
#define AT_EXP(SS, B, PF) do { \
                const float e0 = __builtin_amdgcn_exp2f(SS[B + 0]), e1 = __builtin_amdgcn_exp2f(SS[B + 1]), e2 = __builtin_amdgcn_exp2f(SS[B + 2]), e3 = __builtin_amdgcn_exp2f(SS[B + 3]); \
                const float e4 = __builtin_amdgcn_exp2f(SS[B + 4]), e5 = __builtin_amdgcn_exp2f(SS[B + 5]), e6 = __builtin_amdgcn_exp2f(SS[B + 6]), e7 = __builtin_amdgcn_exp2f(SS[B + 7]); \
                ls0 += e0; ls1 += e4; ls0 += e1; ls1 += e5; ls0 += e2; ls1 += e6; ls0 += e3; ls1 += e7; \
                PF.u.x = cvtpk_s(e0, e1); PF.u.y = cvtpk_s(e2, e3); PF.u.z = cvtpk_s(e4, e5); PF.u.w = cvtpk_s(e6, e7); } while (0)
            union PFU { u32x4 u; bf16x8 b; };
            PFU p0, p1, p2, p3;
            AT_EXP(s0, 0, p0);
#pragma unroll
            for (int kk = 0; kk < 2; ++kk)
#pragma unroll
                for (int db = 0; db < NDB; ++db) vc[kk * NDB + db] = *(const ALAS bf16x8*)(sb + vx[kk + 2] + db * 4096);
            __builtin_amdgcn_sched_barrier(0);
#pragma unroll
            for (int db = 0; db < NDB; ++db) o[db] = __builtin_amdgcn_mfma_f32_32x32x16_bf16(va[db], p0.b, o[db], 0, 0, 0);
            AT_EXP(s0, 8, p1);
            __builtin_amdgcn_sched_barrier(0);
#pragma unroll
            for (int db = 0; db < NDB; ++db) o[db] = __builtin_amdgcn_mfma_f32_32x32x16_bf16(va[NDB + db], p1.b, o[db], 0, 0, 0);
            AT_EXP(s1, 0, p2);
            __builtin_amdgcn_sched_barrier(0);
#pragma unroll
            for (int db = 0; db < NDB; ++db) o[db] = __builtin_amdgcn_mfma_f32_32x32x16_bf16(vc[db], p2.b, o[db], 0, 0, 0);
            AT_EXP(s1, 8, p3);
            __builtin_amdgcn_sched_barrier(0);
#pragma unroll
            for (int db = 0; db < NDB; ++db) o[db] = __builtin_amdgcn_mfma_f32_32x32x16_bf16(vc[NDB + db], p3.b, o[db], 0, 0, 0);
            __builtin_amdgcn_sched_barrier(0);
#undef AT_EXP
            l_run += ls0 + ls1;
        }
    }
    asm volatile("s_waitcnt lgkmcnt(0)\n\ts_barrier" ::: "memory");
#undef qf
#undef AT_DMA
    const float l_tot = l_run + __shfl_xor(l_run, 32);
    const float inv = 1.0f / l_tot;
    const size_t orow = (size_t)(seq_base + qw + l31) * 1024;
    if (WIN) {
        bf16_t* yp = Y + orow + (2 * hsel + half) * 64 + 4 * hi;
#pragma unroll
        for (int db = 0; db < NDB; ++db)
#pragma unroll
            for (int g = 0; g < 4; ++g) {
                u32x2 w; w.x = cvt_pk_bf16(o[db][4 * g] * inv, o[db][4 * g + 1] * inv); w.y = cvt_pk_bf16(o[db][4 * g + 2] * inv, o[db][4 * g + 3] * inv);
                *(u32x2*)(yp + 32 * db + 8 * g) = w;
            }
    } else {
        ALAS f32x4* xch = (ALAS f32x4*)lds + (size_t)wq * 1024 + l31;
        if (half == 1) {
#pragma unroll
            for (int db = 0; db < NDB; ++db)
#pragma unroll
                for (int g = 0; g < 4; ++g) { f32x4 v; v[0] = o[db][4 * g] * inv; v[1] = o[db][4 * g + 1] * inv; v[2] = o[db][4 * g + 2] * inv; v[3] = o[db][4 * g + 3] * inv;
                    xch[(8 * db + 2 * g + hi) * 32] = v; }
        }
        __syncthreads();
        if (half == 0) {
            float ss = 0.f;
#pragma unroll
            for (int db = 0; db < NDB; ++db)
#pragma unroll
                for (int g = 0; g < 4; ++g) { const f32x4 v = xch[(8 * db + 2 * g + hi) * 32];
#pragma unroll
                    for (int i = 0; i < 4; ++i) { const float x = o[db][4 * g + i] * inv - lam * v[i]; o[db][4 * g + i] = x; ss += x * x; } }
            ss += __shfl_xor(ss, 32);
            const float rn = __builtin_amdgcn_rsqf(ss * (1.0f / 128.0f) + 1e-6f) * 0.8f;
            bf16_t* yp = Y + orow + 512 + hsel * 128 + 4 * hi;
#pragma unroll
            for (int db = 0; db < NDB; ++db)
#pragma unroll
                for (int g = 0; g < 4; ++g) { const f32x4 gsc = *(const ALAS f32x4*)(lds + OFF_SUB + (32 * db + 8 * g + 4 * hi) * 4);
                    u32x2 w; w.x = cvt_pk_bf16(o[db][4 * g] * rn * gsc[0], o[db][4 * g + 1] * rn * gsc[1]); w.y = cvt_pk_bf16(o[db][4 * g + 2] * rn * gsc[2], o[db][4 * g + 3] * rn * gsc[3]);
                    *(u32x2*)(yp + 32 * db + 8 * g) = w; }
        }
        __syncthreads();
    }
}

__device__ __forceinline__ void attn_phase(ALAS unsigned char* lds, const bf16_t* QK, const bf16_t* VT, bf16_t* Y, const float* rel_bias, const float* sinkp, const float* subln, const float* blam) {
    float lam;
    { const int lane = threadIdx.x & 63; float a = blam[lane] * blam[64 + lane], b = blam[128 + lane] * blam[192 + lane];
#pragma unroll
      for (int o = 1; o < 64; o <<= 1) { a += __shfl_xor(a, o); b += __shfl_xor(b, o); }
      lam = __expf(a) - __expf(b) + 0.2f; }
    { constexpr float LOG2E = 1.4426950408889634f; ALAS float* lutw = (ALAS float*)(lds + OFF_LUT);
      for (int i = threadIdx.x; i < 12 * 257; i += 512) { const int hh = i / 257, ri = i - hh * 257; lutw[hh * 260 + ri] = rel_bias[t5_bucket(ri - 128) * 12 + hh] * LOG2E; }
      if (threadIdx.x < 128) ((ALAS float*)(lds + OFF_SUB))[threadIdx.x] = subln[threadIdx.x];
      __syncthreads(); }
    const int G = gridDim.x, bx = blockIdx.x;
    for (int u = bx; u < 2048; u += G) { const int qb = u & 63, bh = u >> 6; attn_unit<false>(lds, QK, VT, Y, rel_bias, sinkp, subln, lam, (bh >> 2) * 8192, 8192, qb * 128, bh & 3); }
    for (int u = bx; u < 2048; u += G) { const int qb = u & 15, bh = u >> 4; attn_unit<false>(lds, QK, VT, Y, rel_bias, sinkp, subln, lam, 65536 + (bh >> 2) * 2048, 2048, qb * 128, bh & 3); }
    for (int u = bx; u < 4096; u += G) { const int hp = u & 3, qb = u >> 2;
        const int row0 = qb * 128; int seq_base, S;
        if (row0 < 65536) { seq_base = row0 & ~8191; S = 8192; } else { seq_base = row0 & ~2047; S = 2048; }
        attn_unit<true>(lds, QK, VT, Y, rel_bias, sinkp, subln, lam, seq_base, S, row0 - seq_base, hp); }
}
}

namespace cv {
using pg8::bf16_t; using pg8::f32x4; using pg8::u32x4; using pg8::cvt_pk_bf16; using pg8::bf_lo; using pg8::bf_hi; using pg8::fast_sigmoid;
#define CLAS __attribute__((address_space(3)))
constexpr int T = 32, HALO = 15, ROWS = T + 2 * HALO;
constexpr int OFF_U0 = 0, OFF_U1 = 64 * 1024;
constexpr int CONV_LDS = OFF_U1 + T * 512 * 4;
__device__ __forceinline__ void conv_unit(CLAS unsigned char* lds, const bf16_t* __restrict__ PC, bf16_t* __restrict__ YC, const float* __restrict__ w3, const float* __restrict__ w31,
                                          const float* __restrict__ dwb, const float* __restrict__ lng, const float* __restrict__ lnb, int seq_base, int S, int t0) {
    const int tid = threadIdx.x;
    {
        u32x4 w8[8];
#pragma unroll
        for (int it = 0; it < 8; ++it) { const int idx = tid + 512 * it, j = idx >> 6, v = idx & 63, tok = t0 - HALO + j;
            w8[it] = (u32x4){0u, 0u, 0u, 0u};
            if (idx < ROWS * 64 && tok >= 0 && tok < S) w8[it] = *(const u32x4*)(PC + (size_t)(seq_base + tok) * 1536 + 1024 + v * 8); }
#pragma unroll
        for (int it = 0; it < 8; ++it) { const int idx = tid + 512 * it, j = idx >> 6, v = idx & 63;
            if (idx < ROWS * 64) *(CLAS u32x4*)(lds + OFF_U0 + j * 1024 + v * 16) = w8[it]; }
    }
    __syncthreads();
    const int cp = tid & 255, th = tid >> 8;
    {
        const float wa0 = w3[2 * cp], wa1 = w3[512 + 2 * cp], wa2 = w3[1024 + 2 * cp];
        const float wb0 = w3[2 * cp + 1], wb1 = w3[512 + 2 * cp + 1], wb2 = w3[1024 + 2 * cp + 1];
        const int tb = t0 + 16 * th;
        unsigned pw[18], gw[16];
#pragma unroll
        for (int i = 0; i < 18; ++i) { const int tok = tb - 1 + i; pw[i] = 0u; if (tok >= 0 && tok < S) pw[i] = *(const unsigned*)(PC + (size_t)(seq_base + tok) * 1536 + 512 + 2 * cp); }
#pragma unroll
        for (int i = 0; i < 16; ++i) gw[i] = *(const unsigned*)(PC + (size_t)(seq_base + tb + i) * 1536 + 2 * cp);
#pragma unroll
        for (int i = 0; i < 16; ++i) {
            const float ya = bf_lo(gw[i]) * (wa0 * bf_lo(pw[i]) + wa1 * bf_lo(pw[i + 1]) + wa2 * bf_lo(pw[i + 2]));
            const float yb = bf_hi(gw[i]) * (wb0 * bf_hi(pw[i]) + wb1 * bf_hi(pw[i + 1]) + wb2 * bf_hi(pw[i + 2]));
            *(unsigned*)(YC + (size_t)(seq_base + tb + i) * 1024 + 2 * cp) = cvt_pk_bf16(ya, yb);
        }
    }
    {
        float wa[31], wb[31];
#pragma unroll
        for (int j = 0; j < 31; ++j) { wa[j] = w31[j * 512 + 2 * cp]; wb[j] = w31[j * 512 + 2 * cp + 1]; }
        const float ba = dwb[2 * cp], bb = dwb[2 * cp + 1];
        for (int g4 = 0; g4 < 4; ++g4) {
            const int tt = 16 * th + 4 * g4;
            float aa[4], ab[4];
#pragma unroll
            for (int k = 0; k < 4; ++k) { aa[k] = ba; ab[k] = bb; }
            const CLAS unsigned char* up = lds + OFF_U0 + tt * 1024 + cp * 4;
#pragma unroll
            for (int rr = 0; rr < 34; ++rr) {
                const unsigned w = *(const CLAS unsigned*)(up + rr * 1024);
                const float xa = bf_lo(w), xb = bf_hi(w);
#pragma unroll
                for (int k = 0; k < 4; ++k) { const int j = rr - k; if (j >= 0 && j < 31) { aa[k] += wa[j] * xa; ab[k] += wb[j] * xb; } }
            }
#pragma unroll
            for (int k = 0; k < 4; ++k) { typedef float f32x2 __attribute__((ext_vector_type(2))); *(CLAS f32x2*)(lds + OFF_U1 + (tt + k) * 2048 + cp * 8) = (f32x2){aa[k], ab[k]}; }
        }
    }
    __syncthreads();
    {
        const int lane = tid & 63, wid = tid >> 6;
        const f32x4 g0 = *(const f32x4*)(lng + 8 * lane), g1 = *(const f32x4*)(lng + 8 * lane + 4), b0 = *(const f32x4*)(lnb + 8 * lane), b1 = *(const f32x4*)(lnb + 8 * lane + 4);
        for (int k = 0; k < 4; ++k) {
            const int tt = 4 * wid + k;
            const f32x4 x0 = *(const CLAS f32x4*)(lds + OFF_U1 + tt * 2048 + lane * 32), x1 = *(const CLAS f32x4*)(lds + OFF_U1 + tt * 2048 + lane * 32 + 16);
            float s = ((x0[0] + x0[1]) + (x0[2] + x0[3])) + ((x1[0] + x1[1]) + (x1[2] + x1[3]));
#pragma unroll
            for (int o = 1; o < 64; o <<= 1) s += __shfl_xor(s, o);
            const float mean = s * (1.0f / 512.0f);
            const f32x4 d0 = x0 - mean, d1 = x1 - mean;
            float q = ((d0[0] * d0[0] + d0[1] * d0[1]) + (d0[2] * d0[2] + d0[3] * d0[3])) + ((d1[0] * d1[0] + d1[1] * d1[1]) + (d1[2] * d1[2] + d1[3] * d1[3]));
#pragma unroll
            for (int o = 1; o < 64; o <<= 1) q += __shfl_xor(q, o);
            const float rstd = __builtin_amdgcn_rsqf(q * (1.0f / 512.0f) + 1e-6f);
            f32x4 y0 = d0 * rstd * g0 + b0, y1 = d1 * rstd * g1 + b1;
#pragma unroll
            for (int i = 0; i < 4; ++i) { y0[i] = y0[i] * fast_sigmoid(y0[i]); y1[i] = y1[i] * fast_sigmoid(y1[i]); }
            u32x4 w; w.x = cvt_pk_bf16(y0[0], y0[1]); w.y = cvt_pk_bf16(y0[2], y0[3]); w.z = cvt_pk_bf16(y1[0], y1[1]); w.w = cvt_pk_bf16(y1[2], y1[3]);
            *(u32x4*)(YC + (size_t)(seq_base + t0 + tt) * 1024 + 512 + 8 * lane) = w;
        }
    }
    __syncthreads();
}
__device__ __forceinline__ void conv_phase(CLAS unsigned char* lds, const bf16_t* PC, bf16_t* YC, const float* w3, const float* w31, const float* dwb, const float* lng, const float* lnb) {
    for (int u = blockIdx.x; u < 131072 / T; u += gridDim.x) {
        const int row0 = u * T; int seq_base, S;
        if (row0 < 65536) { seq_base = row0 & ~8191; S = 8192; } else { seq_base = row0 & ~2047; S = 2048; }
        conv_unit(lds, PC, YC, w3, w31, dwb, lng, lnb, seq_base, S, row0 - seq_base);
    }
}
}

namespace mk {
using pg8::bf16_t; using pg8::f32x4; using pg8::u32x4; using pg8::u32x2; using pg8::cvt_pk_bf16;
#define MLAS __attribute__((address_space(3)))
constexpr int M = 131072, D = 1024, FF = 2816, NQKV = 2304, NCI = 2560;
constexpr size_t MiB = 1u << 20;
constexpr size_t WS_X = 0;
constexpr size_t WS_BIG = 256 * MiB;
constexpr size_t WS_VT = WS_BIG + (size_t)M * pg8::QKW * 2;
constexpr size_t WS_W = 960 * MiB;
constexpr size_t WS_WQKV = WS_W, WS_WO = WS_WQKV + (size_t)NQKV * D * 2, WS_WGU0 = WS_WO + (size_t)D * D * 2, WS_WGU1 = WS_WGU0 + (size_t)2 * FF * D * 2,
                 WS_WD0 = WS_WGU1 + (size_t)2 * FF * D * 2, WS_WD1 = WS_WD0 + (size_t)D * FF * 2, WS_WCI = WS_WD1 + (size_t)D * FF * 2, WS_WCO = WS_WCI + (size_t)NCI * D * 2;
constexpr size_t WS_SSQ = 1008 * MiB;
constexpr size_t WS_CTL = 1016 * MiB, CTL_BYTES = 16384;
constexpr size_t WS_END = WS_CTL + 65536;
static_assert(WS_VT + (size_t)640 * pg8::VT_PITCH * 2 <= WS_W && WS_BIG + (size_t)M * FF * 2 <= WS_W && WS_WCO + (size_t)D * D * 2 <= WS_SSQ, "ws map");
constexpr int MISC_OFF = 147456, LDS_BYTES = MISC_OFF + 256;
static_assert(att::ATT_LDS <= MISC_OFF && cv::CONV_LDS <= MISC_OFF && pg8::STAGE_BYTES + 16384 <= MISC_OFF, "lds map");

#define XB_TMO      128
#define XB_XCNT(j)  (256  + 64 * (j))
#define XB_XSUB(j)  (1280 + 64 * (j))
#define XB_XGEN(j)  (2304 + 64 * (j))
#define XB_TOP      3328
#define XB_TOPGEN   3392
#define XCD_BAR_WORDS 3456
#define XB_SPIN_CAP (1u << 18)

__device__ __forceinline__ unsigned xb_ld(unsigned* p)              { return __hip_atomic_load(p, __ATOMIC_RELAXED, __HIP_MEMORY_SCOPE_AGENT); }
__device__ __forceinline__ unsigned xb_add(unsigned* p, unsigned v) { return __hip_atomic_fetch_add(p, v, __ATOMIC_RELAXED, __HIP_MEMORY_SCOPE_AGENT); }
__device__ __forceinline__ unsigned xb_xcc_id() { return (unsigned)__builtin_amdgcn_s_getreg((3 << 11) | 20) & 0xFu; }
#define XB_SPIN(cond, bar) do { unsigned _sp = 0; while (cond) { __builtin_amdgcn_s_sleep(1); \
    if ((++_sp & 255u) == 0u) { if (xb_ld(&(bar)[XB_TMO])) break; if (_sp > XB_SPIN_CAP) { atomicAdd(&(bar)[XB_TMO], 1u); break; } } } } while (0)

struct XcdBarrier {
    unsigned* bar; unsigned x;
    volatile MLAS unsigned* st;
};

__device__ __forceinline__ XcdBarrier xcd_barrier_post(unsigned* bar, volatile MLAS unsigned* st) {
    XcdBarrier b; b.bar = bar; b.x = xb_xcc_id(); b.st = st;
    if (threadIdx.x == 0) (void)xb_add(&bar[XB_XCNT(b.x)], 1u);
    return b;
}
__device__ __forceinline__ void xcd_barrier_complete(unsigned* bar, unsigned x, unsigned& nloc, unsigned& nx) {
    const unsigned G = gridDim.x * gridDim.y * gridDim.z;
    unsigned sum, cnt, mine, sp = 0u;
    for (;;) {
        sum = 0u; cnt = 0u; mine = 0u;
#pragma unroll
        for (unsigned j = 0; j < 16; ++j) { const unsigned c = xb_ld(&bar[XB_XCNT(j)]); sum += c; cnt += (c > 0u) ? 1u : 0u; mine = (j == x) ? c : mine; }
        if (sum == G) break;
        __builtin_amdgcn_s_sleep(1);
        if ((++sp & 255u) == 0u) { if (xb_ld(&bar[XB_TMO])) break; if (sp > XB_SPIN_CAP) { atomicAdd(&bar[XB_TMO], 1u); break; } }
    }
    nloc = mine > 0u ? mine : 1u; nx = cnt > 0u ? cnt : 1u;
}

__device__ __forceinline__ void xcd_barrier(const XcdBarrier& b) {
    asm volatile("s_waitcnt vmcnt(0)" ::: "memory");
    __syncthreads();
    if (threadIdx.x == 0) {
        unsigned* bar = b.bar;
        __builtin_amdgcn_s_waitcnt(0);
        unsigned nloc = b.st[0], nx = b.st[1];
        if (nloc == 0u) { xcd_barrier_complete(bar, b.x, nloc, nx); b.st[0] = nloc; b.st[1] = nx; }
        const unsigned old = xb_add(&bar[XB_XSUB(b.x)], 1u);
        const unsigned gen = old / nloc;
        if (old + 1u == (gen + 1u) * nloc) {
            __builtin_amdgcn_fence(__ATOMIC_RELEASE, "agent");
            asm volatile("s_waitcnt vmcnt(0)" ::: "memory");
            const unsigned og = xb_add(&bar[XB_TOP], 1u);
            const unsigned tg = og / nx;
            if (og + 1u == (tg + 1u) * nx) xb_add(&bar[XB_TOPGEN], 1u);
            else XB_SPIN(xb_ld(&bar[XB_TOPGEN]) == tg, bar);
            __builtin_amdgcn_fence(__ATOMIC_ACQUIRE, "agent");
            xb_add(&bar[XB_XGEN(b.x)], 1u);
            asm volatile("s_waitcnt vmcnt(0)" ::: "memory");
        } else {
            XB_SPIN(xb_ld(&bar[XB_XGEN(b.x)]) == gen, bar);
            __builtin_amdgcn_fence(__ATOMIC_ACQUIRE, "agent");
            asm volatile("s_waitcnt vmcnt(0)" ::: "memory");
        }
    }
    __syncthreads();
}

static_assert(XCD_BAR_WORDS * 4 <= CTL_BYTES, "barrier words");
struct Params { const float* in[24]; float* out; unsigned char* ws; int ph_lo, ph_hi; };

__device__ __forceinline__ void tr_item(const float* __restrict__ W, int ldw, int srccol0, const float* __restrict__ gain, bf16_t* __restrict__ WT, int K, int destrow0, int k0, MLAS float* scr, int lane) {
    float wv[32];
#pragma unroll
    for (int i = 0; i < 32; ++i) { const int kk = 2 * i + (lane >> 5); wv[i] = W[(size_t)(k0 + kk) * ldw + srccol0 + (lane & 31)]; }
    const float g0 = gain ? gain[k0 + (lane & 31) * 2] : 1.0f, g1 = gain ? gain[k0 + (lane & 31) * 2 + 1] : 1.0f;
#pragma unroll
    for (int i = 0; i < 32; ++i) { const int kk = 2 * i + (lane >> 5); const float ga = __shfl(g0, i), gb = __shfl(g1, i); scr[kk * 33 + (lane & 31)] = wv[i] * ((lane >> 5) ? gb : ga); }
    asm volatile("s_waitcnt lgkmcnt(0)" ::: "memory");
    const int c = lane & 7;
#pragma unroll
    for (int j = 0; j < 4; ++j) { const int n = (lane >> 3) + 8 * j; const MLAS float* s = scr + (8 * c) * 33 + n;
        u32x4 o; o.x = cvt_pk_bf16(s[0 * 33], s[1 * 33]); o.y = cvt_pk_bf16(s[2 * 33], s[3 * 33]); o.z = cvt_pk_bf16(s[4 * 33], s[5 * 33]); o.w = cvt_pk_bf16(s[6 * 33], s[7 * 33]);
        *(u32x4*)(WT + (size_t)(destrow0 + n) * K + k0 + 8 * c) = o; }
    asm volatile("s_waitcnt lgkmcnt(0)" ::: "memory");
}

__device__ __forceinline__ void prologue(const Params& p, MLAS unsigned char* lds) {
    const int tid = threadIdx.x, lane = tid & 63, wave = tid >> 6;
    MLAS float* scr = (MLAS float*)(lds + wave * 16384);
    const int gw = blockIdx.x * 8 + wave, NGW = gridDim.x * 8;
    unsigned char* ws = p.ws;
    constexpr int I_QKV = (NQKV / 32) * (D / 64), I_O = (D / 32) * (D / 64), I_GU = (2 * FF / 32) * (D / 64), I_D = (D / 32) * (FF / 64), I_CI = (NCI / 32) * (D / 64);
    constexpr int NIT = I_QKV + I_O + 2 * I_GU + 2 * I_D + I_CI + I_O;
    for (int it = gw; it < NIT; it += NGW) {
        int r = it;
        if (r < I_QKV) { const int kb = r / (NQKV / 32), nb = r % (NQKV / 32); const int n0 = nb * 32, pn = n0 >> 8, within = n0 & 255, bj = within >> 7, wc = (within & 127) >> 5;
            tr_item(p.in[8], NQKV, 256 * pn + 64 * wc + 32 * bj, p.in[3], (bf16_t*)(ws + WS_WQKV), D, n0, kb * 64, scr, lane); continue; }
        r -= I_QKV;
        if (r < I_O) { const int kb = r / (D / 32), nb = r % (D / 32); tr_item(p.in[9], D, nb * 32, nullptr, (bf16_t*)(ws + WS_WO), D, nb * 32, kb * 64, scr, lane); continue; }
        r -= I_O;
        if (r < 2 * I_GU) { const int l = r / I_GU; r -= l * I_GU; const int kb = r / (2 * FF / 32), nb = r % (2 * FF / 32); const int n0 = nb * 32, pn = n0 >> 8, within = n0 & 255, bj = within >> 7, j = within & 127;
            const float* src = (bj ? p.in[6] : p.in[5]) + (size_t)l * D * FF;
            tr_item(src, FF, 128 * pn + j, p.in[4] + l * D, (bf16_t*)(ws + (l ? WS_WGU1 : WS_WGU0)), D, n0, kb * 64, scr, lane); continue; }
        r -= 2 * I_GU;
        if (r < 2 * I_D) { const int l = r / I_D; r -= l * I_D; const int kb = r / (D / 32), nb = r % (D / 32);
            tr_item(p.in[7] + (size_t)l * FF * D, D, nb * 32, nullptr, (bf16_t*)(ws + (l ? WS_WD1 : WS_WD0)), FF, nb * 32, kb * 64, scr, lane); continue; }
        r -= 2 * I_D;
        if (r < I_CI) { const int kb = r / (NCI / 32), nb = r % (NCI / 32); const int n0 = nb * 32, pn = n0 >> 8, within = n0 & 255, bj = within >> 7, j = within & 127;
            const int src = pn < 2 ? n0 : (pn < 6 ? (bj ? 1024 : 512) + 128 * (pn - 2) + j : (bj ? 2048 : 1536) + 128 * (pn - 6) + j);
            tr_item(p.in[17], NCI, src, p.in[3] + D, (bf16_t*)(ws + WS_WCI), D, n0, kb * 64, scr, lane); continue; }
        r -= I_CI;
        { const int kb = r / (D / 32), nb = r % (D / 32); tr_item(p.in[18], D, nb * 32, nullptr, (bf16_t*)(ws + WS_WCO), D, nb * 32, kb * 64, scr, lane); }
    }
    bf16_t* X = (bf16_t*)(ws + WS_X); float* ssq = (float*)(ws + WS_SSQ);
    for (int m0 = gw; m0 < M; m0 += 4 * NGW) {
        f32x4 v[4][4];
#pragma unroll
        for (int r = 0; r < 4; ++r) { const int m = m0 + r * NGW; if (m < M) { const float* xrow = (m < 65536) ? p.in[0] + (size_t)m * D : p.in[1] + (size_t)(m - 65536) * D; const f32x4* xr = (const f32x4*)xrow + lane;
#pragma unroll
            for (int j = 0; j < 4; ++j) v[r][j] = xr[64 * j]; } }
#pragma unroll
        for (int r = 0; r < 4; ++r) { const int m = m0 + r * NGW; if (m < M) {
            float s = 0.f;
#pragma unroll
            for (int j = 0; j < 4; ++j) s += (v[r][j][0] * v[r][j][0] + v[r][j][1] * v[r][j][1]) + (v[r][j][2] * v[r][j][2] + v[r][j][3] * v[r][j][3]);
#pragma unroll
            for (int o = 1; o < 64; o <<= 1) s += __shfl_xor(s, o);
            u32x2* o8 = (u32x2*)(X + (size_t)m * D) + lane;
#pragma unroll
            for (int j = 0; j < 4; ++j) { u32x2 w; w.x = cvt_pk_bf16(v[r][j][0], v[r][j][1]); w.y = cvt_pk_bf16(v[r][j][2], v[r][j][3]); o8[64 * j] = w; }
            if (lane < 16) ssq[(size_t)m * 16 + lane] = (lane == 0) ? s : 0.f; } }
    }
}

__global__ void __launch_bounds__(512, 2) fwd_kernel(Params p) {
    extern __shared__ __attribute__((aligned(16))) unsigned char lds_raw[];
    MLAS unsigned char* lds = (MLAS unsigned char*)lds_raw;
    cg::grid_group grid = cg::this_grid();
    unsigned char* ws = p.ws;
    bf16_t* X = (bf16_t*)(ws + WS_X); bf16_t* BIG = (bf16_t*)(ws + WS_BIG); bf16_t* VT = (bf16_t*)(ws + WS_VT); float* ssq = (float*)(ws + WS_SSQ);
    bf16_t* Y = (bf16_t*)p.out;
    const int lo = p.ph_lo, hi = p.ph_hi, G = gridDim.x, bx = blockIdx.x;
    volatile MLAS unsigned* misc = (volatile MLAS unsigned*)(lds + MISC_OFF);
    if (threadIdx.x < 2) misc[threadIdx.x] = 0u;
    __syncthreads();
    const XcdBarrier xbar = xcd_barrier_post((unsigned*)(ws + WS_CTL), misc);
#ifndef PH_MASK
#define PH_MASK 0x7ff
#endif
#define IN(k) (((PH_MASK >> (k)) & 1) && lo <= (k) && (k) < hi)
#define SEAM(k) do { if (IN(k) && IN((k) + 1)) { if ((k) == 0) grid.sync(); else xcd_barrier(xbar); } } while (0)
    if (IN(0)) { prologue(p, lds); __syncthreads(); }
    SEAM(0);
    if (IN(1)) { pg8::Gemm g{X, (const bf16_t*)(ws + WS_WQKV), M, NQKV, D}; pg8::StaticOrder S; S.init(M, NQKV, G, bx);
        pg8::EpiQKV E{BIG, VT, ssq, p.in[10], p.in[11], p.in[13], p.in[14], lds + pg8::STAGE_BYTES};
        pg8::gemm_phase<pg8::EpiQKV, pg8::StaticOrder, true, true>(lds, g, S, E); }
    SEAM(1);
    if (IN(2)) { for (int rep = 0; rep < PROBE_ATT; ++rep) att::attn_phase(lds, BIG, VT, Y, p.in[2], p.in[12], p.in[16], p.in[15]); }
    SEAM(2);
    if (IN(3)) { pg8::Gemm g{Y, (const bf16_t*)(ws + WS_WO), M, D, D}; pg8::StaticOrder S; S.init(M, D, G, bx);
        pg8::EpiRes<false> E{X, nullptr, ssq};
        pg8::gemm_phase<pg8::EpiRes<false>, pg8::StaticOrder, true, true>(lds, g, S, E); }
    SEAM(3);
    if (IN(4)) { pg8::Gemm g{X, (const bf16_t*)(ws + WS_WGU0), M, 2 * FF, D}; pg8::StaticOrder S; S.init(M, 2 * FF, G, bx);
        pg8::EpiGlu E{BIG, ssq};
        pg8::gemm_phase<pg8::EpiGlu, pg8::StaticOrder, true, true>(lds, g, S, E); }
    SEAM(4);
    if (IN(5)) { pg8::Gemm g{BIG, (const bf16_t*)(ws + WS_WD0), M, D, FF}; pg8::StaticOrder S; S.init(M, D, G, bx);
        pg8::EpiRes<false> E{X, nullptr, ssq};
        pg8::gemm_phase<pg8::EpiRes<false>, pg8::StaticOrder, true, true>(lds, g, S, E); }
    SEAM(5);
    if (IN(6)) { pg8::Gemm g{X, (const bf16_t*)(ws + WS_WCI), M, NCI, D}; pg8::StaticOrder S; S.init(M, NCI, G, bx);
        pg8::EpiConvIn E{BIG, ssq};
        pg8::gemm_phase<pg8::EpiConvIn, pg8::StaticOrder, true, true>(lds, g, S, E); }
    SEAM(6);
    if (IN(7)) { cv::conv_phase(lds, BIG, Y, p.in[19], p.in[20], p.in[21], p.in[22], p.in[23]); }
    SEAM(7);
    if (IN(8)) { pg8::Gemm g{Y, (const bf16_t*)(ws + WS_WCO), M, D, D}; pg8::StaticOrder S; S.init(M, D, G, bx);
        pg8::EpiRes<false> E{X, nullptr, ssq};
        pg8::gemm_phase<pg8::EpiRes<false>, pg8::StaticOrder, true, true>(lds, g, S, E); }
    SEAM(8);
    if (IN(9)) { pg8::Gemm g{X, (const bf16_t*)(ws + WS_WGU1), M, 2 * FF, D}; pg8::StaticOrder S; S.init(M, 2 * FF, G, bx);
        pg8::EpiGlu E{BIG, ssq};
        pg8::gemm_phase<pg8::EpiGlu, pg8::StaticOrder, true, true>(lds, g, S, E); }
    SEAM(9);
    if (IN(10)) { pg8::Gemm g{BIG, (const bf16_t*)(ws + WS_WD1), M, D, FF}; pg8::StaticOrder S; S.init(M, D, G, bx);
        pg8::EpiRes<true> E{X, p.out, ssq};
        pg8::gemm_phase<pg8::EpiRes<true>, pg8::StaticOrder, true, true>(lds, g, S, E); }
#undef IN
#undef SEAM
}
}

#ifndef MK_N_LAUNCHES_X
#define MK_N_LAUNCHES 1
#endif
extern "C" void kernel_launch(void* const* d_in, const int* in_sizes, int n_in, void* d_out, int out_size, void* d_ws, size_t ws_size, hipStream_t stream) {
    static int grid = 0;
    if (grid == 0) {
        if (n_in != 24 || out_size != mk::M * mk::D || ws_size < mk::WS_END) { fprintf(stderr, "kernel_launch: unexpected shapes (n_in %d out %d ws %zu)\n", n_in, out_size, ws_size); grid = -1; return; }
        int dev = 0, cus = 0, per_cu = 0;
        (void)hipGetDevice(&dev); (void)hipDeviceGetAttribute(&cus, hipDeviceAttributeMultiprocessorCount, dev);
        (void)hipFuncSetAttribute((const void*)mk::fwd_kernel, hipFuncAttributeMaxDynamicSharedMemorySize, mk::LDS_BYTES);
        (void)hipOccupancyMaxActiveBlocksPerMultiprocessor(&per_cu, (const void*)mk::fwd_kernel, 512, mk::LDS_BYTES);
        if (per_cu < 1) per_cu = 1;
        (void)hipGetLastError();
        grid = cus * per_cu;
    }
    if (grid < 0) return;
    if (hipMemsetAsync((char*)d_ws + mk::WS_CTL, 0, mk::CTL_BYTES, stream) != hipSuccess) { fprintf(stderr, "kernel_launch: memset of the barrier words failed\n"); return; }
    mk::Params p{};
    for (int i = 0; i < 24; ++i) p.in[i] = (const float*)d_in[i];
    p.out = (float*)d_out; p.ws = (unsigned char*)d_ws;
#if MK_N_LAUNCHES == 1
    p.ph_lo = 0; p.ph_hi = 11;
    void* args[] = {&p};
    hipError_t e = hipLaunchCooperativeKernel((const void*)mk::fwd_kernel, dim3(grid), dim3(512), args, mk::LDS_BYTES, stream);
    if (e != hipSuccess) fprintf(stderr, "cooperative launch failed: %s (grid %d)\n", hipGetErrorString(e), grid);
#else
    for (int ph = 0; ph < 11; ++ph) { p.ph_lo = ph; p.ph_hi = ph + 1; hipLaunchKernelGGL(mk::fwd_kernel, dim3(grid), dim3(512), mk::LDS_BYTES, stream, p); }
#endif
}
```

```cpp
#include <hip/hip_runtime.h>
#include <hip/hip_cooperative_groups.h>
#include <cstdio>
#include <cstdint>
namespace cg = cooperative_groups;
#ifndef PROBE_ATT
#define PROBE_ATT 1
#endif
#ifndef MK_N_LAUNCHES
#define MK_N_LAUNCHES 1
#endif
namespace pg8 {
#define PG8_LAS __attribute__((address_space(3)))
typedef unsigned short bf16_t;
typedef short bf16x8 __attribute__((ext_vector_type(8)));
typedef float f32x4 __attribute__((ext_vector_type(4)));
typedef unsigned u32x4 __attribute__((ext_vector_type(4)));
constexpr int BM = 256, BK = 64, HALF = 128, HTB = HALF * BK * 2  , STAGE_BYTES = 8 * HTB, NXCD = 8, WGM = 8;

__host__ __device__ __forceinline__ int lds_byte(int r, int c) { const int st = (r >> 4) * 2 + (c >> 5), rr = r & 15, cc = c & 31, ob = rr * 64 + cc * 2; return st * 1024 + (ob ^ (((ob >> 9) & 1) << 5)); }
__host__ __device__ __forceinline__ void stage_rc(int b, int& R, int& C) { const int st = b / 1024, sb = b % 1024, swz = sb ^ (((sb >> 9) & 1) << 5); R = (st >> 1) * 16 + swz / 64; C = (st & 1) * 32 + (swz % 64) / 2; }
__host__ __device__ __forceinline__ int perm32(int rho) { const int n = rho >> 4, i = rho & 15; return 8 * (i >> 2) + 4 * n + (i & 3); }

struct Unit { int pm, pn; };
struct Gemm { const bf16_t* A; const bf16_t* Bt; int M, N, K; };

struct StaticOrder {
    int nM, nN, nwg, G, c;
    __host__ __device__ void init(int M, int N, int G_, int c_) { nM = M / BM; nN = N / BM; nwg = nM * nN; G = G_; c = c_; }
    __host__ __device__ bool next(int i, Unit& u) const {
        const long L = (long)i * G + c; if (L >= nwg) return false;
        int wgid = (int)L; { const int q = nwg / NXCD, r = nwg % NXCD, xcd = wgid % NXCD, off = wgid / NXCD; wgid = (xcd < r ? xcd * (q + 1) : r * (q + 1) + (xcd - r) * q) + off; }
        const int nig = WGM * nN, gid = wgid / nig, fm = gid * WGM, gsz = (nM - fm) < WGM ? (nM - fm) : WGM;
        u.pm = fm + ((wgid % nig) % gsz); u.pn = (wgid % nig) / gsz; return true;
    }
    __device__ __forceinline__ void a_ready(const Unit&) const {}
    __device__ __forceinline__ void done(const Unit&) const {}
};

__device__ __forceinline__ unsigned cvt_pk_bf16(float lo, float hi) { unsigned r; asm volatile("v_cvt_pk_bf16_f32 %0, %1, %2" : "=v"(r) : "v"(lo), "v"(hi)); return r; }
typedef float f32x2 __attribute__((ext_vector_type(2)));
typedef unsigned u32x2 __attribute__((ext_vector_type(2)));
__device__ __forceinline__ float bf_lo(unsigned w) { return __uint_as_float(w << 16); }
__device__ __forceinline__ float bf_hi(unsigned w) { return __uint_as_float(w & 0xffff0000u); }
__device__ __forceinline__ float row_rstd(const float* ssq, int row) {
    const f32x4* p = (const f32x4*)(ssq + (size_t)row * 16);
    const f32x4 a = p[0], b = p[1], c = p[2], d = p[3];
    const float s = ((a[0] + a[1]) + (a[2] + a[3])) + ((b[0] + b[1]) + (b[2] + b[3])) + ((c[0] + c[1]) + (c[2] + c[3])) + ((d[0] + d[1]) + (d[2] + d[3]));
    return __builtin_amdgcn_rsqf(s * (1.0f / 1024.0f) + 1e-6f);
}
__device__ __forceinline__ void rows_rstd(const float* ssq, int row0, int fq, float (&rs)[2][4]) {
    f32x4 pr[2][4];
#pragma unroll
    for (int ai = 0; ai < 2; ++ai)
#pragma unroll
        for (int m = 0; m < 4; ++m) pr[ai][m] = *(const f32x4*)(ssq + (size_t)(row0 + ai * HALF + m * 16) * 16 + 4 * fq);
#pragma unroll
    for (int ai = 0; ai < 2; ++ai)
#pragma unroll
        for (int m = 0; m < 4; ++m) { float t = (pr[ai][m][0] + pr[ai][m][1]) + (pr[ai][m][2] + pr[ai][m][3]); t += __shfl_xor(t, 16); t += __shfl_xor(t, 32); rs[ai][m] = __builtin_amdgcn_rsqf(t * (1.0f / 1024.0f) + 1e-6f); }
}
__device__ __forceinline__ float fast_sigmoid(float x) { return __builtin_amdgcn_rcpf(1.0f + __expf(-x)); }

constexpr int QKW = 1664;
constexpr int VT_PITCH = 131072 + 128;
constexpr float C2Q = 0.125f * 1.4426950408889634f;

struct EpiQKV {
    static constexpr bool PERM = true, AFTER_DRAIN = false;
    bf16_t* QK; bf16_t* VT; const float* ssq; const float* aq; const float* ak; const float* bq; const float* bk; PG8_LAS unsigned char* xlds;
    __device__ __forceinline__ void operator()(const f32x4 (&acc)[2][2][4][2], const Unit& u, int wr, int wc, int fr, int fq) const {
        const int L = u.pn * 256 + wc * 64;
        int kind; const float* gain = nullptr; float scale = 1.f; int ccol = 0, vrow = 0;
        if (L < 512) { kind = 0; gain = aq; scale = C2Q; ccol = L; }
        else if (L < 640) { kind = 0; gain = ak; ccol = L; }
        else if (L < 768) { kind = 1; vrow = L - 640; }
        else if (L < 1280) { kind = 0; gain = bq; scale = C2Q; ccol = L - 128; }
        else if (L < 1792) { kind = 0; gain = bk; ccol = L - 128; }
        else { kind = 1; vrow = L - 1792 + 128; }
        if (kind == 0) {
            f32x4 gv[2][2];
#pragma unroll
            for (int bj = 0; bj < 2; ++bj)
#pragma unroll
                for (int n = 0; n < 2; ++n) gv[bj][n] = *(const f32x4*)(gain + 32 * bj + 8 * fq + 4 * n);
            float rsv[2][4]; rows_rstd(ssq, u.pm * BM + wr * 64 + fr, fq, rsv);
#pragma unroll
            for (int ai = 0; ai < 2; ++ai)
#pragma unroll
                for (int m = 0; m < 4; ++m) {
                    const int row = u.pm * BM + ai * HALF + wr * 64 + m * 16 + fr;
                    const float rs = rsv[ai][m];
                    float ss = 0.f;
#pragma unroll
                    for (int bj = 0; bj < 2; ++bj)
#pragma unroll
                        for (int n = 0; n < 2; ++n) { const f32x4 v = acc[ai][bj][m][n] * rs; ss += (v[0] * v[0] + v[1] * v[1]) + (v[2] * v[2] + v[3] * v[3]); }
                    ss += __shfl_xor(ss, 16); ss += __shfl_xor(ss, 32);
                    const float f = rs * __builtin_amdgcn_rsqf(ss * (1.0f / 64.0f) + 1e-6f) * scale;
                    bf16_t* rowp = QK + ((size_t)((row >> 6) * 26 + (ccol >> 6)) * 64 + (row & 63)) * 64 + 8 * fq;
#pragma unroll
                    for (int bj = 0; bj < 2; ++bj) {
                        const f32x4 v0 = acc[ai][bj][m][0] * f * gv[bj][0], v1 = acc[ai][bj][m][1] * f * gv[bj][1];
                        u32x4 w; w.x = cvt_pk_bf16(v0[0], v0[1]); w.y = cvt_pk_bf16(v0[2], v0[3]); w.z = cvt_pk_bf16(v1[0], v1[1]); w.w = cvt_pk_bf16(v1[2], v1[3]);
                        *(u32x4*)(rowp + 32 * bj) = w;
                    }
                }
        } else {
            PG8_LAS unsigned char* xl = xlds + (wr * 4 + wc) * 2048;
            const int lane = fq * 16 + fr;
            float rsv[2][4]; rows_rstd(ssq, u.pm * BM + wr * 64 + fr, fq, rsv);
#pragma unroll
            for (int ai = 0; ai < 2; ++ai) {
                float rs[4];
#pragma unroll
                for (int m = 0; m < 4; ++m) rs[m] = rsv[ai][m];
                const size_t tb = (size_t)(u.pm * 4 + ai * 2 + wr) * 640;
#pragma unroll
                for (int bj = 0; bj < 2; ++bj)
#pragma unroll
                    for (int n = 0; n < 2; ++n) {
#pragma unroll
                        for (int m = 0; m < 4; ++m) {
                            const f32x4 v = acc[ai][bj][m][n] * rs[m];
                            const unsigned w0 = cvt_pk_bf16(v[0], v[1]), w1 = cvt_pk_bf16(v[2], v[3]);
                            PG8_LAS bf16_t* q = (PG8_LAS bf16_t*)(xl + (4 * fq) * 128 + (16 * m + fr) * 2);
                            q[0] = (bf16_t)(w0 & 0xffffu); q[64] = (bf16_t)(w0 >> 16); q[128] = (bf16_t)(w1 & 0xffffu); q[192] = (bf16_t)(w1 >> 16);
                        }
                        asm volatile("s_waitcnt lgkmcnt(0)" ::: "memory");
                        const int c16 = lane >> 2, part = lane & 3;
                        const u32x4 a = *(const PG8_LAS u32x4*)(xl + c16 * 128 + part * 32), b = *(const PG8_LAS u32x4*)(xl + c16 * 128 + part * 32 + 16);
                        bf16_t* gp = VT + (tb + vrow + 32 * bj + 8 * (c16 >> 2) + 4 * n + (c16 & 3)) * 64 + part * 16;
                        *(u32x4*)gp = a; *(u32x4*)(gp + 8) = b;
                        asm volatile("s_waitcnt lgkmcnt(0)" ::: "memory");
                    }
            }
        }
    }
};

template <bool FINAL> struct EpiRes {
    static constexpr bool PERM = true, AFTER_DRAIN = false;
    bf16_t* X; float* out; float* ssq;
    __device__ __forceinline__ void operator()(const f32x4 (&acc)[2][2][4][2], const Unit& u, int wr, int wc, int fr, int fq) const {
        const int col0 = u.pn * BM + wc * 32 + 8 * fq;
        u32x4 xin[2][4][2];
#pragma unroll
        for (int ai = 0; ai < 2; ++ai)
#pragma unroll
            for (int m = 0; m < 4; ++m)
#pragma unroll
                for (int bj = 0; bj < 2; ++bj) xin[ai][m][bj] = *(const u32x4*)(X + (size_t)(u.pm * BM + ai * HALF + wr * 64 + m * 16 + fr) * 1024 + col0 + bj * HALF);
#pragma unroll
        for (int ai = 0; ai < 2; ++ai)
#pragma unroll
            for (int m = 0; m < 4; ++m) {
                const int row = u.pm * BM + ai * HALF + wr * 64 + m * 16 + fr;
                float ss = 0.f;
#pragma unroll
                for (int bj = 0; bj < 2; ++bj) {
                    bf16_t* xp = X + (size_t)row * 1024 + col0 + bj * HALF;
                    const u32x4 xv = xin[ai][m][bj];
                    f32x4 y0 = acc[ai][bj][m][0], y1 = acc[ai][bj][m][1];
                    y0[0] += bf_lo(xv.x); y0[1] += bf_hi(xv.x); y0[2] += bf_lo(xv.y); y0[3] += bf_hi(xv.y);
                    y1[0] += bf_lo(xv.z); y1[1] += bf_hi(xv.z); y1[2] += bf_lo(xv.w); y1[3] += bf_hi(xv.w);
                    if (FINAL) {
                        float* op = out + (size_t)row * 1024 + col0 + bj * HALF;
                        *(f32x4*)op = y0; *(f32x4*)(op + 4) = y1;
                    } else {
                        u32x4 w; w.x = cvt_pk_bf16(y0[0], y0[1]); w.y = cvt_pk_bf16(y0[2], y0[3]); w.z = cvt_pk_bf16(y1[0], y1[1]); w.w = cvt_pk_bf16(y1[2], y1[3]);
                        *(u32x4*)xp = w;
                        ss += (y0[0] * y0[0] + y0[1] * y0[1]) + (y0[2] * y0[2] + y0[3] * y0[3]) + (y1[0] * y1[0] + y1[1] * y1[1]) + (y1[2] * y1[2] + y1[3] * y1[3]);
                    }
                }
                if (!FINAL) {
                    ss += __shfl_xor(ss, 16); ss += __shfl_xor(ss, 32);
                    if (fq == 0) ssq[(size_t)row * 16 + u.pn * 4 + wc] = ss;
                }
            }
    }
};

struct EpiGlu {
    static constexpr bool PERM = true, AFTER_DRAIN = false;
    bf16_t* H; const float* ssq;
    __device__ __forceinline__ void operator()(const f32x4 (&acc)[2][2][4][2], const Unit& u, int wr, int wc, int fr, int fq) const {
        const int col0 = u.pn * HALF + wc * 32 + 8 * fq;
        float rsv[2][4]; rows_rstd(ssq, u.pm * BM + wr * 64 + fr, fq, rsv);
#pragma unroll
        for (int ai = 0; ai < 2; ++ai)
#pragma unroll
            for (int m = 0; m < 4; ++m) {
                const int row = u.pm * BM + ai * HALF + wr * 64 + m * 16 + fr;
                const float rs = rsv[ai][m];
                float h[8];
#pragma unroll
                for (int n = 0; n < 2; ++n)
#pragma unroll
                    for (int i = 0; i < 4; ++i) { const float g = acc[ai][0][m][n][i] * rs, up = acc[ai][1][m][n][i] * rs; h[4 * n + i] = g * up * fast_sigmoid(g); }
                u32x4 w; w.x = cvt_pk_bf16(h[0], h[1]); w.y = cvt_pk_bf16(h[2], h[3]); w.z = cvt_pk_bf16(h[4], h[5]); w.w = cvt_pk_bf16(h[6], h[7]);
                *(u32x4*)(H + (size_t)row * 2816 + col0) = w;
            }
    }
};

struct EpiConvIn {
    static constexpr bool PERM = true, AFTER_DRAIN = false;
    bf16_t* O; const float* ssq;
    __device__ __forceinline__ void operator()(const f32x4 (&acc)[2][2][4][2], const Unit& u, int wr, int wc, int fr, int fq) const {
        float rsv[2][4]; rows_rstd(ssq, u.pm * BM + wr * 64 + fr, fq, rsv);
#pragma unroll
        for (int ai = 0; ai < 2; ++ai)
#pragma unroll
            for (int m = 0; m < 4; ++m) {
                const int row = u.pm * BM + ai * HALF + wr * 64 + m * 16 + fr;
                const float rs = rsv[ai][m];
                bf16_t* rp = O + (size_t)row * 1536 + wc * 32 + 8 * fq;
                if (u.pn < 2) {
#pragma unroll
                    for (int bj = 0; bj < 2; ++bj) {
                        const f32x4 v0 = acc[ai][bj][m][0] * rs, v1 = acc[ai][bj][m][1] * rs;
                        u32x4 w; w.x = cvt_pk_bf16(v0[0], v0[1]); w.y = cvt_pk_bf16(v0[2], v0[3]); w.z = cvt_pk_bf16(v1[0], v1[1]); w.w = cvt_pk_bf16(v1[2], v1[3]);
                        *(u32x4*)(rp + u.pn * BM + bj * HALF) = w;
                    }
                } else {
                    float h[8];
                    const bool glu = u.pn >= 6;
#pragma unroll
                    for (int n = 0; n < 2; ++n)
#pragma unroll
                        for (int i = 0; i < 4; ++i) { const float a = acc[ai][0][m][n][i] * rs, b = acc[ai][1][m][n][i] * rs; h[4 * n + i] = glu ? a * fast_sigmoid(b) : a * b; }
                    u32x4 w; w.x = cvt_pk_bf16(h[0], h[1]); w.y = cvt_pk_bf16(h[2], h[3]); w.z = cvt_pk_bf16(h[4], h[5]); w.w = cvt_pk_bf16(h[6], h[7]);
                    *(u32x4*)(rp + 512 + (u.pn - 2) * HALF) = w;
                }
            }
    }
};

struct EpiPlain {
    static constexpr bool PERM = true, AFTER_DRAIN = false;
    bf16_t* O; int ldc; const float* ssq;
    __device__ __forceinline__ void operator()(const f32x4 (&acc)[2][2][4][2], const Unit& u, int wr, int wc, int fr, int fq) const {
        const int col0 = u.pn * BM + wc * 32 + 8 * fq;
#pragma unroll
        for (int ai = 0; ai < 2; ++ai)
#pragma unroll
            for (int m = 0; m < 4; ++m) {
                const int row = u.pm * BM + ai * HALF + wr * 64 + m * 16 + fr;
                const float rs = row_rstd(ssq, row);
#pragma unroll
                for (int bj = 0; bj < 2; ++bj) {
                    const f32x4 v0 = acc[ai][bj][m][0] * rs, v1 = acc[ai][bj][m][1] * rs;
                    u32x4 w; w.x = cvt_pk_bf16(v0[0], v0[1]); w.y = cvt_pk_bf16(v0[2], v0[3]); w.z = cvt_pk_bf16(v1[0], v1[1]); w.w = cvt_pk_bf16(v1[2], v1[3]);
                    *(u32x4*)(O + (size_t)row * ldc + col0 + bj * HALF) = w;
                }
            }
    }
};

template <class Epi, class Sched, bool ALIGN_EPI = false, bool SP2 = false>
__device__ __forceinline__ void gemm_phase(PG8_LAS unsigned char* lds, const Gemm g, const Sched& S, const Epi& E) {
    const int tid = threadIdx.x, wid = __builtin_amdgcn_readfirstlane(tid >> 6), lane = tid & 63, wr = wid >> 2, wc = wid & 3, fr = lane & 15, fq = lane >> 4;
    const int K = g.K, nt = K / BK;
    unsigned voffA[2], voffB[2];
#pragma unroll
    for (int i = 0; i < 2; ++i) { int R, C; stage_rc(tid * 16 + i * 8192, R, C); const int Rb = Epi::PERM ? ((R & ~31) + perm32(R & 31)) : R;
        voffA[i] = (unsigned)(R * K + C) * 2u; voffB[i] = (unsigned)(Rb * K + C) * 2u; }
    const size_t kstep = (size_t)(BK * 2);
    const size_t hstep = (size_t)HALF * K * 2;
    const size_t tstep = 2 * hstep;
    const unsigned ldsw = (unsigned)wid * 1024u;
    const int aoff = lds_byte(wr * 64 + fr, fq * 8), boff = lds_byte(wc * 32 + fr, fq * 8);
#define PG8_SA(b, h) (((b) * 2 + (h)) * HTB)
#define PG8_SB(b, h) ((4 + (b) * 2 + (h)) * HTB)
#define PG8_STAGE(bufoff, gbase, voff) do { _Pragma("unroll") for (int _i = 0; _i < 2; ++_i) \
        __builtin_amdgcn_global_load_lds((const unsigned*)((const char*)(gbase) + (voff)[_i]), (PG8_LAS unsigned*)(lds + (bufoff) + ldsw + _i * 8192), 16, 0, 0); } while (0)
#define PG8_LDA(dst, b, h) do { _Pragma("unroll") for (int m = 0; m < 4; ++m) _Pragma("unroll") for (int k = 0; k < 2; ++k) dst[m][k] = *(const PG8_LAS bf16x8*)(lds + PG8_SA(b, h) + aoff + m * 2048 + k * 1024); } while (0)
#define PG8_LDB(dst, b, h) do { _Pragma("unroll") for (int n = 0; n < 2; ++n) _Pragma("unroll") for (int k = 0; k < 2; ++k) dst[n][k] = *(const PG8_LAS bf16x8*)(lds + PG8_SB(b, h) + boff + n * 2048 + k * 1024); } while (0)
#define PG8_MMA(ai, bj, At, Bt) do { __builtin_amdgcn_s_setprio(1); _Pragma("unroll") for (int m = 0; m < 4; ++m) _Pragma("unroll") for (int n = 0; n < 2; ++n) _Pragma("unroll") for (int k = 0; k < 2; ++k) \
        acc[ai][bj][m][n] = __builtin_amdgcn_mfma_f32_16x16x32_bf16(Bt[n][k], At[m][k], acc[ai][bj][m][n], 0, 0, 0); __builtin_amdgcn_s_setprio(0); } while (0)
#define PG8_WAIT_V(n) asm volatile("s_waitcnt vmcnt(" #n ")" ::: "memory")
#define PG8_WAIT_L(n) asm volatile("s_waitcnt lgkmcnt(" #n ")" ::: "memory")
#define PG8_BAR __builtin_amdgcn_s_barrier()
#define PG8_SCHED __builtin_amdgcn_sched_barrier(0)
    Unit cur, nxt; int ui = 0;
    if (!S.next(0, cur)) return;
    f32x4 acc[2][2][4][2];
#pragma unroll
    for (int a = 0; a < 2; ++a)
#pragma unroll
        for (int b = 0; b < 2; ++b)
#pragma unroll
            for (int m = 0; m < 4; ++m)
#pragma unroll
                for (int n = 0; n < 2; ++n) acc[a][b][m][n] = (f32x4){0.f, 0.f, 0.f, 0.f};
    bf16x8 At[4][2], B0[2][2], B1[2][2];
    const char* cA = (const char*)g.A + (size_t)cur.pm * tstep; const char* cB = (const char*)g.Bt + (size_t)cur.pn * tstep;
    S.a_ready(cur);
    if constexpr (SP2) {
        PG8_STAGE(PG8_SB(0, 0), cB, voffB); PG8_STAGE(PG8_SB(0, 1), cB + hstep, voffB); PG8_STAGE(PG8_SA(0, 0), cA, voffA); PG8_STAGE(PG8_SA(0, 1), cA + hstep, voffA);
        if (wr == 1) PG8_BAR;
        PG8_WAIT_V(2); PG8_BAR;
        PG8_STAGE(PG8_SB(1, 0), cB + kstep, voffB); PG8_STAGE(PG8_SA(1, 0), cA + kstep, voffA); PG8_STAGE(PG8_SB(1, 1), cB + hstep + kstep, voffB);
        PG8_WAIT_V(6); PG8_BAR;
    } else {
        PG8_STAGE(PG8_SB(0, 0), cB, voffB); PG8_STAGE(PG8_SA(0, 0), cA, voffA); PG8_STAGE(PG8_SB(0, 1), cB + hstep, voffB); PG8_STAGE(PG8_SA(0, 1), cA + hstep, voffA);
        if (wr == 1) PG8_BAR;
        PG8_WAIT_V(4); PG8_BAR;
        PG8_STAGE(PG8_SB(1, 0), cB + kstep, voffB); PG8_STAGE(PG8_SA(1, 0), cA + kstep, voffA); PG8_STAGE(PG8_SB(1, 1), cB + hstep + kstep, voffB);
        PG8_WAIT_V(6); PG8_BAR;
    }
    for (;;) {
        const bool has_next = S.next(ui + 1, nxt);
        const char* nA = has_next ? (const char*)g.A + (size_t)nxt.pm * tstep : cA; const char* nB = has_next ? (const char*)g.Bt + (size_t)nxt.pn * tstep : cB;
        for (int t = 0; t < nt; t += 2) {
            const bool last = (t == nt - 2);
            const char* a1 = cA + (size_t)(t + 1) * kstep;
            const char* a2 = last ? nA : cA + (size_t)(t + 2) * kstep; const char* b2 = last ? nB : cB + (size_t)(t + 2) * kstep;
            const char* a3 = a2 + kstep; const char* b3 = b2 + kstep;
            if (last && has_next) S.a_ready(nxt);
            if constexpr (SP2) {
            PG8_LDB(B0, 0, 0); PG8_LDB(B1, 0, 1); PG8_SCHED; PG8_LDA(At, 0, 0); PG8_STAGE(PG8_SA(1, 1), a1 + hstep, voffA);
            PG8_WAIT_V(8); PG8_WAIT_L(0); PG8_BAR; PG8_MMA(0, 0, At, B0); PG8_MMA(0, 1, At, B1); PG8_BAR; PG8_SCHED;
            PG8_LDA(At, 0, 1); PG8_STAGE(PG8_SB(0, 0), b2, voffB); PG8_STAGE(PG8_SB(0, 1), b2 + hstep, voffB); PG8_STAGE(PG8_SA(0, 0), a2, voffA);
            PG8_WAIT_V(8); PG8_WAIT_L(0); PG8_BAR; PG8_MMA(1, 0, At, B0); PG8_MMA(1, 1, At, B1); PG8_BAR; PG8_SCHED;
            PG8_LDB(B0, 1, 0); PG8_LDB(B1, 1, 1); PG8_SCHED; PG8_LDA(At, 1, 0); PG8_STAGE(PG8_SA(0, 1), a2 + hstep, voffA);
            PG8_WAIT_V(8); PG8_WAIT_L(0); PG8_BAR; PG8_MMA(0, 0, At, B0); PG8_MMA(0, 1, At, B1); PG8_BAR; PG8_SCHED;
            PG8_LDA(At, 1, 1); PG8_STAGE(PG8_SB(1, 0), b3, voffB); PG8_STAGE(PG8_SB(1, 1), b3 + hstep, voffB); PG8_STAGE(PG8_SA(1, 0), a3, voffA);
            PG8_WAIT_V(8); PG8_WAIT_L(0); PG8_BAR; PG8_MMA(1, 0, At, B0); PG8_MMA(1, 1, At, B1); PG8_BAR; PG8_SCHED;
            } else {
            PG8_LDB(B0, 0, 0); PG8_SCHED; PG8_LDA(At, 0, 0); PG8_STAGE(PG8_SA(1, 1), a1 + hstep, voffA);
            PG8_WAIT_L(8); PG8_BAR; PG8_WAIT_L(0); PG8_MMA(0, 0, At, B0); PG8_BAR; PG8_SCHED;
            PG8_LDB(B1, 0, 1); PG8_STAGE(PG8_SB(0, 0), b2, voffB);
            PG8_BAR; PG8_WAIT_L(0); PG8_MMA(0, 1, At, B1); PG8_BAR;
            PG8_LDA(At, 0, 1); PG8_STAGE(PG8_SA(0, 0), a2, voffA);
            PG8_BAR; PG8_WAIT_L(0); PG8_MMA(1, 0, At, B0); PG8_BAR; PG8_SCHED;
            PG8_STAGE(PG8_SB(0, 1), b2 + hstep, voffB);
            PG8_WAIT_V(6); PG8_BAR; PG8_MMA(1, 1, At, B1); PG8_BAR;
            PG8_LDB(B0, 1, 0); PG8_SCHED; PG8_LDA(At, 1, 0); PG8_STAGE(PG8_SA(0, 1), a2 + hstep, voffA);
            PG8_WAIT_L(8); PG8_BAR; PG8_WAIT_L(0); PG8_MMA(0, 0, At, B0); PG8_BAR; PG8_SCHED;
            PG8_LDB(B1, 1, 1); PG8_STAGE(PG8_SB(1, 0), b3, voffB);
            PG8_BAR; PG8_WAIT_L(0); PG8_MMA(0, 1, At, B1); PG8_BAR;
            PG8_LDA(At, 1, 1); PG8_STAGE(PG8_SA(1, 0), a3, voffA);
            PG8_BAR; PG8_WAIT_L(0); PG8_MMA(1, 0, At, B0); PG8_BAR; PG8_SCHED;
            PG8_STAGE(PG8_SB(1, 1), b3 + hstep, voffB);
            PG8_WAIT_V(6); PG8_BAR; PG8_MMA(1, 1, At, B1); PG8_BAR;
            }
        }
        if constexpr (ALIGN_EPI) { if (wr == 0) PG8_BAR; }
        if constexpr (!Epi::AFTER_DRAIN) { E(acc, cur, wr, wc, fr, fq); S.done(cur); }
        if (!has_next) break;
#pragma unroll
        for (int a = 0; a < 2; ++a)
#pragma unroll
            for (int b = 0; b < 2; ++b)
#pragma unroll
                for (int m = 0; m < 4; ++m)
#pragma unroll
                    for (int n = 0; n < 2; ++n) acc[a][b][m][n] = (f32x4){0.f, 0.f, 0.f, 0.f};
        cur = nxt; cA = nA; cB = nB; ++ui;
        if constexpr (ALIGN_EPI) { if (wr == 1) PG8_BAR; }
    }
    PG8_WAIT_V(0);
    if constexpr (!ALIGN_EPI) { if (wr == 0) PG8_BAR; }
    PG8_BAR;
    if constexpr (Epi::AFTER_DRAIN) { E.fused(acc, cur, wr, wc, fr, fq, lds, wid, lane); S.done(cur); }
#undef PG8_SA
#undef PG8_SB
#undef PG8_STAGE
#undef PG8_LDA
#undef PG8_LDB
#undef PG8_MMA
#undef PG8_WAIT_V
#undef PG8_WAIT_L
#undef PG8_BAR
#undef PG8_SCHED
}
}
namespace att {
using pg8::bf16_t; using pg8::bf16x8; using pg8::f32x4; using pg8::u32x4; using pg8::u32x2; using pg8::cvt_pk_bf16; using pg8::QKW; using pg8::VT_PITCH;
typedef float f32x16 __attribute__((ext_vector_type(16)));
#define ALAS __attribute__((address_space(3)))
constexpr int OFF_K0 = 0, OFF_K1 = 8192, OFF_V = 16384, STAGE = 32768, NSTG = 4, OFF_LUT = NSTG * STAGE;
constexpr int OFF_SUB = OFF_LUT + 12 * 260 * 4;
constexpr int ATT_LDS = OFF_SUB + 512;
__device__ __forceinline__ int pi32(int r) { return (r & ~12) | ((r & 4) << 1) | ((r & 8) >> 1); }
__device__ __forceinline__ int t5_bucket(int rel) {
    const int n = rel < 0 ? -rel : rel;
    int b = n < 8 ? n : (n < 12 ? 8 : n < 16 ? 9 : n < 23 ? 10 : n < 32 ? 11 : n < 46 ? 12 : n < 64 ? 13 : n < 91 ? 14 : 15);
    return b + (rel > 0 ? 16 : 0);
}

__device__ __forceinline__ void glds16(const void* gsrc, unsigned lds_dst) { unsigned keep;
    asm volatile("s_mov_b32 %0, m0\n\ts_mov_b32 m0, %2\n\ts_nop 0\n\tglobal_load_lds_dwordx4 %1, off\n\ts_mov_b32 m0, %0" : "=&s"(keep) : "v"(gsrc), "s"(lds_dst) : "memory"); }
typedef float f32x2_t __attribute__((ext_vector_type(2))); typedef __bf16 bf16x2_t __attribute__((ext_vector_type(2)));
__device__ __forceinline__ unsigned cvtpk_s(float lo, float hi) { f32x2_t v = {lo, hi}; bf16x2_t b = __builtin_convertvector(v, bf16x2_t); return __builtin_bit_cast(unsigned, b); }
template <int N> __device__ __forceinline__ void wait_bar() { asm volatile("s_waitcnt vmcnt(%0) lgkmcnt(0)\n\ts_barrier" :: "n"(N) : "memory"); }

template <bool WIN>
__device__ __forceinline__ void attn_unit(ALAS unsigned char* lds, const bf16_t* __restrict__ QK, const bf16_t* __restrict__ VT, bf16_t* __restrict__ Y,
                                          const float* __restrict__ rel_bias, const float* __restrict__ sinkp, const float* __restrict__ subln, float lam,
                                          int seq_base, int S, int q0, int hsel) {
    constexpr float LOG2E = 1.4426950408889634f;
    constexpr int NDB = WIN ? 2 : 4;
    const int tid = threadIdx.x, lane = tid & 63, l31 = lane & 31, hi = lane >> 5;
    const int wid = __builtin_amdgcn_readfirstlane(tid >> 6), half = wid >> 2, wq = wid & 3;
    const int qw = q0 + 32 * wq;
    int qcol, kcol0, kcol1, vrow0, bhead;
    if (WIN) { qcol = (2 * hsel + half) * 64; kcol0 = 512 + (hsel >> 1) * 64; kcol1 = kcol0; vrow0 = (hsel >> 1) * 64; bhead = 2 * hsel; }
    else { qcol = 640 + (2 * hsel + half) * 64; kcol0 = 1152 + (2 * hsel) * 64; kcol1 = kcol0 + 64; vrow0 = 128 + hsel * 128; bhead = 8 + hsel; }
    const ALAS float* lut = (const ALAS float*)(lds + OFF_LUT) + (WIN ? (bhead + half) : bhead) * 260;

    const int t_lo = WIN ? (q0 >= 128 ? (q0 - 128) / 64 : 0) : 0;
    const int t_hi = WIN ? ((q0 + 256) / 64 < S / 64 ? (q0 + 256) / 64 : S / 64) : S / 64;
    const int NT = t_hi - t_lo;
    const unsigned ldsb = (unsigned)(uintptr_t)lds;
    const int drow = 8 * wid + (lane >> 3), dch = (lane & 7) ^ ((4 * wid + (lane >> 4)) & 7);
    const bf16_t* kg = QK + ((size_t)((seq_base >> 6) + t_lo) * 26 * 64 + drow) * 64 + dch * 8 + kcol0 * 64;
    const bf16_t* vg = VT + ((size_t)((seq_base >> 6) + t_lo) * 640 + vrow0 + drow) * 64 + dch * 8;
    const unsigned dk = ldsb + wid * 1024;
#define AT_DMA(tr) do { const unsigned sb_ = (unsigned)__builtin_amdgcn_readfirstlane(dk + (((tr) & (NSTG - 1)) * STAGE)); const size_t ko_ = (size_t)(tr) * 26 * 4096, vo_ = (size_t)(tr) * 640 * 64; \
        glds16(kg + ko_, sb_ + OFF_K0); if (!WIN) glds16(kg + ko_ + 4096, sb_ + OFF_K1); glds16(vg + vo_, sb_ + OFF_V); if (!WIN) glds16(vg + vo_ + 64 * 64, sb_ + OFF_V + 8192); } while (0)
    constexpr int NPW = WIN ? 2 : 4;
    bf16x8 qfr[4];
    { const int qrow = seq_base + qw + l31; const bf16_t* qp = QK + ((size_t)((qrow >> 6) * 26 + (qcol >> 6)) * 64 + (qrow & 63)) * 64 + hi * 8;
#pragma unroll
      for (int ds = 0; ds < 4; ++ds) qfr[ds] = *(const bf16x8*)(qp + ds * 16); }
#define qf(ds) qfr[ds]
    AT_DMA(0); if (NT > 1) AT_DMA(1); if (NT > 2) AT_DMA(2);
    constexpr float THR = 8.0f;
    float m_ref = WIN ? sinkp[2 * hsel + half] * LOG2E : 0.f;
    float l_run = (WIN && hi == 0) ? 1.f : 0.f;
    float cbase = 0.f;
    f32x16 cvec;
#pragma unroll
    for (int r = 0; r < 16; ++r) cvec[r] = cbase - m_ref;
    f32x16 o[NDB];
#pragma unroll
    for (int db = 0; db < NDB; ++db)
#pragma unroll
        for (int r = 0; r < 16; ++r) o[db][r] = 0.f;
    const int krow = pi32(l31), fK = (krow >> 1) & 7, fV = (l31 >> 1) & 7;
    int kx[4], vx[4];
#pragma unroll
    for (int c = 0; c < 4; ++c) { kx[c] = (WIN ? OFF_K0 : (half ? OFF_K1 : OFF_K0)) + krow * 128 + (((2 * c + hi) ^ fK) << 4); vx[c] = OFF_V + l31 * 128 + (((2 * c + hi) ^ fV) << 4); }
    const int qabs = qw + l31;
    const float cfar_lo = __uint_as_float(__builtin_amdgcn_readfirstlane(__float_as_uint(lut[0]))), cfar_hi = __uint_as_float(__builtin_amdgcn_readfirstlane(__float_as_uint(lut[256])));
    asm volatile("" : "+v"(qfr[0]), "+v"(qfr[1]), "+v"(qfr[2]), "+v"(qfr[3]));
#pragma clang loop unroll(disable)
    for (int tr = 0; tr < NT; ++tr) {
        if (tr + 2 < NT) wait_bar<2 * NPW>(); else if (tr + 1 < NT) wait_bar<NPW>(); else wait_bar<0>();
        if (tr + 3 < NT) AT_DMA(tr + 3);
        const int k0 = (t_lo + tr) * 64;
        const bool skip = WIN && (k0 > qw + 31 + 128 || k0 + 63 < qw - 128);
        if (!skip) {
            const bool near = WIN || ((k0 - (qw + 31)) < 128 && (qw - (k0 + 63)) < 128);
            const float cinit = near ? 0.f : (k0 > qw ? cfar_hi : cfar_lo);
            if (__builtin_expect(cinit != cbase, 0)) { cbase = cinit; asm volatile("" ::: "memory");
#pragma unroll
                for (int r = 0; r < 16; ++r) cvec[r] = cbase - m_ref; }
            f32x16 s0, s1;
            const ALAS unsigned char* sb = lds + (tr & (NSTG - 1)) * STAGE;
            {
                bf16x8 ka[8];
#pragma unroll
                for (int ds = 0; ds < 4; ++ds) { ka[2 * ds] = *(const ALAS bf16x8*)(sb + kx[ds]); ka[2 * ds + 1] = *(const ALAS bf16x8*)(sb + kx[ds] + 4096); }
                __builtin_amdgcn_sched_barrier(0);
                s0 = __builtin_amdgcn_mfma_f32_32x32x16_bf16(ka[0], qf(0), cvec, 0, 0, 0);
                s1 = __builtin_amdgcn_mfma_f32_32x32x16_bf16(ka[1], qf(0), cvec, 0, 0, 0);
#pragma unroll
                for (int ds = 1; ds < 4; ++ds) {
                    s0 = __builtin_amdgcn_mfma_f32_32x32x16_bf16(ka[2 * ds], qf(ds), s0, 0, 0, 0);
                    s1 = __builtin_amdgcn_mfma_f32_32x32x16_bf16(ka[2 * ds + 1], qf(ds), s1, 0, 0, 0);
                }
            }
            bf16x8 va[2 * NDB], vc[2 * NDB];
#pragma unroll
            for (int kk = 0; kk < 2; ++kk)
#pragma unroll
                for (int db = 0; db < NDB; ++db) va[kk * NDB + db] = *(const ALAS bf16x8*)(sb + vx[kk] + db * 4096);
            __builtin_amdgcn_sched_barrier(0);
            if (near) {
#pragma unroll
                for (int r = 0; r < 16; ++r) {
                    const int rel = k0 + 16 * (r >> 3) + 8 * hi + (r & 7) - qabs;
                    const int i0 = (rel < -128 ? -128 : (rel > 128 ? 128 : rel)) + 128;
                    const int rel1 = rel + 32;
                    const int i1 = (rel1 < -128 ? -128 : (rel1 > 128 ? 128 : rel1)) + 128;
                    s0[r] += lut[i0]; s1[r] += lut[i1];
                    if (WIN) { if (rel < -128 || rel > 128) s0[r] = -1e30f; if (rel1 < -128 || rel1 > 128) s1[r] = -1e30f; }
                    if ((r & 3) == 3) __builtin_amdgcn_sched_barrier(0);
                }
            }
#define MX3(a, b, c) __builtin_fmaxf(__builtin_fmaxf((a), (b)), (c))
            float mxa = MX3(s0[0], s0[1], s1[0]), mxb = MX3(s0[2], s0[3], s1[1]);
            mxa = MX3(mxa, s1[2], s1[3]);
#pragma unroll
            for (int r = 4; r < 16; r += 4) { mxa = MX3(mxa, s0[r], s0[r + 1]); mxb = MX3(mxb, s0[r + 2], s0[r + 3]); mxa = MX3(mxa, s1[r], s1[r + 1]); mxb = MX3(mxb, s1[r + 2], s1[r + 3]); }
#undef MX3
            float mx = fmaxf(mxa, mxb);
            if (__any(mx > THR)) {
                mx = fmaxf(mx, __shfl_xor(mx, 32));
                const float dl = fmaxf(mx, 0.f);
                m_ref += dl;
                const float f = __builtin_amdgcn_exp2f(-dl);
                l_run *= f;
#pragma unroll
                for (int db = 0; db < NDB; ++db)
#pragma unroll
                    for (int r = 0; r < 16; ++r) o[db][r] *= f;
#pragma unroll
                for (int r = 0; r < 16; ++r) { s0[r] -= dl; s1[r] -= dl; cvec[r] = cbase - m_ref; }
            }
            float ls0 = 0.f, ls1 = 0.f;
#define AT_EXP(SS, B, PF) do { \
                const float e0 = __builtin_amdgcn_exp2f(SS[B + 0]), e1 = __builtin_amdgcn_exp2f(SS[B + 1]), e2 = __builtin_amdgcn_exp2f(SS[B + 2]), e3 = __builtin_amdgcn_exp2f(SS[B + 3]); \
                const float e4 = __builtin_amdgcn_exp2f(SS[B + 4]), e5 = __builtin_amdgcn_exp2f(SS[B + 5]), e6 = __builtin_amdgcn_exp2f(SS[B + 6]), e7 = __builtin_amdgcn_exp2f(SS[B + 7]); \
                ls0 += e0; ls1 += e4; ls0 += e1; ls1 += e5; ls0 += e2; ls1 += e6; ls0 += e3; ls1 += e7; \
                PF.u.x = cvtpk_s(e0, e1); PF.u.y = cvtpk_s(e2, e3); PF.u.z = cvtpk_s(e4, e5); PF.u.w = cvtpk_s(e6, e7); } while (0)
            union PFU { u32x4 u; bf16x8 b; };
            PFU p0, p1, p2, p3;
            AT_EXP(s0, 0, p0);
#pragma unroll
            for (int kk = 0; kk < 2; ++kk)
#pragma unroll
                for (int db = 0; db < NDB; ++db) vc[kk * NDB + db] = *(const ALAS bf16x8*)(sb + vx[kk + 2] + db * 4096);
            __builtin_amdgcn_sched_barrier(0);
#pragma unroll
            for (int db = 0; db < NDB; ++db) o[db] = __builtin_amdgcn_mfma_f32_32x32x16_bf16(va[db], p0.b, o[db], 0, 0, 0);
            AT_EXP(s0, 8, p1);
            __builtin_amdgcn_sched_barrier(0);
#pragma unroll
            for (int db = 0; db < NDB; ++db) o[db] = __builtin_amdgcn_mfma_f32_32x32x16_bf16(va[NDB + db], p1.b, o[db], 0, 0, 0);
            AT_EXP(s1, 0, p2);
            __builtin_amdgcn_sched_barrier(0);
#pragma unroll
            for (int db = 0; db < NDB; ++db) o[db] = __builtin_amdgcn_mfma_f32_32x32x16_bf16(vc[db], p2.b, o[db], 0, 0, 0);
            AT_EXP(s1, 8, p3);
            __builtin_amdgcn_sched_barrier(0);
#pragma unroll
            for (int db = 0; db < NDB; ++db) o[db] = __builtin_amdgcn_mfma_f32_32x32x16_bf16(vc[NDB + db], p3.b, o[db], 0, 0, 0);
            __builtin_amdgcn_sched_barrier(0);
#undef AT_EXP
            l_run += ls0 + ls1;
        }
    }
    asm volatile("s_waitcnt lgkmcnt(0)\n\ts_barrier" ::: "memory");
#undef qf
#undef AT_DMA
    const float l_tot = l_run + __shfl_xor(l_run, 32);
    const float inv = 1.0f / l_tot;
    const size_t orow = (size_t)(seq_base + qw + l31) * 1024;
    if (WIN) {
        bf16_t* yp = Y + orow + (2 * hsel + half) * 64 + 4 * hi;
#pragma unroll
        for (int db = 0; db < NDB; ++db)
#pragma unroll
            for (int g = 0; g < 4; ++g) {
                u32x2 w; w.x = cvt_pk_bf16(o[db][4 * g] * inv, o[db][4 * g + 1] * inv); w.y = cvt_pk_bf16(o[db][4 * g + 2] * inv, o[db][4 * g + 3] * inv);
                *(u32x2*)(yp + 32 * db + 8 * g) = w;
            }
    } else {
        ALAS f32x4* xch = (ALAS f32x4*)lds + (size_t)wq * 1024 + l31;
        if (half == 1) {
#pragma unroll
            for (int db = 0; db < NDB; ++db)
#pragma unroll
                for (int g = 0; g < 4; ++g) { f32x4 v; v[0] = o[db][4 * g] * inv; v[1] = o[db][4 * g + 1] * inv; v[2] = o[db][4 * g + 2] * inv; v[3] = o[db][4 * g + 3] * inv;
                    xch[(8 * db + 2 * g + hi) * 32] = v; }
        }
        __syncthreads();
        if (half == 0) {
            float ss = 0.f;
#pragma unroll
            for (int db = 0; db < NDB; ++db)
#pragma unroll
                for (int g = 0; g < 4; ++g) { const f32x4 v = xch[(8 * db + 2 * g + hi) * 32];
#pragma unroll
                    for (int i = 0; i < 4; ++i) { const float x = o[db][4 * g + i] * inv - lam * v[i]; o[db][4 * g + i] = x; ss += x * x; } }
            ss += __shfl_xor(ss, 32);
            const float rn = __builtin_amdgcn_rsqf(ss * (1.0f / 128.0f) + 1e-6f) * 0.8f;
            bf16_t* yp = Y + orow + 512 + hsel * 128 + 4 * hi;
#pragma unroll
            for (int db = 0; db < NDB; ++db)
#pragma unroll
                for (int g = 0; g < 4; ++g) { const f32x4 gsc = *(const ALAS f32x4*)(lds + OFF_SUB + (32 * db + 8 * g + 4 * hi) * 4);
                    u32x2 w; w.x = cvt_pk_bf16(o[db][4 * g] * rn * gsc[0], o[db][4 * g + 1] * rn * gsc[1]); w.y = cvt_pk_bf16(o[db][4 * g + 2] * rn * gsc[2], o[db][4 * g + 3] * rn * gsc[3]);
                    *(u32x2*)(yp + 32 * db + 8 * g) = w; }
        }
        __syncthreads();
    }
}

__device__ __forceinline__ void attn_phase(ALAS unsigned char* lds, const bf16_t* QK, const bf16_t* VT, bf16_t* Y, const float* rel_bias, const float* sinkp, const float* subln, const float* blam) {
    float lam;
    { const int lane = threadIdx.x & 63; float a = blam[lane] * blam[64 + lane], b = blam[128 + lane] * blam[192 + lane];
#pragma unroll
      for (int o = 1; o < 64; o <<= 1) { a += __shfl_xor(a, o); b += __shfl_xor(b, o); }
      lam = __expf(a) - __expf(b) + 0.2f; }
    { constexpr float LOG2E = 1.4426950408889634f; ALAS float* lutw = (ALAS float*)(lds + OFF_LUT);
      for (int i = threadIdx.x; i < 12 * 257; i += 512) { const int hh = i / 257, ri = i - hh * 257; lutw[hh * 260 + ri] = rel_bias[t5_bucket(ri - 128) * 12 + hh] * LOG2E; }
      if (threadIdx.x < 128) ((ALAS float*)(lds + OFF_SUB))[threadIdx.x] = subln[threadIdx.x];
      __syncthreads(); }
    const int G = gridDim.x, bx = blockIdx.x;
    if (G == 256) {
        const int x = bx & 7, j = bx >> 3;
        for (int r = 0; r < 8; ++r) { const int bh = x + 8 * (r >> 1), qb = j + 32 * (r & 1);
            attn_unit<false>(lds, QK, VT, Y, rel_bias, sinkp, subln, lam, (bh >> 2) * 8192, 8192, qb * 128, bh & 3); }
        for (int r = 0; r < 8; ++r) { const int bh = x + 8 * ((j >> 4) + 2 * r), qb = j & 15;
            attn_unit<false>(lds, QK, VT, Y, rel_bias, sinkp, subln, lam, 65536 + (bh >> 2) * 2048, 2048, qb * 128, bh & 3); }
    } else {
    for (int u = bx; u < 2048; u += G) { const int qb = u & 63, bh = u >> 6; attn_unit<false>(lds, QK, VT, Y, rel_bias, sinkp, subln, lam, (bh >> 2) * 8192, 8192, qb * 128, bh & 3); }
    for (int u = bx; u < 2048; u += G) { const int qb = u & 15, bh = u >> 4; attn_unit<false>(lds, QK, VT, Y, rel_bias, sinkp, subln, lam, 65536 + (bh >> 2) * 2048, 2048, qb * 128, bh & 3); }
    }
    for (int u = bx; u < 4096; u += G) { const int hp = u & 3, qb = u >> 2;
        const int row0 = qb * 128; int seq_base, S;
        if (row0 < 65536) { seq_base = row0 & ~8191; S = 8192; } else { seq_base = row0 & ~2047; S = 2048; }
        attn_unit<true>(lds, QK, VT, Y, rel_bias, sinkp, subln, lam, seq_base, S, row0 - seq_base, hp); }
}
}

namespace cv {
using pg8::bf16_t; using pg8::f32x4; using pg8::u32x4; using pg8::cvt_pk_bf16; using pg8::bf_lo; using pg8::bf_hi; using pg8::fast_sigmoid;
#define CLAS __attribute__((address_space(3)))
constexpr int T = 32, HALO = 15, ROWS = T + 2 * HALO;
constexpr int OFF_U0 = 0, OFF_U1 = 64 * 1024;
constexpr int CONV_LDS = OFF_U1 + T * 512 * 4;
__device__ __forceinline__ void conv_unit(CLAS unsigned char* lds, const bf16_t* __restrict__ PC, bf16_t* __restrict__ YC, const float* __restrict__ w3, const float* __restrict__ w31,
                                          const float* __restrict__ dwb, const float* __restrict__ lng, const float* __restrict__ lnb, int seq_base, int S, int t0) {
    const int tid = threadIdx.x;
    {
        u32x4 w8[8];
#pragma unroll
        for (int it = 0; it < 8; ++it) { const int idx = tid + 512 * it, j = idx >> 6, v = idx & 63, tok = t0 - HALO + j;
            w8[it] = (u32x4){0u, 0u, 0u, 0u};
            if (idx < ROWS * 64 && tok >= 0 && tok < S) w8[it] = *(const u32x4*)(PC + (size_t)(seq_base + tok) * 1536 + 1024 + v * 8); }
#pragma unroll
        for (int it = 0; it < 8; ++it) { const int idx = tid + 512 * it, j = idx >> 6, v = idx & 63;
            if (idx < ROWS * 64) *(CLAS u32x4*)(lds + OFF_U0 + j * 1024 + v * 16) = w8[it]; }
    }
    __syncthreads();
    const int cp = tid & 255, th = tid >> 8;
    {
        const float wa0 = w3[2 * cp], wa1 = w3[512 + 2 * cp], wa2 = w3[1024 + 2 * cp];
        const float wb0 = w3[2 * cp + 1], wb1 = w3[512 + 2 * cp + 1], wb2 = w3[1024 + 2 * cp + 1];
        const int tb = t0 + 16 * th;
        unsigned pw[18], gw[16];
#pragma unroll
        for (int i = 0; i < 18; ++i) { const int tok = tb - 1 + i; pw[i] = 0u; if (tok >= 0 && tok < S) pw[i] = *(const unsigned*)(PC + (size_t)(seq_base + tok) * 1536 + 512 + 2 * cp); }
#pragma unroll
        for (int i = 0; i < 16; ++i) gw[i] = *(const unsigned*)(PC + (size_t)(seq_base + tb + i) * 1536 + 2 * cp);
#pragma unroll
        for (int i = 0; i < 16; ++i) {
            const float ya = bf_lo(gw[i]) * (wa0 * bf_lo(pw[i]) + wa1 * bf_lo(pw[i + 1]) + wa2 * bf_lo(pw[i + 2]));
            const float yb = bf_hi(gw[i]) * (wb0 * bf_hi(pw[i]) + wb1 * bf_hi(pw[i + 1]) + wb2 * bf_hi(pw[i + 2]));
            *(unsigned*)(YC + (size_t)(seq_base + tb + i) * 1024 + 2 * cp) = cvt_pk_bf16(ya, yb);
        }
    }
    {
        float wa[31], wb[31];
#pragma unroll
        for (int j = 0; j < 31; ++j) { wa[j] = w31[j * 512 + 2 * cp]; wb[j] = w31[j * 512 + 2 * cp + 1]; }
        const float ba = dwb[2 * cp], bb = dwb[2 * cp + 1];
        for (int g4 = 0; g4 < 4; ++g4) {
            const int tt = 16 * th + 4 * g4;
            float aa[4], ab[4];
#pragma unroll
            for (int k = 0; k < 4; ++k) { aa[k] = ba; ab[k] = bb; }
            const CLAS unsigned char* up = lds + OFF_U0 + tt * 1024 + cp * 4;
#pragma unroll
            for (int rr = 0; rr < 34; ++rr) {
                const unsigned w = *(const CLAS unsigned*)(up + rr * 1024);
                const float xa = bf_lo(w), xb = bf_hi(w);
#pragma unroll
                for (int k = 0; k < 4; ++k) { const int j = rr - k; if (j >= 0 && j < 31) { aa[k] += wa[j] * xa; ab[k] += wb[j] * xb; } }
            }
#pragma unroll
            for (int k = 0; k < 4; ++k) { typedef float f32x2 __attribute__((ext_vector_type(2))); *(CLAS f32x2*)(lds + OFF_U1 + (tt + k) * 2048 + cp * 8) = (f32x2){aa[k], ab[k]}; }
        }
    }
    __syncthreads();
    {
        const int lane = tid & 63, wid = tid >> 6;
        const f32x4 g0 = *(const f32x4*)(lng + 8 * lane), g1 = *(const f32x4*)(lng + 8 * lane + 4), b0 = *(const f32x4*)(lnb + 8 * lane), b1 = *(const f32x4*)(lnb + 8 * lane + 4);
        for (int k = 0; k < 4; ++k) {
            const int tt = 4 * wid + k;
            const f32x4 x0 = *(const CLAS f32x4*)(lds + OFF_U1 + tt * 2048 + lane * 32), x1 = *(const CLAS f32x4*)(lds + OFF_U1 + tt * 2048 + lane * 32 + 16);
            float s = ((x0[0] + x0[1]) + (x0[2] + x0[3])) + ((x1[0] + x1[1]) + (x1[2] + x1[3]));
#pragma unroll
            for (int o = 1; o < 64; o <<= 1) s += __shfl_xor(s, o);
            const float mean = s * (1.0f / 512.0f);
            const f32x4 d0 = x0 - mean, d1 = x1 - mean;
            float q = ((d0[0] * d0[0] + d0[1] * d0[1]) + (d0[2] * d0[2] + d0[3] * d0[3])) + ((d1[0] * d1[0] + d1[1] * d1[1]) + (d1[2] * d1[2] + d1[3] * d1[3]));
#pragma unroll
            for (int o = 1; o < 64; o <<= 1) q += __shfl_xor(q, o);
            const float rstd = __builtin_amdgcn_rsqf(q * (1.0f / 512.0f) + 1e-6f);
            f32x4 y0 = d0 * rstd * g0 + b0, y1 = d1 * rstd * g1 + b1;
#pragma unroll
            for (int i = 0; i < 4; ++i) { y0[i] = y0[i] * fast_sigmoid(y0[i]); y1[i] = y1[i] * fast_sigmoid(y1[i]); }
            u32x4 w; w.x = cvt_pk_bf16(y0[0], y0[1]); w.y = cvt_pk_bf16(y0[2], y0[3]); w.z = cvt_pk_bf16(y1[0], y1[1]); w.w = cvt_pk_bf16(y1[2], y1[3]);
            *(u32x4*)(YC + (size_t)(seq_base + t0 + tt) * 1024 + 512 + 8 * lane) = w;
        }
    }
    __syncthreads();
}
__device__ __forceinline__ void conv_phase(CLAS unsigned char* lds, const bf16_t* PC, bf16_t* YC, const float* w3, const float* w31, const float* dwb, const float* lng, const float* lnb) {
    for (int u = blockIdx.x; u < 131072 / T; u += gridDim.x) {
        const int row0 = u * T; int seq_base, S;
        if (row0 < 65536) { seq_base = row0 & ~8191; S = 8192; } else { seq_base = row0 & ~2047; S = 2048; }
        conv_unit(lds, PC, YC, w3, w31, dwb, lng, lnb, seq_base, S, row0 - seq_base);
    }
}
}

namespace mk {
using pg8::bf16_t; using pg8::f32x4; using pg8::u32x4; using pg8::u32x2; using pg8::cvt_pk_bf16;
#define MLAS __attribute__((address_space(3)))
constexpr int M = 131072, D = 1024, FF = 2816, NQKV = 2304, NCI = 2560;
constexpr size_t MiB = 1u << 20;
constexpr size_t WS_X = 0;
constexpr size_t WS_BIG = 256 * MiB;
constexpr size_t WS_VT = WS_BIG + (size_t)M * pg8::QKW * 2;
constexpr size_t WS_W = 960 * MiB;
constexpr size_t WS_WQKV = WS_W, WS_WO = WS_WQKV + (size_t)NQKV * D * 2, WS_WGU0 = WS_WO + (size_t)D * D * 2, WS_WGU1 = WS_WGU0 + (size_t)2 * FF * D * 2,
                 WS_WD0 = WS_WGU1 + (size_t)2 * FF * D * 2, WS_WD1 = WS_WD0 + (size_t)D * FF * 2, WS_WCI = WS_WD1 + (size_t)D * FF * 2, WS_WCO = WS_WCI + (size_t)NCI * D * 2;
constexpr size_t WS_SSQ = 1008 * MiB;
constexpr size_t WS_CTL = 1016 * MiB, CTL_BYTES = 16384;
constexpr size_t WS_END = WS_CTL + 65536;
static_assert(WS_VT + (size_t)640 * pg8::VT_PITCH * 2 <= WS_W && WS_BIG + (size_t)M * FF * 2 <= WS_W && WS_WCO + (size_t)D * D * 2 <= WS_SSQ, "ws map");
constexpr int MISC_OFF = 147456, LDS_BYTES = MISC_OFF + 256;
static_assert(att::ATT_LDS <= MISC_OFF && cv::CONV_LDS <= MISC_OFF && pg8::STAGE_BYTES + 16384 <= MISC_OFF, "lds map");

#define XB_TMO      128
#define XB_XCNT(j)  (256  + 64 * (j))
#define XB_XSUB(j)  (1280 + 64 * (j))
#define XB_XGEN(j)  (2304 + 64 * (j))
#define XB_TOP      3328
#define XB_TOPGEN   3392
#define XCD_BAR_WORDS 3456
#define XB_SPIN_CAP (1u << 18)

__device__ __forceinline__ unsigned xb_ld(unsigned* p)              { return __hip_atomic_load(p, __ATOMIC_RELAXED, __HIP_MEMORY_SCOPE_AGENT); }
__device__ __forceinline__ unsigned xb_add(unsigned* p, unsigned v) { return __hip_atomic_fetch_add(p, v, __ATOMIC_RELAXED, __HIP_MEMORY_SCOPE_AGENT); }
__device__ __forceinline__ unsigned xb_xcc_id() { return (unsigned)__builtin_amdgcn_s_getreg((3 << 11) | 20) & 0xFu; }
#define XB_SPIN(cond, bar) do { unsigned _sp = 0; while (cond) { __builtin_amdgcn_s_sleep(1); \
    if ((++_sp & 255u) == 0u) { if (xb_ld(&(bar)[XB_TMO])) break; if (_sp > XB_SPIN_CAP) { atomicAdd(&(bar)[XB_TMO], 1u); break; } } } } while (0)

struct XcdBarrier {
    unsigned* bar; unsigned x;
    volatile MLAS unsigned* st;
};

__device__ __forceinline__ XcdBarrier xcd_barrier_post(unsigned* bar, volatile MLAS unsigned* st) {
    XcdBarrier b; b.bar = bar; b.x = xb_xcc_id(); b.st = st;
    if (threadIdx.x == 0) (void)xb_add(&bar[XB_XCNT(b.x)], 1u);
    return b;
}
__device__ __forceinline__ void xcd_barrier_complete(unsigned* bar, unsigned x, unsigned& nloc, unsigned& nx) {
    const unsigned G = gridDim.x * gridDim.y * gridDim.z;
    unsigned sum, cnt, mine, sp = 0u;
    for (;;) {
        sum = 0u; cnt = 0u; mine = 0u;
#pragma unroll
        for (unsigned j = 0; j < 16; ++j) { const unsigned c = xb_ld(&bar[XB_XCNT(j)]); sum += c; cnt += (c > 0u) ? 1u : 0u; mine = (j == x) ? c : mine; }
        if (sum == G) break;
        __builtin_amdgcn_s_sleep(1);
        if ((++sp & 255u) == 0u) { if (xb_ld(&bar[XB_TMO])) break; if (sp > XB_SPIN_CAP) { atomicAdd(&bar[XB_TMO], 1u); break; } }
    }
    nloc = mine > 0u ? mine : 1u; nx = cnt > 0u ? cnt : 1u;
}

__device__ __forceinline__ void xcd_barrier(const XcdBarrier& b) {
    asm volatile("s_waitcnt vmcnt(0)" ::: "memory");
    __syncthreads();
    if (threadIdx.x == 0) {
        unsigned* bar = b.bar;
        __builtin_amdgcn_s_waitcnt(0);
        unsigned nloc = b.st[0], nx = b.st[1];
        if (nloc == 0u) { xcd_barrier_complete(bar, b.x, nloc, nx); b.st[0] = nloc; b.st[1] = nx; }
        const unsigned old = xb_add(&bar[XB_XSUB(b.x)], 1u);
        const unsigned gen = old / nloc;
        if (old + 1u == (gen + 1u) * nloc) {
            __builtin_amdgcn_fence(__ATOMIC_RELEASE, "agent");
            asm volatile("s_waitcnt vmcnt(0)" ::: "memory");
            const unsigned og = xb_add(&bar[XB_TOP], 1u);
            const unsigned tg = og / nx;
            if (og + 1u == (tg + 1u) * nx) xb_add(&bar[XB_TOPGEN], 1u);
            else XB_SPIN(xb_ld(&bar[XB_TOPGEN]) == tg, bar);
            __builtin_amdgcn_fence(__ATOMIC_ACQUIRE, "agent");
            xb_add(&bar[XB_XGEN(b.x)], 1u);
            asm volatile("s_waitcnt vmcnt(0)" ::: "memory");
        } else {
            XB_SPIN(xb_ld(&bar[XB_XGEN(b.x)]) == gen, bar);
            __builtin_amdgcn_fence(__ATOMIC_ACQUIRE, "agent");
            asm volatile("s_waitcnt vmcnt(0)" ::: "memory");
        }
    }
    __syncthreads();
}

static_assert(XCD_BAR_WORDS * 4 <= CTL_BYTES, "barrier words");
struct Params { const float* in[24]; float* out; unsigned char* ws; int ph_lo, ph_hi; };

__device__ __forceinline__ void tr_item(const float* __restrict__ W, int ldw, int srccol0, const float* __restrict__ gain, bf16_t* __restrict__ WT, int K, int destrow0, int k0, MLAS float* scr, int lane) {
    float wv[32];
#pragma unroll
    for (int i = 0; i < 32; ++i) { const int kk = 2 * i + (lane >> 5); wv[i] = W[(size_t)(k0 + kk) * ldw + srccol0 + (lane & 31)]; }
    const float g0 = gain ? gain[k0 + (lane & 31) * 2] : 1.0f, g1 = gain ? gain[k0 + (lane & 31) * 2 + 1] : 1.0f;
#pragma unroll
    for (int i = 0; i < 32; ++i) { const int kk = 2 * i + (lane >> 5); const float ga = __shfl(g0, i), gb = __shfl(g1, i); scr[kk * 33 + (lane & 31)] = wv[i] * ((lane >> 5) ? gb : ga); }
    asm volatile("s_waitcnt lgkmcnt(0)" ::: "memory");
    const int c = lane & 7;
#pragma unroll
    for (int j = 0; j < 4; ++j) { const int n = (lane >> 3) + 8 * j; const MLAS float* s = scr + (8 * c) * 33 + n;
        u32x4 o; o.x = cvt_pk_bf16(s[0 * 33], s[1 * 33]); o.y = cvt_pk_bf16(s[2 * 33], s[3 * 33]); o.z = cvt_pk_bf16(s[4 * 33], s[5 * 33]); o.w = cvt_pk_bf16(s[6 * 33], s[7 * 33]);
        *(u32x4*)(WT + (size_t)(destrow0 + n) * K + k0 + 8 * c) = o; }
    asm volatile("s_waitcnt lgkmcnt(0)" ::: "memory");
}

__device__ __forceinline__ void prologue(const Params& p, MLAS unsigned char* lds) {
    const int tid = threadIdx.x, lane = tid & 63, wave = tid >> 6;
    MLAS float* scr = (MLAS float*)(lds + wave * 16384);
    const int gw = blockIdx.x * 8 + wave, NGW = gridDim.x * 8;
    unsigned char* ws = p.ws;
    constexpr int I_QKV = (NQKV / 32) * (D / 64), I_O = (D / 32) * (D / 64), I_GU = (2 * FF / 32) * (D / 64), I_D = (D / 32) * (FF / 64), I_CI = (NCI / 32) * (D / 64);
    constexpr int NIT = I_QKV + I_O + 2 * I_GU + 2 * I_D + I_CI + I_O;
    for (int it = gw; it < NIT; it += NGW) {
        int r = it;
        if (r < I_QKV) { const int kb = r / (NQKV / 32), nb = r % (NQKV / 32); const int n0 = nb * 32, pn = n0 >> 8, within = n0 & 255, bj = within >> 7, wc = (within & 127) >> 5;
            tr_item(p.in[8], NQKV, 256 * pn + 64 * wc + 32 * bj, p.in[3], (bf16_t*)(ws + WS_WQKV), D, n0, kb * 64, scr, lane); continue; }
        r -= I_QKV;
        if (r < I_O) { const int kb = r / (D / 32), nb = r % (D / 32); tr_item(p.in[9], D, nb * 32, nullptr, (bf16_t*)(ws + WS_WO), D, nb * 32, kb * 64, scr, lane); continue; }
        r -= I_O;
        if (r < 2 * I_GU) { const int l = r / I_GU; r -= l * I_GU; const int kb = r / (2 * FF / 32), nb = r % (2 * FF / 32); const int n0 = nb * 32, pn = n0 >> 8, within = n0 & 255, bj = within >> 7, j = within & 127;
            const float* src = (bj ? p.in[6] : p.in[5]) + (size_t)l * D * FF;
            tr_item(src, FF, 128 * pn + j, p.in[4] + l * D, (bf16_t*)(ws + (l ? WS_WGU1 : WS_WGU0)), D, n0, kb * 64, scr, lane); continue; }
        r -= 2 * I_GU;
        if (r < 2 * I_D) { const int l = r / I_D; r -= l * I_D; const int kb = r / (D / 32), nb = r % (D / 32);
            tr_item(p.in[7] + (size_t)l * FF * D, D, nb * 32, nullptr, (bf16_t*)(ws + (l ? WS_WD1 : WS_WD0)), FF, nb * 32, kb * 64, scr, lane); continue; }
        r -= 2 * I_D;
        if (r < I_CI) { const int kb = r / (NCI / 32), nb = r % (NCI / 32); const int n0 = nb * 32, pn = n0 >> 8, within = n0 & 255, bj = within >> 7, j = within & 127;
            const int src = pn < 2 ? n0 : (pn < 6 ? (bj ? 1024 : 512) + 128 * (pn - 2) + j : (bj ? 2048 : 1536) + 128 * (pn - 6) + j);
            tr_item(p.in[17], NCI, src, p.in[3] + D, (bf16_t*)(ws + WS_WCI), D, n0, kb * 64, scr, lane); continue; }
        r -= I_CI;
        { const int kb = r / (D / 32), nb = r % (D / 32); tr_item(p.in[18], D, nb * 32, nullptr, (bf16_t*)(ws + WS_WCO), D, nb * 32, kb * 64, scr, lane); }
    }
    bf16_t* X = (bf16_t*)(ws + WS_X); float* ssq = (float*)(ws + WS_SSQ);
    for (int m0 = gw; m0 < M; m0 += 4 * NGW) {
        f32x4 v[4][4];
#pragma unroll
        for (int r = 0; r < 4; ++r) { const int m = m0 + r * NGW; if (m < M) { const float* xrow = (m < 65536) ? p.in[0] + (size_t)m * D : p.in[1] + (size_t)(m - 65536) * D; const f32x4* xr = (const f32x4*)xrow + lane;
#pragma unroll
            for (int j = 0; j < 4; ++j) v[r][j] = xr[64 * j]; } }
#pragma unroll
        for (int r = 0; r < 4; ++r) { const int m = m0 + r * NGW; if (m < M) {
            float s = 0.f;
#pragma unroll
            for (int j = 0; j < 4; ++j) s += (v[r][j][0] * v[r][j][0] + v[r][j][1] * v[r][j][1]) + (v[r][j][2] * v[r][j][2] + v[r][j][3] * v[r][j][3]);
#pragma unroll
            for (int o = 1; o < 64; o <<= 1) s += __shfl_xor(s, o);
            u32x2* o8 = (u32x2*)(X + (size_t)m * D) + lane;
#pragma unroll
            for (int j = 0; j < 4; ++j) { u32x2 w; w.x = cvt_pk_bf16(v[r][j][0], v[r][j][1]); w.y = cvt_pk_bf16(v[r][j][2], v[r][j][3]); o8[64 * j] = w; }
            if (lane < 16) ssq[(size_t)m * 16 + lane] = (lane == 0) ? s : 0.f; } }
    }
}

__global__ void __launch_bounds__(512, 2) fwd_kernel(Params p) {
    extern __shared__ __attribute__((aligned(16))) unsigned char lds_raw[];
    MLAS unsigned char* lds = (MLAS unsigned char*)lds_raw;
    cg::grid_group grid = cg::this_grid();
    unsigned char* ws = p.ws;
    bf16_t* X = (bf16_t*)(ws + WS_X); bf16_t* BIG = (bf16_t*)(ws + WS_BIG); bf16_t* VT = (bf16_t*)(ws + WS_VT); float* ssq = (float*)(ws + WS_SSQ);
    bf16_t* Y = (bf16_t*)p.out;
    const int lo = p.ph_lo, hi = p.ph_hi, G = gridDim.x, bx = blockIdx.x;
    volatile MLAS unsigned* misc = (volatile MLAS unsigned*)(lds + MISC_OFF);
    if (threadIdx.x < 2) misc[threadIdx.x] = 0u;
    __syncthreads();
    const XcdBarrier xbar = xcd_barrier_post((unsigned*)(ws + WS_CTL), misc);
#ifndef PH_MASK
#define PH_MASK 0x7ff
#endif
#define IN(k) (((PH_MASK >> (k)) & 1) && lo <= (k) && (k) < hi)
#define SEAM(k) do { if (IN(k) && IN((k) + 1)) { if ((k) == 0) grid.sync(); else xcd_barrier(xbar); } } while (0)
    if (IN(0)) { prologue(p, lds); __syncthreads(); }
    SEAM(0);
    if (IN(1)) { pg8::Gemm g{X, (const bf16_t*)(ws + WS_WQKV), M, NQKV, D}; pg8::StaticOrder S; S.init(M, NQKV, G, bx);
        pg8::EpiQKV E{BIG, VT, ssq, p.in[10], p.in[11], p.in[13], p.in[14], lds + pg8::STAGE_BYTES};
        pg8::gemm_phase<pg8::EpiQKV, pg8::StaticOrder, true, true>(lds, g, S, E); }
    SEAM(1);
    if (IN(2)) { for (int rep = 0; rep < PROBE_ATT; ++rep) att::attn_phase(lds, BIG, VT, Y, p.in[2], p.in[12], p.in[16], p.in[15]); }
    SEAM(2);
    if (IN(3)) { pg8::Gemm g{Y, (const bf16_t*)(ws + WS_WO), M, D, D}; pg8::StaticOrder S; S.init(M, D, G, bx);
        pg8::EpiRes<false> E{X, nullptr, ssq};
        pg8::gemm_phase<pg8::EpiRes<false>, pg8::StaticOrder, true, true>(lds, g, S, E); }
    SEAM(3);
    if (IN(4)) { pg8::Gemm g{X, (const bf16_t*)(ws + WS_WGU0), M, 2 * FF, D}; pg8::StaticOrder S; S.init(M, 2 * FF, G, bx);
        pg8::EpiGlu E{BIG, ssq};
        pg8::gemm_phase<pg8::EpiGlu, pg8::StaticOrder, true, true>(lds, g, S, E); }
    SEAM(4);
    if (IN(5)) { pg8::Gemm g{BIG, (const bf16_t*)(ws + WS_WD0), M, D, FF}; pg8::StaticOrder S; S.init(M, D, G, bx);
        pg8::EpiRes<false> E{X, nullptr, ssq};
        pg8::gemm_phase<pg8::EpiRes<false>, pg8::StaticOrder, true, true>(lds, g, S, E); }
    SEAM(5);
    if (IN(6)) { pg8::Gemm g{X, (const bf16_t*)(ws + WS_WCI), M, NCI, D}; pg8::StaticOrder S; S.init(M, NCI, G, bx);
        pg8::EpiConvIn E{BIG, ssq};
        pg8::gemm_phase<pg8::EpiConvIn, pg8::StaticOrder, true, true>(lds, g, S, E); }
    SEAM(6);
    if (IN(7)) { cv::conv_phase(lds, BIG, Y, p.in[19], p.in[20], p.in[21], p.in[22], p.in[23]); }
    SEAM(7);
    if (IN(8)) { pg8::Gemm g{Y, (const bf16_t*)(ws + WS_WCO), M, D, D}; pg8::StaticOrder S; S.init(M, D, G, bx);
        pg8::EpiRes<false> E{X, nullptr, ssq};
        pg8::gemm_phase<pg8::EpiRes<false>, pg8::StaticOrder, true, true>(lds, g, S, E); }
    SEAM(8);
    if (IN(9)) { pg8::Gemm g{X, (const bf16_t*)(ws + WS_WGU1), M, 2 * FF, D}; pg8::StaticOrder S; S.init(M, 2 * FF, G, bx);
        pg8::EpiGlu E{BIG, ssq};
        pg8::gemm_phase<pg8::EpiGlu, pg8::StaticOrder, true, true>(lds, g, S, E); }
    SEAM(9);
    if (IN(10)) { pg8::Gemm g{BIG, (const bf16_t*)(ws + WS_WD1), M, D, FF}; pg8::StaticOrder S; S.init(M, D, G, bx);
        pg8::EpiRes<true> E{X, p.out, ssq};
        pg8::gemm_phase<pg8::EpiRes<true>, pg8::StaticOrder, true, true>(lds, g, S, E); }
#undef IN
#undef SEAM
}
}

#ifndef MK_N_LAUNCHES_X
#define MK_N_LAUNCHES 1
#endif
extern "C" void kernel_launch(void* const* d_in, const int* in_sizes, int n_in, void* d_out, int out_size, void* d_ws, size_t ws_size, hipStream_t stream) {
    static int grid = 0;
    if (grid == 0) {
        if (n_in != 24 || out_size != mk::M * mk::D || ws_size < mk::WS_END) { fprintf(stderr, "kernel_launch: unexpected shapes (n_in %d out %d ws %zu)\n", n_in, out_size, ws_size); grid = -1; return; }
        int dev = 0, cus = 0, per_cu = 0;
        (void)hipGetDevice(&dev); (void)hipDeviceGetAttribute(&cus, hipDeviceAttributeMultiprocessorCount, dev);
        (void)hipFuncSetAttribute((const void*)mk::fwd_kernel, hipFuncAttributeMaxDynamicSharedMemorySize, mk::LDS_BYTES);
        (void)hipOccupancyMaxActiveBlocksPerMultiprocessor(&per_cu, (const void*)mk::fwd_kernel, 512, mk::LDS_BYTES);
        if (per_cu < 1) per_cu = 1;
        (void)hipGetLastError();
        grid = cus * per_cu;
    }
    if (grid < 0) return;
    if (hipMemsetAsync((char*)d_ws + mk::WS_CTL, 0, mk::CTL_BYTES, stream) != hipSuccess) { fprintf(stderr, "kernel_launch: memset of the barrier words failed\n"); return; }
    mk::Params p{};
    for (int i = 0; i < 24; ++i) p.in[i] = (const float*)d_in[i];
    p.out = (float*)d_out; p.ws = (unsigned char*)d_ws;
#if MK_N_LAUNCHES == 1
    p.ph_lo = 0; p.ph_hi = 11;
    void* args[] = {&p};
    hipError_t e = hipLaunchCooperativeKernel((const void*)mk::fwd_kernel, dim3(grid), dim3(512), args, mk::LDS_BYTES, stream);
    if (e != hipSuccess) fprintf(stderr, "cooperative launch failed: %s (grid %d)\n", hipGetErrorString(e), grid);
#else
    for (int ph = 0; ph < 11; ++ph) { p.ph_lo = ph; p.ph_hi = ph + 1; hipLaunchKernelGGL(mk::fwd_kernel, dim3(grid), dim3(512), mk::LDS_BYTES, stream, p); }
#endif
}
```

```cpp
#include <hip/hip_runtime.h>
#include <hip/hip_cooperative_groups.h>
#include <cstdio>
#include <cstdint>
namespace cg = cooperative_groups;
#ifndef PROBE_ATT
#define PROBE_ATT 1
#endif
#ifndef MK_N_LAUNCHES
#define MK_N_LAUNCHES 1
#endif
namespace pg8 {
#define PG8_LAS __attribute__((address_space(3)))
typedef unsigned short bf16_t;
typedef short bf16x8 __attribute__((ext_vector_type(8)));
typedef float f32x4 __attribute__((ext_vector_type(4)));
typedef unsigned u32x4 __attribute__((ext_vector_type(4)));
constexpr int BM = 256, BK = 64, HALF = 128, HTB = HALF * BK * 2  , STAGE_BYTES = 8 * HTB, NXCD = 8, WGM = 8;

__host__ __device__ __forceinline__ int lds_byte(int r, int c) { const int st = (r >> 4) * 2 + (c >> 5), rr = r & 15, cc = c & 31, ob = rr * 64 + cc * 2; return st * 1024 + (ob ^ (((ob >> 9) & 1) << 5)); }
__host__ __device__ __forceinline__ void stage_rc(int b, int& R, int& C) { const int st = b / 1024, sb = b % 1024, swz = sb ^ (((sb >> 9) & 1) << 5); R = (st >> 1) * 16 + swz / 64; C = (st & 1) * 32 + (swz % 64) / 2; }
__host__ __device__ __forceinline__ int perm32(int rho) { const int n = rho >> 4, i = rho & 15; return 8 * (i >> 2) + 4 * n + (i & 3); }

struct Unit { int pm, pn; };
struct Gemm { const bf16_t* A; const bf16_t* Bt; int M, N, K; };

struct StaticOrder {
    int nM, nN, nwg, G, c;
    __host__ __device__ void init(int M, int N, int G_, int c_) { nM = M / BM; nN = N / BM; nwg = nM * nN; G = G_; c = c_; }
    __host__ __device__ bool next(int i, Unit& u) const {
        const long L = (long)i * G + c; if (L >= nwg) return false;
        int wgid = (int)L; { const int q = nwg / NXCD, r = nwg % NXCD, xcd = wgid % NXCD, off = wgid / NXCD; wgid = (xcd < r ? xcd * (q + 1) : r * (q + 1) + (xcd - r) * q) + off; }
        const int nig = WGM * nN, gid = wgid / nig, fm = gid * WGM, gsz = (nM - fm) < WGM ? (nM - fm) : WGM;
        u.pm = fm + ((wgid % nig) % gsz); u.pn = (wgid % nig) / gsz; return true;
    }
    __device__ __forceinline__ void a_ready(const Unit&) const {}
    __device__ __forceinline__ void done(const Unit&) const {}
};

__device__ __forceinline__ unsigned cvt_pk_bf16(float lo, float hi) { unsigned r; asm volatile("v_cvt_pk_bf16_f32 %0, %1, %2" : "=v"(r) : "v"(lo), "v"(hi)); return r; }
typedef float f32x2 __attribute__((ext_vector_type(2)));
typedef unsigned u32x2 __attribute__((ext_vector_type(2)));
__device__ __forceinline__ float bf_lo(unsigned w) { return __uint_as_float(w << 16); }
__device__ __forceinline__ float bf_hi(unsigned w) { return __uint_as_float(w & 0xffff0000u); }
__device__ __forceinline__ float row_rstd(const float* ssq, int row) {
    const f32x4* p = (const f32x4*)(ssq + (size_t)row * 16);
    const f32x4 a = p[0], b = p[1], c = p[2], d = p[3];
    const float s = ((a[0] + a[1]) + (a[2] + a[3])) + ((b[0] + b[1]) + (b[2] + b[3])) + ((c[0] + c[1]) + (c[2] + c[3])) + ((d[0] + d[1]) + (d[2] + d[3]));
    return __builtin_amdgcn_rsqf(s * (1.0f / 1024.0f) + 1e-6f);
}
__device__ __forceinline__ void rows_rstd(const float* ssq, int row0, int fq, float (&rs)[2][4]) {
    f32x4 pr[2][4];
#pragma unroll
    for (int ai = 0; ai < 2; ++ai)
#pragma unroll
        for (int m = 0; m < 4; ++m) pr[ai][m] = *(const f32x4*)(ssq + (size_t)(row0 + ai * HALF + m * 16) * 16 + 4 * fq);
#pragma unroll
    for (int ai = 0; ai < 2; ++ai)
#pragma unroll
        for (int m = 0; m < 4; ++m) { float t = (pr[ai][m][0] + pr[ai][m][1]) + (pr[ai][m][2] + pr[ai][m][3]); t += __shfl_xor(t, 16); t += __shfl_xor(t, 32); rs[ai][m] = __builtin_amdgcn_rsqf(t * (1.0f / 1024.0f) + 1e-6f); }
}
__device__ __forceinline__ float fast_sigmoid(float x) { return __builtin_amdgcn_rcpf(1.0f + __expf(-x)); }

constexpr int QKW = 1664;
constexpr int VT_PITCH = 131072 + 128;
constexpr float C2Q = 0.125f * 1.4426950408889634f;

struct EpiQKV {
    static constexpr bool PERM = true, AFTER_DRAIN = false;
    bf16_t* QK; bf16_t* VT; const float* ssq; const float* aq; const float* ak; const float* bq; const float* bk; PG8_LAS unsigned char* xlds;
    __device__ __forceinline__ void operator()(const f32x4 (&acc)[2][2][4][2], const Unit& u, int wr, int wc, int fr, int fq) const {
        const int L = u.pn * 256 + wc * 64;
        int kind; const float* gain = nullptr; float scale = 1.f; int ccol = 0, vrow = 0;
        if (L < 512) { kind = 0; gain = aq; scale = C2Q; ccol = L; }
        else if (L < 640) { kind = 0; gain = ak; ccol = L; }
        else if (L < 768) { kind = 1; vrow = L - 640; }
        else if (L < 1280) { kind = 0; gain = bq; scale = C2Q; ccol = L - 128; }
        else if (L < 1792) { kind = 0; gain = bk; ccol = L - 128; }
        else { kind = 1; vrow = L - 1792 + 128; }
        if (kind == 0) {
            f32x4 gv[2][2];
#pragma unroll
            for (int bj = 0; bj < 2; ++bj)
#pragma unroll
                for (int n = 0; n < 2; ++n) gv[bj][n] = *(const f32x4*)(gain + 32 * bj + 8 * fq + 4 * n);
            float rsv[2][4]; rows_rstd(ssq, u.pm * BM + wr * 64 + fr, fq, rsv);
#pragma unroll
            for (int ai = 0; ai < 2; ++ai)
#pragma unroll
                for (int m = 0; m < 4; ++m) {
                    const int row = u.pm * BM + ai * HALF + wr * 64 + m * 16 + fr;
                    const float rs = rsv[ai][m];
                    float ss = 0.f;
#pragma unroll
                    for (int bj = 0; bj < 2; ++bj)
#pragma unroll
                        for (int n = 0; n < 2; ++n) { const f32x4 v = acc[ai][bj][m][n] * rs; ss += (v[0] * v[0] + v[1] * v[1]) + (v[2] * v[2] + v[3] * v[3]); }
                    ss += __shfl_xor(ss, 16); ss += __shfl_xor(ss, 32);
                    const float f = rs * __builtin_amdgcn_rsqf(ss * (1.0f / 64.0f) + 1e-6f) * scale;
                    bf16_t* rowp = QK + ((size_t)((row >> 6) * 26 + (ccol >> 6)) * 64 + (row & 63)) * 64 + 8 * fq;
#pragma unroll
                    for (int bj = 0; bj < 2; ++bj) {
                        const f32x4 v0 = acc[ai][bj][m][0] * f * gv[bj][0], v1 = acc[ai][bj][m][1] * f * gv[bj][1];
                        u32x4 w; w.x = cvt_pk_bf16(v0[0], v0[1]); w.y = cvt_pk_bf16(v0[2], v0[3]); w.z = cvt_pk_bf16(v1[0], v1[1]); w.w = cvt_pk_bf16(v1[2], v1[3]);
                        *(u32x4*)(rowp + 32 * bj) = w;
                    }
                }
        } else {
            PG8_LAS unsigned char* xl = xlds + (wr * 4 + wc) * 2048;
            const int lane = fq * 16 + fr;
            float rsv[2][4]; rows_rstd(ssq, u.pm * BM + wr * 64 + fr, fq, rsv);
#pragma unroll
            for (int ai = 0; ai < 2; ++ai) {
                float rs[4];
#pragma unroll
                for (int m = 0; m < 4; ++m) rs[m] = rsv[ai][m];
                const size_t tb = (size_t)(u.pm * 4 + ai * 2 + wr) * 640;
#pragma unroll
                for (int bj = 0; bj < 2; ++bj)
#pragma unroll
                    for (int n = 0; n < 2; ++n) {
#pragma unroll
                        for (int m = 0; m < 4; ++m) {
                            const f32x4 v = acc[ai][bj][m][n] * rs[m];
                            const unsigned w0 = cvt_pk_bf16(v[0], v[1]), w1 = cvt_pk_bf16(v[2], v[3]);
                            PG8_LAS bf16_t* q = (PG8_LAS bf16_t*)(xl + (4 * fq) * 128 + (16 * m + fr) * 2);
                            q[0] = (bf16_t)(w0 & 0xffffu); q[64] = (bf16_t)(w0 >> 16); q[128] = (bf16_t)(w1 & 0xffffu); q[192] = (bf16_t)(w1 >> 16);
                        }
                        asm volatile("s_waitcnt lgkmcnt(0)" ::: "memory");
                        const int c16 = lane >> 2, part = lane & 3;
                        const u32x4 a = *(const PG8_LAS u32x4*)(xl + c16 * 128 + part * 32), b = *(const PG8_LAS u32x4*)(xl + c16 * 128 + part * 32 + 16);
                        bf16_t* gp = VT + (tb + vrow + 32 * bj + 8 * (c16 >> 2) + 4 * n + (c16 & 3)) * 64 + part * 16;
                        *(u32x4*)gp = a; *(u32x4*)(gp + 8) = b;
                        asm volatile("s_waitcnt lgkmcnt(0)" ::: "memory");
                    }
            }
        }
    }
};

template <bool FINAL> struct EpiRes {
    static constexpr bool PERM = true, AFTER_DRAIN = false;
    bf16_t* X; float* out; float* ssq;
    __device__ __forceinline__ void operator()(const f32x4 (&acc)[2][2][4][2], const Unit& u, int wr, int wc, int fr, int fq) const {
        const int col0 = u.pn * BM + wc * 32 + 8 * fq;
        u32x4 xin[2][4][2];
#pragma unroll
        for (int ai = 0; ai < 2; ++ai)
#pragma unroll
            for (int m = 0; m < 4; ++m)
#pragma unroll
                for (int bj = 0; bj < 2; ++bj) xin[ai][m][bj] = *(const u32x4*)(X + (size_t)(u.pm * BM + ai * HALF + wr * 64 + m * 16 + fr) * 1024 + col0 + bj * HALF);
#pragma unroll
        for (int ai = 0; ai < 2; ++ai)
#pragma unroll
            for (int m = 0; m < 4; ++m) {
                const int row = u.pm * BM + ai * HALF + wr * 64 + m * 16 + fr;
                float ss = 0.f;
#pragma unroll
                for (int bj = 0; bj < 2; ++bj) {
                    bf16_t* xp = X + (size_t)row * 1024 + col0 + bj * HALF;
                    const u32x4 xv = xin[ai][m][bj];
                    f32x4 y0 = acc[ai][bj][m][0], y1 = acc[ai][bj][m][1];
                    y0[0] += bf_lo(xv.x); y0[1] += bf_hi(xv.x); y0[2] += bf_lo(xv.y); y0[3] += bf_hi(xv.y);
                    y1[0] += bf_lo(xv.z); y1[1] += bf_hi(xv.z); y1[2] += bf_lo(xv.w); y1[3] += bf_hi(xv.w);
                    if (FINAL) {
                        float* op = out + (size_t)row * 1024 + col0 + bj * HALF;
                        *(f32x4*)op = y0; *(f32x4*)(op + 4) = y1;
                    } else {
                        u32x4 w; w.x = cvt_pk_bf16(y0[0], y0[1]); w.y = cvt_pk_bf16(y0[2], y0[3]); w.z = cvt_pk_bf16(y1[0], y1[1]); w.w = cvt_pk_bf16(y1[2], y1[3]);
                        *(u32x4*)xp = w;
                        ss += (y0[0] * y0[0] + y0[1] * y0[1]) + (y0[2] * y0[2] + y0[3] * y0[3]) + (y1[0] * y1[0] + y1[1] * y1[1]) + (y1[2] * y1[2] + y1[3] * y1[3]);
                    }
                }
                if (!FINAL) {
                    ss += __shfl_xor(ss, 16); ss += __shfl_xor(ss, 32);
                    if (fq == 0) ssq[(size_t)row * 16 + u.pn * 4 + wc] = ss;
                }
            }
    }
};

struct EpiGlu {
    static constexpr bool PERM = true, AFTER_DRAIN = false;
    bf16_t* H; const float* ssq;
    __device__ __forceinline__ void operator()(const f32x4 (&acc)[2][2][4][2], const Unit& u, int wr, int wc, int fr, int fq) const {
        const int col0 = u.pn * HALF + wc * 32 + 8 * fq;
        float rsv[2][4]; rows_rstd(ssq, u.pm * BM + wr * 64 + fr, fq, rsv);
#pragma unroll
        for (int ai = 0; ai < 2; ++ai)
#pragma unroll
            for (int m = 0; m < 4; ++m) {
                const int row = u.pm * BM + ai * HALF + wr * 64 + m * 16 + fr;
                const float rs = rsv[ai][m];
                float h[8];
#pragma unroll
                for (int n = 0; n < 2; ++n)
#pragma unroll
                    for (int i = 0; i < 4; ++i) { const float g = acc[ai][0][m][n][i] * rs, up = acc[ai][1][m][n][i] * rs; h[4 * n + i] = g * up * fast_sigmoid(g); }
                u32x4 w; w.x = cvt_pk_bf16(h[0], h[1]); w.y = cvt_pk_bf16(h[2], h[3]); w.z = cvt_pk_bf16(h[4], h[5]); w.w = cvt_pk_bf16(h[6], h[7]);
                *(u32x4*)(H + (size_t)row * 2816 + col0) = w;
            }
    }
};

struct EpiConvIn {
    static constexpr bool PERM = true, AFTER_DRAIN = false;
    bf16_t* O; const float* ssq;
    __device__ __forceinline__ void operator()(const f32x4 (&acc)[2][2][4][2], const Unit& u, int wr, int wc, int fr, int fq) const {
        float rsv[2][4]; rows_rstd(ssq, u.pm * BM + wr * 64 + fr, fq, rsv);
#pragma unroll
        for (int ai = 0; ai < 2; ++ai)
#pragma unroll
            for (int m = 0; m < 4; ++m) {
                const int row = u.pm * BM + ai * HALF + wr * 64 + m * 16 + fr;
                const float rs = rsv[ai][m];
                bf16_t* rp = O + (size_t)row * 1536 + wc * 32 + 8 * fq;
                if (u.pn < 2) {
#pragma unroll
                    for (int bj = 0; bj < 2; ++bj) {
                        const f32x4 v0 = acc[ai][bj][m][0] * rs, v1 = acc[ai][bj][m][1] * rs;
                        u32x4 w; w.x = cvt_pk_bf16(v0[0], v0[1]); w.y = cvt_pk_bf16(v0[2], v0[3]); w.z = cvt_pk_bf16(v1[0], v1[1]); w.w = cvt_pk_bf16(v1[2], v1[3]);
                        *(u32x4*)(rp + u.pn * BM + bj * HALF) = w;
                    }
                } else {
                    float h[8];
                    const bool glu = u.pn >= 6;
#pragma unroll
                    for (int n = 0; n < 2; ++n)
#pragma unroll
                        for (int i = 0; i < 4; ++i) { const float a = acc[ai][0][m][n][i] * rs, b = acc[ai][1][m][n][i] * rs; h[4 * n + i] = glu ? a * fast_sigmoid(b) : a * b; }
                    u32x4 w; w.x = cvt_pk_bf16(h[0], h[1]); w.y = cvt_pk_bf16(h[2], h[3]); w.z = cvt_pk_bf16(h[4], h[5]); w.w = cvt_pk_bf16(h[6], h[7]);
                    *(u32x4*)(rp + 512 + (u.pn - 2) * HALF) = w;
                }
            }
    }
};

struct EpiPlain {
    static constexpr bool PERM = true, AFTER_DRAIN = false;
    bf16_t* O; int ldc; const float* ssq;
    __device__ __forceinline__ void operator()(const f32x4 (&acc)[2][2][4][2], const Unit& u, int wr, int wc, int fr, int fq) const {
        const int col0 = u.pn * BM + wc * 32 + 8 * fq;
#pragma unroll
        for (int ai = 0; ai < 2; ++ai)
#pragma unroll
            for (int m = 0; m < 4; ++m) {
                const int row = u.pm * BM + ai * HALF + wr * 64 + m * 16 + fr;
                const float rs = row_rstd(ssq, row);
#pragma unroll
                for (int bj = 0; bj < 2; ++bj) {
                    const f32x4 v0 = acc[ai][bj][m][0] * rs, v1 = acc[ai][bj][m][1] * rs;
                    u32x4 w; w.x = cvt_pk_bf16(v0[0], v0[1]); w.y = cvt_pk_bf16(v0[2], v0[3]); w.z = cvt_pk_bf16(v1[0], v1[1]); w.w = cvt_pk_bf16(v1[2], v1[3]);
                    *(u32x4*)(O + (size_t)row * ldc + col0 + bj * HALF) = w;
                }
            }
    }
};

template <class Epi, class Sched, bool ALIGN_EPI = false, bool SP2 = false>
__device__ __forceinline__ void gemm_phase(PG8_LAS unsigned char* lds, const Gemm g, const Sched& S, const Epi& E) {
    const int tid = threadIdx.x, wid = __builtin_amdgcn_readfirstlane(tid >> 6), lane = tid & 63, wr = wid >> 2, wc = wid & 3, fr = lane & 15, fq = lane >> 4;
    const int K = g.K, nt = K / BK;
    unsigned voffA[2], voffB[2];
#pragma unroll
    for (int i = 0; i < 2; ++i) { int R, C; stage_rc(tid * 16 + i * 8192, R, C); const int Rb = Epi::PERM ? ((R & ~31) + perm32(R & 31)) : R;
        voffA[i] = (unsigned)(R * K + C) * 2u; voffB[i] = (unsigned)(Rb * K + C) * 2u; }
    const size_t kstep = (size_t)(BK * 2);
    const size_t hstep = (size_t)HALF * K * 2;
    const size_t tstep = 2 * hstep;
    const unsigned ldsw = (unsigned)wid * 1024u;
    const int aoff = lds_byte(wr * 64 + fr, fq * 8), boff = lds_byte(wc * 32 + fr, fq * 8);
#define PG8_SA(b, h) (((b) * 2 + (h)) * HTB)
#define PG8_SB(b, h) ((4 + (b) * 2 + (h)) * HTB)
#define PG8_STAGE(bufoff, gbase, voff) do { _Pragma("unroll") for (int _i = 0; _i < 2; ++_i) \
        __builtin_amdgcn_global_load_lds((const unsigned*)((const char*)(gbase) + (voff)[_i]), (PG8_LAS unsigned*)(lds + (bufoff) + ldsw + _i * 8192), 16, 0, 0); } while (0)
#define PG8_LDA(dst, b, h) do { _Pragma("unroll") for (int m = 0; m < 4; ++m) _Pragma("unroll") for (int k = 0; k < 2; ++k) dst[m][k] = *(const PG8_LAS bf16x8*)(lds + PG8_SA(b, h) + aoff + m * 2048 + k * 1024); } while (0)
#define PG8_LDB(dst, b, h) do { _Pragma("unroll") for (int n = 0; n < 2; ++n) _Pragma("unroll") for (int k = 0; k < 2; ++k) dst[n][k] = *(const PG8_LAS bf16x8*)(lds + PG8_SB(b, h) + boff + n * 2048 + k * 1024); } while (0)
#define PG8_MMA(ai, bj, At, Bt) do { __builtin_amdgcn_s_setprio(1); _Pragma("unroll") for (int m = 0; m < 4; ++m) _Pragma("unroll") for (int n = 0; n < 2; ++n) _Pragma("unroll") for (int k = 0; k < 2; ++k) \
        acc[ai][bj][m][n] = __builtin_amdgcn_mfma_f32_16x16x32_bf16(Bt[n][k], At[m][k], acc[ai][bj][m][n], 0, 0, 0); __builtin_amdgcn_s_setprio(0); } while (0)
#define PG8_WAIT_V(n) asm volatile("s_waitcnt vmcnt(" #n ")" ::: "memory")
#define PG8_WAIT_L(n) asm volatile("s_waitcnt lgkmcnt(" #n ")" ::: "memory")
#define PG8_BAR __builtin_amdgcn_s_barrier()
#define PG8_SCHED __builtin_amdgcn_sched_barrier(0)
    Unit cur, nxt; int ui = 0;
    if (!S.next(0, cur)) return;
    f32x4 acc[2][2][4][2];
#pragma unroll
    for (int a = 0; a < 2; ++a)
#pragma unroll
        for (int b = 0; b < 2; ++b)
#pragma unroll
            for (int m = 0; m < 4; ++m)
#pragma unroll
                for (int n = 0; n < 2; ++n) acc[a][b][m][n] = (f32x4){0.f, 0.f, 0.f, 0.f};
    bf16x8 At[4][2], B0[2][2], B1[2][2];
    const char* cA = (const char*)g.A + (size_t)cur.pm * tstep; const char* cB = (const char*)g.Bt + (size_t)cur.pn * tstep;
    S.a_ready(cur);
    if constexpr (SP2) {
        PG8_STAGE(PG8_SB(0, 0), cB, voffB); PG8_STAGE(PG8_SB(0, 1), cB + hstep, voffB); PG8_STAGE(PG8_SA(0, 0), cA, voffA); PG8_STAGE(PG8_SA(0, 1), cA + hstep, voffA);
        if (wr == 1) PG8_BAR;
        PG8_WAIT_V(2); PG8_BAR;
        PG8_STAGE(PG8_SB(1, 0), cB + kstep, voffB); PG8_STAGE(PG8_SA(1, 0), cA + kstep, voffA); PG8_STAGE(PG8_SB(1, 1), cB + hstep + kstep, voffB);
        PG8_WAIT_V(6); PG8_BAR;
    } else {
        PG8_STAGE(PG8_SB(0, 0), cB, voffB); PG8_STAGE(PG8_SA(0, 0), cA, voffA); PG8_STAGE(PG8_SB(0, 1), cB + hstep, voffB); PG8_STAGE(PG8_SA(0, 1), cA + hstep, voffA);
        if (wr == 1) PG8_BAR;
        PG8_WAIT_V(4); PG8_BAR;
        PG8_STAGE(PG8_SB(1, 0), cB + kstep, voffB); PG8_STAGE(PG8_SA(1, 0), cA + kstep, voffA); PG8_STAGE(PG8_SB(1, 1), cB + hstep + kstep, voffB);
        PG8_WAIT_V(6); PG8_BAR;
    }
    for (;;) {
        const bool has_next = S.next(ui + 1, nxt);
        const char* nA = has_next ? (const char*)g.A + (size_t)nxt.pm * tstep : cA; const char* nB = has_next ? (const char*)g.Bt + (size_t)nxt.pn * tstep : cB;
        for (int t = 0; t < nt; t += 2) {
            const bool last = (t == nt - 2);
            const char* a1 = cA + (size_t)(t + 1) * kstep;
            const char* a2 = last ? nA : cA + (size_t)(t + 2) * kstep; const char* b2 = last ? nB : cB + (size_t)(t + 2) * kstep;
            const char* a3 = a2 + kstep; const char* b3 = b2 + kstep;
            if (last && has_next) S.a_ready(nxt);
            if constexpr (SP2) {
            PG8_LDB(B0, 0, 0); PG8_LDB(B1, 0, 1); PG8_SCHED; PG8_LDA(At, 0, 0); PG8_STAGE(PG8_SA(1, 1), a1 + hstep, voffA);
            PG8_WAIT_V(8); PG8_WAIT_L(0); PG8_BAR; PG8_MMA(0, 0, At, B0); PG8_MMA(0, 1, At, B1); PG8_BAR; PG8_SCHED;
            PG8_LDA(At, 0, 1); PG8_STAGE(PG8_SB(0, 0), b2, voffB); PG8_STAGE(PG8_SB(0, 1), b2 + hstep, voffB); PG8_STAGE(PG8_SA(0, 0), a2, voffA);
            PG8_WAIT_V(8); PG8_WAIT_L(0); PG8_BAR; PG8_MMA(1, 0, At, B0); PG8_MMA(1, 1, At, B1); PG8_BAR; PG8_SCHED;
            PG8_LDB(B0, 1, 0); PG8_LDB(B1, 1, 1); PG8_SCHED; PG8_LDA(At, 1, 0); PG8_STAGE(PG8_SA(0, 1), a2 + hstep, voffA);
            PG8_WAIT_V(8); PG8_WAIT_L(0); PG8_BAR; PG8_MMA(0, 0, At, B0); PG8_MMA(0, 1, At, B1); PG8_BAR; PG8_SCHED;
            PG8_LDA(At, 1, 1); PG8_STAGE(PG8_SB(1, 0), b3, voffB); PG8_STAGE(PG8_SB(1, 1), b3 + hstep, voffB); PG8_STAGE(PG8_SA(1, 0), a3, voffA);
            PG8_WAIT_V(8); PG8_WAIT_L(0); PG8_BAR; PG8_MMA(1, 0, At, B0); PG8_MMA(1, 1, At, B1); PG8_BAR; PG8_SCHED;
            } else {
            PG8_LDB(B0, 0, 0); PG8_SCHED; PG8_LDA(At, 0, 0); PG8_STAGE(PG8_SA(1, 1), a1 + hstep, voffA);
            PG8_WAIT_L(8); PG8_BAR; PG8_WAIT_L(0); PG8_MMA(0, 0, At, B0); PG8_BAR; PG8_SCHED;
            PG8_LDB(B1, 0, 1); PG8_STAGE(PG8_SB(0, 0), b2, voffB);
            PG8_BAR; PG8_WAIT_L(0); PG8_MMA(0, 1, At, B1); PG8_BAR;
            PG8_LDA(At, 0, 1); PG8_STAGE(PG8_SA(0, 0), a2, voffA);
            PG8_BAR; PG8_WAIT_L(0); PG8_MMA(1, 0, At, B0); PG8_BAR; PG8_SCHED;
            PG8_STAGE(PG8_SB(0, 1), b2 + hstep, voffB);
            PG8_WAIT_V(6); PG8_BAR; PG8_MMA(1, 1, At, B1); PG8_BAR;
            PG8_LDB(B0, 1, 0); PG8_SCHED; PG8_LDA(At, 1, 0); PG8_STAGE(PG8_SA(0, 1), a2 + hstep, voffA);
            PG8_WAIT_L(8); PG8_BAR; PG8_WAIT_L(0); PG8_MMA(0, 0, At, B0); PG8_BAR; PG8_SCHED;
            PG8_LDB(B1, 1, 1); PG8_STAGE(PG8_SB(1, 0), b3, voffB);
            PG8_BAR; PG8_WAIT_L(0); PG8_MMA(0, 1, At, B1); PG8_BAR;
            PG8_LDA(At, 1, 1); PG8_STAGE(PG8_SA(1, 0), a3, voffA);
            PG8_BAR; PG8_WAIT_L(0); PG8_MMA(1, 0, At, B0); PG8_BAR; PG8_SCHED;
            PG8_STAGE(PG8_SB(1, 1), b3 + hstep, voffB);
            PG8_WAIT_V(6); PG8_BAR; PG8_MMA(1, 1, At, B1); PG8_BAR;
            }
        }
        if constexpr (ALIGN_EPI) { if (wr == 0) PG8_BAR; }
        if constexpr (!Epi::AFTER_DRAIN) { E(acc, cur, wr, wc, fr, fq); S.done(cur); }
        if (!has_next) break;
#pragma unroll
        for (int a = 0; a < 2; ++a)
#pragma unroll
            for (int b = 0; b < 2; ++b)
#pragma unroll
                for (int m = 0; m < 4; ++m)
#pragma unroll
                    for (int n = 0; n < 2; ++n) acc[a][b][m][n] = (f32x4){0.f, 0.f, 0.f, 0.f};
        cur = nxt; cA = nA; cB = nB; ++ui;
        if constexpr (ALIGN_EPI) { if (wr == 1) PG8_BAR; }
    }
    PG8_WAIT_V(0);
    if constexpr (!ALIGN_EPI) { if (wr == 0) PG8_BAR; }
    PG8_BAR;
    if constexpr (Epi::AFTER_DRAIN) { E.fused(acc, cur, wr, wc, fr, fq, lds, wid, lane); S.done(cur); }
#undef PG8_SA
#undef PG8_SB
#undef PG8_STAGE
#undef PG8_LDA
#undef PG8_LDB
#undef PG8_MMA
#undef PG8_WAIT_V
#undef PG8_WAIT_L
#undef PG8_BAR
#undef PG8_SCHED
}
}
namespace att {
using pg8::bf16_t; using pg8::bf16x8; using pg8::f32x4; using pg8::u32x4; using pg8::u32x2; using pg8::cvt_pk_bf16; using pg8::QKW; using pg8::VT_PITCH;
typedef float f32x16 __attribute__((ext_vector_type(16)));
#define ALAS __attribute__((address_space(3)))
constexpr int OFF_K0 = 0, OFF_K1 = 8192, OFF_V = 16384, STAGE = 32768, NSTG = 4, OFF_LUT = NSTG * STAGE;
constexpr int OFF_SUB = OFF_LUT + 12 * 260 * 4;
constexpr int ATT_LDS = OFF_SUB + 512;
__device__ __forceinline__ int pi32(int r) { return (r & ~12) | ((r & 4) << 1) | ((r & 8) >> 1); }
__device__ __forceinline__ int t5_bucket(int rel) {
    const int n = rel < 0 ? -rel : rel;
    int b = n < 8 ? n : (n < 12 ? 8 : n < 16 ? 9 : n < 23 ? 10 : n < 32 ? 11 : n < 46 ? 12 : n < 64 ? 13 : n < 91 ? 14 : 15);
    return b + (rel > 0 ? 16 : 0);
}

__device__ __forceinline__ void glds16(const void* gsrc, unsigned lds_dst) { unsigned keep;
    asm volatile("s_mov_b32 %0, m0\n\ts_mov_b32 m0, %2\n\ts_nop 0\n\tglobal_load_lds_dwordx4 %1, off\n\ts_mov_b32 m0, %0" : "=&s"(keep) : "v"(gsrc), "s"(lds_dst) : "memory"); }
typedef float f32x2_t __attribute__((ext_vector_type(2))); typedef __bf16 bf16x2_t __attribute__((ext_vector_type(2)));
__device__ __forceinline__ unsigned cvtpk_s(float lo, float hi) { f32x2_t v = {lo, hi}; bf16x2_t b = __builtin_convertvector(v, bf16x2_t); return __builtin_bit_cast(unsigned, b); }
template <int N> __device__ __forceinline__ void wait_bar() { asm volatile("s_waitcnt vmcnt(%0) lgkmcnt(0)\n\ts_barrier" :: "n"(N) : "memory"); }

template <bool WIN>
__device__ __forceinline__ void attn_unit(ALAS unsigned char* lds, const bf16_t* __restrict__ QK, const bf16_t* __restrict__ VT, bf16_t* __restrict__ Y,
                                          const float* __restrict__ rel_bias, const float* __restrict__ sinkp, const float* __restrict__ subln, float lam,
                                          int seq_base, int S, int q0, int hsel) {
    constexpr float LOG2E = 1.4426950408889634f;
    constexpr int NDB = WIN ? 2 : 4;
    const int tid = threadIdx.x, lane = tid & 63, l31 = lane & 31, hi = lane >> 5;
    const int wid = __builtin_amdgcn_readfirstlane(tid >> 6), half = wid >> 2, wq = wid & 3;
    const int qw = q0 + 32 * wq;
    int qcol, kcol0, kcol1, vrow0, bhead;
    if (WIN) { qcol = (2 * hsel + half) * 64; kcol0 = 512 + (hsel >> 1) * 64; kcol1 = kcol0; vrow0 = (hsel >> 1) * 64; bhead = 2 * hsel; }
    else { qcol = 640 + (2 * hsel + half) * 64; kcol0 = 1152 + (2 * hsel) * 64; kcol1 = kcol0 + 64; vrow0 = 128 + hsel * 128; bhead = 8 + hsel; }
    const ALAS float* lut = (const ALAS float*)(lds + OFF_LUT) + (WIN ? (bhead + half) : bhead) * 260;

    const int t_lo = WIN ? (q0 >= 128 ? (q0 - 128) / 64 : 0) : 0;
    const int t_hi = WIN ? ((q0 + 256) / 64 < S / 64 ? (q0 + 256) / 64 : S / 64) : S / 64;
    const int NT = t_hi - t_lo;
    const unsigned ldsb = (unsigned)(uintptr_t)lds;
    const int drow = 8 * wid + (lane >> 3), dch = (lane & 7) ^ ((4 * wid + (lane >> 4)) & 7);
    const bf16_t* kg = QK + ((size_t)((seq_base >> 6) + t_lo) * 26 * 64 + drow) * 64 + dch * 8 + kcol0 * 64;
    const bf16_t* vg = VT + ((size_t)((seq_base >> 6) + t_lo) * 640 + vrow0 + drow) * 64 + dch * 8;
    const unsigned dk = ldsb + wid * 1024;
#define AT_DMA(tr) do { const unsigned sb_ = (unsigned)__builtin_amdgcn_readfirstlane(dk + (((tr) & (NSTG - 1)) * STAGE)); const size_t ko_ = (size_t)(tr) * 26 * 4096, vo_ = (size_t)(tr) * 640 * 64; \
        glds16(kg + ko_, sb_ + OFF_K0); if (!WIN) glds16(kg + ko_ + 4096, sb_ + OFF_K1); glds16(vg + vo_, sb_ + OFF_V); if (!WIN) glds16(vg + vo_ + 64 * 64, sb_ + OFF_V + 8192); } while (0)
    constexpr int NPW = WIN ? 2 : 4;
    bf16x8 qfr[4];
    { const int qrow = seq_base + qw + l31; const bf16_t* qp = QK + ((size_t)((qrow >> 6) * 26 + (qcol >> 6)) * 64 + (qrow & 63)) * 64 + hi * 8;
#pragma unroll
      for (int ds = 0; ds < 4; ++ds) qfr[ds] = *(const bf16x8*)(qp + ds * 16); }
#define qf(ds) qfr[ds]
    AT_DMA(0); if (NT > 1) AT_DMA(1); if (NT > 2) AT_DMA(2);
    constexpr float THR = 8.0f;
    float m_ref = WIN ? sinkp[2 * hsel + half] * LOG2E : 0.f;
    float l_run = (WIN && hi == 0) ? 1.f : 0.f;
    float cbase = 0.f;
    f32x16 cvec;
#pragma unroll
    for (int r = 0; r < 16; ++r) cvec[r] = cbase - m_ref;
    f32x16 o[NDB];
#pragma unroll
    for (int db = 0; db < NDB; ++db)
#pragma unroll
        for (int r = 0; r < 16; ++r) o[db][r] = 0.f;
    const int krow = pi32(l31), fK = (krow >> 1) & 7, fV = (l31 >> 1) & 7;
    int kx[4], vx[4];
#pragma unroll
    for (int c = 0; c < 4; ++c) { kx[c] = (WIN ? OFF_K0 : (half ? OFF_K1 : OFF_K0)) + krow * 128 + (((2 * c + hi) ^ fK) << 4); vx[c] = OFF_V + l31 * 128 + (((2 * c + hi) ^ fV) << 4); }
    const int qabs = qw + l31;
    const float cfar_lo = __uint_as_float(__builtin_amdgcn_readfirstlane(__float_as_uint(lut[0]))), cfar_hi = __uint_as_float(__builtin_amdgcn_readfirstlane(__float_as_uint(lut[256])));
    asm volatile("" : "+v"(qfr[0]), "+v"(qfr[1]), "+v"(qfr[2]), "+v"(qfr[3]));
#pragma clang loop unroll(disable)
    for (int tr = 0; tr < NT; ++tr) {
        if (tr + 2 < NT) wait_bar<2 * NPW>(); else if (tr + 1 < NT) wait_bar<NPW>(); else wait_bar<0>();
        if (tr + 3 < NT) AT_DMA(tr + 3);
        const int k0 = (t_lo + tr) * 64;
        const bool skip = WIN && (k0 > qw + 31 + 128 || k0 + 63 < qw - 128);
        if (!skip) {
            const bool near = WIN || ((k0 - (qw + 31)) < 128 && (qw - (k0 + 63)) < 128);
            const float cinit = near ? 0.f : (k0 > qw ? cfar_hi : cfar_lo);
            if (__builtin_expect(cinit != cbase, 0)) { cbase = cinit; asm volatile("" ::: "memory");
#pragma unroll
                for (int r = 0; r < 16; ++r) cvec[r] = cbase - m_ref; }
            f32x16 s0, s1;
            const ALAS unsigned char* sb = lds + (tr & (NSTG - 1)) * STAGE;
            {
                bf16x8 ka[8];
#pragma unroll
                for (int ds = 0; ds < 4; ++ds) { ka[2 * ds] = *(const ALAS bf16x8*)(sb + kx[ds]); ka[2 * ds + 1] = *(const ALAS bf16x8*)(sb + kx[ds] + 4096); }
                __builtin_amdgcn_sched_barrier(0);
                s0 = __builtin_amdgcn_mfma_f32_32x32x16_bf16(ka[0], qf(0), cvec, 0, 0, 0);
                s1 = __builtin_amdgcn_mfma_f32_32x32x16_bf16(ka[1], qf(0), cvec, 0, 0, 0);
#pragma unroll
                for (int ds = 1; ds < 4; ++ds) {
                    s0 = __builtin_amdgcn_mfma_f32_32x32x16_bf16(ka[2 * ds], qf(ds), s0, 0, 0, 0);
                    s1 = __builtin_amdgcn_mfma_f32_32x32x16_bf16(ka[2 * ds + 1], qf(ds), s1, 0, 0, 0);
                }
            }
            bf16x8 va[2 * NDB], vc[2 * NDB];
#pragma unroll
            for (int kk = 0; kk < 2; ++kk)
#pragma unroll
                for (int db = 0; db < NDB; ++db) va[kk * NDB + db] = *(const ALAS bf16x8*)(sb + vx[kk] + db * 4096);
            __builtin_amdgcn_sched_barrier(0);
            if (near) {
#pragma unroll
                for (int r = 0; r < 16; ++r) {
                    const int rel = k0 + 16 * (r >> 3) + 8 * hi + (r & 7) - qabs;
                    const int i0 = (rel < -128 ? -128 : (rel > 128 ? 128 : rel)) + 128;
                    const int rel1 = rel + 32;
                    const int i1 = (rel1 < -128 ? -128 : (rel1 > 128 ? 128 : rel1)) + 128;
                    s0[r] += lut[i0]; s1[r] += lut[i1];
                    if (WIN) { if (rel < -128 || rel > 128) s0[r] = -1e30f; if (rel1 < -128 || rel1 > 128) s1[r] = -1e30f; }
                    if ((r & 3) == 3) __builtin_amdgcn_sched_barrier(0);
                }
            }
#define MX3(a, b, c) __builtin_fmaxf(__builtin_fmaxf((a), (b)), (c))
            float mxa = MX3(s0[0], s0[1], s1[0]), mxb = MX3(s0[2], s0[3], s1[1]);
            mxa = MX3(mxa, s1[2], s1[3]);
#pragma unroll
            for (int r = 4; r < 16; r += 4) { mxa = MX3(mxa, s0[r], s0[r + 1]); mxb = MX3(mxb, s0[r + 2], s0[r + 3]); mxa = MX3(mxa, s1[r], s1[r + 1]); mxb = MX3(mxb, s1[r + 2], s1[r + 3]); }
#undef MX3
            float mx = fmaxf(mxa, mxb);
            if (__any(mx > THR)) {
                mx = fmaxf(mx, __shfl_xor(mx, 32));
                const float dl = fmaxf(mx, 0.f);
                m_ref += dl;
                const float f = __builtin_amdgcn_exp2f(-dl);
                l_run *= f;
#pragma unroll
                for (int db = 0; db < NDB; ++db)
#pragma unroll
                    for (int r = 0; r < 16; ++r) o[db][r] *= f;
#pragma unroll
                for (int r = 0; r < 16; ++r) { s0[r] -= dl; s1[r] -= dl; cvec[r] = cbase - m_ref; }
            }
            float ls0 = 0.f, ls1 = 0.f;
#define AT_EXP(SS, B, PF) do { \
                const float e0 = __builtin_amdgcn_exp2f(SS[B + 0]), e1 = __builtin_amdgcn_exp2f(SS[B + 1]), e2 = __builtin_amdgcn_exp2f(SS[B + 2]), e3 = __builtin_amdgcn_exp2f(SS[B + 3]); \
                const float e4 = __builtin_amdgcn_exp2f(SS[B + 4]), e5 = __builtin_amdgcn_exp2f(SS[B + 5]), e6 = __builtin_amdgcn_exp2f(SS[B + 6]), e7 = __builtin_amdgcn_exp2f(SS[B + 7]); \
                ls0 += e0; ls1 += e4; ls0 += e1; ls1 += e5; ls0 += e2; ls1 += e6; ls0 += e3; ls1 += e7; \
                PF.u.x = cvtpk_s(e0, e1); PF.u.y = cvtpk_s(e2, e3); PF.u.z = cvtpk_s(e4, e5); PF.u.w = cvtpk_s(e6, e7); } while (0)
            union PFU { u32x4 u; bf16x8 b; };
            PFU p0, p1, p2, p3;
            AT_EXP(s0, 0, p0);
#pragma unroll
            for (int kk = 0; kk < 2; ++kk)
#pragma unroll
                for (int db = 0; db < NDB; ++db) vc[kk * NDB + db] = *(const ALAS bf16x8*)(sb + vx[kk + 2] + db * 4096);
            __builtin_amdgcn_sched_barrier(0);
#pragma unroll
            for (int db = 0; db < NDB; ++db) o[db] = __builtin_amdgcn_mfma_f32_32x32x16_bf16(va[db], p0.b, o[db], 0, 0, 0);
            AT_EXP(s0, 8, p1);
            __builtin_amdgcn_sched_barrier(0);
#pragma unroll
            for (int db = 0; db < NDB; ++db) o[db] = __builtin_amdgcn_mfma_f32_32x32x16_bf16(va[NDB + db], p1.b, o[db], 0, 0, 0);
            AT_EXP(s1, 0, p2);
            __builtin_amdgcn_sched_barrier(0);
#pragma unroll
            for (int db = 0; db < NDB; ++db) o[db] = __builtin_amdgcn_mfma_f32_32x32x16_bf16(vc[db], p2.b, o[db], 0, 0, 0);
            AT_EXP(s1, 8, p3);
            __builtin_amdgcn_sched_barrier(0);
#pragma unroll
            for (int db = 0; db < NDB; ++db) o[db] = __builtin_amdgcn_mfma_f32_32x32x16_bf16(vc[NDB + db], p3.b, o[db], 0, 0, 0);
            __builtin_amdgcn_sched_barrier(0);
#undef AT_EXP
            l_run += ls0 + ls1;
        }
    }
    asm volatile("s_waitcnt lgkmcnt(0)\n\ts_barrier" ::: "memory");
#undef qf
#undef AT_DMA
    const float l_tot = l_run + __shfl_xor(l_run, 32);
    const float inv = 1.0f / l_tot;
    const size_t orow = (size_t)(seq_base + qw + l31) * 1024;
    if (WIN) {
        bf16_t* yp = Y + orow + (2 * hsel + half) * 64 + 4 * hi;
#pragma unroll
        for (int db = 0; db < NDB; ++db)
#pragma unroll
            for (int g = 0; g < 4; ++g) {
                u32x2 w; w.x = cvt_pk_bf16(o[db][4 * g] * inv, o[db][4 * g + 1] * inv); w.y = cvt_pk_bf16(o[db][4 * g + 2] * inv, o[db][4 * g + 3] * inv);
                *(u32x2*)(yp + 32 * db + 8 * g) = w;
            }
    } else {
        ALAS f32x4* xch = (ALAS f32x4*)lds + (size_t)wq * 1024 + l31;
        if (half == 1) {
#pragma unroll
            for (int db = 0; db < NDB; ++db)
#pragma unroll
                for (int g = 0; g < 4; ++g) { f32x4 v; v[0] = o[db][4 * g] * inv; v[1] = o[db][4 * g + 1] * inv; v[2] = o[db][4 * g + 2] * inv; v[3] = o[db][4 * g + 3] * inv;
                    xch[(8 * db + 2 * g + hi) * 32] = v; }
        }
        __syncthreads();
        if (half == 0) {
            float ss = 0.f;
#pragma unroll
            for (int db = 0; db < NDB; ++db)
#pragma unroll
                for (int g = 0; g < 4; ++g) { const f32x4 v = xch[(8 * db + 2 * g + hi) * 32];
#pragma unroll
                    for (int i = 0; i < 4; ++i) { const float x = o[db][4 * g + i] * inv - lam * v[i]; o[db][4 * g + i] = x; ss += x * x; } }
            ss += __shfl_xor(ss, 32);
            const float rn = __builtin_amdgcn_rsqf(ss * (1.0f / 128.0f) + 1e-6f) * 0.8f;
            bf16_t* yp = Y + orow + 512 + hsel * 128 + 4 * hi;
#pragma unroll
            for (int db = 0; db < NDB; ++db)
#pragma unroll
                for (int g = 0; g < 4; ++g) { const f32x4 gsc = *(const ALAS f32x4*)(lds + OFF_SUB + (32 * db + 8 * g + 4 * hi) * 4);
                    u32x2 w; w.x = cvt_pk_bf16(o[db][4 * g] * rn * gsc[0], o[db][4 * g + 1] * rn * gsc[1]); w.y = cvt_pk_bf16(o[db][4 * g + 2] * rn * gsc[2], o[db][4 * g + 3] * rn * gsc[3]);
                    *(u32x2*)(yp + 32 * db + 8 * g) = w; }
        }
        __syncthreads();
    }
}

__device__ __forceinline__ void attn_phase(ALAS unsigned char* lds, const bf16_t* QK, const bf16_t* VT, bf16_t* Y, const float* rel_bias, const float* sinkp, const float* subln, const float* blam) {
    float lam;
    { const int lane = threadIdx.x & 63; float a = blam[lane] * blam[64 + lane], b = blam[128 + lane] * blam[192 + lane];
#pragma unroll
      for (int o = 1; o < 64; o <<= 1) { a += __shfl_xor(a, o); b += __shfl_xor(b, o); }
      lam = __expf(a) - __expf(b) + 0.2f; }
    { constexpr float LOG2E = 1.4426950408889634f; ALAS float* lutw = (ALAS float*)(lds + OFF_LUT);
      for (int i = threadIdx.x; i < 12 * 257; i += 512) { const int hh = i / 257, ri = i - hh * 257; lutw[hh * 260 + ri] = rel_bias[t5_bucket(ri - 128) * 12 + hh] * LOG2E; }
      if (threadIdx.x < 128) ((ALAS float*)(lds + OFF_SUB))[threadIdx.x] = subln[threadIdx.x];
      __syncthreads(); }
    const int G = gridDim.x, bx = blockIdx.x;
    if (__builtin_amdgcn_readfirstlane((int)threadIdx.x) >= 256) __builtin_amdgcn_s_setprio(1);
    if (G == 256) {
        const int x = bx & 7, j = bx >> 3;
        for (int r = 0; r < 8; ++r) { const int bh = x + 8 * (r >> 1), qb = j + 32 * (r & 1);
            attn_unit<false>(lds, QK, VT, Y, rel_bias, sinkp, subln, lam, (bh >> 2) * 8192, 8192, qb * 128, bh & 3); }
        for (int r = 0; r < 8; ++r) { const int bh = x + 8 * ((j >> 4) + 2 * r), qb = j & 15;
            attn_unit<false>(lds, QK, VT, Y, rel_bias, sinkp, subln, lam, 65536 + (bh >> 2) * 2048, 2048, qb * 128, bh & 3); }
    } else {
    for (int u = bx; u < 2048; u += G) { const int qb = u & 63, bh = u >> 6; attn_unit<false>(lds, QK, VT, Y, rel_bias, sinkp, subln, lam, (bh >> 2) * 8192, 8192, qb * 128, bh & 3); }
    for (int u = bx; u < 2048; u += G) { const int qb = u & 15, bh = u >> 4; attn_unit<false>(lds, QK, VT, Y, rel_bias, sinkp, subln, lam, 65536 + (bh >> 2) * 2048, 2048, qb * 128, bh & 3); }
    }
    for (int u = bx; u < 4096; u += G) { const int hp = u & 3, qb = u >> 2;
        const int row0 = qb * 128; int seq_base, S;
        if (row0 < 65536) { seq_base = row0 & ~8191; S = 8192; } else { seq_base = row0 & ~2047; S = 2048; }
        attn_unit<true>(lds, QK, VT, Y, rel_bias, sinkp, subln, lam, seq_base, S, row0 - seq_base, hp); }
    __builtin_amdgcn_s_setprio(0);
}
}

namespace cv {
using pg8::bf16_t; using pg8::f32x4; using pg8::u32x4; using pg8::cvt_pk_bf16; using pg8::bf_lo; using pg8::bf_hi; using pg8::fast_sigmoid;
#define CLAS __attribute__((address_space(3)))
constexpr int T = 32, HALO = 15, ROWS = T + 2 * HALO;
constexpr int OFF_U0 = 0, OFF_U1 = 64 * 1024;
constexpr int CONV_LDS = OFF_U1 + T * 512 * 4;
__device__ __forceinline__ void conv_unit(CLAS unsigned char* lds, const bf16_t* __restrict__ PC, bf16_t* __restrict__ YC, const float* __restrict__ w3, const float* __restrict__ w31,
                                          const float* __restrict__ dwb, const float* __restrict__ lng, const float* __restrict__ lnb, int seq_base, int S, int t0) {
    const int tid = threadIdx.x;
    {
        u32x4 w8[8];
#pragma unroll
        for (int it = 0; it < 8; ++it) { const int idx = tid + 512 * it, j = idx >> 6, v = idx & 63, tok = t0 - HALO + j;
            w8[it] = (u32x4){0u, 0u, 0u, 0u};
            if (idx < ROWS * 64 && tok >= 0 && tok < S) w8[it] = *(const u32x4*)(PC + (size_t)(seq_base + tok) * 1536 + 1024 + v * 8); }
#pragma unroll
        for (int it = 0; it < 8; ++it) { const int idx = tid + 512 * it, j = idx >> 6, v = idx & 63;
            if (idx < ROWS * 64) *(CLAS u32x4*)(lds + OFF_U0 + j * 1024 + v * 16) = w8[it]; }
    }
    __syncthreads();
    const int cp = tid & 255, th = tid >> 8;
    {
        const float wa0 = w3[2 * cp], wa1 = w3[512 + 2 * cp], wa2 = w3[1024 + 2 * cp];
        const float wb0 = w3[2 * cp + 1], wb1 = w3[512 + 2 * cp + 1], wb2 = w3[1024 + 2 * cp + 1];
        const int tb = t0 + 16 * th;
        unsigned pw[18], gw[16];
#pragma unroll
        for (int i = 0; i < 18; ++i) { const int tok = tb - 1 + i; pw[i] = 0u; if (tok >= 0 && tok < S) pw[i] = *(const unsigned*)(PC + (size_t)(seq_base + tok) * 1536 + 512 + 2 * cp); }
#pragma unroll
        for (int i = 0; i < 16; ++i) gw[i] = *(const unsigned*)(PC + (size_t)(seq_base + tb + i) * 1536 + 2 * cp);
#pragma unroll
        for (int i = 0; i < 16; ++i) {
            const float ya = bf_lo(gw[i]) * (wa0 * bf_lo(pw[i]) + wa1 * bf_lo(pw[i + 1]) + wa2 * bf_lo(pw[i + 2]));
            const float yb = bf_hi(gw[i]) * (wb0 * bf_hi(pw[i]) + wb1 * bf_hi(pw[i + 1]) + wb2 * bf_hi(pw[i + 2]));
            *(unsigned*)(YC + (size_t)(seq_base + tb + i) * 1024 + 2 * cp) = cvt_pk_bf16(ya, yb);
        }
    }
    {
        float wa[31], wb[31];
#pragma unroll
        for (int j = 0; j < 31; ++j) { wa[j] = w31[j * 512 + 2 * cp]; wb[j] = w31[j * 512 + 2 * cp + 1]; }
        const float ba = dwb[2 * cp], bb = dwb[2 * cp + 1];
        for (int g4 = 0; g4 < 4; ++g4) {
            const int tt = 16 * th + 4 * g4;
            float aa[4], ab[4];
#pragma unroll
            for (int k = 0; k < 4; ++k) { aa[k] = ba; ab[k] = bb; }
            const CLAS unsigned char* up = lds + OFF_U0 + tt * 1024 + cp * 4;
#pragma unroll
            for (int rr = 0; rr < 34; ++rr) {
                const unsigned w = *(const CLAS unsigned*)(up + rr * 1024);
                const float xa = bf_lo(w), xb = bf_hi(w);
#pragma unroll
                for (int k = 0; k < 4; ++k) { const int j = rr - k; if (j >= 0 && j < 31) { aa[k] += wa[j] * xa; ab[k] += wb[j] * xb; } }
            }
#pragma unroll
            for (int k = 0; k < 4; ++k) { typedef float f32x2 __attribute__((ext_vector_type(2))); *(CLAS f32x2*)(lds + OFF_U1 + (tt + k) * 2048 + cp * 8) = (f32x2){aa[k], ab[k]}; }
        }
    }
    __syncthreads();
    {
        const int lane = tid & 63, wid = tid >> 6;
        const f32x4 g0 = *(const f32x4*)(lng + 8 * lane), g1 = *(const f32x4*)(lng + 8 * lane + 4), b0 = *(const f32x4*)(lnb + 8 * lane), b1 = *(const f32x4*)(lnb + 8 * lane + 4);
        for (int k = 0; k < 4; ++k) {
            const int tt = 4 * wid + k;
            const f32x4 x0 = *(const CLAS f32x4*)(lds + OFF_U1 + tt * 2048 + lane * 32), x1 = *(const CLAS f32x4*)(lds + OFF_U1 + tt * 2048 + lane * 32 + 16);
            float s = ((x0[0] + x0[1]) + (x0[2] + x0[3])) + ((x1[0] + x1[1]) + (x1[2] + x1[3]));
#pragma unroll
            for (int o = 1; o < 64; o <<= 1) s += __shfl_xor(s, o);
            const float mean = s * (1.0f / 512.0f);
            const f32x4 d0 = x0 - mean, d1 = x1 - mean;
            float q = ((d0[0] * d0[0] + d0[1] * d0[1]) + (d0[2] * d0[2] + d0[3] * d0[3])) + ((d1[0] * d1[0] + d1[1] * d1[1]) + (d1[2] * d1[2] + d1[3] * d1[3]));
#pragma unroll
            for (int o = 1; o < 64; o <<= 1) q += __shfl_xor(q, o);
            const float rstd = __builtin_amdgcn_rsqf(q * (1.0f / 512.0f) + 1e-6f);
            f32x4 y0 = d0 * rstd * g0 + b0, y1 = d1 * rstd * g1 + b1;
#pragma unroll
            for (int i = 0; i < 4; ++i) { y0[i] = y0[i] * fast_sigmoid(y0[i]); y1[i] = y1[i] * fast_sigmoid(y1[i]); }
            u32x4 w; w.x = cvt_pk_bf16(y0[0], y0[1]); w.y = cvt_pk_bf16(y0[2], y0[3]); w.z = cvt_pk_bf16(y1[0], y1[1]); w.w = cvt_pk_bf16(y1[2], y1[3]);
            *(u32x4*)(YC + (size_t)(seq_base + t0 + tt) * 1024 + 512 + 8 * lane) = w;
        }
    }
    __syncthreads();
}
__device__ __forceinline__ void conv_phase(CLAS unsigned char* lds, const bf16_t* PC, bf16_t* YC, const float* w3, const float* w31, const float* dwb, const float* lng, const float* lnb) {
    for (int u = blockIdx.x; u < 131072 / T; u += gridDim.x) {
        const int row0 = u * T; int seq_base, S;
        if (row0 < 65536) { seq_base = row0 & ~8191; S = 8192; } else { seq_base = row0 & ~2047; S = 2048; }
        conv_unit(lds, PC, YC, w3, w31, dwb, lng, lnb, seq_base, S, row0 - seq_base);
    }
}
}

namespace mk {
using pg8::bf16_t; using pg8::f32x4; using pg8::u32x4; using pg8::u32x2; using pg8::cvt_pk_bf16;
#define MLAS __attribute__((address_space(3)))
constexpr int M = 131072, D = 1024, FF = 2816, NQKV = 2304, NCI = 2560;
constexpr size_t MiB = 1u << 20;
constexpr size_t WS_X = 0;
constexpr size_t WS_BIG = 256 * MiB;
constexpr size_t WS_VT = WS_BIG + (size_t)M * pg8::QKW * 2;
constexpr size_t WS_W = 960 * MiB;
constexpr size_t WS_WQKV = WS_W, WS_WO = WS_WQKV + (size_t)NQKV * D * 2, WS_WGU0 = WS_WO + (size_t)D * D * 2, WS_WGU1 = WS_WGU0 + (size_t)2 * FF * D * 2,
                 WS_WD0 = WS_WGU1 + (size_t)2 * FF * D * 2, WS_WD1 = WS_WD0 + (size_t)D * FF * 2, WS_WCI = WS_WD1 + (size_t)D * FF * 2, WS_WCO = WS_WCI + (size_t)NCI * D * 2;
constexpr size_t WS_SSQ = 1008 * MiB;
constexpr size_t WS_CTL = 1016 * MiB, CTL_BYTES = 16384;
constexpr size_t WS_END = WS_CTL + 65536;
static_assert(WS_VT + (size_t)640 * pg8::VT_PITCH * 2 <= WS_W && WS_BIG + (size_t)M * FF * 2 <= WS_W && WS_WCO + (size_t)D * D * 2 <= WS_SSQ, "ws map");
constexpr int MISC_OFF = 147456, LDS_BYTES = MISC_OFF + 256;
static_assert(att::ATT_LDS <= MISC_OFF && cv::CONV_LDS <= MISC_OFF && pg8::STAGE_BYTES + 16384 <= MISC_OFF, "lds map");

#define XB_TMO      128
#define XB_XCNT(j)  (256  + 64 * (j))
#define XB_XSUB(j)  (1280 + 64 * (j))
#define XB_XGEN(j)  (2304 + 64 * (j))
#define XB_TOP      3328
#define XB_TOPGEN   3392
#define XCD_BAR_WORDS 3456
#define XB_SPIN_CAP (1u << 18)

__device__ __forceinline__ unsigned xb_ld(unsigned* p)              { return __hip_atomic_load(p, __ATOMIC_RELAXED, __HIP_MEMORY_SCOPE_AGENT); }
__device__ __forceinline__ unsigned xb_add(unsigned* p, unsigned v) { return __hip_atomic_fetch_add(p, v, __ATOMIC_RELAXED, __HIP_MEMORY_SCOPE_AGENT); }
__device__ __forceinline__ unsigned xb_xcc_id() { return (unsigned)__builtin_amdgcn_s_getreg((3 << 11) | 20) & 0xFu; }
#define XB_SPIN(cond, bar) do { unsigned _sp = 0; while (cond) { __builtin_amdgcn_s_sleep(1); \
    if ((++_sp & 255u) == 0u) { if (xb_ld(&(bar)[XB_TMO])) break; if (_sp > XB_SPIN_CAP) { atomicAdd(&(bar)[XB_TMO], 1u); break; } } } } while (0)

struct XcdBarrier {
    unsigned* bar; unsigned x;
    volatile MLAS unsigned* st;
};

__device__ __forceinline__ XcdBarrier xcd_barrier_post(unsigned* bar, volatile MLAS unsigned* st) {
    XcdBarrier b; b.bar = bar; b.x = xb_xcc_id(); b.st = st;
    if (threadIdx.x == 0) (void)xb_add(&bar[XB_XCNT(b.x)], 1u);
    return b;
}
__device__ __forceinline__ void xcd_barrier_complete(unsigned* bar, unsigned x, unsigned& nloc, unsigned& nx) {
    const unsigned G = gridDim.x * gridDim.y * gridDim.z;
    unsigned sum, cnt, mine, sp = 0u;
    for (;;) {
        sum = 0u; cnt = 0u; mine = 0u;
#pragma unroll
        for (unsigned j = 0; j < 16; ++j) { const unsigned c = xb_ld(&bar[XB_XCNT(j)]); sum += c; cnt += (c > 0u) ? 1u : 0u; mine = (j == x) ? c : mine; }
        if (sum == G) break;
        __builtin_amdgcn_s_sleep(1);
        if ((++sp & 255u) == 0u) { if (xb_ld(&bar[XB_TMO])) break; if (sp > XB_SPIN_CAP) { atomicAdd(&bar[XB_TMO], 1u); break; } }
    }
    nloc = mine > 0u ? mine : 1u; nx = cnt > 0u ? cnt : 1u;
}

__device__ __forceinline__ void xcd_barrier(const XcdBarrier& b) {
    asm volatile("s_waitcnt vmcnt(0)" ::: "memory");
    __syncthreads();
    if (threadIdx.x == 0) {
        unsigned* bar = b.bar;
        __builtin_amdgcn_s_waitcnt(0);
        unsigned nloc = b.st[0], nx = b.st[1];
        if (nloc == 0u) { xcd_barrier_complete(bar, b.x, nloc, nx); b.st[0] = nloc; b.st[1] = nx; }
        const unsigned old = xb_add(&bar[XB_XSUB(b.x)], 1u);
        const unsigned gen = old / nloc;
        if (old + 1u == (gen + 1u) * nloc) {
            __builtin_amdgcn_fence(__ATOMIC_RELEASE, "agent");
            asm volatile("s_waitcnt vmcnt(0)" ::: "memory");
            const unsigned og = xb_add(&bar[XB_TOP], 1u);
            const unsigned tg = og / nx;
            if (og + 1u == (tg + 1u) * nx) xb_add(&bar[XB_TOPGEN], 1u);
            else XB_SPIN(xb_ld(&bar[XB_TOPGEN]) == tg, bar);
            __builtin_amdgcn_fence(__ATOMIC_ACQUIRE, "agent");
            xb_add(&bar[XB_XGEN(b.x)], 1u);
            asm volatile("s_waitcnt vmcnt(0)" ::: "memory");
        } else {
            XB_SPIN(xb_ld(&bar[XB_XGEN(b.x)]) == gen, bar);
            __builtin_amdgcn_fence(__ATOMIC_ACQUIRE, "agent");
            asm volatile("s_waitcnt vmcnt(0)" ::: "memory");
        }
    }
    __syncthreads();
}

static_assert(XCD_BAR_WORDS * 4 <= CTL_BYTES, "barrier words");
struct Params { const float* in[24]; float* out; unsigned char* ws; int ph_lo, ph_hi; };

__device__ __forceinline__ void tr_item(const float* __restrict__ W, int ldw, int srccol0, const float* __restrict__ gain, bf16_t* __restrict__ WT, int K, int destrow0, int k0, MLAS float* scr, int lane) {
    float wv[32];
#pragma unroll
    for (int i = 0; i < 32; ++i) { const int kk = 2 * i + (lane >> 5); wv[i] = W[(size_t)(k0 + kk) * ldw + srccol0 + (lane & 31)]; }
    const float g0 = gain ? gain[k0 + (lane & 31) * 2] : 1.0f, g1 = gain ? gain[k0 + (lane & 31) * 2 + 1] : 1.0f;
#pragma unroll
    for (int i = 0; i < 32; ++i) { const int kk = 2 * i + (lane >> 5); const float ga = __shfl(g0, i), gb = __shfl(g1, i); scr[kk * 33 + (lane & 31)] = wv[i] * ((lane >> 5) ? gb : ga); }
    asm volatile("s_waitcnt lgkmcnt(0)" ::: "memory");
    const int c = lane & 7;
#pragma unroll
    for (int j = 0; j < 4; ++j) { const int n = (lane >> 3) + 8 * j; const MLAS float* s = scr + (8 * c) * 33 + n;
        u32x4 o; o.x = cvt_pk_bf16(s[0 * 33], s[1 * 33]); o.y = cvt_pk_bf16(s[2 * 33], s[3 * 33]); o.z = cvt_pk_bf16(s[4 * 33], s[5 * 33]); o.w = cvt_pk_bf16(s[6 * 33], s[7 * 33]);
        *(u32x4*)(WT + (size_t)(destrow0 + n) * K + k0 + 8 * c) = o; }
    asm volatile("s_waitcnt lgkmcnt(0)" ::: "memory");
}

__device__ __forceinline__ void prologue(const Params& p, MLAS unsigned char* lds) {
    const int tid = threadIdx.x, lane = tid & 63, wave = tid >> 6;
    MLAS float* scr = (MLAS float*)(lds + wave * 16384);
    const int gw = blockIdx.x * 8 + wave, NGW = gridDim.x * 8;
    unsigned char* ws = p.ws;
    constexpr int I_QKV = (NQKV / 32) * (D / 64), I_O = (D / 32) * (D / 64), I_GU = (2 * FF / 32) * (D / 64), I_D = (D / 32) * (FF / 64), I_CI = (NCI / 32) * (D / 64);
    constexpr int NIT = I_QKV + I_O + 2 * I_GU + 2 * I_D + I_CI + I_O;
    for (int it = gw; it < NIT; it += NGW) {
        int r = it;
        if (r < I_QKV) { const int kb = r / (NQKV / 32), nb = r % (NQKV / 32); const int n0 = nb * 32, pn = n0 >> 8, within = n0 & 255, bj = within >> 7, wc = (within & 127) >> 5;
            tr_item(p.in[8], NQKV, 256 * pn + 64 * wc + 32 * bj, p.in[3], (bf16_t*)(ws + WS_WQKV), D, n0, kb * 64, scr, lane); continue; }
        r -= I_QKV;
        if (r < I_O) { const int kb = r / (D / 32), nb = r % (D / 32); tr_item(p.in[9], D, nb * 32, nullptr, (bf16_t*)(ws + WS_WO), D, nb * 32, kb * 64, scr, lane); continue; }
        r -= I_O;
        if (r < 2 * I_GU) { const int l = r / I_GU; r -= l * I_GU; const int kb = r / (2 * FF / 32), nb = r % (2 * FF / 32); const int n0 = nb * 32, pn = n0 >> 8, within = n0 & 255, bj = within >> 7, j = within & 127;
            const float* src = (bj ? p.in[6] : p.in[5]) + (size_t)l * D * FF;
            tr_item(src, FF, 128 * pn + j, p.in[4] + l * D, (bf16_t*)(ws + (l ? WS_WGU1 : WS_WGU0)), D, n0, kb * 64, scr, lane); continue; }
        r -= 2 * I_GU;
        if (r < 2 * I_D) { const int l = r / I_D; r -= l * I_D; const int kb = r / (D / 32), nb = r % (D / 32);
            tr_item(p.in[7] + (size_t)l * FF * D, D, nb * 32, nullptr, (bf16_t*)(ws + (l ? WS_WD1 : WS_WD0)), FF, nb * 32, kb * 64, scr, lane); continue; }
        r -= 2 * I_D;
        if (r < I_CI) { const int kb = r / (NCI / 32), nb = r % (NCI / 32); const int n0 = nb * 32, pn = n0 >> 8, within = n0 & 255, bj = within >> 7, j = within & 127;
            const int src = pn < 2 ? n0 : (pn < 6 ? (bj ? 1024 : 512) + 128 * (pn - 2) + j : (bj ? 2048 : 1536) + 128 * (pn - 6) + j);
            tr_item(p.in[17], NCI, src, p.in[3] + D, (bf16_t*)(ws + WS_WCI), D, n0, kb * 64, scr, lane); continue; }
        r -= I_CI;
        { const int kb = r / (D / 32), nb = r % (D / 32); tr_item(p.in[18], D, nb * 32, nullptr, (bf16_t*)(ws + WS_WCO), D, nb * 32, kb * 64, scr, lane); }
    }
    bf16_t* X = (bf16_t*)(ws + WS_X); float* ssq = (float*)(ws + WS_SSQ);
    for (int m0 = gw; m0 < M; m0 += 4 * NGW) {
        f32x4 v[4][4];
#pragma unroll
        for (int r = 0; r < 4; ++r) { const int m = m0 + r * NGW; if (m < M) { const float* xrow = (m < 65536) ? p.in[0] + (size_t)m * D : p.in[1] + (size_t)(m - 65536) * D; const f32x4* xr = (const f32x4*)xrow + lane;
#pragma unroll
            for (int j = 0; j < 4; ++j) v[r][j] = xr[64 * j]; } }
#pragma unroll
        for (int r = 0; r < 4; ++r) { const int m = m0 + r * NGW; if (m < M) {
            float s = 0.f;
#pragma unroll
            for (int j = 0; j < 4; ++j) s += (v[r][j][0] * v[r][j][0] + v[r][j][1] * v[r][j][1]) + (v[r][j][2] * v[r][j][2] + v[r][j][3] * v[r][j][3]);
#pragma unroll
            for (int o = 1; o < 64; o <<= 1) s += __shfl_xor(s, o);
            u32x2* o8 = (u32x2*)(X + (size_t)m * D) + lane;
#pragma unroll
            for (int j = 0; j < 4; ++j) { u32x2 w; w.x = cvt_pk_bf16(v[r][j][0], v[r][j][1]); w.y = cvt_pk_bf16(v[r][j][2], v[r][j][3]); o8[64 * j] = w; }
            if (lane < 16) ssq[(size_t)m * 16 + lane] = (lane == 0) ? s : 0.f; } }
    }
}

__global__ void __launch_bounds__(512, 2) fwd_kernel(Params p) {
    extern __shared__ __attribute__((aligned(16))) unsigned char lds_raw[];
    MLAS unsigned char* lds = (MLAS unsigned char*)lds_raw;
    cg::grid_group grid = cg::this_grid();
    unsigned char* ws = p.ws;
    bf16_t* X = (bf16_t*)(ws + WS_X); bf16_t* BIG = (bf16_t*)(ws + WS_BIG); bf16_t* VT = (bf16_t*)(ws + WS_VT); float* ssq = (float*)(ws + WS_SSQ);
    bf16_t* Y = (bf16_t*)p.out;
    const int lo = p.ph_lo, hi = p.ph_hi, G = gridDim.x, bx = blockIdx.x;
    volatile MLAS unsigned* misc = (volatile MLAS unsigned*)(lds + MISC_OFF);
    if (threadIdx.x < 2) misc[threadIdx.x] = 0u;
    __syncthreads();
    const XcdBarrier xbar = xcd_barrier_post((unsigned*)(ws + WS_CTL), misc);
#ifndef PH_MASK
#define PH_MASK 0x7ff
#endif
#define IN(k) (((PH_MASK >> (k)) & 1) && lo <= (k) && (k) < hi)
#define SEAM(k) do { if (IN(k) && IN((k) + 1)) { if ((k) == 0) grid.sync(); else xcd_barrier(xbar); } } while (0)
    if (IN(0)) { prologue(p, lds); __syncthreads(); }
    SEAM(0);
    if (IN(1)) { pg8::Gemm g{X, (const bf16_t*)(ws + WS_WQKV), M, NQKV, D}; pg8::StaticOrder S; S.init(M, NQKV, G, bx);
        pg8::EpiQKV E{BIG, VT, ssq, p.in[10], p.in[11], p.in[13], p.in[14], lds + pg8::STAGE_BYTES};
        pg8::gemm_phase<pg8::EpiQKV, pg8::StaticOrder, true, true>(lds, g, S, E); }
    SEAM(1);
    if (IN(2)) { for (int rep = 0; rep < PROBE_ATT; ++rep) att::attn_phase(lds, BIG, VT, Y, p.in[2], p.in[12], p.in[16], p.in[15]); }
    SEAM(2);
    if (IN(3)) { pg8::Gemm g{Y, (const bf16_t*)(ws + WS_WO), M, D, D}; pg8::StaticOrder S; S.init(M, D, G, bx);
        pg8::EpiRes<false> E{X, nullptr, ssq};
        pg8::gemm_phase<pg8::EpiRes<false>, pg8::StaticOrder, true, true>(lds, g, S, E); }
    SEAM(3);
    if (IN(4)) { pg8::Gemm g{X, (const bf16_t*)(ws + WS_WGU0), M, 2 * FF, D}; pg8::StaticOrder S; S.init(M, 2 * FF, G, bx);
        pg8::EpiGlu E{BIG, ssq};
        pg8::gemm_phase<pg8::EpiGlu, pg8::StaticOrder, true, true>(lds, g, S, E); }
    SEAM(4);
    if (IN(5)) { pg8::Gemm g{BIG, (const bf16_t*)(ws + WS_WD0), M, D, FF}; pg8::StaticOrder S; S.init(M, D, G, bx);
        pg8::EpiRes<false> E{X, nullptr, ssq};
        pg8::gemm_phase<pg8::EpiRes<false>, pg8::StaticOrder, true, true>(lds, g, S, E); }
    SEAM(5);
    if (IN(6)) { pg8::Gemm g{X, (const bf16_t*)(ws + WS_WCI), M, NCI, D}; pg8::StaticOrder S; S.init(M, NCI, G, bx);
        pg8::EpiConvIn E{BIG, ssq};
        pg8::gemm_phase<pg8::EpiConvIn, pg8::StaticOrder, true, true>(lds, g, S, E); }
    SEAM(6);
    if (IN(7)) { cv::conv_phase(lds, BIG, Y, p.in[19], p.in[20], p.in[21], p.in[22], p.in[23]); }
    SEAM(7);
    if (IN(8)) { pg8::Gemm g{Y, (const bf16_t*)(ws + WS_WCO), M, D, D}; pg8::StaticOrder S; S.init(M, D, G, bx);
        pg8::EpiRes<false> E{X, nullptr, ssq};
        pg8::gemm_phase<pg8::EpiRes<false>, pg8::StaticOrder, true, true>(lds, g, S, E); }
    SEAM(8);
    if (IN(9)) { pg8::Gemm g{X, (const bf16_t*)(ws + WS_WGU1), M, 2 * FF, D}; pg8::StaticOrder S; S.init(M, 2 * FF, G, bx);
        pg8::EpiGlu E{BIG, ssq};
        pg8::gemm_phase<pg8::EpiGlu, pg8::StaticOrder, true, true>(lds, g, S, E); }
    SEAM(9);
    if (IN(10)) { pg8::Gemm g{BIG, (const bf16_t*)(ws + WS_WD1), M, D, FF}; pg8::StaticOrder S; S.init(M, D, G, bx);
        pg8::EpiRes<true> E{X, p.out, ssq};
        pg8::gemm_phase<pg8::EpiRes<true>, pg8::StaticOrder, true, true>(lds, g, S, E); }
#undef IN
#undef SEAM
}
}

#ifndef MK_N_LAUNCHES_X
#define MK_N_LAUNCHES 1
#endif
extern "C" void kernel_launch(void* const* d_in, const int* in_sizes, int n_in, void* d_out, int out_size, void* d_ws, size_t ws_size, hipStream_t stream) {
    static int grid = 0;
    if (grid == 0) {
        if (n_in != 24 || out_size != mk::M * mk::D || ws_size < mk::WS_END) { fprintf(stderr, "kernel_launch: unexpected shapes (n_in %d out %d ws %zu)\n", n_in, out_size, ws_size); grid = -1; return; }
        int dev = 0, cus = 0, per_cu = 0;
        (void)hipGetDevice(&dev); (void)hipDeviceGetAttribute(&cus, hipDeviceAttributeMultiprocessorCount, dev);
        (void)hipFuncSetAttribute((const void*)mk::fwd_kernel, hipFuncAttributeMaxDynamicSharedMemorySize, mk::LDS_BYTES);
        (void)hipOccupancyMaxActiveBlocksPerMultiprocessor(&per_cu, (const void*)mk::fwd_kernel, 512, mk::LDS_BYTES);
        if (per_cu < 1) per_cu = 1;
        (void)hipGetLastError();
        grid = cus * per_cu;
    }
    if (grid < 0) return;
    if (hipMemsetAsync((char*)d_ws + mk::WS_CTL, 0, mk::CTL_BYTES, stream) != hipSuccess) { fprintf(stderr, "kernel_launch: memset of the barrier words failed\n"); return; }
    mk::Params p{};
    for (int i = 0; i < 24; ++i) p.in[i] = (const float*)d_in[i];
    p.out = (float*)d_out; p.ws = (unsigned char*)d_ws;
#if MK_N_LAUNCHES == 1
    p.ph_lo = 0; p.ph_hi = 11;
    void* args[] = {&p};
    hipError_t e = hipLaunchCooperativeKernel((const void*)mk::fwd_kernel, dim3(grid), dim3(512), args, mk::LDS_BYTES, stream);
    if (e != hipSuccess) fprintf(stderr, "cooperative launch failed: %s (grid %d)\n", hipGetErrorString(e), grid);
#else
    for (int ph = 0; ph < 11; ++ph) { p.ph_lo = ph; p.ph_hi = ph + 1; hipLaunchKernelGGL(mk::fwd_kernel, dim3(grid), dim3(512), mk::LDS_BYTES, stream, p); }
#endif
}
```

```cpp
#include <hip/hip_runtime.h>
#include <hip/hip_cooperative_groups.h>
#include <cstdio>
#include <cstdint>
namespace cg = cooperative_groups;
#ifndef PROBE_ATT
#define PROBE_ATT 1
#endif
#ifndef MK_N_LAUNCHES
#define MK_N_LAUNCHES 1
#endif
namespace pg8 {
#define PG8_LAS __attribute__((address_space(3)))
typedef unsigned short bf16_t;
typedef short bf16x8 __attribute__((ext_vector_type(8)));
typedef float f32x4 __attribute__((ext_vector_type(4)));
typedef unsigned u32x4 __attribute__((ext_vector_type(4)));
constexpr int BM = 256, BK = 64, HALF = 128, HTB = HALF * BK * 2  , STAGE_BYTES = 8 * HTB, NXCD = 8, WGM = 8;

__host__ __device__ __forceinline__ int lds_byte(int r, int c) { const int st = (r >> 4) * 2 + (c >> 5), rr = r & 15, cc = c & 31, ob = rr * 64 + cc * 2; return st * 1024 + (ob ^ (((ob >> 9) & 1) << 5)); }
__host__ __device__ __forceinline__ void stage_rc(int b, int& R, int& C) { const int st = b / 1024, sb = b % 1024, swz = sb ^ (((sb >> 9) & 1) << 5); R = (st >> 1) * 16 + swz / 64; C = (st & 1) * 32 + (swz % 64) / 2; }
__host__ __device__ __forceinline__ int perm32(int rho) { const int n = rho >> 4, i = rho & 15; return 8 * (i >> 2) + 4 * n + (i & 3); }

struct Unit { int pm, pn; };
struct Gemm { const bf16_t* A; const bf16_t* Bt; int M, N, K; };

struct StaticOrder {
    int nM, nN, nwg, G, c;
    __host__ __device__ void init(int M, int N, int G_, int c_) { nM = M / BM; nN = N / BM; nwg = nM * nN; G = G_; c = c_; }
    __host__ __device__ bool next(int i, Unit& u) const {
        const long L = (long)i * G + c; if (L >= nwg) return false;
        int wgid = (int)L; { const int q = nwg / NXCD, r = nwg % NXCD, xcd = wgid % NXCD, off = wgid / NXCD; wgid = (xcd < r ? xcd * (q + 1) : r * (q + 1) + (xcd - r) * q) + off; }
        const int nig = WGM * nN, gid = wgid / nig, fm = gid * WGM, gsz = (nM - fm) < WGM ? (nM - fm) : WGM;
        u.pm = fm + ((wgid % nig) % gsz); u.pn = (wgid % nig) / gsz; return true;
    }
    __device__ __forceinline__ void a_ready(const Unit&) const {}
    __device__ __forceinline__ void done(const Unit&) const {}
};

__device__ __forceinline__ unsigned cvt_pk_bf16(float lo, float hi) { unsigned r; asm volatile("v_cvt_pk_bf16_f32 %0, %1, %2" : "=v"(r) : "v"(lo), "v"(hi)); return r; }
typedef float f32x2 __attribute__((ext_vector_type(2)));
typedef unsigned u32x2 __attribute__((ext_vector_type(2)));
__device__ __forceinline__ float bf_lo(unsigned w) { return __uint_as_float(w << 16); }
__device__ __forceinline__ float bf_hi(unsigned w) { return __uint_as_float(w & 0xffff0000u); }
__device__ __forceinline__ float row_rstd(const float* ssq, int row) {
    const f32x4* p = (const f32x4*)(ssq + (size_t)row * 16);
    const f32x4 a = p[0], b = p[1], c = p[2], d = p[3];
    const float s = ((a[0] + a[1]) + (a[2] + a[3])) + ((b[0] + b[1]) + (b[2] + b[3])) + ((c[0] + c[1]) + (c[2] + c[3])) + ((d[0] + d[1]) + (d[2] + d[3]));
    return __builtin_amdgcn_rsqf(s * (1.0f / 1024.0f) + 1e-6f);
}
__device__ __forceinline__ void rows_rstd(const float* ssq, int row0, int fq, float (&rs)[2][4]) {
    f32x4 pr[2][4];
#pragma unroll
    for (int ai = 0; ai < 2; ++ai)
#pragma unroll
        for (int m = 0; m < 4; ++m) pr[ai][m] = *(const f32x4*)(ssq + (size_t)(row0 + ai * HALF + m * 16) * 16 + 4 * fq);
#pragma unroll
    for (int ai = 0; ai < 2; ++ai)
#pragma unroll
        for (int m = 0; m < 4; ++m) { float t = (pr[ai][m][0] + pr[ai][m][1]) + (pr[ai][m][2] + pr[ai][m][3]); t += __shfl_xor(t, 16); t += __shfl_xor(t, 32); rs[ai][m] = __builtin_amdgcn_rsqf(t * (1.0f / 1024.0f) + 1e-6f); }
}
__device__ __forceinline__ float fast_sigmoid(float x) { return __builtin_amdgcn_rcpf(1.0f + __expf(-x)); }

constexpr int QKW = 1664;
constexpr int VT_PITCH = 131072 + 128;
constexpr float C2Q = 0.125f * 1.4426950408889634f;

struct EpiQKV {
    static constexpr bool PERM = true, AFTER_DRAIN = false;
    bf16_t* QK; bf16_t* VT; const float* ssq; const float* aq; const float* ak; const float* bq; const float* bk; PG8_LAS unsigned char* xlds;
    __device__ __forceinline__ void operator()(const f32x4 (&acc)[2][2][4][2], const Unit& u, int wr, int wc, int fr, int fq) const {
        const int L = u.pn * 256 + wc * 64;
        int kind; const float* gain = nullptr; float scale = 1.f; int ccol = 0, vrow = 0;
        if (L < 512) { kind = 0; gain = aq; scale = C2Q; ccol = L; }
        else if (L < 640) { kind = 0; gain = ak; ccol = L; }
        else if (L < 768) { kind = 1; vrow = L - 640; }
        else if (L < 1280) { kind = 0; gain = bq; scale = C2Q; ccol = L - 128; }
        else if (L < 1792) { kind = 0; gain = bk; ccol = L - 128; }
        else { kind = 1; vrow = L - 1792 + 128; }
        if (kind == 0) {
            f32x4 gv[2][2];
#pragma unroll
            for (int bj = 0; bj < 2; ++bj)
#pragma unroll
                for (int n = 0; n < 2; ++n) gv[bj][n] = *(const f32x4*)(gain + 32 * bj + 8 * fq + 4 * n);
            float rsv[2][4]; rows_rstd(ssq, u.pm * BM + wr * 64 + fr, fq, rsv);
#pragma unroll
            for (int ai = 0; ai < 2; ++ai)
#pragma unroll
                for (int m = 0; m < 4; ++m) {
                    const int row = u.pm * BM + ai * HALF + wr * 64 + m * 16 + fr;
                    const float rs = rsv[ai][m];
                    float ss = 0.f;
#pragma unroll
                    for (int bj = 0; bj < 2; ++bj)
#pragma unroll
                        for (int n = 0; n < 2; ++n) { const f32x4 v = acc[ai][bj][m][n] * rs; ss += (v[0] * v[0] + v[1] * v[1]) + (v[2] * v[2] + v[3] * v[3]); }
                    ss += __shfl_xor(ss, 16); ss += __shfl_xor(ss, 32);
                    const float f = rs * __builtin_amdgcn_rsqf(ss * (1.0f / 64.0f) + 1e-6f) * scale;
                    bf16_t* rowp = QK + ((size_t)((row >> 6) * 26 + (ccol >> 6)) * 64 + (row & 63)) * 64 + 8 * fq;
#pragma unroll
                    for (int bj = 0; bj < 2; ++bj) {
                        const f32x4 v0 = acc[ai][bj][m][0] * f * gv[bj][0], v1 = acc[ai][bj][m][1] * f * gv[bj][1];
                        u32x4 w; w.x = cvt_pk_bf16(v0[0], v0[1]); w.y = cvt_pk_bf16(v0[2], v0[3]); w.z = cvt_pk_bf16(v1[0], v1[1]); w.w = cvt_pk_bf16(v1[2], v1[3]);
                        *(u32x4*)(rowp + 32 * bj) = w;
                    }
                }
        } else {
            PG8_LAS unsigned char* xl = xlds + (wr * 4 + wc) * 2048;
            const int lane = fq * 16 + fr;
            float rsv[2][4]; rows_rstd(ssq, u.pm * BM + wr * 64 + fr, fq, rsv);
#pragma unroll
            for (int ai = 0; ai < 2; ++ai) {
                float rs[4];
#pragma unroll
                for (int m = 0; m < 4; ++m) rs[m] = rsv[ai][m];
                const size_t tb = (size_t)(u.pm * 4 + ai * 2 + wr) * 640;
#pragma unroll
                for (int bj = 0; bj < 2; ++bj)
#pragma unroll
                    for (int n = 0; n < 2; ++n) {
#pragma unroll
                        for (int m = 0; m < 4; ++m) {
                            const f32x4 v = acc[ai][bj][m][n] * rs[m];
                            const unsigned w0 = cvt_pk_bf16(v[0], v[1]), w1 = cvt_pk_bf16(v[2], v[3]);
                            PG8_LAS bf16_t* q = (PG8_LAS bf16_t*)(xl + (4 * fq) * 128 + (16 * m + fr) * 2);
                            q[0] = (bf16_t)(w0 & 0xffffu); q[64] = (bf16_t)(w0 >> 16); q[128] = (bf16_t)(w1 & 0xffffu); q[192] = (bf16_t)(w1 >> 16);
                        }
                        asm volatile("s_waitcnt lgkmcnt(0)" ::: "memory");
                        const int c16 = lane >> 2, part = lane & 3;
                        const u32x4 a = *(const PG8_LAS u32x4*)(xl + c16 * 128 + part * 32), b = *(const PG8_LAS u32x4*)(xl + c16 * 128 + part * 32 + 16);
                        bf16_t* gp = VT + (tb + vrow + 32 * bj + 8 * (c16 >> 2) + 4 * n + (c16 & 3)) * 64 + part * 16;
                        *(u32x4*)gp = a; *(u32x4*)(gp + 8) = b;
                        asm volatile("s_waitcnt lgkmcnt(0)" ::: "memory");
                    }
            }
        }
    }
};

template <bool FINAL> struct EpiRes {
    static constexpr bool PERM = true, AFTER_DRAIN = false;
    bf16_t* X; float* out; float* ssq;
    __device__ __forceinline__ void operator()(const f32x4 (&acc)[2][2][4][2], const Unit& u, int wr, int wc, int fr, int fq) const {
        const int col0 = u.pn * BM + wc * 32 + 8 * fq;
        u32x4 xin[2][4][2];
#pragma unroll
        for (int ai = 0; ai < 2; ++ai)
#pragma unroll
            for (int m = 0; m < 4; ++m)
#pragma unroll
                for (int bj = 0; bj < 2; ++bj) xin[ai][m][bj] = *(const u32x4*)(X + (size_t)(u.pm * BM + ai * HALF + wr * 64 + m * 16 + fr) * 1024 + col0 + bj * HALF);
#pragma unroll
        for (int ai = 0; ai < 2; ++ai)
#pragma unroll
            for (int m = 0; m < 4; ++m) {
                const int row = u.pm * BM + ai * HALF + wr * 64 + m * 16 + fr;
                float ss = 0.f;
#pragma unroll
                for (int bj = 0; bj < 2; ++bj) {
                    bf16_t* xp = X + (size_t)row * 1024 + col0 + bj * HALF;
                    const u32x4 xv = xin[ai][m][bj];
                    f32x4 y0 = acc[ai][bj][m][0], y1 = acc[ai][bj][m][1];
                    y0[0] += bf_lo(xv.x); y0[1] += bf_hi(xv.x); y0[2] += bf_lo(xv.y); y0[3] += bf_hi(xv.y);
                    y1[0] += bf_lo(xv.z); y1[1] += bf_hi(xv.z); y1[2] += bf_lo(xv.w); y1[3] += bf_hi(xv.w);
                    if (FINAL) {
                        float* op = out + (size_t)row * 1024 + col0 + bj * HALF;
                        *(f32x4*)op = y0; *(f32x4*)(op + 4) = y1;
                    } else {
                        u32x4 w; w.x = cvt_pk_bf16(y0[0], y0[1]); w.y = cvt_pk_bf16(y0[2], y0[3]); w.z = cvt_pk_bf16(y1[0], y1[1]); w.w = cvt_pk_bf16(y1[2], y1[3]);
                        *(u32x4*)xp = w;
                        ss += (y0[0] * y0[0] + y0[1] * y0[1]) + (y0[2] * y0[2] + y0[3] * y0[3]) + (y1[0] * y1[0] + y1[1] * y1[1]) + (y1[2] * y1[2] + y1[3] * y1[3]);
                    }
                }
                if (!FINAL) {
                    ss += __shfl_xor(ss, 16); ss += __shfl_xor(ss, 32);
                    if (fq == 0) ssq[(size_t)row * 16 + u.pn * 4 + wc] = ss;
                }
            }
    }
};

struct EpiGlu {
    static constexpr bool PERM = true, AFTER_DRAIN = false;
    bf16_t* H; const float* ssq;
    __device__ __forceinline__ void operator()(const f32x4 (&acc)[2][2][4][2], const Unit& u, int wr, int wc, int fr, int fq) const {
        const int col0 = u.pn * HALF + wc * 32 + 8 * fq;
        float rsv[2][4]; rows_rstd(ssq, u.pm * BM + wr * 64 + fr, fq, rsv);
#pragma unroll
        for (int ai = 0; ai < 2; ++ai)
#pragma unroll
            for (int m = 0; m < 4; ++m) {
                const int row = u.pm * BM + ai * HALF + wr * 64 + m * 16 + fr;
                const float rs = rsv[ai][m];
                float h[8];
#pragma unroll
                for (int n = 0; n < 2; ++n)
#pragma unroll
                    for (int i = 0; i < 4; ++i) { const float g = acc[ai][0][m][n][i] * rs, up = acc[ai][1][m][n][i] * rs; h[4 * n + i] = g * up * fast_sigmoid(g); }
                u32x4 w; w.x = cvt_pk_bf16(h[0], h[1]); w.y = cvt_pk_bf16(h[2], h[3]); w.z = cvt_pk_bf16(h[4], h[5]); w.w = cvt_pk_bf16(h[6], h[7]);
                *(u32x4*)(H + (size_t)row * 2816 + col0) = w;
            }
    }
};

struct EpiConvIn {
    static constexpr bool PERM = true, AFTER_DRAIN = false;
    bf16_t* O; const float* ssq;
    __device__ __forceinline__ void operator()(const f32x4 (&acc)[2][2][4][2], const Unit& u, int wr, int wc, int fr, int fq) const {
        float rsv[2][4]; rows_rstd(ssq, u.pm * BM + wr * 64 + fr, fq, rsv);
#pragma unroll
        for (int ai = 0; ai < 2; ++ai)
#pragma unroll
            for (int m = 0; m < 4; ++m) {
                const int row = u.pm * BM + ai * HALF + wr * 64 + m * 16 + fr;
                const float rs = rsv[ai][m];
                bf16_t* rp = O + (size_t)row * 1536 + wc * 32 + 8 * fq;
                if (u.pn < 2) {
#pragma unroll
                    for (int bj = 0; bj < 2; ++bj) {
                        const f32x4 v0 = acc[ai][bj][m][0] * rs, v1 = acc[ai][bj][m][1] * rs;
                        u32x4 w; w.x = cvt_pk_bf16(v0[0], v0[1]); w.y = cvt_pk_bf16(v0[2], v0[3]); w.z = cvt_pk_bf16(v1[0], v1[1]); w.w = cvt_pk_bf16(v1[2], v1[3]);
                        *(u32x4*)(rp + u.pn * BM + bj * HALF) = w;
                    }
                } else {
                    float h[8];
                    const bool glu = u.pn >= 6;
#pragma unroll
                    for (int n = 0; n < 2; ++n)
#pragma unroll
                        for (int i = 0; i < 4; ++i) { const float a = acc[ai][0][m][n][i] * rs, b = acc[ai][1][m][n][i] * rs; h[4 * n + i] = glu ? a * fast_sigmoid(b) : a * b; }
                    u32x4 w; w.x = cvt_pk_bf16(h[0], h[1]); w.y = cvt_pk_bf16(h[2], h[3]); w.z = cvt_pk_bf16(h[4], h[5]); w.w = cvt_pk_bf16(h[6], h[7]);
                    *(u32x4*)(rp + 512 + (u.pn - 2) * HALF) = w;
                }
            }
    }
};

struct EpiPlain {
    static constexpr bool PERM = true, AFTER_DRAIN = false;
    bf16_t* O; int ldc; const float* ssq;
    __device__ __forceinline__ void operator()(const f32x4 (&acc)[2][2][4][2], const Unit& u, int wr, int wc, int fr, int fq) const {
        const int col0 = u.pn * BM + wc * 32 + 8 * fq;
#pragma unroll
        for (int ai = 0; ai < 2; ++ai)
#pragma unroll
            for (int m = 0; m < 4; ++m) {
                const int row = u.pm * BM + ai * HALF + wr * 64 + m * 16 + fr;
                const float rs = row_rstd(ssq, row);
#pragma unroll
                for (int bj = 0; bj < 2; ++bj) {
                    const f32x4 v0 = acc[ai][bj][m][0] * rs, v1 = acc[ai][bj][m][1] * rs;
                    u32x4 w; w.x = cvt_pk_bf16(v0[0], v0[1]); w.y = cvt_pk_bf16(v0[2], v0[3]); w.z = cvt_pk_bf16(v1[0], v1[1]); w.w = cvt_pk_bf16(v1[2], v1[3]);
                    *(u32x4*)(O + (size_t)row * ldc + col0 + bj * HALF) = w;
                }
            }
    }
};

template <class Epi, class Sched, bool ALIGN_EPI = false, bool SP2 = false>
__device__ __forceinline__ void gemm_phase(PG8_LAS unsigned char* lds, const Gemm g, const Sched& S, const Epi& E) {
    const int tid = threadIdx.x, wid = __builtin_amdgcn_readfirstlane(tid >> 6), lane = tid & 63, wr = wid >> 2, wc = wid & 3, fr = lane & 15, fq = lane >> 4;
    const int K = g.K, nt = K / BK;
    unsigned voffA[2], voffB[2];
#pragma unroll
    for (int i = 0; i < 2; ++i) { int R, C; stage_rc(tid * 16 + i * 8192, R, C); const int Rb = Epi::PERM ? ((R & ~31) + perm32(R & 31)) : R;
        voffA[i] = (unsigned)(R * K + C) * 2u; voffB[i] = (unsigned)(Rb * K + C) * 2u; }
    const size_t kstep = (size_t)(BK * 2);
    const size_t hstep = (size_t)HALF * K * 2;
    const size_t tstep = 2 * hstep;
    const unsigned ldsw = (unsigned)wid * 1024u;
    const int aoff = lds_byte(wr * 64 + fr, fq * 8), boff = lds_byte(wc * 32 + fr, fq * 8);
#define PG8_SA(b, h) (((b) * 2 + (h)) * HTB)
#define PG8_SB(b, h) ((4 + (b) * 2 + (h)) * HTB)
#define PG8_STAGE(bufoff, gbase, voff) do { _Pragma("unroll") for (int _i = 0; _i < 2; ++_i) \
        __builtin_amdgcn_global_load_lds((const unsigned*)((const char*)(gbase) + (voff)[_i]), (PG8_LAS unsigned*)(lds + (bufoff) + ldsw + _i * 8192), 16, 0, 0); } while (0)
#define PG8_LDA(dst, b, h) do { _Pragma("unroll") for (int m = 0; m < 4; ++m) _Pragma("unroll") for (int k = 0; k < 2; ++k) dst[m][k] = *(const PG8_LAS bf16x8*)(lds + PG8_SA(b, h) + aoff + m * 2048 + k * 1024); } while (0)
#define PG8_LDB(dst, b, h) do { _Pragma("unroll") for (int n = 0; n < 2; ++n) _Pragma("unroll") for (int k = 0; k < 2; ++k) dst[n][k] = *(const PG8_LAS bf16x8*)(lds + PG8_SB(b, h) + boff + n * 2048 + k * 1024); } while (0)
#define PG8_MMA(ai, bj, At, Bt) do { __builtin_amdgcn_s_setprio(1); _Pragma("unroll") for (int m = 0; m < 4; ++m) _Pragma("unroll") for (int n = 0; n < 2; ++n) _Pragma("unroll") for (int k = 0; k < 2; ++k) \
        acc[ai][bj][m][n] = __builtin_amdgcn_mfma_f32_16x16x32_bf16(Bt[n][k], At[m][k], acc[ai][bj][m][n], 0, 0, 0); __builtin_amdgcn_s_setprio(0); } while (0)
#define PG8_WAIT_V(n) asm volatile("s_waitcnt vmcnt(" #n ")" ::: "memory")
#define PG8_WAIT_L(n) asm volatile("s_waitcnt lgkmcnt(" #n ")" ::: "memory")
#define PG8_BAR __builtin_amdgcn_s_barrier()
#define PG8_SCHED __builtin_amdgcn_sched_barrier(0)
    Unit cur, nxt; int ui = 0;
    if (!S.next(0, cur)) return;
    f32x4 acc[2][2][4][2];
#pragma unroll
    for (int a = 0; a < 2; ++a)
#pragma unroll
        for (int b = 0; b < 2; ++b)
#pragma unroll
            for (int m = 0; m < 4; ++m)
#pragma unroll
                for (int n = 0; n < 2; ++n) acc[a][b][m][n] = (f32x4){0.f, 0.f, 0.f, 0.f};
    bf16x8 At[4][2], B0[2][2], B1[2][2];
    const char* cA = (const char*)g.A + (size_t)cur.pm * tstep; const char* cB = (const char*)g.Bt + (size_t)cur.pn * tstep;
    S.a_ready(cur);
    if constexpr (SP2) {
        PG8_STAGE(PG8_SB(0, 0), cB, voffB); PG8_STAGE(PG8_SB(0, 1), cB + hstep, voffB); PG8_STAGE(PG8_SA(0, 0), cA, voffA); PG8_STAGE(PG8_SA(0, 1), cA + hstep, voffA);
        if (wr == 1) PG8_BAR;
        PG8_WAIT_V(2); PG8_BAR;
        PG8_STAGE(PG8_SB(1, 0), cB + kstep, voffB); PG8_STAGE(PG8_SA(1, 0), cA + kstep, voffA); PG8_STAGE(PG8_SB(1, 1), cB + hstep + kstep, voffB);
        PG8_WAIT_V(6); PG8_BAR;
    } else {
        PG8_STAGE(PG8_SB(0, 0), cB, voffB); PG8_STAGE(PG8_SA(0, 0), cA, voffA); PG8_STAGE(PG8_SB(0, 1), cB + hstep, voffB); PG8_STAGE(PG8_SA(0, 1), cA + hstep, voffA);
        if (wr == 1) PG8_BAR;
        PG8_WAIT_V(4); PG8_BAR;
        PG8_STAGE(PG8_SB(1, 0), cB + kstep, voffB); PG8_STAGE(PG8_SA(1, 0), cA + kstep, voffA); PG8_STAGE(PG8_SB(1, 1), cB + hstep + kstep, voffB);
        PG8_WAIT_V(6); PG8_BAR;
    }
    for (;;) {
        const bool has_next = S.next(ui + 1, nxt);
        const char* nA = has_next ? (const char*)g.A + (size_t)nxt.pm * tstep : cA; const char* nB = has_next ? (const char*)g.Bt + (size_t)nxt.pn * tstep : cB;
        for (int t = 0; t < nt; t += 2) {
            const bool last = (t == nt - 2);
            const char* a1 = cA + (size_t)(t + 1) * kstep;
            const char* a2 = last ? nA : cA + (size_t)(t + 2) * kstep; const char* b2 = last ? nB : cB + (size_t)(t + 2) * kstep;
            const char* a3 = a2 + kstep; const char* b3 = b2 + kstep;
            if (last && has_next) S.a_ready(nxt);
            if constexpr (SP2) {
            PG8_LDB(B0, 0, 0); PG8_LDB(B1, 0, 1); PG8_SCHED; PG8_LDA(At, 0, 0); PG8_STAGE(PG8_SA(1, 1), a1 + hstep, voffA);
            PG8_WAIT_V(8); PG8_WAIT_L(0); PG8_BAR; PG8_MMA(0, 0, At, B0); PG8_MMA(0, 1, At, B1); PG8_BAR; PG8_SCHED;
            PG8_LDA(At, 0, 1); PG8_STAGE(PG8_SB(0, 0), b2, voffB); PG8_STAGE(PG8_SB(0, 1), b2 + hstep, voffB); PG8_STAGE(PG8_SA(0, 0), a2, voffA);
            PG8_WAIT_V(8); PG8_WAIT_L(0); PG8_BAR; PG8_MMA(1, 0, At, B0); PG8_MMA(1, 1, At, B1); PG8_BAR; PG8_SCHED;
            PG8_LDB(B0, 1, 0); PG8_LDB(B1, 1, 1); PG8_SCHED; PG8_LDA(At, 1, 0); PG8_STAGE(PG8_SA(0, 1), a2 + hstep, voffA);
            PG8_WAIT_V(8); PG8_WAIT_L(0); PG8_BAR; PG8_MMA(0, 0, At, B0); PG8_MMA(0, 1, At, B1); PG8_BAR; PG8_SCHED;
            PG8_LDA(At, 1, 1); PG8_STAGE(PG8_SB(1, 0), b3, voffB); PG8_STAGE(PG8_SB(1, 1), b3 + hstep, voffB); PG8_STAGE(PG8_SA(1, 0), a3, voffA);
            PG8_WAIT_V(8); PG8_WAIT_L(0); PG8_BAR; PG8_MMA(1, 0, At, B0); PG8_MMA(1, 1, At, B1); PG8_BAR; PG8_SCHED;
            } else {
            PG8_LDB(B0, 0, 0); PG8_SCHED; PG8_LDA(At, 0, 0); PG8_STAGE(PG8_SA(1, 1), a1 + hstep, voffA);
            PG8_WAIT_L(8); PG8_BAR; PG8_WAIT_L(0); PG8_MMA(0, 0, At, B0); PG8_BAR; PG8_SCHED;
            PG8_LDB(B1, 0, 1); PG8_STAGE(PG8_SB(0, 0), b2, voffB);
            PG8_BAR; PG8_WAIT_L(0); PG8_MMA(0, 1, At, B1); PG8_BAR;
            PG8_LDA(At, 0, 1); PG8_STAGE(PG8_SA(0, 0), a2, voffA);
            PG8_BAR; PG8_WAIT_L(0); PG8_MMA(1, 0, At, B0); PG8_BAR; PG8_SCHED;
            PG8_STAGE(PG8_SB(0, 1), b2 + hstep, voffB);
            PG8_WAIT_V(6); PG8_BAR; PG8_MMA(1, 1, At, B1); PG8_BAR;
            PG8_LDB(B0, 1, 0); PG8_SCHED; PG8_LDA(At, 1, 0); PG8_STAGE(PG8_SA(0, 1), a2 + hstep, voffA);
            PG8_WAIT_L(8); PG8_BAR; PG8_WAIT_L(0); PG8_MMA(0, 0, At, B0); PG8_BAR; PG8_SCHED;
            PG8_LDB(B1, 1, 1); PG8_STAGE(PG8_SB(1, 0), b3, voffB);
            PG8_BAR; PG8_WAIT_L(0); PG8_MMA(0, 1, At, B1); PG8_BAR;
            PG8_LDA(At, 1, 1); PG8_STAGE(PG8_SA(1, 0), a3, voffA);
            PG8_BAR; PG8_WAIT_L(0); PG8_MMA(1, 0, At, B0); PG8_BAR; PG8_SCHED;
            PG8_STAGE(PG8_SB(1, 1), b3 + hstep, voffB);
            PG8_WAIT_V(6); PG8_BAR; PG8_MMA(1, 1, At, B1); PG8_BAR;
            }
        }
        if constexpr (ALIGN_EPI) { if (wr == 0) PG8_BAR; }
        if constexpr (!Epi::AFTER_DRAIN) { E(acc, cur, wr, wc, fr, fq); S.done(cur); }
        if (!has_next) break;
#pragma unroll
        for (int a = 0; a < 2; ++a)
#pragma unroll
            for (int b = 0; b < 2; ++b)
#pragma unroll
                for (int m = 0; m < 4; ++m)
#pragma unroll
                    for (int n = 0; n < 2; ++n) acc[a][b][m][n] = (f32x4){0.f, 0.f, 0.f, 0.f};
        cur = nxt; cA = nA; cB = nB; ++ui;
        if constexpr (ALIGN_EPI) { if (wr == 1) PG8_BAR; }
    }
    PG8_WAIT_V(0);
    if constexpr (!ALIGN_EPI) { if (wr == 0) PG8_BAR; }
    PG8_BAR;
    if constexpr (Epi::AFTER_DRAIN) { E.fused(acc, cur, wr, wc, fr, fq, lds, wid, lane); S.done(cur); }
#undef PG8_SA
#undef PG8_SB
#undef PG8_STAGE
#undef PG8_LDA
#undef PG8_LDB
#undef PG8_MMA
#undef PG8_WAIT_V
#undef PG8_WAIT_L
#undef PG8_BAR
#undef PG8_SCHED
}
}
namespace att {
using pg8::bf16_t; using pg8::bf16x8; using pg8::f32x4; using pg8::u32x4; using pg8::u32x2; using pg8::cvt_pk_bf16; using pg8::QKW; using pg8::VT_PITCH;
typedef float f32x16 __attribute__((ext_vector_type(16)));
#define ALAS __attribute__((address_space(3)))
constexpr int OFF_K0 = 0, OFF_K1 = 8192, OFF_V = 16384, STAGE = 32768, NSTG = 4, OFF_LUT = NSTG * STAGE;
constexpr int LUTW = 448, LUTC = 224;
constexpr int OFF_SUB = OFF_LUT + 12 * LUTW * 4;
constexpr int ATT_LDS = OFF_SUB + 512;
__device__ __forceinline__ int pi32(int r) { return (r & ~12) | ((r & 4) << 1) | ((r & 8) >> 1); }
__device__ __forceinline__ int t5_bucket(int rel) {
    const int n = rel < 0 ? -rel : rel;
    int b = n < 8 ? n : (n < 12 ? 8 : n < 16 ? 9 : n < 23 ? 10 : n < 32 ? 11 : n < 46 ? 12 : n < 64 ? 13 : n < 91 ? 14 : 15);
    return b + (rel > 0 ? 16 : 0);
}

__device__ __forceinline__ void glds16(const void* gsrc, unsigned lds_dst) { unsigned keep;
    asm volatile("s_mov_b32 %0, m0\n\ts_mov_b32 m0, %2\n\ts_nop 0\n\tglobal_load_lds_dwordx4 %1, off\n\ts_mov_b32 m0, %0" : "=&s"(keep) : "v"(gsrc), "s"(lds_dst) : "memory"); }
typedef float f32x2_t __attribute__((ext_vector_type(2))); typedef __bf16 bf16x2_t __attribute__((ext_vector_type(2)));
__device__ __forceinline__ unsigned cvtpk_s(float lo, float hi) { f32x2_t v = {lo, hi}; bf16x2_t b = __builtin_convertvector(v, bf16x2_t); return __builtin_bit_cast(unsigned, b); }
template <int N> __device__ __forceinline__ void wait_bar() { asm volatile("s_waitcnt vmcnt(%0) lgkmcnt(0)\n\ts_barrier" :: "n"(N) : "memory"); }

template <bool WIN>
__device__ __forceinline__ void attn_unit(ALAS unsigned char* lds, const bf16_t* __restrict__ QK, const bf16_t* __restrict__ VT, bf16_t* __restrict__ Y,
                                          const float* __restrict__ rel_bias, const float* __restrict__ sinkp, const float* __restrict__ subln, float lam,
                                          int seq_base, int S, int q0, int hsel) {
    constexpr float LOG2E = 1.4426950408889634f;
    constexpr int NDB = WIN ? 2 : 4;
    const int tid = threadIdx.x, lane = tid & 63, l31 = lane & 31, hi = lane >> 5;
    const int wid = __builtin_amdgcn_readfirstlane(tid >> 6), half = wid >> 2, wq = wid & 3;
    const int qw = q0 + 32 * wq;
    int qcol, kcol0, kcol1, vrow0, bhead;
    if (WIN) { qcol = (2 * hsel + half) * 64; kcol0 = 512 + (hsel >> 1) * 64; kcol1 = kcol0; vrow0 = (hsel >> 1) * 64; bhead = 2 * hsel; }
    else { qcol = 640 + (2 * hsel + half) * 64; kcol0 = 1152 + (2 * hsel) * 64; kcol1 = kcol0 + 64; vrow0 = 128 + hsel * 128; bhead = 8 + hsel; }
    const ALAS float* lut = (const ALAS float*)(lds + OFF_LUT) + (WIN ? (bhead + half) : bhead) * LUTW;

    const int t_lo = WIN ? (q0 >= 128 ? (q0 - 128) / 64 : 0) : 0;
    const int t_hi = WIN ? ((q0 + 256) / 64 < S / 64 ? (q0 + 256) / 64 : S / 64) : S / 64;
    const int NT = t_hi - t_lo;
    const unsigned ldsb = (unsigned)(uintptr_t)lds;
    const int drow = 8 * wid + (lane >> 3), dch = (lane & 7) ^ ((4 * wid + (lane >> 4)) & 7);
    const bf16_t* kg = QK + ((size_t)((seq_base >> 6) + t_lo) * 26 * 64 + drow) * 64 + dch * 8 + kcol0 * 64;
    const bf16_t* vg = VT + ((size_t)((seq_base >> 6) + t_lo) * 640 + vrow0 + drow) * 64 + dch * 8;
    const unsigned dk = ldsb + wid * 1024;
#define AT_DMA(tr) do { const unsigned sb_ = (unsigned)__builtin_amdgcn_readfirstlane(dk + (((tr) & (NSTG - 1)) * STAGE)); const size_t ko_ = (size_t)(tr) * 26 * 4096, vo_ = (size_t)(tr) * 640 * 64; \
        glds16(kg + ko_, sb_ + OFF_K0); if (!WIN) glds16(kg + ko_ + 4096, sb_ + OFF_K1); glds16(vg + vo_, sb_ + OFF_V); if (!WIN) glds16(vg + vo_ + 64 * 64, sb_ + OFF_V + 8192); } while (0)
    constexpr int NPW = WIN ? 2 : 4;
    bf16x8 qfr[4];
    { const int qrow = seq_base + qw + l31; const bf16_t* qp = QK + ((size_t)((qrow >> 6) * 26 + (qcol >> 6)) * 64 + (qrow & 63)) * 64 + hi * 8;
#pragma unroll
      for (int ds = 0; ds < 4; ++ds) qfr[ds] = *(const bf16x8*)(qp + ds * 16); }
#define qf(ds) qfr[ds]
    AT_DMA(0); if (NT > 1) AT_DMA(1); if (NT > 2) AT_DMA(2);
    constexpr float THR = 8.0f;
    float m_ref = WIN ? sinkp[2 * hsel + half] * LOG2E : 0.f;
    float l_run = (WIN && hi == 0) ? 1.f : 0.f;
    float cbase = 0.f;
    f32x16 cvec;
#pragma unroll
    for (int r = 0; r < 16; ++r) cvec[r] = cbase - m_ref;
    f32x16 o[NDB];
#pragma unroll
    for (int db = 0; db < NDB; ++db)
#pragma unroll
        for (int r = 0; r < 16; ++r) o[db][r] = 0.f;
    const int krow = pi32(l31), fK = (krow >> 1) & 7, fV = (l31 >> 1) & 7;
    int kx[4], vx[4];
#pragma unroll
    for (int c = 0; c < 4; ++c) { kx[c] = (WIN ? OFF_K0 : (half ? OFF_K1 : OFF_K0)) + krow * 128 + (((2 * c + hi) ^ fK) << 4); vx[c] = OFF_V + l31 * 128 + (((2 * c + hi) ^ fV) << 4); }
    const int qabs = qw + l31;
    const float cfar_lo = __uint_as_float(__builtin_amdgcn_readfirstlane(__float_as_uint(lut[0]))), cfar_hi = __uint_as_float(__builtin_amdgcn_readfirstlane(__float_as_uint(lut[LUTW - 1])));
    asm volatile("" : "+v"(qfr[0]), "+v"(qfr[1]), "+v"(qfr[2]), "+v"(qfr[3]));
#pragma clang loop unroll(disable)
    for (int tr = 0; tr < NT; ++tr) {
        if (tr + 2 < NT) wait_bar<2 * NPW>(); else if (tr + 1 < NT) wait_bar<NPW>(); else wait_bar<0>();
        if (tr + 3 < NT) AT_DMA(tr + 3);
        const int k0 = (t_lo + tr) * 64;
        const bool skip = WIN && (k0 > qw + 31 + 128 || k0 + 63 < qw - 128);
        if (!skip) {
            const bool near = WIN || ((k0 - (qw + 31)) < 128 && (qw - (k0 + 63)) < 128);
            const float cinit = near ? 0.f : (k0 > qw ? cfar_hi : cfar_lo);
            if (__builtin_expect(cinit != cbase, 0)) { cbase = cinit; asm volatile("" ::: "memory");
#pragma unroll
                for (int r = 0; r < 16; ++r) cvec[r] = cbase - m_ref; }
            f32x16 s0, s1;
            const ALAS unsigned char* sb = lds + (tr & (NSTG - 1)) * STAGE;
            {
                bf16x8 ka[8];
#pragma unroll
                for (int ds = 0; ds < 4; ++ds) { ka[2 * ds] = *(const ALAS bf16x8*)(sb + kx[ds]); ka[2 * ds + 1] = *(const ALAS bf16x8*)(sb + kx[ds] + 4096); }
                __builtin_amdgcn_sched_barrier(0);
                s0 = __builtin_amdgcn_mfma_f32_32x32x16_bf16(ka[0], qf(0), cvec, 0, 0, 0);
                s1 = __builtin_amdgcn_mfma_f32_32x32x16_bf16(ka[1], qf(0), cvec, 0, 0, 0);
#pragma unroll
                for (int ds = 1; ds < 4; ++ds) {
                    s0 = __builtin_amdgcn_mfma_f32_32x32x16_bf16(ka[2 * ds], qf(ds), s0, 0, 0, 0);
                    s1 = __builtin_amdgcn_mfma_f32_32x32x16_bf16(ka[2 * ds + 1], qf(ds), s1, 0, 0, 0);
                }
            }
            bf16x8 va[2 * NDB], vc[2 * NDB];
#pragma unroll
            for (int kk = 0; kk < 2; ++kk)
#pragma unroll
                for (int db = 0; db < NDB; ++db) va[kk * NDB + db] = *(const ALAS bf16x8*)(sb + vx[kk] + db * 4096);
            __builtin_amdgcn_sched_barrier(0);
            if (near) {
                const ALAS float* lb = lut + (k0 + 8 * hi - qabs + LUTC);
#pragma unroll
                for (int r = 0; r < 16; ++r) { s0[r] += lb[16 * (r >> 3) + (r & 7)]; s1[r] += lb[32 + 16 * (r >> 3) + (r & 7)];
                    if ((r & 7) == 7) __builtin_amdgcn_sched_barrier(0); }
            }
#define MX3(a, b, c) __builtin_fmaxf(__builtin_fmaxf((a), (b)), (c))
            float mxa = MX3(s0[0], s0[1], s1[0]), mxb = MX3(s0[2], s0[3], s1[1]);
            mxa = MX3(mxa, s1[2], s1[3]);
#pragma unroll
            for (int r = 4; r < 16; r += 4) { mxa = MX3(mxa, s0[r], s0[r + 1]); mxb = MX3(mxb, s0[r + 2], s0[r + 3]); mxa = MX3(mxa, s1[r], s1[r + 1]); mxb = MX3(mxb, s1[r + 2], s1[r + 3]); }
#undef MX3
            float mx = fmaxf(mxa, mxb);
            if (__any(mx > THR)) {
                mx = fmaxf(mx, __shfl_xor(mx, 32));
                const float dl = fmaxf(mx, 0.f);
                m_ref += dl;
                const float f = __builtin_amdgcn_exp2f(-dl);
                l_run *= f;
#pragma unroll
                for (int db = 0; db < NDB; ++db)
#pragma unroll
                    for (int r = 0; r < 16; ++r) o[db][r] *= f;
#pragma unroll
                for (int r = 0; r < 16; ++r) { s0[r] -= dl; s1[r] -= dl; cvec[r] = cbase - m_ref; }
            }
            float ls0 = 0.f, ls1 = 0.f;
#define AT_EXP(SS, B, PF) do { \
                const float e0 = __builtin_amdgcn_exp2f(SS[B + 0]), e1 = __builtin_amdgcn_exp2f(SS[B + 1]), e2 = __builtin_amdgcn_exp2f(SS[B + 2]), e3 = __builtin_amdgcn_exp2f(SS[B + 3]); \
                const float e4 = __builtin_amdgcn_exp2f(SS[B + 4]), e5 = __builtin_amdgcn_exp2f(SS[B + 5]), e6 = __builtin_amdgcn_exp2f(SS[B + 6]), e7 = __builtin_amdgcn_exp2f(SS[B + 7]); \
                ls0 += e0; ls1 += e4; ls0 += e1; ls1 += e5; ls0 += e2; ls1 += e6; ls0 += e3; ls1 += e7; \
                PF.u.x = cvtpk_s(e0, e1); PF.u.y = cvtpk_s(e2, e3); PF.u.z = cvtpk_s(e4, e5); PF.u.w = cvtpk_s(e6, e7); } while (0)
            union PFU { u32x4 u; bf16x8 b; };
            PFU p0, p1, p2, p3;
            AT_EXP(s0, 0, p0);
#pragma unroll
            for (int kk = 0; kk < 2; ++kk)
#pragma unroll
                for (int db = 0; db < NDB; ++db) vc[kk * NDB + db] = *(const ALAS bf16x8*)(sb + vx[kk + 2] + db * 4096);
            __builtin_amdgcn_sched_barrier(0);
#pragma unroll
            for (int db = 0; db < NDB; ++db) o[db] = __builtin_amdgcn_mfma_f32_32x32x16_bf16(va[db], p0.b, o[db], 0, 0, 0);
            AT_EXP(s0, 8, p1);
            __builtin_amdgcn_sched_barrier(0);
#pragma unroll
            for (int db = 0; db < NDB; ++db) o[db] = __builtin_amdgcn_mfma_f32_32x32x16_bf16(va[NDB + db], p1.b, o[db], 0, 0, 0);
            AT_EXP(s1, 0, p2);
            __builtin_amdgcn_sched_barrier(0);
#pragma unroll
            for (int db = 0; db < NDB; ++db) o[db] = __builtin_amdgcn_mfma_f32_32x32x16_bf16(vc[db], p2.b, o[db], 0, 0, 0);
            AT_EXP(s1, 8, p3);
            __builtin_amdgcn_sched_barrier(0);
#pragma unroll
            for (int db = 0; db < NDB; ++db) o[db] = __builtin_amdgcn_mfma_f32_32x32x16_bf16(vc[NDB + db], p3.b, o[db], 0, 0, 0);
            __builtin_amdgcn_sched_barrier(0);
#undef AT_EXP
            l_run += ls0 + ls1;
        }
    }
    asm volatile("s_waitcnt lgkmcnt(0)\n\ts_barrier" ::: "memory");
#undef qf
#undef AT_DMA
    const float l_tot = l_run + __shfl_xor(l_run, 32);
    const float inv = 1.0f / l_tot;
    const size_t orow = (size_t)(seq_base + qw + l31) * 1024;
    if (WIN) {
        bf16_t* yp = Y + orow + (2 * hsel + half) * 64 + 4 * hi;
#pragma unroll
        for (int db = 0; db < NDB; ++db)
#pragma unroll
            for (int g = 0; g < 4; ++g) {
                u32x2 w; w.x = cvt_pk_bf16(o[db][4 * g] * inv, o[db][4 * g + 1] * inv); w.y = cvt_pk_bf16(o[db][4 * g + 2] * inv, o[db][4 * g + 3] * inv);
                *(u32x2*)(yp + 32 * db + 8 * g) = w;
            }
    } else {
        ALAS f32x4* xch = (ALAS f32x4*)lds + (size_t)wq * 1024 + l31;
        if (half == 1) {
#pragma unroll
            for (int db = 0; db < NDB; ++db)
#pragma unroll
                for (int g = 0; g < 4; ++g) { f32x4 v; v[0] = o[db][4 * g] * inv; v[1] = o[db][4 * g + 1] * inv; v[2] = o[db][4 * g + 2] * inv; v[3] = o[db][4 * g + 3] * inv;
                    xch[(8 * db + 2 * g + hi) * 32] = v; }
        }
        __syncthreads();
        if (half == 0) {
            float ss = 0.f;
#pragma unroll
            for (int db = 0; db < NDB; ++db)
#pragma unroll
                for (int g = 0; g < 4; ++g) { const f32x4 v = xch[(8 * db + 2 * g + hi) * 32];
#pragma unroll
                    for (int i = 0; i < 4; ++i) { const float x = o[db][4 * g + i] * inv - lam * v[i]; o[db][4 * g + i] = x; ss += x * x; } }
            ss += __shfl_xor(ss, 32);
            const float rn = __builtin_amdgcn_rsqf(ss * (1.0f / 128.0f) + 1e-6f) * 0.8f;
            bf16_t* yp = Y + orow + 512 + hsel * 128 + 4 * hi;
#pragma unroll
            for (int db = 0; db < NDB; ++db)
#pragma unroll
                for (int g = 0; g < 4; ++g) { const f32x4 gsc = *(const ALAS f32x4*)(lds + OFF_SUB + (32 * db + 8 * g + 4 * hi) * 4);
                    u32x2 w; w.x = cvt_pk_bf16(o[db][4 * g] * rn * gsc[0], o[db][4 * g + 1] * rn * gsc[1]); w.y = cvt_pk_bf16(o[db][4 * g + 2] * rn * gsc[2], o[db][4 * g + 3] * rn * gsc[3]);
                    *(u32x2*)(yp + 32 * db + 8 * g) = w; }
        }
        __syncthreads();
    }
}

__device__ __forceinline__ void attn_phase(ALAS unsigned char* lds, const bf16_t* QK, const bf16_t* VT, bf16_t* Y, const float* rel_bias, const float* sinkp, const float* subln, const float* blam) {
    float lam;
    { const int lane = threadIdx.x & 63; float a = blam[lane] * blam[64 + lane], b = blam[128 + lane] * blam[192 + lane];
#pragma unroll
      for (int o = 1; o < 64; o <<= 1) { a += __shfl_xor(a, o); b += __shfl_xor(b, o); }
      lam = __expf(a) - __expf(b) + 0.2f; }
    { constexpr float LOG2E = 1.4426950408889634f; ALAS float* lutw = (ALAS float*)(lds + OFF_LUT);
      for (int i = threadIdx.x; i < 12 * LUTW; i += 512) { const int hh = i / LUTW, ri = i - hh * LUTW, rel = ri - LUTC;
        lutw[i] = (hh < 8 && (rel < -128 || rel > 128)) ? -1e30f : rel_bias[t5_bucket(rel) * 12 + hh] * LOG2E; }
      if (threadIdx.x < 128) ((ALAS float*)(lds + OFF_SUB))[threadIdx.x] = subln[threadIdx.x];
      __syncthreads(); }
    const int G = gridDim.x, bx = blockIdx.x;
    if (__builtin_amdgcn_readfirstlane((int)threadIdx.x) >= 256) __builtin_amdgcn_s_setprio(1);
    if (G == 256) {
        const int x = bx & 7, j = bx >> 3;
        for (int r = 0; r < 8; ++r) { const int bh = x + 8 * (r >> 1), qb = j + 32 * (r & 1);
            attn_unit<false>(lds, QK, VT, Y, rel_bias, sinkp, subln, lam, (bh >> 2) * 8192, 8192, qb * 128, bh & 3); }
        for (int r = 0; r < 8; ++r) { const int bh = x + 8 * ((j >> 4) + 2 * r), qb = j & 15;
            attn_unit<false>(lds, QK, VT, Y, rel_bias, sinkp, subln, lam, 65536 + (bh >> 2) * 2048, 2048, qb * 128, bh & 3); }
    } else {
    for (int u = bx; u < 2048; u += G) { const int qb = u & 63, bh = u >> 6; attn_unit<false>(lds, QK, VT, Y, rel_bias, sinkp, subln, lam, (bh >> 2) * 8192, 8192, qb * 128, bh & 3); }
    for (int u = bx; u < 2048; u += G) { const int qb = u & 15, bh = u >> 4; attn_unit<false>(lds, QK, VT, Y, rel_bias, sinkp, subln, lam, 65536 + (bh >> 2) * 2048, 2048, qb * 128, bh & 3); }
    }
    for (int u = bx; u < 4096; u += G) { const int hp = u & 3, qb = u >> 2;
        const int row0 = qb * 128; int seq_base, S;
        if (row0 < 65536) { seq_base = row0 & ~8191; S = 8192; } else { seq_base = row0 & ~2047; S = 2048; }
        attn_unit<true>(lds, QK, VT, Y, rel_bias, sinkp, subln, lam, seq_base, S, row0 - seq_base, hp); }
    __builtin_amdgcn_s_setprio(0);
}
}

namespace cv {
using pg8::bf16_t; using pg8::f32x4; using pg8::u32x4; using pg8::cvt_pk_bf16; using pg8::bf_lo; using pg8::bf_hi; using pg8::fast_sigmoid;
#define CLAS __attribute__((address_space(3)))
constexpr int T = 32, HALO = 15, ROWS = T + 2 * HALO;
constexpr int OFF_U0 = 0, OFF_U1 = 64 * 1024;
constexpr int CONV_LDS = OFF_U1 + T * 512 * 4;
__device__ __forceinline__ void conv_unit(CLAS unsigned char* lds, const bf16_t* __restrict__ PC, bf16_t* __restrict__ YC, const float* __restrict__ w3, const float* __restrict__ w31,
                                          const float* __restrict__ dwb, const float* __restrict__ lng, const float* __restrict__ lnb, int seq_base, int S, int t0) {
    const int tid = threadIdx.x;
    {
        u32x4 w8[8];
#pragma unroll
        for (int it = 0; it < 8; ++it) { const int idx = tid + 512 * it, j = idx >> 6, v = idx & 63, tok = t0 - HALO + j;
            w8[it] = (u32x4){0u, 0u, 0u, 0u};
            if (idx < ROWS * 64 && tok >= 0 && tok < S) w8[it] = *(const u32x4*)(PC + (size_t)(seq_base + tok) * 1536 + 1024 + v * 8); }
#pragma unroll
        for (int it = 0; it < 8; ++it) { const int idx = tid + 512 * it, j = idx >> 6, v = idx & 63;
            if (idx < ROWS * 64) *(CLAS u32x4*)(lds + OFF_U0 + j * 1024 + v * 16) = w8[it]; }
    }
    __syncthreads();
    const int cp = tid & 255, th = tid >> 8;
    {
        const float wa0 = w3[2 * cp], wa1 = w3[512 + 2 * cp], wa2 = w3[1024 + 2 * cp];
        const float wb0 = w3[2 * cp + 1], wb1 = w3[512 + 2 * cp + 1], wb2 = w3[1024 + 2 * cp + 1];
        const int tb = t0 + 16 * th;
        unsigned pw[18], gw[16];
#pragma unroll
        for (int i = 0; i < 18; ++i) { const int tok = tb - 1 + i; pw[i] = 0u; if (tok >= 0 && tok < S) pw[i] = *(const unsigned*)(PC + (size_t)(seq_base + tok) * 1536 + 512 + 2 * cp); }
#pragma unroll
        for (int i = 0; i < 16; ++i) gw[i] = *(const unsigned*)(PC + (size_t)(seq_base + tb + i) * 1536 + 2 * cp);
#pragma unroll
        for (int i = 0; i < 16; ++i) {
            const float ya = bf_lo(gw[i]) * (wa0 * bf_lo(pw[i]) + wa1 * bf_lo(pw[i + 1]) + wa2 * bf_lo(pw[i + 2]));
            const float yb = bf_hi(gw[i]) * (wb0 * bf_hi(pw[i]) + wb1 * bf_hi(pw[i + 1]) + wb2 * bf_hi(pw[i + 2]));
            *(unsigned*)(YC + (size_t)(seq_base + tb + i) * 1024 + 2 * cp) = cvt_pk_bf16(ya, yb);
        }
    }
    {
        float wa[31], wb[31];
#pragma unroll
        for (int j = 0; j < 31; ++j) { wa[j] = w31[j * 512 + 2 * cp]; wb[j] = w31[j * 512 + 2 * cp + 1]; }
        const float ba = dwb[2 * cp], bb = dwb[2 * cp + 1];
        for (int g4 = 0; g4 < 4; ++g4) {
            const int tt = 16 * th + 4 * g4;
            float aa[4], ab[4];
#pragma unroll
            for (int k = 0; k < 4; ++k) { aa[k] = ba; ab[k] = bb; }
            const CLAS unsigned char* up = lds + OFF_U0 + tt * 1024 + cp * 4;
#pragma unroll
            for (int rr = 0; rr < 34; ++rr) {
                const unsigned w = *(const CLAS unsigned*)(up + rr * 1024);
                const float xa = bf_lo(w), xb = bf_hi(w);
#pragma unroll
                for (int k = 0; k < 4; ++k) { const int j = rr - k; if (j >= 0 && j < 31) { aa[k] += wa[j] * xa; ab[k] += wb[j] * xb; } }
            }
#pragma unroll
            for (int k = 0; k < 4; ++k) { typedef float f32x2 __attribute__((ext_vector_type(2))); *(CLAS f32x2*)(lds + OFF_U1 + (tt + k) * 2048 + cp * 8) = (f32x2){aa[k], ab[k]}; }
        }
    }
    __syncthreads();
    {
        const int lane = tid & 63, wid = tid >> 6;
        const f32x4 g0 = *(const f32x4*)(lng + 8 * lane), g1 = *(const f32x4*)(lng + 8 * lane + 4), b0 = *(const f32x4*)(lnb + 8 * lane), b1 = *(const f32x4*)(lnb + 8 * lane + 4);
        for (int k = 0; k < 4; ++k) {
            const int tt = 4 * wid + k;
            const f32x4 x0 = *(const CLAS f32x4*)(lds + OFF_U1 + tt * 2048 + lane * 32), x1 = *(const CLAS f32x4*)(lds + OFF_U1 + tt * 2048 + lane * 32 + 16);
            float s = ((x0[0] + x0[1]) + (x0[2] + x0[3])) + ((x1[0] + x1[1]) + (x1[2] + x1[3]));
#pragma unroll
            for (int o = 1; o < 64; o <<= 1) s += __shfl_xor(s, o);
            const float mean = s * (1.0f / 512.0f);
            const f32x4 d0 = x0 - mean, d1 = x1 - mean;
            float q = ((d0[0] * d0[0] + d0[1] * d0[1]) + (d0[2] * d0[2] + d0[3] * d0[3])) + ((d1[0] * d1[0] + d1[1] * d1[1]) + (d1[2] * d1[2] + d1[3] * d1[3]));
#pragma unroll
            for (int o = 1; o < 64; o <<= 1) q += __shfl_xor(q, o);
            const float rstd = __builtin_amdgcn_rsqf(q * (1.0f / 512.0f) + 1e-6f);
            f32x4 y0 = d0 * rstd * g0 + b0, y1 = d1 * rstd * g1 + b1;
#pragma unroll
            for (int i = 0; i < 4; ++i) { y0[i] = y0[i] * fast_sigmoid(y0[i]); y1[i] = y1[i] * fast_sigmoid(y1[i]); }
            u32x4 w; w.x = cvt_pk_bf16(y0[0], y0[1]); w.y = cvt_pk_bf16(y0[2], y0[3]); w.z = cvt_pk_bf16(y1[0], y1[1]); w.w = cvt_pk_bf16(y1[2], y1[3]);
            *(u32x4*)(YC + (size_t)(seq_base + t0 + tt) * 1024 + 512 + 8 * lane) = w;
        }
    }
    __syncthreads();
}
__device__ __forceinline__ void conv_phase(CLAS unsigned char* lds, const bf16_t* PC, bf16_t* YC, const float* w3, const float* w31, const float* dwb, const float* lng, const float* lnb) {
    for (int u = blockIdx.x; u < 131072 / T; u += gridDim.x) {
        const int row0 = u * T; int seq_base, S;
        if (row0 < 65536) { seq_base = row0 & ~8191; S = 8192; } else { seq_base = row0 & ~2047; S = 2048; }
        conv_unit(lds, PC, YC, w3, w31, dwb, lng, lnb, seq_base, S, row0 - seq_base);
    }
}
}

namespace mk {
using pg8::bf16_t; using pg8::f32x4; using pg8::u32x4; using pg8::u32x2; using pg8::cvt_pk_bf16;
#define MLAS __attribute__((address_space(3)))
constexpr int M = 131072, D = 1024, FF = 2816, NQKV = 2304, NCI = 2560;
constexpr size_t MiB = 1u << 20;
constexpr size_t WS_X = 0;
constexpr size_t WS_BIG = 256 * MiB;
constexpr size_t WS_VT = WS_BIG + (size_t)M * pg8::QKW * 2;
constexpr size_t WS_W = 960 * MiB;
constexpr size_t WS_WQKV = WS_W, WS_WO = WS_WQKV + (size_t)NQKV * D * 2, WS_WGU0 = WS_WO + (size_t)D * D * 2, WS_WGU1 = WS_WGU0 + (size_t)2 * FF * D * 2,
                 WS_WD0 = WS_WGU1 + (size_t)2 * FF * D * 2, WS_WD1 = WS_WD0 + (size_t)D * FF * 2, WS_WCI = WS_WD1 + (size_t)D * FF * 2, WS_WCO = WS_WCI + (size_t)NCI * D * 2;
constexpr size_t WS_SSQ = 1008 * MiB;
constexpr size_t WS_CTL = 1016 * MiB, CTL_BYTES = 16384;
constexpr size_t WS_END = WS_CTL + 65536;
static_assert(WS_VT + (size_t)640 * pg8::VT_PITCH * 2 <= WS_W && WS_BIG + (size_t)M * FF * 2 <= WS_W && WS_WCO + (size_t)D * D * 2 <= WS_SSQ, "ws map");
constexpr int MISC_OFF = 155648, LDS_BYTES = MISC_OFF + 256;
static_assert(att::ATT_LDS <= MISC_OFF && cv::CONV_LDS <= MISC_OFF && pg8::STAGE_BYTES + 16384 <= MISC_OFF, "lds map");

#define XB_TMO      128
#define XB_XCNT(j)  (256  + 64 * (j))
#define XB_XSUB(j)  (1280 + 64 * (j))
#define XB_XGEN(j)  (2304 + 64 * (j))
#define XB_TOP      3328
#define XB_TOPGEN   3392
#define XCD_BAR_WORDS 3456
#define XB_SPIN_CAP (1u << 18)

__device__ __forceinline__ unsigned xb_ld(unsigned* p)              { return __hip_atomic_load(p, __ATOMIC_RELAXED, __HIP_MEMORY_SCOPE_AGENT); }
__device__ __forceinline__ unsigned xb_add(unsigned* p, unsigned v) { return __hip_atomic_fetch_add(p, v, __ATOMIC_RELAXED, __HIP_MEMORY_SCOPE_AGENT); }
__device__ __forceinline__ unsigned xb_xcc_id() { return (unsigned)__builtin_amdgcn_s_getreg((3 << 11) | 20) & 0xFu; }
#define XB_SPIN(cond, bar) do { unsigned _sp = 0; while (cond) { __builtin_amdgcn_s_sleep(1); \
    if ((++_sp & 255u) == 0u) { if (xb_ld(&(bar)[XB_TMO])) break; if (_sp > XB_SPIN_CAP) { atomicAdd(&(bar)[XB_TMO], 1u); break; } } } } while (0)

struct XcdBarrier {
    unsigned* bar; unsigned x;
    volatile MLAS unsigned* st;
};

__device__ __forceinline__ XcdBarrier xcd_barrier_post(unsigned* bar, volatile MLAS unsigned* st) {
    XcdBarrier b; b.bar = bar; b.x = xb_xcc_id(); b.st = st;
    if (threadIdx.x == 0) (void)xb_add(&bar[XB_XCNT(b.x)], 1u);
    return b;
}
__device__ __forceinline__ void xcd_barrier_complete(unsigned* bar, unsigned x, unsigned& nloc, unsigned& nx) {
    const unsigned G = gridDim.x * gridDim.y * gridDim.z;
    unsigned sum, cnt, mine, sp = 0u;
    for (;;) {
        sum = 0u; cnt = 0u; mine = 0u;
#pragma unroll
        for (unsigned j = 0; j < 16; ++j) { const unsigned c = xb_ld(&bar[XB_XCNT(j)]); sum += c; cnt += (c > 0u) ? 1u : 0u; mine = (j == x) ? c : mine; }
        if (sum == G) break;
        __builtin_amdgcn_s_sleep(1);
        if ((++sp & 255u) == 0u) { if (xb_ld(&bar[XB_TMO])) break; if (sp > XB_SPIN_CAP) { atomicAdd(&bar[XB_TMO], 1u); break; } }
    }
    nloc = mine > 0u ? mine : 1u; nx = cnt > 0u ? cnt : 1u;
}

__device__ __forceinline__ void xcd_barrier(const XcdBarrier& b) {
    asm volatile("s_waitcnt vmcnt(0)" ::: "memory");
    __syncthreads();
    if (threadIdx.x == 0) {
        unsigned* bar = b.bar;
        __builtin_amdgcn_s_waitcnt(0);
        unsigned nloc = b.st[0], nx = b.st[1];
        if (nloc == 0u) { xcd_barrier_complete(bar, b.x, nloc, nx); b.st[0] = nloc; b.st[1] = nx; }
        const unsigned old = xb_add(&bar[XB_XSUB(b.x)], 1u);
        const unsigned gen = old / nloc;
        if (old + 1u == (gen + 1u) * nloc) {
            __builtin_amdgcn_fence(__ATOMIC_RELEASE, "agent");
            asm volatile("s_waitcnt vmcnt(0)" ::: "memory");
            const unsigned og = xb_add(&bar[XB_TOP], 1u);
            const unsigned tg = og / nx;
            if (og + 1u == (tg + 1u) * nx) xb_add(&bar[XB_TOPGEN], 1u);
            else XB_SPIN(xb_ld(&bar[XB_TOPGEN]) == tg, bar);
            __builtin_amdgcn_fence(__ATOMIC_ACQUIRE, "agent");
            xb_add(&bar[XB_XGEN(b.x)], 1u);
            asm volatile("s_waitcnt vmcnt(0)" ::: "memory");
        } else {
            XB_SPIN(xb_ld(&bar[XB_XGEN(b.x)]) == gen, bar);
            __builtin_amdgcn_fence(__ATOMIC_ACQUIRE, "agent");
            asm volatile("s_waitcnt vmcnt(0)" ::: "memory");
        }
    }
    __syncthreads();
}

static_assert(XCD_BAR_WORDS * 4 <= CTL_BYTES, "barrier words");
struct Params { const float* in[24]; float* out; unsigned char* ws; int ph_lo, ph_hi; };

__device__ __forceinline__ void tr_item(const float* __restrict__ W, int ldw, int srccol0, const float* __restrict__ gain, bf16_t* __restrict__ WT, int K, int destrow0, int k0, MLAS float* scr, int lane) {
    float wv[32];
#pragma unroll
    for (int i = 0; i < 32; ++i) { const int kk = 2 * i + (lane >> 5); wv[i] = W[(size_t)(k0 + kk) * ldw + srccol0 + (lane & 31)]; }
    const float g0 = gain ? gain[k0 + (lane & 31) * 2] : 1.0f, g1 = gain ? gain[k0 + (lane & 31) * 2 + 1] : 1.0f;
#pragma unroll
    for (int i = 0; i < 32; ++i) { const int kk = 2 * i + (lane >> 5); const float ga = __shfl(g0, i), gb = __shfl(g1, i); scr[kk * 33 + (lane & 31)] = wv[i] * ((lane >> 5) ? gb : ga); }
    asm volatile("s_waitcnt lgkmcnt(0)" ::: "memory");
    const int c = lane & 7;
#pragma unroll
    for (int j = 0; j < 4; ++j) { const int n = (lane >> 3) + 8 * j; const MLAS float* s = scr + (8 * c) * 33 + n;
        u32x4 o; o.x = cvt_pk_bf16(s[0 * 33], s[1 * 33]); o.y = cvt_pk_bf16(s[2 * 33], s[3 * 33]); o.z = cvt_pk_bf16(s[4 * 33], s[5 * 33]); o.w = cvt_pk_bf16(s[6 * 33], s[7 * 33]);
        *(u32x4*)(WT + (size_t)(destrow0 + n) * K + k0 + 8 * c) = o; }
    asm volatile("s_waitcnt lgkmcnt(0)" ::: "memory");
}

__device__ __forceinline__ void prologue(const Params& p, MLAS unsigned char* lds) {
    const int tid = threadIdx.x, lane = tid & 63, wave = tid >> 6;
    MLAS float* scr = (MLAS float*)(lds + wave * 16384);
    const int gw = blockIdx.x * 8 + wave, NGW = gridDim.x * 8;
    unsigned char* ws = p.ws;
    constexpr int I_QKV = (NQKV / 32) * (D / 64), I_O = (D / 32) * (D / 64), I_GU = (2 * FF / 32) * (D / 64), I_D = (D / 32) * (FF / 64), I_CI = (NCI / 32) * (D / 64);
    constexpr int NIT = I_QKV + I_O + 2 * I_GU + 2 * I_D + I_CI + I_O;
    for (int it = gw; it < NIT; it += NGW) {
        int r = it;
        if (r < I_QKV) { const int kb = r / (NQKV / 32), nb = r % (NQKV / 32); const int n0 = nb * 32, pn = n0 >> 8, within = n0 & 255, bj = within >> 7, wc = (within & 127) >> 5;
            tr_item(p.in[8], NQKV, 256 * pn + 64 * wc + 32 * bj, p.in[3], (bf16_t*)(ws + WS_WQKV), D, n0, kb * 64, scr, lane); continue; }
        r -= I_QKV;
        if (r < I_O) { const int kb = r / (D / 32), nb = r % (D / 32); tr_item(p.in[9], D, nb * 32, nullptr, (bf16_t*)(ws + WS_WO), D, nb * 32, kb * 64, scr, lane); continue; }
        r -= I_O;
        if (r < 2 * I_GU) { const int l = r / I_GU; r -= l * I_GU; const int kb = r / (2 * FF / 32), nb = r % (2 * FF / 32); const int n0 = nb * 32, pn = n0 >> 8, within = n0 & 255, bj = within >> 7, j = within & 127;
            const float* src = (bj ? p.in[6] : p.in[5]) + (size_t)l * D * FF;
            tr_item(src, FF, 128 * pn + j, p.in[4] + l * D, (bf16_t*)(ws + (l ? WS_WGU1 : WS_WGU0)), D, n0, kb * 64, scr, lane); continue; }
        r -= 2 * I_GU;
        if (r < 2 * I_D) { const int l = r / I_D; r -= l * I_D; const int kb = r / (D / 32), nb = r % (D / 32);
            tr_item(p.in[7] + (size_t)l * FF * D, D, nb * 32, nullptr, (bf16_t*)(ws + (l ? WS_WD1 : WS_WD0)), FF, nb * 32, kb * 64, scr, lane); continue; }
        r -= 2 * I_D;
        if (r < I_CI) { const int kb = r / (NCI / 32), nb = r % (NCI / 32); const int n0 = nb * 32, pn = n0 >> 8, within = n0 & 255, bj = within >> 7, j = within & 127;
            const int src = pn < 2 ? n0 : (pn < 6 ? (bj ? 1024 : 512) + 128 * (pn - 2) + j : (bj ? 2048 : 1536) + 128 * (pn - 6) + j);
            tr_item(p.in[17], NCI, src, p.in[3] + D, (bf16_t*)(ws + WS_WCI), D, n0, kb * 64, scr, lane); continue; }
        r -= I_CI;
        { const int kb = r / (D / 32), nb = r % (D / 32); tr_item(p.in[18], D, nb * 32, nullptr, (bf16_t*)(ws + WS_WCO), D, nb * 32, kb * 64, scr, lane); }
    }
    bf16_t* X = (bf16_t*)(ws + WS_X); float* ssq = (float*)(ws + WS_SSQ);
    for (int m0 = gw; m0 < M; m0 += 4 * NGW) {
        f32x4 v[4][4];
#pragma unroll
        for (int r = 0; r < 4; ++r) { const int m = m0 + r * NGW; if (m < M) { const float* xrow = (m < 65536) ? p.in[0] + (size_t)m * D : p.in[1] + (size_t)(m - 65536) * D; const f32x4* xr = (const f32x4*)xrow + lane;
#pragma unroll
            for (int j = 0; j < 4; ++j) v[r][j] = xr[64 * j]; } }
#pragma unroll
        for (int r = 0; r < 4; ++r) { const int m = m0 + r * NGW; if (m < M) {
            float s = 0.f;
#pragma unroll
            for (int j = 0; j < 4; ++j) s += (v[r][j][0] * v[r][j][0] + v[r][j][1] * v[r][j][1]) + (v[r][j][2] * v[r][j][2] + v[r][j][3] * v[r][j][3]);
#pragma unroll
            for (int o = 1; o < 64; o <<= 1) s += __shfl_xor(s, o);
            u32x2* o8 = (u32x2*)(X + (size_t)m * D) + lane;
#pragma unroll
            for (int j = 0; j < 4; ++j) { u32x2 w; w.x = cvt_pk_bf16(v[r][j][0], v[r][j][1]); w.y = cvt_pk_bf16(v[r][j][2], v[r][j][3]); o8[64 * j] = w; }
            if (lane < 16) ssq[(size_t)m * 16 + lane] = (lane == 0) ? s : 0.f; } }
    }
}

__global__ void __launch_bounds__(512, 2) fwd_kernel(Params p) {
    extern __shared__ __attribute__((aligned(16))) unsigned char lds_raw[];
    MLAS unsigned char* lds = (MLAS unsigned char*)lds_raw;
    cg::grid_group grid = cg::this_grid();
    unsigned char* ws = p.ws;
    bf16_t* X = (bf16_t*)(ws + WS_X); bf16_t* BIG = (bf16_t*)(ws + WS_BIG); bf16_t* VT = (bf16_t*)(ws + WS_VT); float* ssq = (float*)(ws + WS_SSQ);
    bf16_t* Y = (bf16_t*)p.out;
    const int lo = p.ph_lo, hi = p.ph_hi, G = gridDim.x, bx = blockIdx.x;
    volatile MLAS unsigned* misc = (volatile MLAS unsigned*)(lds + MISC_OFF);
    if (threadIdx.x < 2) misc[threadIdx.x] = 0u;
    __syncthreads();
    const XcdBarrier xbar = xcd_barrier_post((unsigned*)(ws + WS_CTL), misc);
#ifndef PH_MASK
#define PH_MASK 0x7ff
#endif
#define IN(k) (((PH_MASK >> (k)) & 1) && lo <= (k) && (k) < hi)
#define SEAM(k) do { if (IN(k) && IN((k) + 1)) { if ((k) == 0) grid.sync(); else xcd_barrier(xbar); } } while (0)
    if (IN(0)) { prologue(p, lds); __syncthreads(); }
    SEAM(0);
    if (IN(1)) { pg8::Gemm g{X, (const bf16_t*)(ws + WS_WQKV), M, NQKV, D}; pg8::StaticOrder S; S.init(M, NQKV, G, bx);
        pg8::EpiQKV E{BIG, VT, ssq, p.in[10], p.in[11], p.in[13], p.in[14], lds + pg8::STAGE_BYTES};
        pg8::gemm_phase<pg8::EpiQKV, pg8::StaticOrder, true, true>(lds, g, S, E); }
    SEAM(1);
    if (IN(2)) { for (int rep = 0; rep < PROBE_ATT; ++rep) att::attn_phase(lds, BIG, VT, Y, p.in[2], p.in[12], p.in[16], p.in[15]); }
    SEAM(2);
    if (IN(3)) { pg8::Gemm g{Y, (const bf16_t*)(ws + WS_WO), M, D, D}; pg8::StaticOrder S; S.init(M, D, G, bx);
        pg8::EpiRes<false> E{X, nullptr, ssq};
        pg8::gemm_phase<pg8::EpiRes<false>, pg8::StaticOrder, true, true>(lds, g, S, E); }
    SEAM(3);
    if (IN(4)) { pg8::Gemm g{X, (const bf16_t*)(ws + WS_WGU0), M, 2 * FF, D}; pg8::StaticOrder S; S.init(M, 2 * FF, G, bx);
        pg8::EpiGlu E{BIG, ssq};
        pg8::gemm_phase<pg8::EpiGlu, pg8::StaticOrder, true, true>(lds, g, S, E); }
    SEAM(4);
    if (IN(5)) { pg8::Gemm g{BIG, (const bf16_t*)(ws + WS_WD0), M, D, FF}; pg8::StaticOrder S; S.init(M, D, G, bx);
        pg8::EpiRes<false> E{X, nullptr, ssq};
        pg8::gemm_phase<pg8::EpiRes<false>, pg8::StaticOrder, true, true>(lds, g, S, E); }
    SEAM(5);
    if (IN(6)) { pg8::Gemm g{X, (const bf16_t*)(ws + WS_WCI), M, NCI, D}; pg8::StaticOrder S; S.init(M, NCI, G, bx);
        pg8::EpiConvIn E{BIG, ssq};
        pg8::gemm_phase<pg8::EpiConvIn, pg8::StaticOrder, true, true>(lds, g, S, E); }
    SEAM(6);
    if (IN(7)) { cv::conv_phase(lds, BIG, Y, p.in[19], p.in[20], p.in[21], p.in[22], p.in[23]); }
    SEAM(7);
    if (IN(8)) { pg8::Gemm g{Y, (const bf16_t*)(ws + WS_WCO), M, D, D}; pg8::StaticOrder S; S.init(M, D, G, bx);
        pg8::EpiRes<false> E{X, nullptr, ssq};
        pg8::gemm_phase<pg8::EpiRes<false>, pg8::StaticOrder, true, true>(lds, g, S, E); }
    SEAM(8);
    if (IN(9)) { pg8::Gemm g{X, (const bf16_t*)(ws + WS_WGU1), M, 2 * FF, D}; pg8::StaticOrder S; S.init(M, 2 * FF, G, bx);
        pg8::EpiGlu E{BIG, ssq};
        pg8::gemm_phase<pg8::EpiGlu, pg8::StaticOrder, true, true>(lds, g, S, E); }
    SEAM(9);
    if (IN(10)) { pg8::Gemm g{BIG, (const bf16_t*)(ws + WS_WD1), M, D, FF}; pg8::StaticOrder S; S.init(M, D, G, bx);
        pg8::EpiRes<true> E{X, p.out, ssq};
        pg8::gemm_phase<pg8::EpiRes<true>, pg8::StaticOrder, true, true>(lds, g, S, E); }
#undef IN
#undef SEAM
}
}

#ifndef MK_N_LAUNCHES_X
#define MK_N_LAUNCHES 1
#endif
extern "C" void kernel_launch(void* const* d_in, const int* in_sizes, int n_in, void* d_out, int out_size, void* d_ws, size_t ws_size, hipStream_t stream) {
    static int grid = 0;
    if (grid == 0) {
        if (n_in != 24 || out_size != mk::M * mk::D || ws_size < mk::WS_END) { fprintf(stderr, "kernel_launch: unexpected shapes (n_in %d out %d ws %zu)\n", n_in, out_size, ws_size); grid = -1; return; }
        int dev = 0, cus = 0, per_cu = 0;
        (void)hipGetDevice(&dev); (void)hipDeviceGetAttribute(&cus, hipDeviceAttributeMultiprocessorCount, dev);
        (void)hipFuncSetAttribute((const void*)mk::fwd_kernel, hipFuncAttributeMaxDynamicSharedMemorySize, mk::LDS_BYTES);
        (void)hipOccupancyMaxActiveBlocksPerMultiprocessor(&per_cu, (const void*)mk::fwd_kernel, 512, mk::LDS_BYTES);
        if (per_cu < 1) per_cu = 1;
        (void)hipGetLastError();
        grid = cus * per_cu;
    }
    if (grid < 0) return;
    if (hipMemsetAsync((char*)d_ws + mk::WS_CTL, 0, mk::CTL_BYTES, stream) != hipSuccess) { fprintf(stderr, "kernel_launch: memset of the barrier words failed\n"); return; }
    mk::Params p{};
    for (int i = 0; i < 24; ++i) p.in[i] = (const float*)d_in[i];
    p.out = (float*)d_out; p.ws = (unsigned char*)d_ws;
#if MK_N_LAUNCHES == 1
    p.ph_lo = 0; p.ph_hi = 11;
    void* args[] = {&p};
    hipError_t e = hipLaunchCooperativeKernel((const void*)mk::fwd_kernel, dim3(grid), dim3(512), args, mk::LDS_BYTES, stream);
    if (e != hipSuccess) fprintf(stderr, "cooperative launch failed: %s (grid %d)\n", hipGetErrorString(e), grid);
#else
    for (int ph = 0; ph < 11; ++ph) { p.ph_lo = ph; p.ph_hi = ph + 1; hipLaunchKernelGGL(mk::fwd_kernel, dim3(grid), dim3(512), mk::LDS_BYTES, stream, p); }
#endif
}
```

```cpp
#include <hip/hip_runtime.h>
#include <hip/hip_cooperative_groups.h>
#include <cstdio>
#include <cstdint>
namespace cg = cooperative_groups;
#ifndef PROBE_ATT
#define PROBE_ATT 1
#endif
#ifndef MK_N_LAUNCHES
#define MK_N_LAUNCHES 1
#endif
namespace pg8 {
#define PG8_LAS __attribute__((address_space(3)))
typedef unsigned short bf16_t;
typedef short bf16x8 __attribute__((ext_vector_type(8)));
typedef float f32x4 __attribute__((ext_vector_type(4)));
typedef unsigned u32x4 __attribute__((ext_vector_type(4)));
constexpr int BM = 256, BK = 64, HALF = 128, HTB = HALF * BK * 2  , STAGE_BYTES = 8 * HTB, NXCD = 8, WGM = 8;

__host__ __device__ __forceinline__ int lds_byte(int r, int c) { const int st = (r >> 4) * 2 + (c >> 5), rr = r & 15, cc = c & 31, ob = rr * 64 + cc * 2; return st * 1024 + (ob ^ (((ob >> 9) & 1) << 5)); }
__host__ __device__ __forceinline__ void stage_rc(int b, int& R, int& C) { const int st = b / 1024, sb = b % 1024, swz = sb ^ (((sb >> 9) & 1) << 5); R = (st >> 1) * 16 + swz / 64; C = (st & 1) * 32 + (swz % 64) / 2; }
__host__ __device__ __forceinline__ int perm32(int rho) { const int n = rho >> 4, i = rho & 15; return 8 * (i >> 2) + 4 * n + (i & 3); }

struct Unit { int pm, pn; };
struct Gemm { const bf16_t* A; const bf16_t* Bt; int M, N, K; };

struct StaticOrder {
    int nM, nN, nwg, G, c;
    __host__ __device__ void init(int M, int N, int G_, int c_) { nM = M / BM; nN = N / BM; nwg = nM * nN; G = G_; c = c_; }
    __host__ __device__ bool next(int i, Unit& u) const {
        const long L = (long)i * G + c; if (L >= nwg) return false;
        int wgid = (int)L; { const int q = nwg / NXCD, r = nwg % NXCD, xcd = wgid % NXCD, off = wgid / NXCD; wgid = (xcd < r ? xcd * (q + 1) : r * (q + 1) + (xcd - r) * q) + off; }
        const int nig = WGM * nN, gid = wgid / nig, fm = gid * WGM, gsz = (nM - fm) < WGM ? (nM - fm) : WGM;
        u.pm = fm + ((wgid % nig) % gsz); u.pn = (wgid % nig) / gsz; return true;
    }
    __device__ __forceinline__ void a_ready(const Unit&) const {}
    __device__ __forceinline__ void done(const Unit&) const {}
};

__device__ __forceinline__ unsigned cvt_pk_bf16(float lo, float hi) { unsigned r; asm volatile("v_cvt_pk_bf16_f32 %0, %1, %2" : "=v"(r) : "v"(lo), "v"(hi)); return r; }
typedef float f32x2 __attribute__((ext_vector_type(2)));
typedef unsigned u32x2 __attribute__((ext_vector_type(2)));
__device__ __forceinline__ float bf_lo(unsigned w) { return __uint_as_float(w << 16); }
__device__ __forceinline__ float bf_hi(unsigned w) { return __uint_as_float(w & 0xffff0000u); }
__device__ __forceinline__ float row_rstd(const float* ssq, int row) {
    const f32x4* p = (const f32x4*)(ssq + (size_t)row * 16);
    const f32x4 a = p[0], b = p[1], c = p[2], d = p[3];
    const float s = ((a[0] + a[1]) + (a[2] + a[3])) + ((b[0] + b[1]) + (b[2] + b[3])) + ((c[0] + c[1]) + (c[2] + c[3])) + ((d[0] + d[1]) + (d[2] + d[3]));
    return __builtin_amdgcn_rsqf(s * (1.0f / 1024.0f) + 1e-6f);
}
__device__ __forceinline__ void rows_rstd(const float* ssq, int row0, int fq, float (&rs)[2][4]) {
    f32x4 pr[2][4];
#pragma unroll
    for (int ai = 0; ai < 2; ++ai)
#pragma unroll
        for (int m = 0; m < 4; ++m) pr[ai][m] = *(const f32x4*)(ssq + (size_t)(row0 + ai * HALF + m * 16) * 16 + 4 * fq);
#pragma unroll
    for (int ai = 0; ai < 2; ++ai)
#pragma unroll
        for (int m = 0; m < 4; ++m) { float t = (pr[ai][m][0] + pr[ai][m][1]) + (pr[ai][m][2] + pr[ai][m][3]); t += __shfl_xor(t, 16); t += __shfl_xor(t, 32); rs[ai][m] = __builtin_amdgcn_rsqf(t * (1.0f / 1024.0f) + 1e-6f); }
}
__device__ __forceinline__ float fast_sigmoid(float x) { return __builtin_amdgcn_rcpf(1.0f + __expf(-x)); }

constexpr int QKW = 1664;
constexpr int VT_PITCH = 131072 + 128;
constexpr float C2Q = 0.125f * 1.4426950408889634f;

struct EpiQKV {
    static constexpr bool PERM = true, AFTER_DRAIN = false;
    bf16_t* QK; bf16_t* VT; const float* ssq; const float* aq; const float* ak; const float* bq; const float* bk; PG8_LAS unsigned char* xlds;
    __device__ __forceinline__ void operator()(const f32x4 (&acc)[2][2][4][2], const Unit& u, int wr, int wc, int fr, int fq) const {
        const int L = u.pn * 256 + wc * 64;
        int kind; const float* gain = nullptr; float scale = 1.f; int ccol = 0, vrow = 0;
        if (L < 512) { kind = 0; gain = aq; scale = C2Q; ccol = L; }
        else if (L < 640) { kind = 0; gain = ak; ccol = L; }
        else if (L < 768) { kind = 1; vrow = L - 640; }
        else if (L < 1280) { kind = 0; gain = bq; scale = C2Q; ccol = L - 128; }
        else if (L < 1792) { kind = 0; gain = bk; ccol = L - 128; }
        else { kind = 1; vrow = L - 1792 + 128; }
        if (kind == 0) {
            f32x4 gv[2][2];
#pragma unroll
            for (int bj = 0; bj < 2; ++bj)
#pragma unroll
                for (int n = 0; n < 2; ++n) gv[bj][n] = *(const f32x4*)(gain + 32 * bj + 8 * fq + 4 * n);
            float rsv[2][4]; rows_rstd(ssq, u.pm * BM + wr * 64 + fr, fq, rsv);
#pragma unroll
            for (int ai = 0; ai < 2; ++ai)
#pragma unroll
                for (int m = 0; m < 4; ++m) {
                    const int row = u.pm * BM + ai * HALF + wr * 64 + m * 16 + fr;
                    const float rs = rsv[ai][m];
                    float ss = 0.f;
#pragma unroll
                    for (int bj = 0; bj < 2; ++bj)
#pragma unroll
                        for (int n = 0; n < 2; ++n) { const f32x4 v = acc[ai][bj][m][n] * rs; ss += (v[0] * v[0] + v[1] * v[1]) + (v[2] * v[2] + v[3] * v[3]); }
                    ss += __shfl_xor(ss, 16); ss += __shfl_xor(ss, 32);
                    const float f = rs * __builtin_amdgcn_rsqf(ss * (1.0f / 64.0f) + 1e-6f) * scale;
                    bf16_t* rowp = QK + ((size_t)((row >> 6) * 26 + (ccol >> 6)) * 64 + (row & 63)) * 64 + 8 * fq;
#pragma unroll
                    for (int bj = 0; bj < 2; ++bj) {
                        const f32x4 v0 = acc[ai][bj][m][0] * f * gv[bj][0], v1 = acc[ai][bj][m][1] * f * gv[bj][1];
                        u32x4 w; w.x = cvt_pk_bf16(v0[0], v0[1]); w.y = cvt_pk_bf16(v0[2], v0[3]); w.z = cvt_pk_bf16(v1[0], v1[1]); w.w = cvt_pk_bf16(v1[2], v1[3]);
                        *(u32x4*)(rowp + 32 * bj) = w;
                    }
                }
        } else {
            PG8_LAS unsigned char* xl = xlds + (wr * 4 + wc) * 2048;
            const int lane = fq * 16 + fr;
            float rsv[2][4]; rows_rstd(ssq, u.pm * BM + wr * 64 + fr, fq, rsv);
#pragma unroll
            for (int ai = 0; ai < 2; ++ai) {
                float rs[4];
#pragma unroll
                for (int m = 0; m < 4; ++m) rs[m] = rsv[ai][m];
                const size_t tb = (size_t)(u.pm * 4 + ai * 2 + wr) * 640;
#pragma unroll
                for (int bj = 0; bj < 2; ++bj)
#pragma unroll
                    for (int n = 0; n < 2; ++n) {
#pragma unroll
                        for (int m = 0; m < 4; ++m) {
                            const f32x4 v = acc[ai][bj][m][n] * rs[m];
                            const unsigned w0 = cvt_pk_bf16(v[0], v[1]), w1 = cvt_pk_bf16(v[2], v[3]);
                            PG8_LAS bf16_t* q = (PG8_LAS bf16_t*)(xl + (4 * fq) * 128 + (16 * m + fr) * 2);
                            q[0] = (bf16_t)(w0 & 0xffffu); q[64] = (bf16_t)(w0 >> 16); q[128] = (bf16_t)(w1 & 0xffffu); q[192] = (bf16_t)(w1 >> 16);
                        }
                        asm volatile("s_waitcnt lgkmcnt(0)" ::: "memory");
                        const int c16 = lane >> 2, part = lane & 3;
                        const u32x4 a = *(const PG8_LAS u32x4*)(xl + c16 * 128 + part * 32), b = *(const PG8_LAS u32x4*)(xl + c16 * 128 + part * 32 + 16);
                        bf16_t* gp = VT + (tb + vrow + 32 * bj + 8 * (c16 >> 2) + 4 * n + (c16 & 3)) * 64 + part * 16;
                        *(u32x4*)gp = a; *(u32x4*)(gp + 8) = b;
                        asm volatile("s_waitcnt lgkmcnt(0)" ::: "memory");
                    }
            }
        }
    }
};

template <bool FINAL> struct EpiRes {
    static constexpr bool PERM = true, AFTER_DRAIN = false;
    bf16_t* X; float* out; float* ssq;
    __device__ __forceinline__ void operator()(const f32x4 (&acc)[2][2][4][2], const Unit& u, int wr, int wc, int fr, int fq) const {
        const int col0 = u.pn * BM + wc * 32 + 8 * fq;
        u32x4 xin[2][4][2];
#pragma unroll
        for (int ai = 0; ai < 2; ++ai)
#pragma unroll
            for (int m = 0; m < 4; ++m)
#pragma unroll
                for (int bj = 0; bj < 2; ++bj) xin[ai][m][bj] = *(const u32x4*)(X + (size_t)(u.pm * BM + ai * HALF + wr * 64 + m * 16 + fr) * 1024 + col0 + bj * HALF);
#pragma unroll
        for (int ai = 0; ai < 2; ++ai)
#pragma unroll
            for (int m = 0; m < 4; ++m) {
                const int row = u.pm * BM + ai * HALF + wr * 64 + m * 16 + fr;
                float ss = 0.f;
#pragma unroll
                for (int bj = 0; bj < 2; ++bj) {
                    bf16_t* xp = X + (size_t)row * 1024 + col0 + bj * HALF;
                    const u32x4 xv = xin[ai][m][bj];
                    f32x4 y0 = acc[ai][bj][m][0], y1 = acc[ai][bj][m][1];
                    y0[0] += bf_lo(xv.x); y0[1] += bf_hi(xv.x); y0[2] += bf_lo(xv.y); y0[3] += bf_hi(xv.y);
                    y1[0] += bf_lo(xv.z); y1[1] += bf_hi(xv.z); y1[2] += bf_lo(xv.w); y1[3] += bf_hi(xv.w);
                    if (FINAL) {
                        float* op = out + (size_t)row * 1024 + col0 + bj * HALF;
                        *(f32x4*)op = y0; *(f32x4*)(op + 4) = y1;
                    } else {
                        u32x4 w; w.x = cvt_pk_bf16(y0[0], y0[1]); w.y = cvt_pk_bf16(y0[2], y0[3]); w.z = cvt_pk_bf16(y1[0], y1[1]); w.w = cvt_pk_bf16(y1[2], y1[3]);
                        *(u32x4*)xp = w;
                        ss += (y0[0] * y0[0] + y0[1] * y0[1]) + (y0[2] * y0[2] + y0[3] * y0[3]) + (y1[0] * y1[0] + y1[1] * y1[1]) + (y1[2] * y1[2] + y1[3] * y1[3]);
                    }
                }
                if (!FINAL) {
                    ss += __shfl_xor(ss, 16); ss += __shfl_xor(ss, 32);
                    if (fq == 0) ssq[(size_t)row * 16 + u.pn * 4 + wc] = ss;
                }
            }
    }
};

struct EpiGlu {
    static constexpr bool PERM = true, AFTER_DRAIN = false;
    bf16_t* H; const float* ssq;
    __device__ __forceinline__ void operator()(const f32x4 (&acc)[2][2][4][2], const Unit& u, int wr, int wc, int fr, int fq) const {
        const int col0 = u.pn * HALF + wc * 32 + 8 * fq;
        float rsv[2][4]; rows_rstd(ssq, u.pm * BM + wr * 64 + fr, fq, rsv);
#pragma unroll
        for (int ai = 0; ai < 2; ++ai)
#pragma unroll
            for (int m = 0; m < 4; ++m) {
                const int row = u.pm * BM + ai * HALF + wr * 64 + m * 16 + fr;
                const float rs = rsv[ai][m];
                float h[8];
#pragma unroll
                for (int n = 0; n < 2; ++n)
#pragma unroll
                    for (int i = 0; i < 4; ++i) { const float g = acc[ai][0][m][n][i] * rs, up = acc[ai][1][m][n][i] * rs; h[4 * n + i] = g * up * fast_sigmoid(g); }
                u32x4 w; w.x = cvt_pk_bf16(h[0], h[1]); w.y = cvt_pk_bf16(h[2], h[3]); w.z = cvt_pk_bf16(h[4], h[5]); w.w = cvt_pk_bf16(h[6], h[7]);
                *(u32x4*)(H + (size_t)row * 2816 + col0) = w;
            }
    }
};

struct EpiConvIn {
    static constexpr bool PERM = true, AFTER_DRAIN = false;
    bf16_t* O; const float* ssq;
    __device__ __forceinline__ void operator()(const f32x4 (&acc)[2][2][4][2], const Unit& u, int wr, int wc, int fr, int fq) const {
        float rsv[2][4]; rows_rstd(ssq, u.pm * BM + wr * 64 + fr, fq, rsv);
#pragma unroll
        for (int ai = 0; ai < 2; ++ai)
#pragma unroll
            for (int m = 0; m < 4; ++m) {
                const int row = u.pm * BM + ai * HALF + wr * 64 + m * 16 + fr;
                const float rs = rsv[ai][m];
                bf16_t* rp = O + (size_t)row * 1536 + wc * 32 + 8 * fq;
                if (u.pn < 2) {
#pragma unroll
                    for (int bj = 0; bj < 2; ++bj) {
                        const f32x4 v0 = acc[ai][bj][m][0] * rs, v1 = acc[ai][bj][m][1] * rs;
                        u32x4 w; w.x = cvt_pk_bf16(v0[0], v0[1]); w.y = cvt_pk_bf16(v0[2], v0[3]); w.z = cvt_pk_bf16(v1[0], v1[1]); w.w = cvt_pk_bf16(v1[2], v1[3]);
                        *(u32x4*)(rp + u.pn * BM + bj * HALF) = w;
                    }
                } else {
                    float h[8];
                    const bool glu = u.pn >= 6;
#pragma unroll
                    for (int n = 0; n < 2; ++n)
#pragma unroll
                        for (int i = 0; i < 4; ++i) { const float a = acc[ai][0][m][n][i] * rs, b = acc[ai][1][m][n][i] * rs; h[4 * n + i] = glu ? a * fast_sigmoid(b) : a * b; }
                    u32x4 w; w.x = cvt_pk_bf16(h[0], h[1]); w.y = cvt_pk_bf16(h[2], h[3]); w.z = cvt_pk_bf16(h[4], h[5]); w.w = cvt_pk_bf16(h[6], h[7]);
                    *(u32x4*)(rp + 512 + (u.pn - 2) * HALF) = w;
                }
            }
    }
};

struct EpiPlain {
    static constexpr bool PERM = true, AFTER_DRAIN = false;
    bf16_t* O; int ldc; const float* ssq;
    __device__ __forceinline__ void operator()(const f32x4 (&acc)[2][2][4][2], const Unit& u, int wr, int wc, int fr, int fq) const {
        const int col0 = u.pn * BM + wc * 32 + 8 * fq;
#pragma unroll
        for (int ai = 0; ai < 2; ++ai)
#pragma unroll
            for (int m = 0; m < 4; ++m) {
                const int row = u.pm * BM + ai * HALF + wr * 64 + m * 16 + fr;
                const float rs = row_rstd(ssq, row);
#pragma unroll
                for (int bj = 0; bj < 2; ++bj) {
                    const f32x4 v0 = acc[ai][bj][m][0] * rs, v1 = acc[ai][bj][m][1] * rs;
                    u32x4 w; w.x = cvt_pk_bf16(v0[0], v0[1]); w.y = cvt_pk_bf16(v0[2], v0[3]); w.z = cvt_pk_bf16(v1[0], v1[1]); w.w = cvt_pk_bf16(v1[2], v1[3]);
                    *(u32x4*)(O + (size_t)row * ldc + col0 + bj * HALF) = w;
                }
            }
    }
};

template <class Epi, class Sched, bool ALIGN_EPI = false, bool SP2 = false>
__device__ __forceinline__ void gemm_phase(PG8_LAS unsigned char* lds, const Gemm g, const Sched& S, const Epi& E) {
    const int tid = threadIdx.x, wid = __builtin_amdgcn_readfirstlane(tid >> 6), lane = tid & 63, wr = wid >> 2, wc = wid & 3, fr = lane & 15, fq = lane >> 4;
    const int K = g.K, nt = K / BK;
    unsigned voffA[2], voffB[2];
#pragma unroll
    for (int i = 0; i < 2; ++i) { int R, C; stage_rc(tid * 16 + i * 8192, R, C); const int Rb = Epi::PERM ? ((R & ~31) + perm32(R & 31)) : R;
        voffA[i] = (unsigned)(R * K + C) * 2u; voffB[i] = (unsigned)(Rb * K + C) * 2u; }
    const size_t kstep = (size_t)(BK * 2);
    const size_t hstep = (size_t)HALF * K * 2;
    const size_t tstep = 2 * hstep;
    const unsigned ldsw = (unsigned)wid * 1024u;
    const int aoff = lds_byte(wr * 64 + fr, fq * 8), boff = lds_byte(wc * 32 + fr, fq * 8);
#define PG8_SA(b, h) (((b) * 2 + (h)) * HTB)
#define PG8_SB(b, h) ((4 + (b) * 2 + (h)) * HTB)
#define PG8_STAGE(bufoff, gbase, voff) do { _Pragma("unroll") for (int _i = 0; _i < 2; ++_i) \
        __builtin_amdgcn_global_load_lds((const unsigned*)((const char*)(gbase) + (voff)[_i]), (PG8_LAS unsigned*)(lds + (bufoff) + ldsw + _i * 8192), 16, 0, 0); } while (0)
#define PG8_LDA(dst, b, h) do { _Pragma("unroll") for (int m = 0; m < 4; ++m) _Pragma("unroll") for (int k = 0; k < 2; ++k) dst[m][k] = *(const PG8_LAS bf16x8*)(lds + PG8_SA(b, h) + aoff + m * 2048 + k * 1024); } while (0)
#define PG8_LDB(dst, b, h) do { _Pragma("unroll") for (int n = 0; n < 2; ++n) _Pragma("unroll") for (int k = 0; k < 2; ++k) dst[n][k] = *(const PG8_LAS bf16x8*)(lds + PG8_SB(b, h) + boff + n * 2048 + k * 1024); } while (0)
#define PG8_MMA(ai, bj, At, Bt) do { __builtin_amdgcn_s_setprio(1); _Pragma("unroll") for (int m = 0; m < 4; ++m) _Pragma("unroll") for (int n = 0; n < 2; ++n) _Pragma("unroll") for (int k = 0; k < 2; ++k) \
        acc[ai][bj][m][n] = __builtin_amdgcn_mfma_f32_16x16x32_bf16(Bt[n][k], At[m][k], acc[ai][bj][m][n], 0, 0, 0); __builtin_amdgcn_s_setprio(0); } while (0)
#define PG8_WAIT_V(n) asm volatile("s_waitcnt vmcnt(" #n ")" ::: "memory")
#define PG8_WAIT_L(n) asm volatile("s_waitcnt lgkmcnt(" #n ")" ::: "memory")
#define PG8_BAR __builtin_amdgcn_s_barrier()
#define PG8_SCHED __builtin_amdgcn_sched_barrier(0)
    Unit cur, nxt; int ui = 0;
    if (!S.next(0, cur)) return;
    f32x4 acc[2][2][4][2];
#pragma unroll
    for (int a = 0; a < 2; ++a)
#pragma unroll
        for (int b = 0; b < 2; ++b)
#pragma unroll
            for (int m = 0; m < 4; ++m)
#pragma unroll
                for (int n = 0; n < 2; ++n) acc[a][b][m][n] = (f32x4){0.f, 0.f, 0.f, 0.f};
    bf16x8 At[4][2], B0[2][2], B1[2][2];
    const char* cA = (const char*)g.A + (size_t)cur.pm * tstep; const char* cB = (const char*)g.Bt + (size_t)cur.pn * tstep;
    S.a_ready(cur);
    if constexpr (SP2) {
        PG8_STAGE(PG8_SB(0, 0), cB, voffB); PG8_STAGE(PG8_SB(0, 1), cB + hstep, voffB); PG8_STAGE(PG8_SA(0, 0), cA, voffA); PG8_STAGE(PG8_SA(0, 1), cA + hstep, voffA);
        if (wr == 1) PG8_BAR;
        PG8_WAIT_V(2); PG8_BAR;
        PG8_STAGE(PG8_SB(1, 0), cB + kstep, voffB); PG8_STAGE(PG8_SA(1, 0), cA + kstep, voffA); PG8_STAGE(PG8_SB(1, 1), cB + hstep + kstep, voffB);
        PG8_WAIT_V(6); PG8_BAR;
    } else {
        PG8_STAGE(PG8_SB(0, 0), cB, voffB); PG8_STAGE(PG8_SA(0, 0), cA, voffA); PG8_STAGE(PG8_SB(0, 1), cB + hstep, voffB); PG8_STAGE(PG8_SA(0, 1), cA + hstep, voffA);
        if (wr == 1) PG8_BAR;
        PG8_WAIT_V(4); PG8_BAR;
        PG8_STAGE(PG8_SB(1, 0), cB + kstep, voffB); PG8_STAGE(PG8_SA(1, 0), cA + kstep, voffA); PG8_STAGE(PG8_SB(1, 1), cB + hstep + kstep, voffB);
        PG8_WAIT_V(6); PG8_BAR;
    }
    for (;;) {
        const bool has_next = S.next(ui + 1, nxt);
        const char* nA = has_next ? (const char*)g.A + (size_t)nxt.pm * tstep : cA; const char* nB = has_next ? (const char*)g.Bt + (size_t)nxt.pn * tstep : cB;
        for (int t = 0; t < nt; t += 2) {
            const bool last = (t == nt - 2);
            const char* a1 = cA + (size_t)(t + 1) * kstep;
            const char* a2 = last ? nA : cA + (size_t)(t + 2) * kstep; const char* b2 = last ? nB : cB + (size_t)(t + 2) * kstep;
            const char* a3 = a2 + kstep; const char* b3 = b2 + kstep;
            if (last && has_next) S.a_ready(nxt);
            if constexpr (SP2) {
            PG8_LDB(B0, 0, 0); PG8_LDB(B1, 0, 1); PG8_SCHED; PG8_LDA(At, 0, 0); PG8_STAGE(PG8_SA(1, 1), a1 + hstep, voffA);
            PG8_WAIT_V(8); PG8_WAIT_L(0); PG8_BAR; PG8_MMA(0, 0, At, B0); PG8_MMA(0, 1, At, B1); PG8_BAR; PG8_SCHED;
            PG8_LDA(At, 0, 1); PG8_STAGE(PG8_SB(0, 0), b2, voffB); PG8_STAGE(PG8_SB(0, 1), b2 + hstep, voffB); PG8_STAGE(PG8_SA(0, 0), a2, voffA);
            PG8_WAIT_V(8); PG8_WAIT_L(0); PG8_BAR; PG8_MMA(1, 0, At, B0); PG8_MMA(1, 1, At, B1); PG8_BAR; PG8_SCHED;
            PG8_LDB(B0, 1, 0); PG8_LDB(B1, 1, 1); PG8_SCHED; PG8_LDA(At, 1, 0); PG8_STAGE(PG8_SA(0, 1), a2 + hstep, voffA);
            PG8_WAIT_V(8); PG8_WAIT_L(0); PG8_BAR; PG8_MMA(0, 0, At, B0); PG8_MMA(0, 1, At, B1); PG8_BAR; PG8_SCHED;
            PG8_LDA(At, 1, 1); PG8_STAGE(PG8_SB(1, 0), b3, voffB); PG8_STAGE(PG8_SB(1, 1), b3 + hstep, voffB); PG8_STAGE(PG8_SA(1, 0), a3, voffA);
            PG8_WAIT_V(8); PG8_WAIT_L(0); PG8_BAR; PG8_MMA(1, 0, At, B0); PG8_MMA(1, 1, At, B1); PG8_BAR; PG8_SCHED;
            } else {
            PG8_LDB(B0, 0, 0); PG8_SCHED; PG8_LDA(At, 0, 0); PG8_STAGE(PG8_SA(1, 1), a1 + hstep, voffA);
            PG8_WAIT_L(8); PG8_BAR; PG8_WAIT_L(0); PG8_MMA(0, 0, At, B0); PG8_BAR; PG8_SCHED;
            PG8_LDB(B1, 0, 1); PG8_STAGE(PG8_SB(0, 0), b2, voffB);
            PG8_BAR; PG8_WAIT_L(0); PG8_MMA(0, 1, At, B1); PG8_BAR;
            PG8_LDA(At, 0, 1); PG8_STAGE(PG8_SA(0, 0), a2, voffA);
            PG8_BAR; PG8_WAIT_L(0); PG8_MMA(1, 0, At, B0); PG8_BAR; PG8_SCHED;
            PG8_STAGE(PG8_SB(0, 1), b2 + hstep, voffB);
            PG8_WAIT_V(6); PG8_BAR; PG8_MMA(1, 1, At, B1); PG8_BAR;
            PG8_LDB(B0, 1, 0); PG8_SCHED; PG8_LDA(At, 1, 0); PG8_STAGE(PG8_SA(0, 1), a2 + hstep, voffA);
            PG8_WAIT_L(8); PG8_BAR; PG8_WAIT_L(0); PG8_MMA(0, 0, At, B0); PG8_BAR; PG8_SCHED;
            PG8_LDB(B1, 1, 1); PG8_STAGE(PG8_SB(1, 0), b3, voffB);
            PG8_BAR; PG8_WAIT_L(0); PG8_MMA(0, 1, At, B1); PG8_BAR;
            PG8_LDA(At, 1, 1); PG8_STAGE(PG8_SA(1, 0), a3, voffA);
            PG8_BAR; PG8_WAIT_L(0); PG8_MMA(1, 0, At, B0); PG8_BAR; PG8_SCHED;
            PG8_STAGE(PG8_SB(1, 1), b3 + hstep, voffB);
            PG8_WAIT_V(6); PG8_BAR; PG8_MMA(1, 1, At, B1); PG8_BAR;
            }
        }
        if constexpr (ALIGN_EPI) { if (wr == 0) PG8_BAR; }
        if constexpr (!Epi::AFTER_DRAIN) { E(acc, cur, wr, wc, fr, fq); S.done(cur); }
        if (!has_next) break;
#pragma unroll
        for (int a = 0; a < 2; ++a)
#pragma unroll
            for (int b = 0; b < 2; ++b)
#pragma unroll
                for (int m = 0; m < 4; ++m)
#pragma unroll
                    for (int n = 0; n < 2; ++n) acc[a][b][m][n] = (f32x4){0.f, 0.f, 0.f, 0.f};
        cur = nxt; cA = nA; cB = nB; ++ui;
        if constexpr (ALIGN_EPI) { if (wr == 1) PG8_BAR; }
    }
    PG8_WAIT_V(0);
    if constexpr (!ALIGN_EPI) { if (wr == 0) PG8_BAR; }
    PG8_BAR;
    if constexpr (Epi::AFTER_DRAIN) { E.fused(acc, cur, wr, wc, fr, fq, lds, wid, lane); S.done(cur); }
#undef PG8_SA
#undef PG8_SB
#undef PG8_STAGE
#undef PG8_LDA
#undef PG8_LDB
#undef PG8_MMA
#undef PG8_WAIT_V
#undef PG8_WAIT_L
#undef PG8_BAR
#undef PG8_SCHED
}
}
namespace att {
using pg8::bf16_t; using pg8::bf16x8; using pg8::f32x4; using pg8::u32x4; using pg8::u32x2; using pg8::cvt_pk_bf16; using pg8::QKW; using pg8::VT_PITCH;
typedef float f32x16 __attribute__((ext_vector_type(16)));
#define ALAS __attribute__((address_space(3)))
constexpr int OFF_K0 = 0, OFF_K1 = 8192, OFF_V = 16384, STAGE = 32768, NSTG = 4, OFF_LUT = NSTG * STAGE;
constexpr int LUTW = 448, LUTC = 224;
constexpr int OFF_SUB = OFF_LUT + 12 * LUTW * 4;
constexpr int ATT_LDS = OFF_SUB + 512;
__device__ __forceinline__ int pi32(int r) { return (r & ~12) | ((r & 4) << 1) | ((r & 8) >> 1); }
__device__ __forceinline__ int t5_bucket(int rel) {
    const int n = rel < 0 ? -rel : rel;
    int b = n < 8 ? n : (n < 12 ? 8 : n < 16 ? 9 : n < 23 ? 10 : n < 32 ? 11 : n < 46 ? 12 : n < 64 ? 13 : n < 91 ? 14 : 15);
    return b + (rel > 0 ? 16 : 0);
}

__device__ __forceinline__ void glds16(const void* gsrc, unsigned lds_dst) { unsigned keep;
    asm volatile("s_mov_b32 %0, m0\n\ts_mov_b32 m0, %2\n\ts_nop 0\n\tglobal_load_lds_dwordx4 %1, off\n\ts_mov_b32 m0, %0" : "=&s"(keep) : "v"(gsrc), "s"(lds_dst) : "memory"); }
typedef float f32x2_t __attribute__((ext_vector_type(2))); typedef __bf16 bf16x2_t __attribute__((ext_vector_type(2)));
__device__ __forceinline__ unsigned cvtpk_s(float lo, float hi) { f32x2_t v = {lo, hi}; bf16x2_t b = __builtin_convertvector(v, bf16x2_t); return __builtin_bit_cast(unsigned, b); }
template <int N> __device__ __forceinline__ void wait_bar() { asm volatile("s_waitcnt vmcnt(%0) lgkmcnt(0)\n\ts_barrier" :: "n"(N) : "memory"); }

template <bool WIN>
__device__ __forceinline__ void attn_unit(ALAS unsigned char* lds, const bf16_t* __restrict__ QK, const bf16_t* __restrict__ VT, bf16_t* __restrict__ Y,
                                          const float* __restrict__ rel_bias, const float* __restrict__ sinkp, const float* __restrict__ subln, float lam,
                                          int seq_base, int S, int q0, int hsel) {
    constexpr float LOG2E = 1.4426950408889634f;
    constexpr int NDB = WIN ? 2 : 4;
    const int tid = threadIdx.x, lane = tid & 63, l31 = lane & 31, hi = lane >> 5;
    const int wid = __builtin_amdgcn_readfirstlane(tid >> 6), half = wid >> 2, wq = wid & 3;
    const int qw = q0 + 32 * wq;
    int qcol, kcol0, kcol1, vrow0, bhead;
    if (WIN) { qcol = (2 * hsel + half) * 64; kcol0 = 512 + (hsel >> 1) * 64; kcol1 = kcol0; vrow0 = (hsel >> 1) * 64; bhead = 2 * hsel; }
    else { qcol = 640 + (2 * hsel + half) * 64; kcol0 = 1152 + (2 * hsel) * 64; kcol1 = kcol0 + 64; vrow0 = 128 + hsel * 128; bhead = 8 + hsel; }
    const ALAS float* lut = (const ALAS float*)(lds + OFF_LUT) + (WIN ? (bhead + half) : bhead) * LUTW;

    const int t_lo = WIN ? (q0 >= 128 ? (q0 - 128) / 64 : 0) : 0;
    const int t_hi = WIN ? ((q0 + 256) / 64 < S / 64 ? (q0 + 256) / 64 : S / 64) : S / 64;
    const int NT = t_hi - t_lo;
    const unsigned ldsb = (unsigned)(uintptr_t)lds;
    const int drow = 8 * wid + (lane >> 3), dch = (lane & 7) ^ ((4 * wid + (lane >> 4)) & 7);
    const bf16_t* kg = QK + ((size_t)((seq_base >> 6) + t_lo) * 26 * 64 + drow) * 64 + dch * 8 + kcol0 * 64;
    const bf16_t* vg = VT + ((size_t)((seq_base >> 6) + t_lo) * 640 + vrow0 + drow) * 64 + dch * 8;
    const unsigned dk = ldsb + wid * 1024;
#define AT_DMA(tr) do { const unsigned sb_ = (unsigned)__builtin_amdgcn_readfirstlane(dk + (((tr) & (NSTG - 1)) * STAGE)); const size_t ko_ = (size_t)(tr) * 26 * 4096, vo_ = (size_t)(tr) * 640 * 64; \
        glds16(kg + ko_, sb_ + OFF_K0); if (!WIN) glds16(kg + ko_ + 4096, sb_ + OFF_K1); glds16(vg + vo_, sb_ + OFF_V); if (!WIN) glds16(vg + vo_ + 64 * 64, sb_ + OFF_V + 8192); } while (0)
    constexpr int NPW = WIN ? 2 : 4;
    bf16x8 qfr[4];
    { const int qrow = seq_base + qw + l31; const bf16_t* qp = QK + ((size_t)((qrow >> 6) * 26 + (qcol >> 6)) * 64 + (qrow & 63)) * 64 + hi * 8;
#pragma unroll
      for (int ds = 0; ds < 4; ++ds) qfr[ds] = *(const bf16x8*)(qp + ds * 16); }
#define qf(ds) qfr[ds]
    AT_DMA(0); if (NT > 1) AT_DMA(1); if (NT > 2) AT_DMA(2);
    constexpr float THR = 8.0f;
    float m_ref = WIN ? sinkp[2 * hsel + half] * LOG2E : 0.f;
    float l_run = (WIN && hi == 0) ? 1.f : 0.f;
    float cbase = 0.f;
    f32x16 cvec;
#pragma unroll
    for (int r = 0; r < 16; ++r) cvec[r] = cbase - m_ref;
    f32x16 o[NDB];
#pragma unroll
    for (int db = 0; db < NDB; ++db)
#pragma unroll
        for (int r = 0; r < 16; ++r) o[db][r] = 0.f;
    const int krow = pi32(l31), fK = (krow >> 1) & 7, fV = (l31 >> 1) & 7;
    int kx[4], vx[4];
#pragma unroll
    for (int c = 0; c < 4; ++c) { kx[c] = (WIN ? OFF_K0 : (half ? OFF_K1 : OFF_K0)) + krow * 128 + (((2 * c + hi) ^ fK) << 4); vx[c] = OFF_V + l31 * 128 + (((2 * c + hi) ^ fV) << 4); }
    const int qabs = qw + l31;
    const float cfar_lo = __uint_as_float(__builtin_amdgcn_readfirstlane(__float_as_uint(lut[0]))), cfar_hi = __uint_as_float(__builtin_amdgcn_readfirstlane(__float_as_uint(lut[LUTW - 1])));
    asm volatile("" : "+v"(qfr[0]), "+v"(qfr[1]), "+v"(qfr[2]), "+v"(qfr[3]));
#pragma clang loop unroll(disable)
    for (int tr = 0; tr < NT; ++tr) {
        if (tr + 2 < NT) wait_bar<2 * NPW>(); else if (tr + 1 < NT) wait_bar<NPW>(); else wait_bar<0>();
        if (tr + 3 < NT) AT_DMA(tr + 3);
        const int k0 = (t_lo + tr) * 64;
        const bool skip = WIN && (k0 > qw + 31 + 128 || k0 + 63 < qw - 128);
        if (!skip) {
            const bool near = WIN || ((k0 - (qw + 31)) < 128 && (qw - (k0 + 63)) < 128);
            const float cinit = near ? 0.f : (k0 > qw ? cfar_hi : cfar_lo);
            if (__builtin_expect(cinit != cbase, 0)) { cbase = cinit; asm volatile("" ::: "memory");
#pragma unroll
                for (int r = 0; r < 16; ++r) cvec[r] = cbase - m_ref; }
            f32x16 s0, s1;
            const ALAS unsigned char* sb = lds + (tr & (NSTG - 1)) * STAGE;
            {
                bf16x8 ka[8];
#pragma unroll
                for (int ds = 0; ds < 4; ++ds) { ka[2 * ds] = *(const ALAS bf16x8*)(sb + kx[ds]); ka[2 * ds + 1] = *(const ALAS bf16x8*)(sb + kx[ds] + 4096); }
                __builtin_amdgcn_sched_barrier(0);
                s0 = __builtin_amdgcn_mfma_f32_32x32x16_bf16(ka[0], qf(0), cvec, 0, 0, 0);
                s1 = __builtin_amdgcn_mfma_f32_32x32x16_bf16(ka[1], qf(0), cvec, 0, 0, 0);
#pragma unroll
                for (int ds = 1; ds < 4; ++ds) {
                    s0 = __builtin_amdgcn_mfma_f32_32x32x16_bf16(ka[2 * ds], qf(ds), s0, 0, 0, 0);
                    s1 = __builtin_amdgcn_mfma_f32_32x32x16_bf16(ka[2 * ds + 1], qf(ds), s1, 0, 0, 0);
                }
            }
            bf16x8 va[2 * NDB], vc[2 * NDB];
#pragma unroll
            for (int kk = 0; kk < 2; ++kk)
#pragma unroll
                for (int db = 0; db < NDB; ++db) va[kk * NDB + db] = *(const ALAS bf16x8*)(sb + vx[kk] + db * 4096);
            __builtin_amdgcn_sched_barrier(0);
            if (near) {
                const ALAS float* lb = lut + (k0 + 8 * hi - qabs + LUTC);
#pragma unroll
                for (int r = 0; r < 16; ++r) { s0[r] += lb[16 * (r >> 3) + (r & 7)]; s1[r] += lb[32 + 16 * (r >> 3) + (r & 7)];
                    if ((r & 7) == 7) __builtin_amdgcn_sched_barrier(0); }
            }
#define MX3(a, b, c) __builtin_fmaxf(__builtin_fmaxf((a), (b)), (c))
            float mxa = MX3(s0[0], s0[1], s1[0]), mxb = MX3(s0[2], s0[3], s1[1]);
            mxa = MX3(mxa, s1[2], s1[3]);
#pragma unroll
            for (int r = 4; r < 16; r += 4) { mxa = MX3(mxa, s0[r], s0[r + 1]); mxb = MX3(mxb, s0[r + 2], s0[r + 3]); mxa = MX3(mxa, s1[r], s1[r + 1]); mxb = MX3(mxb, s1[r + 2], s1[r + 3]); }
#undef MX3
            float mx = fmaxf(mxa, mxb);
            if (__any(mx > THR)) {
                mx = fmaxf(mx, __shfl_xor(mx, 32));
                const float dl = fmaxf(mx, 0.f);
                m_ref += dl;
                const float f = __builtin_amdgcn_exp2f(-dl);
                l_run *= f;
#pragma unroll
                for (int db = 0; db < NDB; ++db)
#pragma unroll
                    for (int r = 0; r < 16; ++r) o[db][r] *= f;
#pragma unroll
                for (int r = 0; r < 16; ++r) { s0[r] -= dl; s1[r] -= dl; cvec[r] = cbase - m_ref; }
            }
            float ls0 = 0.f, ls1 = 0.f;
#define AT_EXP(SS, B, PF) do { \
                const float e0 = __builtin_amdgcn_exp2f(SS[B + 0]), e1 = __builtin_amdgcn_exp2f(SS[B + 1]), e2 = __builtin_amdgcn_exp2f(SS[B + 2]), e3 = __builtin_amdgcn_exp2f(SS[B + 3]); \
                const float e4 = __builtin_amdgcn_exp2f(SS[B + 4]), e5 = __builtin_amdgcn_exp2f(SS[B + 5]), e6 = __builtin_amdgcn_exp2f(SS[B + 6]), e7 = __builtin_amdgcn_exp2f(SS[B + 7]); \
                ls0 += e0; ls1 += e4; ls0 += e1; ls1 += e5; ls0 += e2; ls1 += e6; ls0 += e3; ls1 += e7; \
                PF.u.x = cvtpk_s(e0, e1); PF.u.y = cvtpk_s(e2, e3); PF.u.z = cvtpk_s(e4, e5); PF.u.w = cvtpk_s(e6, e7); } while (0)
            union PFU { u32x4 u; bf16x8 b; };
            PFU p0, p1, p2, p3;
            AT_EXP(s0, 0, p0);
#pragma unroll
            for (int kk = 0; kk < 2; ++kk)
#pragma unroll
                for (int db = 0; db < NDB; ++db) vc[kk * NDB + db] = *(const ALAS bf16x8*)(sb + vx[kk + 2] + db * 4096);
            __builtin_amdgcn_sched_barrier(0);
#pragma unroll
            for (int db = 0; db < NDB; ++db) o[db] = __builtin_amdgcn_mfma_f32_32x32x16_bf16(va[db], p0.b, o[db], 0, 0, 0);
            AT_EXP(s0, 8, p1);
            __builtin_amdgcn_sched_barrier(0);
#pragma unroll
            for (int db = 0; db < NDB; ++db) o[db] = __builtin_amdgcn_mfma_f32_32x32x16_bf16(va[NDB + db], p1.b, o[db], 0, 0, 0);
            AT_EXP(s1, 0, p2);
            __builtin_amdgcn_sched_barrier(0);
#pragma unroll
            for (int db = 0; db < NDB; ++db) o[db] = __builtin_amdgcn_mfma_f32_32x32x16_bf16(vc[db], p2.b, o[db], 0, 0, 0);
            AT_EXP(s1, 8, p3);
            __builtin_amdgcn_sched_barrier(0);
#pragma unroll
            for (int db = 0; db < NDB; ++db) o[db] = __builtin_amdgcn_mfma_f32_32x32x16_bf16(vc[NDB + db], p3.b, o[db], 0, 0, 0);
            __builtin_amdgcn_sched_barrier(0);
#undef AT_EXP
            l_run += ls0 + ls1;
        }
    }
    asm volatile("s_waitcnt lgkmcnt(0)\n\ts_barrier" ::: "memory");
#undef qf
#undef AT_DMA
    const float l_tot = l_run + __shfl_xor(l_run, 32);
    const float inv = 1.0f / l_tot;
    const size_t orow = (size_t)(seq_base + qw + l31) * 1024;
    if (WIN) {
        bf16_t* yp = Y + orow + (2 * hsel + half) * 64 + 8 * hi;
#pragma unroll
        for (int db = 0; db < NDB; ++db)
#pragma unroll
            for (int p = 0; p < 2; ++p) {
                u32x2 w0, w1;
                w0.x = cvt_pk_bf16(o[db][8 * p] * inv, o[db][8 * p + 1] * inv); w0.y = cvt_pk_bf16(o[db][8 * p + 2] * inv, o[db][8 * p + 3] * inv);
                w1.x = cvt_pk_bf16(o[db][8 * p + 4] * inv, o[db][8 * p + 5] * inv); w1.y = cvt_pk_bf16(o[db][8 * p + 6] * inv, o[db][8 * p + 7] * inv);
                const u32x2 snd = hi ? w0 : w1, mine = hi ? w1 : w0;
                u32x2 rcv; rcv.x = (unsigned)__shfl_xor((int)snd.x, 32); rcv.y = (unsigned)__shfl_xor((int)snd.y, 32);
                u32x4 ow; if (hi) { ow.x = rcv.x; ow.y = rcv.y; ow.z = mine.x; ow.w = mine.y; } else { ow.x = mine.x; ow.y = mine.y; ow.z = rcv.x; ow.w = rcv.y; }
                *(u32x4*)(yp + 32 * db + 16 * p) = ow;
            }
    } else {
        ALAS f32x4* xch = (ALAS f32x4*)lds + (size_t)wq * 1024 + l31;
        if (half == 1) {
#pragma unroll
            for (int db = 0; db < NDB; ++db)
#pragma unroll
                for (int g = 0; g < 4; ++g) { f32x4 v; v[0] = o[db][4 * g] * inv; v[1] = o[db][4 * g + 1] * inv; v[2] = o[db][4 * g + 2] * inv; v[3] = o[db][4 * g + 3] * inv;
                    xch[(8 * db + 2 * g + hi) * 32] = v; }
        }
        __syncthreads();
        if (half == 0) {
            float ss = 0.f;
#pragma unroll
            for (int db = 0; db < NDB; ++db)
#pragma unroll
                for (int g = 0; g < 4; ++g) { const f32x4 v = xch[(8 * db + 2 * g + hi) * 32];
#pragma unroll
                    for (int i = 0; i < 4; ++i) { const float x = o[db][4 * g + i] * inv - lam * v[i]; o[db][4 * g + i] = x; ss += x * x; } }
            ss += __shfl_xor(ss, 32);
            const float rn = __builtin_amdgcn_rsqf(ss * (1.0f / 128.0f) + 1e-6f) * 0.8f;
            bf16_t* yp = Y + orow + 512 + hsel * 128 + 8 * hi;
#pragma unroll
            for (int db = 0; db < NDB; ++db)
#pragma unroll
                for (int p = 0; p < 2; ++p) {
                    const f32x4 ga = *(const ALAS f32x4*)(lds + OFF_SUB + (32 * db + 16 * p + 4 * hi) * 4), gb = *(const ALAS f32x4*)(lds + OFF_SUB + (32 * db + 16 * p + 8 + 4 * hi) * 4);
                    u32x2 w0, w1;
                    w0.x = cvt_pk_bf16(o[db][8 * p] * rn * ga[0], o[db][8 * p + 1] * rn * ga[1]); w0.y = cvt_pk_bf16(o[db][8 * p + 2] * rn * ga[2], o[db][8 * p + 3] * rn * ga[3]);
                    w1.x = cvt_pk_bf16(o[db][8 * p + 4] * rn * gb[0], o[db][8 * p + 5] * rn * gb[1]); w1.y = cvt_pk_bf16(o[db][8 * p + 6] * rn * gb[2], o[db][8 * p + 7] * rn * gb[3]);
                    const u32x2 snd = hi ? w0 : w1, mine = hi ? w1 : w0;
                    u32x2 rcv; rcv.x = (unsigned)__shfl_xor((int)snd.x, 32); rcv.y = (unsigned)__shfl_xor((int)snd.y, 32);
                    u32x4 ow; if (hi) { ow.x = rcv.x; ow.y = rcv.y; ow.z = mine.x; ow.w = mine.y; } else { ow.x = mine.x; ow.y = mine.y; ow.z = rcv.x; ow.w = rcv.y; }
                    *(u32x4*)(yp + 32 * db + 16 * p) = ow;
                }
        }
        __syncthreads();
    }
}

__device__ __forceinline__ void attn_phase(ALAS unsigned char* lds, const bf16_t* QK, const bf16_t* VT, bf16_t* Y, const float* rel_bias, const float* sinkp, const float* subln, const float* blam) {
    float lam;
    { const int lane = threadIdx.x & 63; float a = blam[lane] * blam[64 + lane], b = blam[128 + lane] * blam[192 + lane];
#pragma unroll
      for (int o = 1; o < 64; o <<= 1) { a += __shfl_xor(a, o); b += __shfl_xor(b, o); }
      lam = __expf(a) - __expf(b) + 0.2f; }
    { constexpr float LOG2E = 1.4426950408889634f; ALAS float* lutw = (ALAS float*)(lds + OFF_LUT);
      for (int i = threadIdx.x; i < 12 * LUTW; i += 512) { const int hh = i / LUTW, ri = i - hh * LUTW, rel = ri - LUTC;
        lutw[i] = (hh < 8 && (rel < -128 || rel > 128)) ? -1e30f : rel_bias[t5_bucket(rel) * 12 + hh] * LOG2E; }
      if (threadIdx.x < 128) ((ALAS float*)(lds + OFF_SUB))[threadIdx.x] = subln[threadIdx.x];
      __syncthreads(); }
    const int G = gridDim.x, bx = blockIdx.x;
    if (__builtin_amdgcn_readfirstlane((int)threadIdx.x) >= 256) __builtin_amdgcn_s_setprio(1);
    if (G == 256) {
        const int x = bx & 7, j = bx >> 3;
        for (int r = 0; r < 8; ++r) { const int bh = x + 8 * (r >> 1), qb = j + 32 * (r & 1);
            attn_unit<false>(lds, QK, VT, Y, rel_bias, sinkp, subln, lam, (bh >> 2) * 8192, 8192, qb * 128, bh & 3); }
        for (int r = 0; r < 8; ++r) { const int bh = x + 8 * ((j >> 4) + 2 * r), qb = j & 15;
            attn_unit<false>(lds, QK, VT, Y, rel_bias, sinkp, subln, lam, 65536 + (bh >> 2) * 2048, 2048, qb * 128, bh & 3); }
    } else {
    for (int u = bx; u < 2048; u += G) { const int qb = u & 63, bh = u >> 6; attn_unit<false>(lds, QK, VT, Y, rel_bias, sinkp, subln, lam, (bh >> 2) * 8192, 8192, qb * 128, bh & 3); }
    for (int u = bx; u < 2048; u += G) { const int qb = u & 15, bh = u >> 4; attn_unit<false>(lds, QK, VT, Y, rel_bias, sinkp, subln, lam, 65536 + (bh >> 2) * 2048, 2048, qb * 128, bh & 3); }
    }
    for (int u = bx; u < 4096; u += G) { const int hp = u & 3, qb = u >> 2;
        const int row0 = qb * 128; int seq_base, S;
        if (row0 < 65536) { seq_base = row0 & ~8191; S = 8192; } else { seq_base = row0 & ~2047; S = 2048; }
        attn_unit<true>(lds, QK, VT, Y, rel_bias, sinkp, subln, lam, seq_base, S, row0 - seq_base, hp); }
    __builtin_amdgcn_s_setprio(0);
}
}

namespace cv {
using pg8::bf16_t; using pg8::f32x4; using pg8::u32x4; using pg8::cvt_pk_bf16; using pg8::bf_lo; using pg8::bf_hi; using pg8::fast_sigmoid;
#define CLAS __attribute__((address_space(3)))
constexpr int T = 32, HALO = 15, ROWS = T + 2 * HALO;
constexpr int OFF_U0 = 0, OFF_U1 = 64 * 1024;
constexpr int CONV_LDS = OFF_U1 + T * 512 * 4;
__device__ __forceinline__ void conv_unit(CLAS unsigned char* lds, const bf16_t* __restrict__ PC, bf16_t* __restrict__ YC, const float* __restrict__ w3, const float* __restrict__ w31,
                                          const float* __restrict__ dwb, const float* __restrict__ lng, const float* __restrict__ lnb, int seq_base, int S, int t0) {
    const int tid = threadIdx.x;
    {
        u32x4 w8[8];
#pragma unroll
        for (int it = 0; it < 8; ++it) { const int idx = tid + 512 * it, j = idx >> 6, v = idx & 63, tok = t0 - HALO + j;
            w8[it] = (u32x4){0u, 0u, 0u, 0u};
            if (idx < ROWS * 64 && tok >= 0 && tok < S) w8[it] = *(const u32x4*)(PC + (size_t)(seq_base + tok) * 1536 + 1024 + v * 8); }
#pragma unroll
        for (int it = 0; it < 8; ++it) { const int idx = tid + 512 * it, j = idx >> 6, v = idx & 63;
            if (idx < ROWS * 64) *(CLAS u32x4*)(lds + OFF_U0 + j * 1024 + v * 16) = w8[it]; }
    }
    __syncthreads();
    const int cp = tid & 255, th = tid >> 8;
    {
        const float wa0 = w3[2 * cp], wa1 = w3[512 + 2 * cp], wa2 = w3[1024 + 2 * cp];
        const float wb0 = w3[2 * cp + 1], wb1 = w3[512 + 2 * cp + 1], wb2 = w3[1024 + 2 * cp + 1];
        const int tb = t0 + 16 * th;
        unsigned pw[18], gw[16];
#pragma unroll
        for (int i = 0; i < 18; ++i) { const int tok = tb - 1 + i; pw[i] = 0u; if (tok >= 0 && tok < S) pw[i] = *(const unsigned*)(PC + (size_t)(seq_base + tok) * 1536 + 512 + 2 * cp); }
#pragma unroll
        for (int i = 0; i < 16; ++i) gw[i] = *(const unsigned*)(PC + (size_t)(seq_base + tb + i) * 1536 + 2 * cp);
#pragma unroll
        for (int i = 0; i < 16; ++i) {
            const float ya = bf_lo(gw[i]) * (wa0 * bf_lo(pw[i]) + wa1 * bf_lo(pw[i + 1]) + wa2 * bf_lo(pw[i + 2]));
            const float yb = bf_hi(gw[i]) * (wb0 * bf_hi(pw[i]) + wb1 * bf_hi(pw[i + 1]) + wb2 * bf_hi(pw[i + 2]));
            *(unsigned*)(YC + (size_t)(seq_base + tb + i) * 1024 + 2 * cp) = cvt_pk_bf16(ya, yb);
        }
    }
    {
        float wa[31], wb[31];
#pragma unroll
        for (int j = 0; j < 31; ++j) { wa[j] = w31[j * 512 + 2 * cp]; wb[j] = w31[j * 512 + 2 * cp + 1]; }
        const float ba = dwb[2 * cp], bb = dwb[2 * cp + 1];
        for (int g4 = 0; g4 < 4; ++g4) {
            const int tt = 16 * th + 4 * g4;
            float aa[4], ab[4];
#pragma unroll
            for (int k = 0; k < 4; ++k) { aa[k] = ba; ab[k] = bb; }
            const CLAS unsigned char* up = lds + OFF_U0 + tt * 1024 + cp * 4;
#pragma unroll
            for (int rr = 0; rr < 34; ++rr) {
                const unsigned w = *(const CLAS unsigned*)(up + rr * 1024);
                const float xa = bf_lo(w), xb = bf_hi(w);
#pragma unroll
                for (int k = 0; k < 4; ++k) { const int j = rr - k; if (j >= 0 && j < 31) { aa[k] += wa[j] * xa; ab[k] += wb[j] * xb; } }
            }
#pragma unroll
            for (int k = 0; k < 4; ++k) { typedef float f32x2 __attribute__((ext_vector_type(2))); *(CLAS f32x2*)(lds + OFF_U1 + (tt + k) * 2048 + cp * 8) = (f32x2){aa[k], ab[k]}; }
        }
    }
    __syncthreads();
    {
        const int lane = tid & 63, wid = tid >> 6;
        const f32x4 g0 = *(const f32x4*)(lng + 8 * lane), g1 = *(const f32x4*)(lng + 8 * lane + 4), b0 = *(const f32x4*)(lnb + 8 * lane), b1 = *(const f32x4*)(lnb + 8 * lane + 4);
        for (int k = 0; k < 4; ++k) {
            const int tt = 4 * wid + k;
            const f32x4 x0 = *(const CLAS f32x4*)(lds + OFF_U1 + tt * 2048 + lane * 32), x1 = *(const CLAS f32x4*)(lds + OFF_U1 + tt * 2048 + lane * 32 + 16);
            float s = ((x0[0] + x0[1]) + (x0[2] + x0[3])) + ((x1[0] + x1[1]) + (x1[2] + x1[3]));
#pragma unroll
            for (int o = 1; o < 64; o <<= 1) s += __shfl_xor(s, o);
            const float mean = s * (1.0f / 512.0f);
            const f32x4 d0 = x0 - mean, d1 = x1 - mean;
            float q = ((d0[0] * d0[0] + d0[1] * d0[1]) + (d0[2] * d0[2] + d0[3] * d0[3])) + ((d1[0] * d1[0] + d1[1] * d1[1]) + (d1[2] * d1[2] + d1[3] * d1[3]));
#pragma unroll
            for (int o = 1; o < 64; o <<= 1) q += __shfl_xor(q, o);
            const float rstd = __builtin_amdgcn_rsqf(q * (1.0f / 512.0f) + 1e-6f);
            f32x4 y0 = d0 * rstd * g0 + b0, y1 = d1 * rstd * g1 + b1;
#pragma unroll
            for (int i = 0; i < 4; ++i) { y0[i] = y0[i] * fast_sigmoid(y0[i]); y1[i] = y1[i] * fast_sigmoid(y1[i]); }
            u32x4 w; w.x = cvt_pk_bf16(y0[0], y0[1]); w.y = cvt_pk_bf16(y0[2], y0[3]); w.z = cvt_pk_bf16(y1[0], y1[1]); w.w = cvt_pk_bf16(y1[2], y1[3]);
            *(u32x4*)(YC + (size_t)(seq_base + t0 + tt) * 1024 + 512 + 8 * lane) = w;
        }
    }
    __syncthreads();
}
__device__ __forceinline__ void conv_phase(CLAS unsigned char* lds, const bf16_t* PC, bf16_t* YC, const float* w3, const float* w31, const float* dwb, const float* lng, const float* lnb) {
    for (int u = blockIdx.x; u < 131072 / T; u += gridDim.x) {
        const int row0 = u * T; int seq_base, S;
        if (row0 < 65536) { seq_base = row0 & ~8191; S = 8192; } else { seq_base = row0 & ~2047; S = 2048; }
        conv_unit(lds, PC, YC, w3, w31, dwb, lng, lnb, seq_base, S, row0 - seq_base);
    }
}
}

namespace mk {
using pg8::bf16_t; using pg8::f32x4; using pg8::u32x4; using pg8::u32x2; using pg8::cvt_pk_bf16;
#define MLAS __attribute__((address_space(3)))
constexpr int M = 131072, D = 1024, FF = 2816, NQKV = 2304, NCI = 2560;
constexpr size_t MiB = 1u << 20;
constexpr size_t WS_X = 0;
constexpr size_t WS_BIG = 256 * MiB;
constexpr size_t WS_VT = WS_BIG + (size_t)M * pg8::QKW * 2;
constexpr size_t WS_W = 960 * MiB;
constexpr size_t WS_WQKV = WS_W, WS_WO = WS_WQKV + (size_t)NQKV * D * 2, WS_WGU0 = WS_WO + (size_t)D * D * 2, WS_WGU1 = WS_WGU0 + (size_t)2 * FF * D * 2,
                 WS_WD0 = WS_WGU1 + (size_t)2 * FF * D * 2, WS_WD1 = WS_WD0 + (size_t)D * FF * 2, WS_WCI = WS_WD1 + (size_t)D * FF * 2, WS_WCO = WS_WCI + (size_t)NCI * D * 2;
constexpr size_t WS_SSQ = 1008 * MiB;
constexpr size_t WS_CTL = 1016 * MiB, CTL_BYTES = 16384;
constexpr size_t WS_END = WS_CTL + 65536;
static_assert(WS_VT + (size_t)640 * pg8::VT_PITCH * 2 <= WS_W && WS_BIG + (size_t)M * FF * 2 <= WS_W && WS_WCO + (size_t)D * D * 2 <= WS_SSQ, "ws map");
constexpr int MISC_OFF = 155648, LDS_BYTES = MISC_OFF + 256;
static_assert(att::ATT_LDS <= MISC_OFF && cv::CONV_LDS <= MISC_OFF && pg8::STAGE_BYTES + 16384 <= MISC_OFF, "lds map");

#define XB_TMO      128
#define XB_XCNT(j)  (256  + 64 * (j))
#define XB_XSUB(j)  (1280 + 64 * (j))
#define XB_XGEN(j)  (2304 + 64 * (j))
#define XB_TOP      3328
#define XB_TOPGEN   3392
#define XCD_BAR_WORDS 3456
#define XB_SPIN_CAP (1u << 18)

__device__ __forceinline__ unsigned xb_ld(unsigned* p)              { return __hip_atomic_load(p, __ATOMIC_RELAXED, __HIP_MEMORY_SCOPE_AGENT); }
__device__ __forceinline__ unsigned xb_add(unsigned* p, unsigned v) { return __hip_atomic_fetch_add(p, v, __ATOMIC_RELAXED, __HIP_MEMORY_SCOPE_AGENT); }
__device__ __forceinline__ unsigned xb_xcc_id() { return (unsigned)__builtin_amdgcn_s_getreg((3 << 11) | 20) & 0xFu; }
#define XB_SPIN(cond, bar) do { unsigned _sp = 0; while (cond) { __builtin_amdgcn_s_sleep(1); \
    if ((++_sp & 255u) == 0u) { if (xb_ld(&(bar)[XB_TMO])) break; if (_sp > XB_SPIN_CAP) { atomicAdd(&(bar)[XB_TMO], 1u); break; } } } } while (0)

struct XcdBarrier {
    unsigned* bar; unsigned x;
    volatile MLAS unsigned* st;
};

__device__ __forceinline__ XcdBarrier xcd_barrier_post(unsigned* bar, volatile MLAS unsigned* st) {
    XcdBarrier b; b.bar = bar; b.x = xb_xcc_id(); b.st = st;
    if (threadIdx.x == 0) (void)xb_add(&bar[XB_XCNT(b.x)], 1u);
    return b;
}
__device__ __forceinline__ void xcd_barrier_complete(unsigned* bar, unsigned x, unsigned& nloc, unsigned& nx) {
    const unsigned G = gridDim.x * gridDim.y * gridDim.z;
    unsigned sum, cnt, mine, sp = 0u;
    for (;;) {
        sum = 0u; cnt = 0u; mine = 0u;
#pragma unroll
        for (unsigned j = 0; j < 16; ++j) { const unsigned c = xb_ld(&bar[XB_XCNT(j)]); sum += c; cnt += (c > 0u) ? 1u : 0u; mine = (j == x) ? c : mine; }
        if (sum == G) break;
        __builtin_amdgcn_s_sleep(1);
        if ((++sp & 255u) == 0u) { if (xb_ld(&bar[XB_TMO])) break; if (sp > XB_SPIN_CAP) { atomicAdd(&bar[XB_TMO], 1u); break; } }
    }
    nloc = mine > 0u ? mine : 1u; nx = cnt > 0u ? cnt : 1u;
}

__device__ __forceinline__ void xcd_barrier(const XcdBarrier& b) {
    asm volatile("s_waitcnt vmcnt(0)" ::: "memory");
    __syncthreads();
    if (threadIdx.x == 0) {
        unsigned* bar = b.bar;
        __builtin_amdgcn_s_waitcnt(0);
        unsigned nloc = b.st[0], nx = b.st[1];
        if (nloc == 0u) { xcd_barrier_complete(bar, b.x, nloc, nx); b.st[0] = nloc; b.st[1] = nx; }
        const unsigned old = xb_add(&bar[XB_XSUB(b.x)], 1u);
        const unsigned gen = old / nloc;
        if (old + 1u == (gen + 1u) * nloc) {
            __builtin_amdgcn_fence(__ATOMIC_RELEASE, "agent");
            asm volatile("s_waitcnt vmcnt(0)" ::: "memory");
            const unsigned og = xb_add(&bar[XB_TOP], 1u);
            const unsigned tg = og / nx;
            if (og + 1u == (tg + 1u) * nx) xb_add(&bar[XB_TOPGEN], 1u);
            else XB_SPIN(xb_ld(&bar[XB_TOPGEN]) == tg, bar);
            __builtin_amdgcn_fence(__ATOMIC_ACQUIRE, "agent");
            xb_add(&bar[XB_XGEN(b.x)], 1u);
            asm volatile("s_waitcnt vmcnt(0)" ::: "memory");
        } else {
            XB_SPIN(xb_ld(&bar[XB_XGEN(b.x)]) == gen, bar);
            __builtin_amdgcn_fence(__ATOMIC_ACQUIRE, "agent");
            asm volatile("s_waitcnt vmcnt(0)" ::: "memory");
        }
    }
    __syncthreads();
}

static_assert(XCD_BAR_WORDS * 4 <= CTL_BYTES, "barrier words");
struct Params { const float* in[24]; float* out; unsigned char* ws; int ph_lo, ph_hi; };

__device__ __forceinline__ void tr_item(const float* __restrict__ W, int ldw, int srccol0, const float* __restrict__ gain, bf16_t* __restrict__ WT, int K, int destrow0, int k0, MLAS float* scr, int lane) {
    float wv[32];
#pragma unroll
    for (int i = 0; i < 32; ++i) { const int kk = 2 * i + (lane >> 5); wv[i] = W[(size_t)(k0 + kk) * ldw + srccol0 + (lane & 31)]; }
    const float g0 = gain ? gain[k0 + (lane & 31) * 2] : 1.0f, g1 = gain ? gain[k0 + (lane & 31) * 2 + 1] : 1.0f;
#pragma unroll
    for (int i = 0; i < 32; ++i) { const int kk = 2 * i + (lane >> 5); const float ga = __shfl(g0, i), gb = __shfl(g1, i); scr[kk * 33 + (lane & 31)] = wv[i] * ((lane >> 5) ? gb : ga); }
    asm volatile("s_waitcnt lgkmcnt(0)" ::: "memory");
    const int c = lane & 7;
#pragma unroll
    for (int j = 0; j < 4; ++j) { const int n = (lane >> 3) + 8 * j; const MLAS float* s = scr + (8 * c) * 33 + n;
        u32x4 o; o.x = cvt_pk_bf16(s[0 * 33], s[1 * 33]); o.y = cvt_pk_bf16(s[2 * 33], s[3 * 33]); o.z = cvt_pk_bf16(s[4 * 33], s[5 * 33]); o.w = cvt_pk_bf16(s[6 * 33], s[7 * 33]);
        *(u32x4*)(WT + (size_t)(destrow0 + n) * K + k0 + 8 * c) = o; }
    asm volatile("s_waitcnt lgkmcnt(0)" ::: "memory");
}

__device__ __forceinline__ void prologue(const Params& p, MLAS unsigned char* lds) {
    const int tid = threadIdx.x, lane = tid & 63, wave = tid >> 6;
    MLAS float* scr = (MLAS float*)(lds + wave * 16384);
    const int gw = blockIdx.x * 8 + wave, NGW = gridDim.x * 8;
    unsigned char* ws = p.ws;
    constexpr int I_QKV = (NQKV / 32) * (D / 64), I_O = (D / 32) * (D / 64), I_GU = (2 * FF / 32) * (D / 64), I_D = (D / 32) * (FF / 64), I_CI = (NCI / 32) * (D / 64);
    constexpr int NIT = I_QKV + I_O + 2 * I_GU + 2 * I_D + I_CI + I_O;
    for (int it = gw; it < NIT; it += NGW) {
        int r = it;
        if (r < I_QKV) { const int kb = r / (NQKV / 32), nb = r % (NQKV / 32); const int n0 = nb * 32, pn = n0 >> 8, within = n0 & 255, bj = within >> 7, wc = (within & 127) >> 5;
            tr_item(p.in[8], NQKV, 256 * pn + 64 * wc + 32 * bj, p.in[3], (bf16_t*)(ws + WS_WQKV), D, n0, kb * 64, scr, lane); continue; }
        r -= I_QKV;
        if (r < I_O) { const int kb = r / (D / 32), nb = r % (D / 32); tr_item(p.in[9], D, nb * 32, nullptr, (bf16_t*)(ws + WS_WO), D, nb * 32, kb * 64, scr, lane); continue; }
        r -= I_O;
        if (r < 2 * I_GU) { const int l = r / I_GU; r -= l * I_GU; const int kb = r / (2 * FF / 32), nb = r % (2 * FF / 32); const int n0 = nb * 32, pn = n0 >> 8, within = n0 & 255, bj = within >> 7, j = within & 127;
            const float* src = (bj ? p.in[6] : p.in[5]) + (size_t)l * D * FF;
            tr_item(src, FF, 128 * pn + j, p.in[4] + l * D, (bf16_t*)(ws + (l ? WS_WGU1 : WS_WGU0)), D, n0, kb * 64, scr, lane); continue; }
        r -= 2 * I_GU;
        if (r < 2 * I_D) { const int l = r / I_D; r -= l * I_D; const int kb = r / (D / 32), nb = r % (D / 32);
            tr_item(p.in[7] + (size_t)l * FF * D, D, nb * 32, nullptr, (bf16_t*)(ws + (l ? WS_WD1 : WS_WD0)), FF, nb * 32, kb * 64, scr, lane); continue; }
        r -= 2 * I_D;
        if (r < I_CI) { const int kb = r / (NCI / 32), nb = r % (NCI / 32); const int n0 = nb * 32, pn = n0 >> 8, within = n0 & 255, bj = within >> 7, j = within & 127;
            const int src = pn < 2 ? n0 : (pn < 6 ? (bj ? 1024 : 512) + 128 * (pn - 2) + j : (bj ? 2048 : 1536) + 128 * (pn - 6) + j);
            tr_item(p.in[17], NCI, src, p.in[3] + D, (bf16_t*)(ws + WS_WCI), D, n0, kb * 64, scr, lane); continue; }
        r -= I_CI;
        { const int kb = r / (D / 32), nb = r % (D / 32); tr_item(p.in[18], D, nb * 32, nullptr, (bf16_t*)(ws + WS_WCO), D, nb * 32, kb * 64, scr, lane); }
    }
    bf16_t* X = (bf16_t*)(ws + WS_X); float* ssq = (float*)(ws + WS_SSQ);
    for (int m0 = gw; m0 < M; m0 += 4 * NGW) {
        f32x4 v[4][4];
#pragma unroll
        for (int r = 0; r < 4; ++r) { const int m = m0 + r * NGW; if (m < M) { const float* xrow = (m < 65536) ? p.in[0] + (size_t)m * D : p.in[1] + (size_t)(m - 65536) * D; const f32x4* xr = (const f32x4*)xrow + lane;
#pragma unroll
            for (int j = 0; j < 4; ++j) v[r][j] = xr[64 * j]; } }
#pragma unroll
        for (int r = 0; r < 4; ++r) { const int m = m0 + r * NGW; if (m < M) {
            float s = 0.f;
#pragma unroll
            for (int j = 0; j < 4; ++j) s += (v[r][j][0] * v[r][j][0] + v[r][j][1] * v[r][j][1]) + (v[r][j][2] * v[r][j][2] + v[r][j][3] * v[r][j][3]);
#pragma unroll
            for (int o = 1; o < 64; o <<= 1) s += __shfl_xor(s, o);
            u32x2* o8 = (u32x2*)(X + (size_t)m * D) + lane;
#pragma unroll
            for (int j = 0; j < 4; ++j) { u32x2 w; w.x = cvt_pk_bf16(v[r][j][0], v[r][j][1]); w.y = cvt_pk_bf16(v[r][j][2], v[r][j][3]); o8[64 * j] = w; }
            if (lane < 16) ssq[(size_t)m * 16 + lane] = (lane == 0) ? s : 0.f; } }
    }
}

__global__ void __launch_bounds__(512, 2) fwd_kernel(Params p) {
    extern __shared__ __attribute__((aligned(16))) unsigned char lds_raw[];
    MLAS unsigned char* lds = (MLAS unsigned char*)lds_raw;
    cg::grid_group grid = cg::this_grid();
    unsigned char* ws = p.ws;
    bf16_t* X = (bf16_t*)(ws + WS_X); bf16_t* BIG = (bf16_t*)(ws + WS_BIG); bf16_t* VT = (bf16_t*)(ws + WS_VT); float* ssq = (float*)(ws + WS_SSQ);
    bf16_t* Y = (bf16_t*)p.out;
    const int lo = p.ph_lo, hi = p.ph_hi, G = gridDim.x, bx = blockIdx.x;
    volatile MLAS unsigned* misc = (volatile MLAS unsigned*)(lds + MISC_OFF);
    if (threadIdx.x < 2) misc[threadIdx.x] = 0u;
    __syncthreads();
    const XcdBarrier xbar = xcd_barrier_post((unsigned*)(ws + WS_CTL), misc);
#ifndef PH_MASK
#define PH_MASK 0x7ff
#endif
#define IN(k) (((PH_MASK >> (k)) & 1) && lo <= (k) && (k) < hi)
#define SEAM(k) do { if (IN(k) && IN((k) + 1)) { if ((k) == 0) grid.sync(); else xcd_barrier(xbar); } } while (0)
    if (IN(0)) { prologue(p, lds); __syncthreads(); }
    SEAM(0);
    if (IN(1)) { pg8::Gemm g{X, (const bf16_t*)(ws + WS_WQKV), M, NQKV, D}; pg8::StaticOrder S; S.init(M, NQKV, G, bx);
        pg8::EpiQKV E{BIG, VT, ssq, p.in[10], p.in[11], p.in[13], p.in[14], lds + pg8::STAGE_BYTES};
        pg8::gemm_phase<pg8::EpiQKV, pg8::StaticOrder, true, true>(lds, g, S, E); }
    SEAM(1);
    if (IN(2)) { for (int rep = 0; rep < PROBE_ATT; ++rep) att::attn_phase(lds, BIG, VT, Y, p.in[2], p.in[12], p.in[16], p.in[15]); }
    SEAM(2);
    if (IN(3)) { pg8::Gemm g{Y, (const bf16_t*)(ws + WS_WO), M, D, D}; pg8::StaticOrder S; S.init(M, D, G, bx);
        pg8::EpiRes<false> E{X, nullptr, ssq};
        pg8::gemm_phase<pg8::EpiRes<false>, pg8::StaticOrder, true, true>(lds, g, S, E); }
    SEAM(3);
    if (IN(4)) { pg8::Gemm g{X, (const bf16_t*)(ws + WS_WGU0), M, 2 * FF, D}; pg8::StaticOrder S; S.init(M, 2 * FF, G, bx);
        pg8::EpiGlu E{BIG, ssq};
        pg8::gemm_phase<pg8::EpiGlu, pg8::StaticOrder, true, true>(lds, g, S, E); }
    SEAM(4);
    if (IN(5)) { pg8::Gemm g{BIG, (const bf16_t*)(ws + WS_WD0), M, D, FF}; pg8::StaticOrder S; S.init(M, D, G, bx);
        pg8::EpiRes<false> E{X, nullptr, ssq};
        pg8::gemm_phase<pg8::EpiRes<false>, pg8::StaticOrder, true, true>(lds, g, S, E); }
    SEAM(5);
    if (IN(6)) { pg8::Gemm g{X, (const bf16_t*)(ws + WS_WCI), M, NCI, D}; pg8::StaticOrder S; S.init(M, NCI, G, bx);
        pg8::EpiConvIn E{BIG, ssq};
        pg8::gemm_phase<pg8::EpiConvIn, pg8::StaticOrder, true, true>(lds, g, S, E); }
    SEAM(6);
    if (IN(7)) { cv::conv_phase(lds, BIG, Y, p.in[19], p.in[20], p.in[21], p.in[22], p.in[23]); }
    SEAM(7);
    if (IN(8)) { pg8::Gemm g{Y, (const bf16_t*)(ws + WS_WCO), M, D, D}; pg8::StaticOrder S; S.init(M, D, G, bx);
        pg8::EpiRes<false> E{X, nullptr, ssq};
        pg8::gemm_phase<pg8::EpiRes<false>, pg8::StaticOrder, true, true>(lds, g, S, E); }
    SEAM(8);
    if (IN(9)) { pg8::Gemm g{X, (const bf16_t*)(ws + WS_WGU1), M, 2 * FF, D}; pg8::StaticOrder S; S.init(M, 2 * FF, G, bx);
        pg8::EpiGlu E{BIG, ssq};
        pg8::gemm_phase<pg8::EpiGlu, pg8::StaticOrder, true, true>(lds, g, S, E); }
    SEAM(9);
    if (IN(10)) { pg8::Gemm g{BIG, (const bf16_t*)(ws + WS_WD1), M, D, FF}; pg8::StaticOrder S; S.init(M, D, G, bx);
        pg8::EpiRes<true> E{X, p.out, ssq};
        pg8::gemm_phase<pg8::EpiRes<true>, pg8::StaticOrder, true, true>(lds, g, S, E); }
#undef IN
#undef SEAM
}
}

#ifndef MK_N_LAUNCHES_X
#define MK_N_LAUNCHES 1
#endif
extern "C" void kernel_launch(void* const* d_in, const int* in_sizes, int n_in, void* d_out, int out_size, void* d_ws, size_t ws_size, hipStream_t stream) {
    static int grid = 0;
    if (grid == 0) {
        if (n_in != 24 || out_size != mk::M * mk::D || ws_size < mk::WS_END) { fprintf(stderr, "kernel_launch: unexpected shapes (n_in %d out %d ws %zu)\n", n_in, out_size, ws_size); grid = -1; return; }
        int dev = 0, cus = 0, per_cu = 0;
        (void)hipGetDevice(&dev); (void)hipDeviceGetAttribute(&cus, hipDeviceAttributeMultiprocessorCount, dev);
        (void)hipFuncSetAttribute((const void*)mk::fwd_kernel, hipFuncAttributeMaxDynamicSharedMemorySize, mk::LDS_BYTES);
        (void)hipOccupancyMaxActiveBlocksPerMultiprocessor(&per_cu, (const void*)mk::fwd_kernel, 512, mk::LDS_BYTES);
        if (per_cu < 1) per_cu = 1;
        (void)hipGetLastError();
        grid = cus * per_cu;
    }
    if (grid < 0) return;
    if (hipMemsetAsync((char*)d_ws + mk::WS_CTL, 0, mk::CTL_BYTES, stream) != hipSuccess) { fprintf(stderr, "kernel_launch: memset of the barrier words failed\n"); return; }
    mk::Params p{};
    for (int i = 0; i < 24; ++i) p.in[i] = (const float*)d_in[i];
    p.out = (float*)d_out; p.ws = (unsigned char*)d_ws;
#if MK_N_LAUNCHES == 1
    p.ph_lo = 0; p.ph_hi = 11;
    void* args[] = {&p};
    hipError_t e = hipLaunchCooperativeKernel((const void*)mk::fwd_kernel, dim3(grid), dim3(512), args, mk::LDS_BYTES, stream);
    if (e != hipSuccess) fprintf(stderr, "cooperative launch failed: %s (grid %d)\n", hipGetErrorString(e), grid);
#else
    for (int ph = 0; ph < 11; ++ph) { p.ph_lo = ph; p.ph_hi = ph + 1; hipLaunchKernelGGL(mk::fwd_kernel, dim3(grid), dim3(512), mk::LDS_BYTES, stream, p); }
#endif
}
```

```cpp
#include <hip/hip_runtime.h>
#include <hip/hip_cooperative_groups.h>
#include <cstdio>
#include <cstdint>
namespace cg = cooperative_groups;
#ifndef PROBE_ATT
#define PROBE_ATT 1
#endif
#ifndef MK_N_LAUNCHES
#define MK_N_LAUNCHES 1
#endif
namespace pg8 {
#define PG8_LAS __attribute__((address_space(3)))
typedef unsigned short bf16_t;
typedef short bf16x8 __attribute__((ext_vector_type(8)));
typedef float f32x4 __attribute__((ext_vector_type(4)));
typedef unsigned u32x4 __attribute__((ext_vector_type(4)));
constexpr int BM = 256, BK = 64, HALF = 128, HTB = HALF * BK * 2  , STAGE_BYTES = 8 * HTB, NXCD = 8, WGM = 8;

__host__ __device__ __forceinline__ int lds_byte(int r, int c) { const int st = (r >> 4) * 2 + (c >> 5), rr = r & 15, cc = c & 31, ob = rr * 64 + cc * 2; return st * 1024 + (ob ^ (((ob >> 9) & 1) << 5)); }
__host__ __device__ __forceinline__ void stage_rc(int b, int& R, int& C) { const int st = b / 1024, sb = b % 1024, swz = sb ^ (((sb >> 9) & 1) << 5); R = (st >> 1) * 16 + swz / 64; C = (st & 1) * 32 + (swz % 64) / 2; }
__host__ __device__ __forceinline__ int perm32(int rho) { const int n = rho >> 4, i = rho & 15; return 8 * (i >> 2) + 4 * n + (i & 3); }

struct Unit { int pm, pn; };
struct Gemm { const bf16_t* A; const bf16_t* Bt; int M, N, K; };

struct StaticOrder {
    int nM, nN, nwg, G, c;
    __host__ __device__ void init(int M, int N, int G_, int c_) { nM = M / BM; nN = N / BM; nwg = nM * nN; G = G_; c = c_; }
    __host__ __device__ bool next(int i, Unit& u) const {
        const long L = (long)i * G + c; if (L >= nwg) return false;
        int wgid = (int)L; { const int q = nwg / NXCD, r = nwg % NXCD, xcd = wgid % NXCD, off = wgid / NXCD; wgid = (xcd < r ? xcd * (q + 1) : r * (q + 1) + (xcd - r) * q) + off; }
        const int nig = WGM * nN, gid = wgid / nig, fm = gid * WGM, gsz = (nM - fm) < WGM ? (nM - fm) : WGM;
        u.pm = fm + ((wgid % nig) % gsz); u.pn = (wgid % nig) / gsz; return true;
    }
    __device__ __forceinline__ void a_ready(const Unit&) const {}
    __device__ __forceinline__ void done(const Unit&) const {}
};

__device__ __forceinline__ unsigned cvt_pk_bf16(float lo, float hi) { unsigned r; asm volatile("v_cvt_pk_bf16_f32 %0, %1, %2" : "=v"(r) : "v"(lo), "v"(hi)); return r; }
typedef float f32x2 __attribute__((ext_vector_type(2)));
typedef unsigned u32x2 __attribute__((ext_vector_type(2)));
__device__ __forceinline__ float bf_lo(unsigned w) { return __uint_as_float(w << 16); }
__device__ __forceinline__ float bf_hi(unsigned w) { return __uint_as_float(w & 0xffff0000u); }
__device__ __forceinline__ float row_rstd(const float* ssq, int row) {
    const f32x4* p = (const f32x4*)(ssq + (size_t)row * 16);
    const f32x4 a = p[0], b = p[1], c = p[2], d = p[3];
    const float s = ((a[0] + a[1]) + (a[2] + a[3])) + ((b[0] + b[1]) + (b[2] + b[3])) + ((c[0] + c[1]) + (c[2] + c[3])) + ((d[0] + d[1]) + (d[2] + d[3]));
    return __builtin_amdgcn_rsqf(s * (1.0f / 1024.0f) + 1e-6f);
}
__device__ __forceinline__ void rows_rstd(const float* ssq, int row0, int fq, float (&rs)[2][4]) {
    f32x4 pr[2][4];
#pragma unroll
    for (int ai = 0; ai < 2; ++ai)
#pragma unroll
        for (int m = 0; m < 4; ++m) pr[ai][m] = *(const f32x4*)(ssq + (size_t)(row0 + ai * HALF + m * 16) * 16 + 4 * fq);
#pragma unroll
    for (int ai = 0; ai < 2; ++ai)
#pragma unroll
        for (int m = 0; m < 4; ++m) { float t = (pr[ai][m][0] + pr[ai][m][1]) + (pr[ai][m][2] + pr[ai][m][3]); t += __shfl_xor(t, 16); t += __shfl_xor(t, 32); rs[ai][m] = __builtin_amdgcn_rsqf(t * (1.0f / 1024.0f) + 1e-6f); }
}
__device__ __forceinline__ float fast_sigmoid(float x) { return __builtin_amdgcn_rcpf(1.0f + __expf(-x)); }

constexpr int QKW = 1664;
constexpr int VT_PITCH = 131072 + 128;
constexpr float C2Q = 0.125f * 1.4426950408889634f;

struct EpiQKV {
    static constexpr bool PERM = true, AFTER_DRAIN = false;
    bf16_t* QK; bf16_t* VT; const float* ssq; const float* aq; const float* ak; const float* bq; const float* bk; PG8_LAS unsigned char* xlds;
    __device__ __forceinline__ void operator()(const f32x4 (&acc)[2][2][4][2], const Unit& u, int wr, int wc, int fr, int fq) const {
        const int L = u.pn * 256 + wc * 64;
        int kind; const float* gain = nullptr; float scale = 1.f; int ccol = 0, vrow = 0;
        if (L < 512) { kind = 0; gain = aq; scale = C2Q; ccol = L; }
        else if (L < 640) { kind = 0; gain = ak; ccol = L; }
        else if (L < 768) { kind = 1; vrow = L - 640; }
        else if (L < 1280) { kind = 0; gain = bq; scale = C2Q; ccol = L - 128; }
        else if (L < 1792) { kind = 0; gain = bk; ccol = L - 128; }
        else { kind = 1; vrow = L - 1792 + 128; }
        if (kind == 0) {
            f32x4 gv[2][2];
#pragma unroll
            for (int bj = 0; bj < 2; ++bj)
#pragma unroll
                for (int n = 0; n < 2; ++n) gv[bj][n] = *(const f32x4*)(gain + 32 * bj + 8 * fq + 4 * n);
            float rsv[2][4]; rows_rstd(ssq, u.pm * BM + wr * 64 + fr, fq, rsv);
#pragma unroll
            for (int ai = 0; ai < 2; ++ai)
#pragma unroll
                for (int m = 0; m < 4; ++m) {
                    const int row = u.pm * BM + ai * HALF + wr * 64 + m * 16 + fr;
                    const float rs = rsv[ai][m];
                    float ss = 0.f;
#pragma unroll
                    for (int bj = 0; bj < 2; ++bj)
#pragma unroll
                        for (int n = 0; n < 2; ++n) { const f32x4 v = acc[ai][bj][m][n] * rs; ss += (v[0] * v[0] + v[1] * v[1]) + (v[2] * v[2] + v[3] * v[3]); }
                    ss += __shfl_xor(ss, 16); ss += __shfl_xor(ss, 32);
                    const float f = rs * __builtin_amdgcn_rsqf(ss * (1.0f / 64.0f) + 1e-6f) * scale;
                    bf16_t* rowp = QK + ((size_t)((row >> 6) * 26 + (ccol >> 6)) * 64 + (row & 63)) * 64 + 8 * fq;
#pragma unroll
                    for (int bj = 0; bj < 2; ++bj) {
                        const f32x4 v0 = acc[ai][bj][m][0] * f * gv[bj][0], v1 = acc[ai][bj][m][1] * f * gv[bj][1];
                        u32x4 w; w.x = cvt_pk_bf16(v0[0], v0[1]); w.y = cvt_pk_bf16(v0[2], v0[3]); w.z = cvt_pk_bf16(v1[0], v1[1]); w.w = cvt_pk_bf16(v1[2], v1[3]);
                        *(u32x4*)(rowp + 32 * bj) = w;
                    }
                }
        } else {
            PG8_LAS unsigned char* xl = xlds + (wr * 4 + wc) * 2048;
            const int lane = fq * 16 + fr;
            float rsv[2][4]; rows_rstd(ssq, u.pm * BM + wr * 64 + fr, fq, rsv);
#pragma unroll
            for (int ai = 0; ai < 2; ++ai) {
                float rs[4];
#pragma unroll
                for (int m = 0; m < 4; ++m) rs[m] = rsv[ai][m];
                const size_t tb = (size_t)(u.pm * 4 + ai * 2 + wr) * 640;
#pragma unroll
                for (int bj = 0; bj < 2; ++bj)
#pragma unroll
                    for (int n = 0; n < 2; ++n) {
#pragma unroll
                        for (int m = 0; m < 4; ++m) {
                            const f32x4 v = acc[ai][bj][m][n] * rs[m];
                            const unsigned w0 = cvt_pk_bf16(v[0], v[1]), w1 = cvt_pk_bf16(v[2], v[3]);
                            PG8_LAS bf16_t* q = (PG8_LAS bf16_t*)(xl + (4 * fq) * 128 + (16 * m + fr) * 2);
                            q[0] = (bf16_t)(w0 & 0xffffu); q[64] = (bf16_t)(w0 >> 16); q[128] = (bf16_t)(w1 & 0xffffu); q[192] = (bf16_t)(w1 >> 16);
                        }
                        asm volatile("s_waitcnt lgkmcnt(0)" ::: "memory");
                        const int c16 = lane >> 2, part = lane & 3;
                        const u32x4 a = *(const PG8_LAS u32x4*)(xl + c16 * 128 + part * 32), b = *(const PG8_LAS u32x4*)(xl + c16 * 128 + part * 32 + 16);
                        bf16_t* gp = VT + (tb + vrow + 32 * bj + 8 * (c16 >> 2) + 4 * n + (c16 & 3)) * 64 + part * 16;
                        *(u32x4*)gp = a; *(u32x4*)(gp + 8) = b;
                        asm volatile("s_waitcnt lgkmcnt(0)" ::: "memory");
                    }
            }
        }
    }
};

template <bool FINAL> struct EpiRes {
    static constexpr bool PERM = true, AFTER_DRAIN = false;
    bf16_t* X; float* out; float* ssq;
    __device__ __forceinline__ void operator()(const f32x4 (&acc)[2][2][4][2], const Unit& u, int wr, int wc, int fr, int fq) const {
        const int col0 = u.pn * BM + wc * 32 + 8 * fq;
        u32x4 xin[2][4][2];
#pragma unroll
        for (int ai = 0; ai < 2; ++ai)
#pragma unroll
            for (int m = 0; m < 4; ++m)
#pragma unroll
                for (int bj = 0; bj < 2; ++bj) xin[ai][m][bj] = *(const u32x4*)(X + (size_t)(u.pm * BM + ai * HALF + wr * 64 + m * 16 + fr) * 1024 + col0 + bj * HALF);
#pragma unroll
        for (int ai = 0; ai < 2; ++ai)
#pragma unroll
            for (int m = 0; m < 4; ++m) {
                const int row = u.pm * BM + ai * HALF + wr * 64 + m * 16 + fr;
                float ss = 0.f;
#pragma unroll
                for (int bj = 0; bj < 2; ++bj) {
                    bf16_t* xp = X + (size_t)row * 1024 + col0 + bj * HALF;
                    const u32x4 xv = xin[ai][m][bj];
                    f32x4 y0 = acc[ai][bj][m][0], y1 = acc[ai][bj][m][1];
                    y0[0] += bf_lo(xv.x); y0[1] += bf_hi(xv.x); y0[2] += bf_lo(xv.y); y0[3] += bf_hi(xv.y);
                    y1[0] += bf_lo(xv.z); y1[1] += bf_hi(xv.z); y1[2] += bf_lo(xv.w); y1[3] += bf_hi(xv.w);
                    if (FINAL) {
                        float* op = out + (size_t)row * 1024 + col0 + bj * HALF;
                        __builtin_nontemporal_store(y0, (f32x4*)op); __builtin_nontemporal_store(y1, (f32x4*)(op + 4));
                    } else {
                        u32x4 w; w.x = cvt_pk_bf16(y0[0], y0[1]); w.y = cvt_pk_bf16(y0[2], y0[3]); w.z = cvt_pk_bf16(y1[0], y1[1]); w.w = cvt_pk_bf16(y1[2], y1[3]);
                        *(u32x4*)xp = w;
                        ss += (y0[0] * y0[0] + y0[1] * y0[1]) + (y0[2] * y0[2] + y0[3] * y0[3]) + (y1[0] * y1[0] + y1[1] * y1[1]) + (y1[2] * y1[2] + y1[3] * y1[3]);
                    }
                }
                if (!FINAL) {
                    ss += __shfl_xor(ss, 16); ss += __shfl_xor(ss, 32);
                    if (fq == 0) ssq[(size_t)row * 16 + u.pn * 4 + wc] = ss;
                }
            }
    }
};

struct EpiGlu {
    static constexpr bool PERM = true, AFTER_DRAIN = false;
    bf16_t* H; const float* ssq;
    __device__ __forceinline__ void operator()(const f32x4 (&acc)[2][2][4][2], const Unit& u, int wr, int wc, int fr, int fq) const {
        const int col0 = u.pn * HALF + wc * 32 + 8 * fq;
        float rsv[2][4]; rows_rstd(ssq, u.pm * BM + wr * 64 + fr, fq, rsv);
#pragma unroll
        for (int ai = 0; ai < 2; ++ai)
#pragma unroll
            for (int m = 0; m < 4; ++m) {
                const int row = u.pm * BM + ai * HALF + wr * 64 + m * 16 + fr;
                const float rs = rsv[ai][m];
                float h[8];
#pragma unroll
                for (int n = 0; n < 2; ++n)
#pragma unroll
                    for (int i = 0; i < 4; ++i) { const float g = acc[ai][0][m][n][i] * rs, up = acc[ai][1][m][n][i] * rs; h[4 * n + i] = g * up * fast_sigmoid(g); }
                u32x4 w; w.x = cvt_pk_bf16(h[0], h[1]); w.y = cvt_pk_bf16(h[2], h[3]); w.z = cvt_pk_bf16(h[4], h[5]); w.w = cvt_pk_bf16(h[6], h[7]);
                *(u32x4*)(H + (size_t)row * 2816 + col0) = w;
            }
    }
};

struct EpiConvIn {
    static constexpr bool PERM = true, AFTER_DRAIN = false;
    bf16_t* O; const float* ssq;
    __device__ __forceinline__ void operator()(const f32x4 (&acc)[2][2][4][2], const Unit& u, int wr, int wc, int fr, int fq) const {
        float rsv[2][4]; rows_rstd(ssq, u.pm * BM + wr * 64 + fr, fq, rsv);
#pragma unroll
        for (int ai = 0; ai < 2; ++ai)
#pragma unroll
            for (int m = 0; m < 4; ++m) {
                const int row = u.pm * BM + ai * HALF + wr * 64 + m * 16 + fr;
                const float rs = rsv[ai][m];
                bf16_t* rp = O + (size_t)row * 1536 + wc * 32 + 8 * fq;
                if (u.pn < 2) {
#pragma unroll
                    for (int bj = 0; bj < 2; ++bj) {
                        const f32x4 v0 = acc[ai][bj][m][0] * rs, v1 = acc[ai][bj][m][1] * rs;
                        u32x4 w; w.x = cvt_pk_bf16(v0[0], v0[1]); w.y = cvt_pk_bf16(v0[2], v0[3]); w.z = cvt_pk_bf16(v1[0], v1[1]); w.w = cvt_pk_bf16(v1[2], v1[3]);
                        *(u32x4*)(rp + u.pn * BM + bj * HALF) = w;
                    }
                } else {
                    float h[8];
                    const bool glu = u.pn >= 6;
#pragma unroll
                    for (int n = 0; n < 2; ++n)
#pragma unroll
                        for (int i = 0; i < 4; ++i) { const float a = acc[ai][0][m][n][i] * rs, b = acc[ai][1][m][n][i] * rs; h[4 * n + i] = glu ? a * fast_sigmoid(b) : a * b; }
                    u32x4 w; w.x = cvt_pk_bf16(h[0], h[1]); w.y = cvt_pk_bf16(h[2], h[3]); w.z = cvt_pk_bf16(h[4], h[5]); w.w = cvt_pk_bf16(h[6], h[7]);
                    *(u32x4*)(rp + 512 + (u.pn - 2) * HALF) = w;
                }
            }
    }
};

struct EpiPlain {
    static constexpr bool PERM = true, AFTER_DRAIN = false;
    bf16_t* O; int ldc; const float* ssq;
    __device__ __forceinline__ void operator()(const f32x4 (&acc)[2][2][4][2], const Unit& u, int wr, int wc, int fr, int fq) const {
        const int col0 = u.pn * BM + wc * 32 + 8 * fq;
#pragma unroll
        for (int ai = 0; ai < 2; ++ai)
#pragma unroll
            for (int m = 0; m < 4; ++m) {
                const int row = u.pm * BM + ai * HALF + wr * 64 + m * 16 + fr;
                const float rs = row_rstd(ssq, row);
#pragma unroll
                for (int bj = 0; bj < 2; ++bj) {
                    const f32x4 v0 = acc[ai][bj][m][0] * rs, v1 = acc[ai][bj][m][1] * rs;
                    u32x4 w; w.x = cvt_pk_bf16(v0[0], v0[1]); w.y = cvt_pk_bf16(v0[2], v0[3]); w.z = cvt_pk_bf16(v1[0], v1[1]); w.w = cvt_pk_bf16(v1[2], v1[3]);
                    *(u32x4*)(O + (size_t)row * ldc + col0 + bj * HALF) = w;
                }
            }
    }
};

template <class Epi, class Sched, bool ALIGN_EPI = false, bool SP2 = false>
__device__ __forceinline__ void gemm_phase(PG8_LAS unsigned char* lds, const Gemm g, const Sched& S, const Epi& E) {
    const int tid = threadIdx.x, wid = __builtin_amdgcn_readfirstlane(tid >> 6), lane = tid & 63, wr = wid >> 2, wc = wid & 3, fr = lane & 15, fq = lane >> 4;
    const int K = g.K, nt = K / BK;
    unsigned voffA[2], voffB[2];
#pragma unroll
    for (int i = 0; i < 2; ++i) { int R, C; stage_rc(tid * 16 + i * 8192, R, C); const int Rb = Epi::PERM ? ((R & ~31) + perm32(R & 31)) : R;
        voffA[i] = (unsigned)(R * K + C) * 2u; voffB[i] = (unsigned)(Rb * K + C) * 2u; }
    const size_t kstep = (size_t)(BK * 2);
    const size_t hstep = (size_t)HALF * K * 2;
    const size_t tstep = 2 * hstep;
    const unsigned ldsw = (unsigned)wid * 1024u;
    const int aoff = lds_byte(wr * 64 + fr, fq * 8), boff = lds_byte(wc * 32 + fr, fq * 8);
#define PG8_SA(b, h) (((b) * 2 + (h)) * HTB)
#define PG8_SB(b, h) ((4 + (b) * 2 + (h)) * HTB)
#define PG8_STAGE(bufoff, gbase, voff) do { _Pragma("unroll") for (int _i = 0; _i < 2; ++_i) \
        __builtin_amdgcn_global_load_lds((const unsigned*)((const char*)(gbase) + (voff)[_i]), (PG8_LAS unsigned*)(lds + (bufoff) + ldsw + _i * 8192), 16, 0, 0); } while (0)
#define PG8_LDA(dst, b, h) do { _Pragma("unroll") for (int m = 0; m < 4; ++m) _Pragma("unroll") for (int k = 0; k < 2; ++k) dst[m][k] = *(const PG8_LAS bf16x8*)(lds + PG8_SA(b, h) + aoff + m * 2048 + k * 1024); } while (0)
#define PG8_LDB(dst, b, h) do { _Pragma("unroll") for (int n = 0; n < 2; ++n) _Pragma("unroll") for (int k = 0; k < 2; ++k) dst[n][k] = *(const PG8_LAS bf16x8*)(lds + PG8_SB(b, h) + boff + n * 2048 + k * 1024); } while (0)
#define PG8_MMA(ai, bj, At, Bt) do { __builtin_amdgcn_s_setprio(1); _Pragma("unroll") for (int m = 0; m < 4; ++m) _Pragma("unroll") for (int n = 0; n < 2; ++n) _Pragma("unroll") for (int k = 0; k < 2; ++k) \
        acc[ai][bj][m][n] = __builtin_amdgcn_mfma_f32_16x16x32_bf16(Bt[n][k], At[m][k], acc[ai][bj][m][n], 0, 0, 0); __builtin_amdgcn_s_setprio(0); } while (0)
#define PG8_WAIT_V(n) asm volatile("s_waitcnt vmcnt(" #n ")" ::: "memory")
#define PG8_WAIT_L(n) asm volatile("s_waitcnt lgkmcnt(" #n ")" ::: "memory")
#define PG8_BAR __builtin_amdgcn_s_barrier()
#define PG8_SCHED __builtin_amdgcn_sched_barrier(0)
    Unit cur, nxt; int ui = 0;
    if (!S.next(0, cur)) return;
    f32x4 acc[2][2][4][2];
#pragma unroll
    for (int a = 0; a < 2; ++a)
#pragma unroll
        for (int b = 0; b < 2; ++b)
#pragma unroll
            for (int m = 0; m < 4; ++m)
#pragma unroll
                for (int n = 0; n < 2; ++n) acc[a][b][m][n] = (f32x4){0.f, 0.f, 0.f, 0.f};
    bf16x8 At[4][2], B0[2][2], B1[2][2];
    const char* cA = (const char*)g.A + (size_t)cur.pm * tstep; const char* cB = (const char*)g.Bt + (size_t)cur.pn * tstep;
    S.a_ready(cur);
    if constexpr (SP2) {
        PG8_STAGE(PG8_SB(0, 0), cB, voffB); PG8_STAGE(PG8_SB(0, 1), cB + hstep, voffB); PG8_STAGE(PG8_SA(0, 0), cA, voffA); PG8_STAGE(PG8_SA(0, 1), cA + hstep, voffA);
        if (wr == 1) PG8_BAR;
        PG8_WAIT_V(2); PG8_BAR;
        PG8_STAGE(PG8_SB(1, 0), cB + kstep, voffB); PG8_STAGE(PG8_SA(1, 0), cA + kstep, voffA); PG8_STAGE(PG8_SB(1, 1), cB + hstep + kstep, voffB);
        PG8_WAIT_V(6); PG8_BAR;
    } else {
        PG8_STAGE(PG8_SB(0, 0), cB, voffB); PG8_STAGE(PG8_SA(0, 0), cA, voffA); PG8_STAGE(PG8_SB(0, 1), cB + hstep, voffB); PG8_STAGE(PG8_SA(0, 1), cA + hstep, voffA);
        if (wr == 1) PG8_BAR;
        PG8_WAIT_V(4); PG8_BAR;
        PG8_STAGE(PG8_SB(1, 0), cB + kstep, voffB); PG8_STAGE(PG8_SA(1, 0), cA + kstep, voffA); PG8_STAGE(PG8_SB(1, 1), cB + hstep + kstep, voffB);
        PG8_WAIT_V(6); PG8_BAR;
    }
    for (;;) {
        const bool has_next = S.next(ui + 1, nxt);
        const char* nA = has_next ? (const char*)g.A + (size_t)nxt.pm * tstep : cA; const char* nB = has_next ? (const char*)g.Bt + (size_t)nxt.pn * tstep : cB;
        for (int t = 0; t < nt; t += 2) {
            const bool last = (t == nt - 2);
            const char* a1 = cA + (size_t)(t + 1) * kstep;
            const char* a2 = last ? nA : cA + (size_t)(t + 2) * kstep; const char* b2 = last ? nB : cB + (size_t)(t + 2) * kstep;
            const char* a3 = a2 + kstep; const char* b3 = b2 + kstep;
            if (last && has_next) S.a_ready(nxt);
            if constexpr (SP2) {
            PG8_LDB(B0, 0, 0); PG8_LDB(B1, 0, 1); PG8_SCHED; PG8_LDA(At, 0, 0); PG8_STAGE(PG8_SA(1, 1), a1 + hstep, voffA);
            PG8_WAIT_V(8); PG8_WAIT_L(0); PG8_BAR; PG8_MMA(0, 0, At, B0); PG8_MMA(0, 1, At, B1); PG8_BAR; PG8_SCHED;
            PG8_LDA(At, 0, 1); PG8_STAGE(PG8_SB(0, 0), b2, voffB); PG8_STAGE(PG8_SB(0, 1), b2 + hstep, voffB); PG8_STAGE(PG8_SA(0, 0), a2, voffA);
            PG8_WAIT_V(8); PG8_WAIT_L(0); PG8_BAR; PG8_MMA(1, 0, At, B0); PG8_MMA(1, 1, At, B1); PG8_BAR; PG8_SCHED;
            PG8_LDB(B0, 1, 0); PG8_LDB(B1, 1, 1); PG8_SCHED; PG8_LDA(At, 1, 0); PG8_STAGE(PG8_SA(0, 1), a2 + hstep, voffA);
            PG8_WAIT_V(8); PG8_WAIT_L(0); PG8_BAR; PG8_MMA(0, 0, At, B0); PG8_MMA(0, 1, At, B1); PG8_BAR; PG8_SCHED;
            PG8_LDA(At, 1, 1); PG8_STAGE(PG8_SB(1, 0), b3, voffB); PG8_STAGE(PG8_SB(1, 1), b3 + hstep, voffB); PG8_STAGE(PG8_SA(1, 0), a3, voffA);
            PG8_WAIT_V(8); PG8_WAIT_L(0); PG8_BAR; PG8_MMA(1, 0, At, B0); PG8_MMA(1, 1, At, B1); PG8_BAR; PG8_SCHED;
            } else {
            PG8_LDB(B0, 0, 0); PG8_SCHED; PG8_LDA(At, 0, 0); PG8_STAGE(PG8_SA(1, 1), a1 + hstep, voffA);
            PG8_WAIT_L(8); PG8_BAR; PG8_WAIT_L(0); PG8_MMA(0, 0, At, B0); PG8_BAR; PG8_SCHED;
            PG8_LDB(B1, 0, 1); PG8_STAGE(PG8_SB(0, 0), b2, voffB);
            PG8_BAR; PG8_WAIT_L(0); PG8_MMA(0, 1, At, B1); PG8_BAR;
            PG8_LDA(At, 0, 1); PG8_STAGE(PG8_SA(0, 0), a2, voffA);
            PG8_BAR; PG8_WAIT_L(0); PG8_MMA(1, 0, At, B0); PG8_BAR; PG8_SCHED;
            PG8_STAGE(PG8_SB(0, 1), b2 + hstep, voffB);
            PG8_WAIT_V(6); PG8_BAR; PG8_MMA(1, 1, At, B1); PG8_BAR;
            PG8_LDB(B0, 1, 0); PG8_SCHED; PG8_LDA(At, 1, 0); PG8_STAGE(PG8_SA(0, 1), a2 + hstep, voffA);
            PG8_WAIT_L(8); PG8_BAR; PG8_WAIT_L(0); PG8_MMA(0, 0, At, B0); PG8_BAR; PG8_SCHED;
            PG8_LDB(B1, 1, 1); PG8_STAGE(PG8_SB(1, 0), b3, voffB);
            PG8_BAR; PG8_WAIT_L(0); PG8_MMA(0, 1, At, B1); PG8_BAR;
            PG8_LDA(At, 1, 1); PG8_STAGE(PG8_SA(1, 0), a3, voffA);
            PG8_BAR; PG8_WAIT_L(0); PG8_MMA(1, 0, At, B0); PG8_BAR; PG8_SCHED;
            PG8_STAGE(PG8_SB(1, 1), b3 + hstep, voffB);
            PG8_WAIT_V(6); PG8_BAR; PG8_MMA(1, 1, At, B1); PG8_BAR;
            }
        }
        if constexpr (ALIGN_EPI) { if (wr == 0) PG8_BAR; }
        if constexpr (!Epi::AFTER_DRAIN) { E(acc, cur, wr, wc, fr, fq); S.done(cur); }
        if (!has_next) break;
#pragma unroll
        for (int a = 0; a < 2; ++a)
#pragma unroll
            for (int b = 0; b < 2; ++b)
#pragma unroll
                for (int m = 0; m < 4; ++m)
#pragma unroll
                    for (int n = 0; n < 2; ++n) acc[a][b][m][n] = (f32x4){0.f, 0.f, 0.f, 0.f};
        cur = nxt; cA = nA; cB = nB; ++ui;
        if constexpr (ALIGN_EPI) { if (wr == 1) PG8_BAR; }
    }
    PG8_WAIT_V(0);
    if constexpr (!ALIGN_EPI) { if (wr == 0) PG8_BAR; }
    PG8_BAR;
    if constexpr (Epi::AFTER_DRAIN) { E.fused(acc, cur, wr, wc, fr, fq, lds, wid, lane); S.done(cur); }
#undef PG8_SA
#undef PG8_SB
#undef PG8_STAGE
#undef PG8_LDA
#undef PG8_LDB
#undef PG8_MMA
#undef PG8_WAIT_V
#undef PG8_WAIT_L
#undef PG8_BAR
#undef PG8_SCHED
}
}
namespace att {
using pg8::bf16_t; using pg8::bf16x8; using pg8::f32x4; using pg8::u32x4; using pg8::u32x2; using pg8::cvt_pk_bf16; using pg8::QKW; using pg8::VT_PITCH;
typedef float f32x16 __attribute__((ext_vector_type(16)));
#define ALAS __attribute__((address_space(3)))
constexpr int OFF_K0 = 0, OFF_K1 = 8192, OFF_V = 16384, STAGE = 32768, NSTG = 4, OFF_LUT = NSTG * STAGE;
constexpr int LUTW = 448, LUTC = 224;
constexpr int OFF_SUB = OFF_LUT + 12 * LUTW * 4;
constexpr int ATT_LDS = OFF_SUB + 512;
__device__ __forceinline__ int pi32(int r) { return (r & ~12) | ((r & 4) << 1) | ((r & 8) >> 1); }
__device__ __forceinline__ int t5_bucket(int rel) {
    const int n = rel < 0 ? -rel : rel;
    int b = n < 8 ? n : (n < 12 ? 8 : n < 16 ? 9 : n < 23 ? 10 : n < 32 ? 11 : n < 46 ? 12 : n < 64 ? 13 : n < 91 ? 14 : 15);
    return b + (rel > 0 ? 16 : 0);
}

__device__ __forceinline__ void glds16(const void* gsrc, unsigned lds_dst) { unsigned keep;
    asm volatile("s_mov_b32 %0, m0\n\ts_mov_b32 m0, %2\n\ts_nop 0\n\tglobal_load_lds_dwordx4 %1, off\n\ts_mov_b32 m0, %0" : "=&s"(keep) : "v"(gsrc), "s"(lds_dst) : "memory"); }
typedef float f32x2_t __attribute__((ext_vector_type(2))); typedef __bf16 bf16x2_t __attribute__((ext_vector_type(2)));
__device__ __forceinline__ unsigned cvtpk_s(float lo, float hi) { f32x2_t v = {lo, hi}; bf16x2_t b = __builtin_convertvector(v, bf16x2_t); return __builtin_bit_cast(unsigned, b); }
template <int N> __device__ __forceinline__ void wait_bar() { asm volatile("s_waitcnt vmcnt(%0) lgkmcnt(0)\n\ts_barrier" :: "n"(N) : "memory"); }

template <bool WIN>
__device__ __forceinline__ void attn_unit(ALAS unsigned char* lds, const bf16_t* __restrict__ QK, const bf16_t* __restrict__ VT, bf16_t* __restrict__ Y,
                                          const float* __restrict__ rel_bias, const float* __restrict__ sinkp, const float* __restrict__ subln, float lam,
                                          int seq_base, int S, int q0, int hsel) {
    constexpr float LOG2E = 1.4426950408889634f;
    constexpr int NDB = WIN ? 2 : 4;
    const int tid = threadIdx.x, lane = tid & 63, l31 = lane & 31, hi = lane >> 5;
    const int wid = __builtin_amdgcn_readfirstlane(tid >> 6), half = wid >> 2, wq = wid & 3;
    const int qw = q0 + 32 * wq;
    int qcol, kcol0, kcol1, vrow0, bhead;
    if (WIN) { qcol = (2 * hsel + half) * 64; kcol0 = 512 + (hsel >> 1) * 64; kcol1 = kcol0; vrow0 = (hsel >> 1) * 64; bhead = 2 * hsel; }
    else { qcol = 640 + (2 * hsel + half) * 64; kcol0 = 1152 + (2 * hsel) * 64; kcol1 = kcol0 + 64; vrow0 = 128 + hsel * 128; bhead = 8 + hsel; }
    const ALAS float* lut = (const ALAS float*)(lds + OFF_LUT) + (WIN ? (bhead + half) : bhead) * LUTW;

    const int t_lo = WIN ? (q0 >= 128 ? (q0 - 128) / 64 : 0) : 0;
    const int t_hi = WIN ? ((q0 + 256) / 64 < S / 64 ? (q0 + 256) / 64 : S / 64) : S / 64;
    const int NT = t_hi - t_lo;
    const unsigned ldsb = (unsigned)(uintptr_t)lds;
    const int drow = 8 * wid + (lane >> 3), dch = (lane & 7) ^ ((4 * wid + (lane >> 4)) & 7);
    const bf16_t* kg = QK + ((size_t)((seq_base >> 6) + t_lo) * 26 * 64 + drow) * 64 + dch * 8 + kcol0 * 64;
    const bf16_t* vg = VT + ((size_t)((seq_base >> 6) + t_lo) * 640 + vrow0 + drow) * 64 + dch * 8;
    const unsigned dk = ldsb + wid * 1024;
#define AT_DMA(tr) do { const unsigned sb_ = (unsigned)__builtin_amdgcn_readfirstlane(dk + (((tr) & (NSTG - 1)) * STAGE)); const size_t ko_ = (size_t)(tr) * 26 * 4096, vo_ = (size_t)(tr) * 640 * 64; \
        glds16(kg + ko_, sb_ + OFF_K0); if (!WIN) glds16(kg + ko_ + 4096, sb_ + OFF_K1); glds16(vg + vo_, sb_ + OFF_V); if (!WIN) glds16(vg + vo_ + 64 * 64, sb_ + OFF_V + 8192); } while (0)
    constexpr int NPW = WIN ? 2 : 4;
    bf16x8 qfr[4];
    { const int qrow = seq_base + qw + l31; const bf16_t* qp = QK + ((size_t)((qrow >> 6) * 26 + (qcol >> 6)) * 64 + (qrow & 63)) * 64 + hi * 8;
#pragma unroll
      for (int ds = 0; ds < 4; ++ds) qfr[ds] = *(const bf16x8*)(qp + ds * 16); }
#define qf(ds) qfr[ds]
    AT_DMA(0); if (NT > 1) AT_DMA(1); if (NT > 2) AT_DMA(2);
    constexpr float THR = 8.0f;
    float m_ref = WIN ? sinkp[2 * hsel + half] * LOG2E : 0.f;
    float l_run = (WIN && hi == 0) ? 1.f : 0.f;
    float cbase = 0.f;
    f32x16 cvec;
#pragma unroll
    for (int r = 0; r < 16; ++r) cvec[r] = cbase - m_ref;
    f32x16 o[NDB];
#pragma unroll
    for (int db = 0; db < NDB; ++db)
#pragma unroll
        for (int r = 0; r < 16; ++r) o[db][r] = 0.f;
    const int krow = pi32(l31), fK = (krow >> 1) & 7, fV = (l31 >> 1) & 7;
    int kx[4], vx[4];
#pragma unroll
    for (int c = 0; c < 4; ++c) { kx[c] = (WIN ? OFF_K0 : (half ? OFF_K1 : OFF_K0)) + krow * 128 + (((2 * c + hi) ^ fK) << 4); vx[c] = OFF_V + l31 * 128 + (((2 * c + hi) ^ fV) << 4); }
    const int qabs = qw + l31;
    const float cfar_lo = __uint_as_float(__builtin_amdgcn_readfirstlane(__float_as_uint(lut[0]))), cfar_hi = __uint_as_float(__builtin_amdgcn_readfirstlane(__float_as_uint(lut[LUTW - 1])));
    asm volatile("" : "+v"(qfr[0]), "+v"(qfr[1]), "+v"(qfr[2]), "+v"(qfr[3]));
#pragma clang loop unroll(disable)
    for (int tr = 0; tr < NT; ++tr) {
        if (tr + 2 < NT) wait_bar<2 * NPW>(); else if (tr + 1 < NT) wait_bar<NPW>(); else wait_bar<0>();
        if (tr + 3 < NT) AT_DMA(tr + 3);
        const int k0 = (t_lo + tr) * 64;
        const bool skip = WIN && (k0 > qw + 31 + 128 || k0 + 63 < qw - 128);
        if (!skip) {
            const bool near = WIN || ((k0 - (qw + 31)) < 128 && (qw - (k0 + 63)) < 128);
            const float cinit = near ? 0.f : (k0 > qw ? cfar_hi : cfar_lo);
            if (__builtin_expect(cinit != cbase, 0)) { cbase = cinit; asm volatile("" ::: "memory");
#pragma unroll
                for (int r = 0; r < 16; ++r) cvec[r] = cbase - m_ref; }
            f32x16 s0, s1;
            const ALAS unsigned char* sb = lds + (tr & (NSTG - 1)) * STAGE;
            {
                bf16x8 ka[8];
#pragma unroll
                for (int ds = 0; ds < 4; ++ds) { ka[2 * ds] = *(const ALAS bf16x8*)(sb + kx[ds]); ka[2 * ds + 1] = *(const ALAS bf16x8*)(sb + kx[ds] + 4096); }
                __builtin_amdgcn_sched_barrier(0);
                s0 = __builtin_amdgcn_mfma_f32_32x32x16_bf16(ka[0], qf(0), cvec, 0, 0, 0);
                s1 = __builtin_amdgcn_mfma_f32_32x32x16_bf16(ka[1], qf(0), cvec, 0, 0, 0);
#pragma unroll
                for (int ds = 1; ds < 4; ++ds) {
                    s0 = __builtin_amdgcn_mfma_f32_32x32x16_bf16(ka[2 * ds], qf(ds), s0, 0, 0, 0);
                    s1 = __builtin_amdgcn_mfma_f32_32x32x16_bf16(ka[2 * ds + 1], qf(ds), s1, 0, 0, 0);
                }
            }
            bf16x8 va[2 * NDB], vc[2 * NDB];
#pragma unroll
            for (int kk = 0; kk < 2; ++kk)
#pragma unroll
                for (int db = 0; db < NDB; ++db) va[kk * NDB + db] = *(const ALAS bf16x8*)(sb + vx[kk] + db * 4096);
            __builtin_amdgcn_sched_barrier(0);
            if (near) {
                const ALAS float* lb = lut + (k0 + 8 * hi - qabs + LUTC);
#pragma unroll
                for (int r = 0; r < 16; ++r) { s0[r] += lb[16 * (r >> 3) + (r & 7)]; s1[r] += lb[32 + 16 * (r >> 3) + (r & 7)];
                    if ((r & 7) == 7) __builtin_amdgcn_sched_barrier(0); }
            }
#define MX3(a, b, c) __builtin_fmaxf(__builtin_fmaxf((a), (b)), (c))
            float mxa = MX3(s0[0], s0[1], s1[0]), mxb = MX3(s0[2], s0[3], s1[1]);
            mxa = MX3(mxa, s1[2], s1[3]);
#pragma unroll
            for (int r = 4; r < 16; r += 4) { mxa = MX3(mxa, s0[r], s0[r + 1]); mxb = MX3(mxb, s0[r + 2], s0[r + 3]); mxa = MX3(mxa, s1[r], s1[r + 1]); mxb = MX3(mxb, s1[r + 2], s1[r + 3]); }
#undef MX3
            float mx = fmaxf(mxa, mxb);
            if (__any(mx > THR)) {
                mx = fmaxf(mx, __shfl_xor(mx, 32));
                const float dl = fmaxf(mx, 0.f);
                m_ref += dl;
                const float f = __builtin_amdgcn_exp2f(-dl);
                l_run *= f;
#pragma unroll
                for (int db = 0; db < NDB; ++db)
#pragma unroll
                    for (int r = 0; r < 16; ++r) o[db][r] *= f;
#pragma unroll
                for (int r = 0; r < 16; ++r) { s0[r] -= dl; s1[r] -= dl; cvec[r] = cbase - m_ref; }
            }
            float ls0 = 0.f, ls1 = 0.f;
#define AT_EXP(SS, B, PF) do { \
                const float e0 = __builtin_amdgcn_exp2f(SS[B + 0]), e1 = __builtin_amdgcn_exp2f(SS[B + 1]), e2 = __builtin_amdgcn_exp2f(SS[B + 2]), e3 = __builtin_amdgcn_exp2f(SS[B + 3]); \
                const float e4 = __builtin_amdgcn_exp2f(SS[B + 4]), e5 = __builtin_amdgcn_exp2f(SS[B + 5]), e6 = __builtin_amdgcn_exp2f(SS[B + 6]), e7 = __builtin_amdgcn_exp2f(SS[B + 7]); \
                ls0 += e0; ls1 += e4; ls0 += e1; ls1 += e5; ls0 += e2; ls1 += e6; ls0 += e3; ls1 += e7; \
                PF.u.x = cvtpk_s(e0, e1); PF.u.y = cvtpk_s(e2, e3); PF.u.z = cvtpk_s(e4, e5); PF.u.w = cvtpk_s(e6, e7); } while (0)
            union PFU { u32x4 u; bf16x8 b; };
            PFU p0, p1, p2, p3;
            AT_EXP(s0, 0, p0);
#pragma unroll
            for (int kk = 0; kk < 2; ++kk)
#pragma unroll
                for (int db = 0; db < NDB; ++db) vc[kk * NDB + db] = *(const ALAS bf16x8*)(sb + vx[kk + 2] + db * 4096);
            __builtin_amdgcn_sched_barrier(0);
#pragma unroll
            for (int db = 0; db < NDB; ++db) o[db] = __builtin_amdgcn_mfma_f32_32x32x16_bf16(va[db], p0.b, o[db], 0, 0, 0);
            AT_EXP(s0, 8, p1);
            __builtin_amdgcn_sched_barrier(0);
#pragma unroll
            for (int db = 0; db < NDB; ++db) o[db] = __builtin_amdgcn_mfma_f32_32x32x16_bf16(va[NDB + db], p1.b, o[db], 0, 0, 0);
            AT_EXP(s1, 0, p2);
            __builtin_amdgcn_sched_barrier(0);
#pragma unroll
            for (int db = 0; db < NDB; ++db) o[db] = __builtin_amdgcn_mfma_f32_32x32x16_bf16(vc[db], p2.b, o[db], 0, 0, 0);
            AT_EXP(s1, 8, p3);
            __builtin_amdgcn_sched_barrier(0);
#pragma unroll
            for (int db = 0; db < NDB; ++db) o[db] = __builtin_amdgcn_mfma_f32_32x32x16_bf16(vc[NDB + db], p3.b, o[db], 0, 0, 0);
            __builtin_amdgcn_sched_barrier(0);
#undef AT_EXP
            l_run += ls0 + ls1;
        }
    }
    asm volatile("s_waitcnt lgkmcnt(0)\n\ts_barrier" ::: "memory");
#undef qf
#undef AT_DMA
    const float l_tot = l_run + __shfl_xor(l_run, 32);
    const float inv = 1.0f / l_tot;
    const size_t orow = (size_t)(seq_base + qw + l31) * 1024;
    if (WIN) {
        bf16_t* yp = Y + orow + (2 * hsel + half) * 64 + 8 * hi;
#pragma unroll
        for (int db = 0; db < NDB; ++db)
#pragma unroll
            for (int p = 0; p < 2; ++p) {
                u32x2 w0, w1;
                w0.x = cvt_pk_bf16(o[db][8 * p] * inv, o[db][8 * p + 1] * inv); w0.y = cvt_pk_bf16(o[db][8 * p + 2] * inv, o[db][8 * p + 3] * inv);
                w1.x = cvt_pk_bf16(o[db][8 * p + 4] * inv, o[db][8 * p + 5] * inv); w1.y = cvt_pk_bf16(o[db][8 * p + 6] * inv, o[db][8 * p + 7] * inv);
                const u32x2 snd = hi ? w0 : w1, mine = hi ? w1 : w0;
                u32x2 rcv; rcv.x = (unsigned)__shfl_xor((int)snd.x, 32); rcv.y = (unsigned)__shfl_xor((int)snd.y, 32);
                u32x4 ow; if (hi) { ow.x = rcv.x; ow.y = rcv.y; ow.z = mine.x; ow.w = mine.y; } else { ow.x = mine.x; ow.y = mine.y; ow.z = rcv.x; ow.w = rcv.y; }
                *(u32x4*)(yp + 32 * db + 16 * p) = ow;
            }
    } else {
        ALAS f32x4* xch = (ALAS f32x4*)lds + (size_t)wq * 1024 + l31;
        if (half == 1) {
#pragma unroll
            for (int db = 0; db < NDB; ++db)
#pragma unroll
                for (int g = 0; g < 4; ++g) { f32x4 v; v[0] = o[db][4 * g] * inv; v[1] = o[db][4 * g + 1] * inv; v[2] = o[db][4 * g + 2] * inv; v[3] = o[db][4 * g + 3] * inv;
                    xch[(8 * db + 2 * g + hi) * 32] = v; }
        }
        __syncthreads();
        if (half == 0) {
            float ss = 0.f;
#pragma unroll
            for (int db = 0; db < NDB; ++db)
#pragma unroll
                for (int g = 0; g < 4; ++g) { const f32x4 v = xch[(8 * db + 2 * g + hi) * 32];
#pragma unroll
                    for (int i = 0; i < 4; ++i) { const float x = o[db][4 * g + i] * inv - lam * v[i]; o[db][4 * g + i] = x; ss += x * x; } }
            ss += __shfl_xor(ss, 32);
            const float rn = __builtin_amdgcn_rsqf(ss * (1.0f / 128.0f) + 1e-6f) * 0.8f;
            bf16_t* yp = Y + orow + 512 + hsel * 128 + 8 * hi;
#pragma unroll
            for (int db = 0; db < NDB; ++db)
#pragma unroll
                for (int p = 0; p < 2; ++p) {
                    const f32x4 ga = *(const ALAS f32x4*)(lds + OFF_SUB + (32 * db + 16 * p + 4 * hi) * 4), gb = *(const ALAS f32x4*)(lds + OFF_SUB + (32 * db + 16 * p + 8 + 4 * hi) * 4);
                    u32x2 w0, w1;
                    w0.x = cvt_pk_bf16(o[db][8 * p] * rn * ga[0], o[db][8 * p + 1] * rn * ga[1]); w0.y = cvt_pk_bf16(o[db][8 * p + 2] * rn * ga[2], o[db][8 * p + 3] * rn * ga[3]);
                    w1.x = cvt_pk_bf16(o[db][8 * p + 4] * rn * gb[0], o[db][8 * p + 5] * rn * gb[1]); w1.y = cvt_pk_bf16(o[db][8 * p + 6] * rn * gb[2], o[db][8 * p + 7] * rn * gb[3]);
                    const u32x2 snd = hi ? w0 : w1, mine = hi ? w1 : w0;
                    u32x2 rcv; rcv.x = (unsigned)__shfl_xor((int)snd.x, 32); rcv.y = (unsigned)__shfl_xor((int)snd.y, 32);
                    u32x4 ow; if (hi) { ow.x = rcv.x; ow.y = rcv.y; ow.z = mine.x; ow.w = mine.y; } else { ow.x = mine.x; ow.y = mine.y; ow.z = rcv.x; ow.w = rcv.y; }
                    *(u32x4*)(yp + 32 * db + 16 * p) = ow;
                }
        }
        __syncthreads();
    }
}

__device__ __forceinline__ void attn_phase(ALAS unsigned char* lds, const bf16_t* QK, const bf16_t* VT, bf16_t* Y, const float* rel_bias, const float* sinkp, const float* subln, const float* blam) {
    float lam;
    { const int lane = threadIdx.x & 63; float a = blam[lane] * blam[64 + lane], b = blam[128 + lane] * blam[192 + lane];
#pragma unroll
      for (int o = 1; o < 64; o <<= 1) { a += __shfl_xor(a, o); b += __shfl_xor(b, o); }
      lam = __expf(a) - __expf(b) + 0.2f; }
    { constexpr float LOG2E = 1.4426950408889634f; ALAS float* lutw = (ALAS float*)(lds + OFF_LUT);
      for (int i = threadIdx.x; i < 12 * LUTW; i += 512) { const int hh = i / LUTW, ri = i - hh * LUTW, rel = ri - LUTC;
        lutw[i] = (hh < 8 && (rel < -128 || rel > 128)) ? -1e30f : rel_bias[t5_bucket(rel) * 12 + hh] * LOG2E; }
      if (threadIdx.x < 128) ((ALAS float*)(lds + OFF_SUB))[threadIdx.x] = subln[threadIdx.x];
      __syncthreads(); }
    const int G = gridDim.x, bx = blockIdx.x;
    if (__builtin_amdgcn_readfirstlane((int)threadIdx.x) >= 256) __builtin_amdgcn_s_setprio(1);
    if (G == 256) {
        const int x = bx & 7, j = bx >> 3;
        for (int r = 0; r < 8; ++r) { const int bh = x + 8 * (r >> 1), qb = j + 32 * (r & 1);
            attn_unit<false>(lds, QK, VT, Y, rel_bias, sinkp, subln, lam, (bh >> 2) * 8192, 8192, qb * 128, bh & 3); }
        for (int r = 0; r < 8; ++r) { const int bh = x + 8 * ((j >> 4) + 2 * r), qb = j & 15;
            attn_unit<false>(lds, QK, VT, Y, rel_bias, sinkp, subln, lam, 65536 + (bh >> 2) * 2048, 2048, qb * 128, bh & 3); }
    } else {
    for (int u = bx; u < 2048; u += G) { const int qb = u & 63, bh = u >> 6; attn_unit<false>(lds, QK, VT, Y, rel_bias, sinkp, subln, lam, (bh >> 2) * 8192, 8192, qb * 128, bh & 3); }
    for (int u = bx; u < 2048; u += G) { const int qb = u & 15, bh = u >> 4; attn_unit<false>(lds, QK, VT, Y, rel_bias, sinkp, subln, lam, 65536 + (bh >> 2) * 2048, 2048, qb * 128, bh & 3); }
    }
    for (int u = bx; u < 4096; u += G) { const int hp = u & 3, qb = u >> 2;
        const int row0 = qb * 128; int seq_base, S;
        if (row0 < 65536) { seq_base = row0 & ~8191; S = 8192; } else { seq_base = row0 & ~2047; S = 2048; }
        attn_unit<true>(lds, QK, VT, Y, rel_bias, sinkp, subln, lam, seq_base, S, row0 - seq_base, hp); }
    __builtin_amdgcn_s_setprio(0);
}
}

namespace cv {
using pg8::bf16_t; using pg8::f32x4; using pg8::u32x4; using pg8::cvt_pk_bf16; using pg8::bf_lo; using pg8::bf_hi; using pg8::fast_sigmoid;
#define CLAS __attribute__((address_space(3)))
constexpr int T = 32, HALO = 15, ROWS = T + 2 * HALO;
constexpr int OFF_U0 = 0, OFF_U1 = 64 * 1024;
constexpr int CONV_LDS = OFF_U1 + T * 512 * 4;
__device__ __forceinline__ void conv_unit(CLAS unsigned char* lds, const bf16_t* __restrict__ PC, bf16_t* __restrict__ YC, const float* __restrict__ w3, const float* __restrict__ w31,
                                          const float* __restrict__ dwb, const float* __restrict__ lng, const float* __restrict__ lnb, int seq_base, int S, int t0) {
    const int tid = threadIdx.x;
    {
        u32x4 w8[8];
#pragma unroll
        for (int it = 0; it < 8; ++it) { const int idx = tid + 512 * it, j = idx >> 6, v = idx & 63, tok = t0 - HALO + j;
            w8[it] = (u32x4){0u, 0u, 0u, 0u};
            if (idx < ROWS * 64 && tok >= 0 && tok < S) w8[it] = *(const u32x4*)(PC + (size_t)(seq_base + tok) * 1536 + 1024 + v * 8); }
#pragma unroll
        for (int it = 0; it < 8; ++it) { const int idx = tid + 512 * it, j = idx >> 6, v = idx & 63;
            if (idx < ROWS * 64) *(CLAS u32x4*)(lds + OFF_U0 + j * 1024 + v * 16) = w8[it]; }
    }
    __syncthreads();
    const int cp = tid & 255, th = tid >> 8;
    {
        const float wa0 = w3[2 * cp], wa1 = w3[512 + 2 * cp], wa2 = w3[1024 + 2 * cp];
        const float wb0 = w3[2 * cp + 1], wb1 = w3[512 + 2 * cp + 1], wb2 = w3[1024 + 2 * cp + 1];
        const int tb = t0 + 16 * th;
        unsigned pw[18], gw[16];
#pragma unroll
        for (int i = 0; i < 18; ++i) { const int tok = tb - 1 + i; pw[i] = 0u; if (tok >= 0 && tok < S) pw[i] = *(const unsigned*)(PC + (size_t)(seq_base + tok) * 1536 + 512 + 2 * cp); }
#pragma unroll
        for (int i = 0; i < 16; ++i) gw[i] = *(const unsigned*)(PC + (size_t)(seq_base + tb + i) * 1536 + 2 * cp);
#pragma unroll
        for (int i = 0; i < 16; ++i) {
            const float ya = bf_lo(gw[i]) * (wa0 * bf_lo(pw[i]) + wa1 * bf_lo(pw[i + 1]) + wa2 * bf_lo(pw[i + 2]));
            const float yb = bf_hi(gw[i]) * (wb0 * bf_hi(pw[i]) + wb1 * bf_hi(pw[i + 1]) + wb2 * bf_hi(pw[i + 2]));
            *(unsigned*)(YC + (size_t)(seq_base + tb + i) * 1024 + 2 * cp) = cvt_pk_bf16(ya, yb);
        }
    }
    {
        float wa[31], wb[31];
#pragma unroll
        for (int j = 0; j < 31; ++j) { wa[j] = w31[j * 512 + 2 * cp]; wb[j] = w31[j * 512 + 2 * cp + 1]; }
        const float ba = dwb[2 * cp], bb = dwb[2 * cp + 1];
        for (int g4 = 0; g4 < 4; ++g4) {
            const int tt = 16 * th + 4 * g4;
            float aa[4], ab[4];
#pragma unroll
            for (int k = 0; k < 4; ++k) { aa[k] = ba; ab[k] = bb; }
            const CLAS unsigned char* up = lds + OFF_U0 + tt * 1024 + cp * 4;
#pragma unroll
            for (int rr = 0; rr < 34; ++rr) {
                const unsigned w = *(const CLAS unsigned*)(up + rr * 1024);
                const float xa = bf_lo(w), xb = bf_hi(w);
#pragma unroll
                for (int k = 0; k < 4; ++k) { const int j = rr - k; if (j >= 0 && j < 31) { aa[k] += wa[j] * xa; ab[k] += wb[j] * xb; } }
            }
#pragma unroll
            for (int k = 0; k < 4; ++k) { typedef float f32x2 __attribute__((ext_vector_type(2))); *(CLAS f32x2*)(lds + OFF_U1 + (tt + k) * 2048 + cp * 8) = (f32x2){aa[k], ab[k]}; }
        }
    }
    __syncthreads();
    {
        const int lane = tid & 63, wid = tid >> 6;
        const f32x4 g0 = *(const f32x4*)(lng + 8 * lane), g1 = *(const f32x4*)(lng + 8 * lane + 4), b0 = *(const f32x4*)(lnb + 8 * lane), b1 = *(const f32x4*)(lnb + 8 * lane + 4);
        for (int k = 0; k < 4; ++k) {
            const int tt = 4 * wid + k;
            const f32x4 x0 = *(const CLAS f32x4*)(lds + OFF_U1 + tt * 2048 + lane * 32), x1 = *(const CLAS f32x4*)(lds + OFF_U1 + tt * 2048 + lane * 32 + 16);
            float s = ((x0[0] + x0[1]) + (x0[2] + x0[3])) + ((x1[0] + x1[1]) + (x1[2] + x1[3]));
#pragma unroll
            for (int o = 1; o < 64; o <<= 1) s += __shfl_xor(s, o);
            const float mean = s * (1.0f / 512.0f);
            const f32x4 d0 = x0 - mean, d1 = x1 - mean;
            float q = ((d0[0] * d0[0] + d0[1] * d0[1]) + (d0[2] * d0[2] + d0[3] * d0[3])) + ((d1[0] * d1[0] + d1[1] * d1[1]) + (d1[2] * d1[2] + d1[3] * d1[3]));
#pragma unroll
            for (int o = 1; o < 64; o <<= 1) q += __shfl_xor(q, o);
            const float rstd = __builtin_amdgcn_rsqf(q * (1.0f / 512.0f) + 1e-6f);
            f32x4 y0 = d0 * rstd * g0 + b0, y1 = d1 * rstd * g1 + b1;
#pragma unroll
            for (int i = 0; i < 4; ++i) { y0[i] = y0[i] * fast_sigmoid(y0[i]); y1[i] = y1[i] * fast_sigmoid(y1[i]); }
            u32x4 w; w.x = cvt_pk_bf16(y0[0], y0[1]); w.y = cvt_pk_bf16(y0[2], y0[3]); w.z = cvt_pk_bf16(y1[0], y1[1]); w.w = cvt_pk_bf16(y1[2], y1[3]);
            *(u32x4*)(YC + (size_t)(seq_base + t0 + tt) * 1024 + 512 + 8 * lane) = w;
        }
    }
    __syncthreads();
}
__device__ __forceinline__ void conv_phase(CLAS unsigned char* lds, const bf16_t* PC, bf16_t* YC, const float* w3, const float* w31, const float* dwb, const float* lng, const float* lnb) {
    for (int u = blockIdx.x; u < 131072 / T; u += gridDim.x) {
        const int row0 = u * T; int seq_base, S;
        if (row0 < 65536) { seq_base = row0 & ~8191; S = 8192; } else { seq_base = row0 & ~2047; S = 2048; }
        conv_unit(lds, PC, YC, w3, w31, dwb, lng, lnb, seq_base, S, row0 - seq_base);
    }
}
}

namespace mk {
using pg8::bf16_t; using pg8::f32x4; using pg8::u32x4; using pg8::u32x2; using pg8::cvt_pk_bf16;
#define MLAS __attribute__((address_space(3)))
constexpr int M = 131072, D = 1024, FF = 2816, NQKV = 2304, NCI = 2560;
constexpr size_t MiB = 1u << 20;
constexpr size_t WS_X = 0;
constexpr size_t WS_BIG = 256 * MiB;
constexpr size_t WS_VT = WS_BIG + (size_t)M * pg8::QKW * 2;
constexpr size_t WS_W = 960 * MiB;
constexpr size_t WS_WQKV = WS_W, WS_WO = WS_WQKV + (size_t)NQKV * D * 2, WS_WGU0 = WS_WO + (size_t)D * D * 2, WS_WGU1 = WS_WGU0 + (size_t)2 * FF * D * 2,
                 WS_WD0 = WS_WGU1 + (size_t)2 * FF * D * 2, WS_WD1 = WS_WD0 + (size_t)D * FF * 2, WS_WCI = WS_WD1 + (size_t)D * FF * 2, WS_WCO = WS_WCI + (size_t)NCI * D * 2;
constexpr size_t WS_SSQ = 1008 * MiB;
constexpr size_t WS_CTL = 1016 * MiB, CTL_BYTES = 16384;
constexpr size_t WS_END = WS_CTL + 65536;
static_assert(WS_VT + (size_t)640 * pg8::VT_PITCH * 2 <= WS_W && WS_BIG + (size_t)M * FF * 2 <= WS_W && WS_WCO + (size_t)D * D * 2 <= WS_SSQ, "ws map");
constexpr int MISC_OFF = 155648, LDS_BYTES = MISC_OFF + 256;
static_assert(att::ATT_LDS <= MISC_OFF && cv::CONV_LDS <= MISC_OFF && pg8::STAGE_BYTES + 16384 <= MISC_OFF, "lds map");

#define XB_TMO      128
#define XB_XCNT(j)  (256  + 64 * (j))
#define XB_XSUB(j)  (1280 + 64 * (j))
#define XB_XGEN(j)  (2304 + 64 * (j))
#define XB_TOP      3328
#define XB_TOPGEN   3392
#define XCD_BAR_WORDS 3456
#define XB_SPIN_CAP (1u << 18)

__device__ __forceinline__ unsigned xb_ld(unsigned* p)              { return __hip_atomic_load(p, __ATOMIC_RELAXED, __HIP_MEMORY_SCOPE_AGENT); }
__device__ __forceinline__ unsigned xb_add(unsigned* p, unsigned v) { return __hip_atomic_fetch_add(p, v, __ATOMIC_RELAXED, __HIP_MEMORY_SCOPE_AGENT); }
__device__ __forceinline__ unsigned xb_xcc_id() { return (unsigned)__builtin_amdgcn_s_getreg((3 << 11) | 20) & 0xFu; }
#define XB_SPIN(cond, bar) do { unsigned _sp = 0; while (cond) { __builtin_amdgcn_s_sleep(1); \
    if ((++_sp & 255u) == 0u) { if (xb_ld(&(bar)[XB_TMO])) break; if (_sp > XB_SPIN_CAP) { atomicAdd(&(bar)[XB_TMO], 1u); break; } } } } while (0)

struct XcdBarrier {
    unsigned* bar; unsigned x;
    volatile MLAS unsigned* st;
};

__device__ __forceinline__ XcdBarrier xcd_barrier_post(unsigned* bar, volatile MLAS unsigned* st) {
    XcdBarrier b; b.bar = bar; b.x = xb_xcc_id(); b.st = st;
    if (threadIdx.x == 0) (void)xb_add(&bar[XB_XCNT(b.x)], 1u);
    return b;
}
__device__ __forceinline__ void xcd_barrier_complete(unsigned* bar, unsigned x, unsigned& nloc, unsigned& nx) {
    const unsigned G = gridDim.x * gridDim.y * gridDim.z;
    unsigned sum, cnt, mine, sp = 0u;
    for (;;) {
        sum = 0u; cnt = 0u; mine = 0u;
#pragma unroll
        for (unsigned j = 0; j < 16; ++j) { const unsigned c = xb_ld(&bar[XB_XCNT(j)]); sum += c; cnt += (c > 0u) ? 1u : 0u; mine = (j == x) ? c : mine; }
        if (sum == G) break;
        __builtin_amdgcn_s_sleep(1);
        if ((++sp & 255u) == 0u) { if (xb_ld(&bar[XB_TMO])) break; if (sp > XB_SPIN_CAP) { atomicAdd(&bar[XB_TMO], 1u); break; } }
    }
    nloc = mine > 0u ? mine : 1u; nx = cnt > 0u ? cnt : 1u;
}

__device__ __forceinline__ void xcd_barrier(const XcdBarrier& b) {
    asm volatile("s_waitcnt vmcnt(0)" ::: "memory");
    __syncthreads();
    if (threadIdx.x == 0) {
        unsigned* bar = b.bar;
        __builtin_amdgcn_s_waitcnt(0);
        unsigned nloc = b.st[0], nx = b.st[1];
        if (nloc == 0u) { xcd_barrier_complete(bar, b.x, nloc, nx); b.st[0] = nloc; b.st[1] = nx; }
        const unsigned old = xb_add(&bar[XB_XSUB(b.x)], 1u);
        const unsigned gen = old / nloc;
        if (old + 1u == (gen + 1u) * nloc) {
            __builtin_amdgcn_fence(__ATOMIC_RELEASE, "agent");
            asm volatile("s_waitcnt vmcnt(0)" ::: "memory");
            const unsigned og = xb_add(&bar[XB_TOP], 1u);
            const unsigned tg = og / nx;
            if (og + 1u == (tg + 1u) * nx) xb_add(&bar[XB_TOPGEN], 1u);
            else XB_SPIN(xb_ld(&bar[XB_TOPGEN]) == tg, bar);
            __builtin_amdgcn_fence(__ATOMIC_ACQUIRE, "agent");
            xb_add(&bar[XB_XGEN(b.x)], 1u);
            asm volatile("s_waitcnt vmcnt(0)" ::: "memory");
        } else {
            XB_SPIN(xb_ld(&bar[XB_XGEN(b.x)]) == gen, bar);
            __builtin_amdgcn_fence(__ATOMIC_ACQUIRE, "agent");
            asm volatile("s_waitcnt vmcnt(0)" ::: "memory");
        }
    }
    __syncthreads();
}

static_assert(XCD_BAR_WORDS * 4 <= CTL_BYTES, "barrier words");
struct Params { const float* in[24]; float* out; unsigned char* ws; int ph_lo, ph_hi; };

__device__ __forceinline__ void tr_item(const float* __restrict__ W, int ldw, int srccol0, const float* __restrict__ gain, bf16_t* __restrict__ WT, int K, int destrow0, int k0, MLAS float* scr, int lane) {
    float wv[32];
#pragma unroll
    for (int i = 0; i < 32; ++i) { const int kk = 2 * i + (lane >> 5); wv[i] = __builtin_nontemporal_load(W + (size_t)(k0 + kk) * ldw + srccol0 + (lane & 31)); }
    const float g0 = gain ? gain[k0 + (lane & 31) * 2] : 1.0f, g1 = gain ? gain[k0 + (lane & 31) * 2 + 1] : 1.0f;
#pragma unroll
    for (int i = 0; i < 32; ++i) { const int kk = 2 * i + (lane >> 5); const float ga = __shfl(g0, i), gb = __shfl(g1, i); scr[kk * 33 + (lane & 31)] = wv[i] * ((lane >> 5) ? gb : ga); }
    asm volatile("s_waitcnt lgkmcnt(0)" ::: "memory");
    const int c = lane & 7;
#pragma unroll
    for (int j = 0; j < 4; ++j) { const int n = (lane >> 3) + 8 * j; const MLAS float* s = scr + (8 * c) * 33 + n;
        u32x4 o; o.x = cvt_pk_bf16(s[0 * 33], s[1 * 33]); o.y = cvt_pk_bf16(s[2 * 33], s[3 * 33]); o.z = cvt_pk_bf16(s[4 * 33], s[5 * 33]); o.w = cvt_pk_bf16(s[6 * 33], s[7 * 33]);
        *(u32x4*)(WT + (size_t)(destrow0 + n) * K + k0 + 8 * c) = o; }
    asm volatile("s_waitcnt lgkmcnt(0)" ::: "memory");
}

__device__ __forceinline__ void prologue(const Params& p, MLAS unsigned char* lds) {
    const int tid = threadIdx.x, lane = tid & 63, wave = tid >> 6;
    MLAS float* scr = (MLAS float*)(lds + wave * 16384);
    const int gw = blockIdx.x * 8 + wave, NGW = gridDim.x * 8;
    unsigned char* ws = p.ws;
    constexpr int I_QKV = (NQKV / 32) * (D / 64), I_O = (D / 32) * (D / 64), I_GU = (2 * FF / 32) * (D / 64), I_D = (D / 32) * (FF / 64), I_CI = (NCI / 32) * (D / 64);
    constexpr int NIT = I_QKV + I_O + 2 * I_GU + 2 * I_D + I_CI + I_O;
    for (int it = gw; it < NIT; it += NGW) {
        int r = it;
        if (r < I_QKV) { const int kb = r / (NQKV / 32), nb = r % (NQKV / 32); const int n0 = nb * 32, pn = n0 >> 8, within = n0 & 255, bj = within >> 7, wc = (within & 127) >> 5;
            tr_item(p.in[8], NQKV, 256 * pn + 64 * wc + 32 * bj, p.in[3], (bf16_t*)(ws + WS_WQKV), D, n0, kb * 64, scr, lane); continue; }
        r -= I_QKV;
        if (r < I_O) { const int kb = r / (D / 32), nb = r % (D / 32); tr_item(p.in[9], D, nb * 32, nullptr, (bf16_t*)(ws + WS_WO), D, nb * 32, kb * 64, scr, lane); continue; }
        r -= I_O;
        if (r < 2 * I_GU) { const int l = r / I_GU; r -= l * I_GU; const int kb = r / (2 * FF / 32), nb = r % (2 * FF / 32); const int n0 = nb * 32, pn = n0 >> 8, within = n0 & 255, bj = within >> 7, j = within & 127;
            const float* src = (bj ? p.in[6] : p.in[5]) + (size_t)l * D * FF;
            tr_item(src, FF, 128 * pn + j, p.in[4] + l * D, (bf16_t*)(ws + (l ? WS_WGU1 : WS_WGU0)), D, n0, kb * 64, scr, lane); continue; }
        r -= 2 * I_GU;
        if (r < 2 * I_D) { const int l = r / I_D; r -= l * I_D; const int kb = r / (D / 32), nb = r % (D / 32);
            tr_item(p.in[7] + (size_t)l * FF * D, D, nb * 32, nullptr, (bf16_t*)(ws + (l ? WS_WD1 : WS_WD0)), FF, nb * 32, kb * 64, scr, lane); continue; }
        r -= 2 * I_D;
        if (r < I_CI) { const int kb = r / (NCI / 32), nb = r % (NCI / 32); const int n0 = nb * 32, pn = n0 >> 8, within = n0 & 255, bj = within >> 7, j = within & 127;
            const int src = pn < 2 ? n0 : (pn < 6 ? (bj ? 1024 : 512) + 128 * (pn - 2) + j : (bj ? 2048 : 1536) + 128 * (pn - 6) + j);
            tr_item(p.in[17], NCI, src, p.in[3] + D, (bf16_t*)(ws + WS_WCI), D, n0, kb * 64, scr, lane); continue; }
        r -= I_CI;
        { const int kb = r / (D / 32), nb = r % (D / 32); tr_item(p.in[18], D, nb * 32, nullptr, (bf16_t*)(ws + WS_WCO), D, nb * 32, kb * 64, scr, lane); }
    }
    bf16_t* X = (bf16_t*)(ws + WS_X); float* ssq = (float*)(ws + WS_SSQ);
    for (int m0 = gw; m0 < M; m0 += 4 * NGW) {
        f32x4 v[4][4];
#pragma unroll
        for (int r = 0; r < 4; ++r) { const int m = m0 + r * NGW; if (m < M) { const float* xrow = (m < 65536) ? p.in[0] + (size_t)m * D : p.in[1] + (size_t)(m - 65536) * D; const f32x4* xr = (const f32x4*)xrow + lane;
#pragma unroll
            for (int j = 0; j < 4; ++j) v[r][j] = __builtin_nontemporal_load(xr + 64 * j); } }
#pragma unroll
        for (int r = 0; r < 4; ++r) { const int m = m0 + r * NGW; if (m < M) {
            float s = 0.f;
#pragma unroll
            for (int j = 0; j < 4; ++j) s += (v[r][j][0] * v[r][j][0] + v[r][j][1] * v[r][j][1]) + (v[r][j][2] * v[r][j][2] + v[r][j][3] * v[r][j][3]);
#pragma unroll
            for (int o = 1; o < 64; o <<= 1) s += __shfl_xor(s, o);
            u32x2* o8 = (u32x2*)(X + (size_t)m * D) + lane;
#pragma unroll
            for (int j = 0; j < 4; ++j) { u32x2 w; w.x = cvt_pk_bf16(v[r][j][0], v[r][j][1]); w.y = cvt_pk_bf16(v[r][j][2], v[r][j][3]); o8[64 * j] = w; }
            if (lane < 16) ssq[(size_t)m * 16 + lane] = (lane == 0) ? s : 0.f; } }
    }
}

__global__ void __launch_bounds__(512, 2) fwd_kernel(Params p) {
    extern __shared__ __attribute__((aligned(16))) unsigned char lds_raw[];
    MLAS unsigned char* lds = (MLAS unsigned char*)lds_raw;
    cg::grid_group grid = cg::this_grid();
    unsigned char* ws = p.ws;
    bf16_t* X = (bf16_t*)(ws + WS_X); bf16_t* BIG = (bf16_t*)(ws + WS_BIG); bf16_t* VT = (bf16_t*)(ws + WS_VT); float* ssq = (float*)(ws + WS_SSQ);
    bf16_t* Y = (bf16_t*)p.out;
    const int lo = p.ph_lo, hi = p.ph_hi, G = gridDim.x, bx = blockIdx.x;
    volatile MLAS unsigned* misc = (volatile MLAS unsigned*)(lds + MISC_OFF);
    if (threadIdx.x < 2) misc[threadIdx.x] = 0u;
    __syncthreads();
    const XcdBarrier xbar = xcd_barrier_post((unsigned*)(ws + WS_CTL), misc);
#ifndef PH_MASK
#define PH_MASK 0x7ff
#endif
#define IN(k) (((PH_MASK >> (k)) & 1) && lo <= (k) && (k) < hi)
#define SEAM(k) do { if (IN(k) && IN((k) + 1)) { if ((k) == 0) grid.sync(); else xcd_barrier(xbar); } } while (0)
    if (IN(0)) { prologue(p, lds); __syncthreads(); }
    SEAM(0);
    if (IN(1)) { pg8::Gemm g{X, (const bf16_t*)(ws + WS_WQKV), M, NQKV, D}; pg8::StaticOrder S; S.init(M, NQKV, G, bx);
        pg8::EpiQKV E{BIG, VT, ssq, p.in[10], p.in[11], p.in[13], p.in[14], lds + pg8::STAGE_BYTES};
        pg8::gemm_phase<pg8::EpiQKV, pg8::StaticOrder, true, true>(lds, g, S, E); }
    SEAM(1);
    if (IN(2)) { for (int rep = 0; rep < PROBE_ATT; ++rep) att::attn_phase(lds, BIG, VT, Y, p.in[2], p.in[12], p.in[16], p.in[15]); }
    SEAM(2);
    if (IN(3)) { pg8::Gemm g{Y, (const bf16_t*)(ws + WS_WO), M, D, D}; pg8::StaticOrder S; S.init(M, D, G, bx);
        pg8::EpiRes<false> E{X, nullptr, ssq};
        pg8::gemm_phase<pg8::EpiRes<false>, pg8::StaticOrder, true, true>(lds, g, S, E); }
    SEAM(3);
    if (IN(4)) { pg8::Gemm g{X, (const bf16_t*)(ws + WS_WGU0), M, 2 * FF, D}; pg8::StaticOrder S; S.init(M, 2 * FF, G, bx);
        pg8::EpiGlu E{BIG, ssq};
        pg8::gemm_phase<pg8::EpiGlu, pg8::StaticOrder, true, true>(lds, g, S, E); }
    SEAM(4);
    if (IN(5)) { pg8::Gemm g{BIG, (const bf16_t*)(ws + WS_WD0), M, D, FF}; pg8::StaticOrder S; S.init(M, D, G, bx);
        pg8::EpiRes<false> E{X, nullptr, ssq};
        pg8::gemm_phase<pg8::EpiRes<false>, pg8::StaticOrder, true, true>(lds, g, S, E); }
    SEAM(5);
    if (IN(6)) { pg8::Gemm g{X, (const bf16_t*)(ws + WS_WCI), M, NCI, D}; pg8::StaticOrder S; S.init(M, NCI, G, bx);
        pg8::EpiConvIn E{BIG, ssq};
        pg8::gemm_phase<pg8::EpiConvIn, pg8::StaticOrder, true, true>(lds, g, S, E); }
    SEAM(6);
    if (IN(7)) { cv::conv_phase(lds, BIG, Y, p.in[19], p.in[20], p.in[21], p.in[22], p.in[23]); }
    SEAM(7);
    if (IN(8)) { pg8::Gemm g{Y, (const bf16_t*)(ws + WS_WCO), M, D, D}; pg8::StaticOrder S; S.init(M, D, G, bx);
        pg8::EpiRes<false> E{X, nullptr, ssq};
        pg8::gemm_phase<pg8::EpiRes<false>, pg8::StaticOrder, true, true>(lds, g, S, E); }
    SEAM(8);
    if (IN(9)) { pg8::Gemm g{X, (const bf16_t*)(ws + WS_WGU1), M, 2 * FF, D}; pg8::StaticOrder S; S.init(M, 2 * FF, G, bx);
        pg8::EpiGlu E{BIG, ssq};
        pg8::gemm_phase<pg8::EpiGlu, pg8::StaticOrder, true, true>(lds, g, S, E); }
    SEAM(9);
    if (IN(10)) { pg8::Gemm g{BIG, (const bf16_t*)(ws + WS_WD1), M, D, FF}; pg8::StaticOrder S; S.init(M, D, G, bx);
        pg8::EpiRes<true> E{X, p.out, ssq};
        pg8::gemm_phase<pg8::EpiRes<true>, pg8::StaticOrder, true, true>(lds, g, S, E); }
#undef IN
#undef SEAM
}
}

#ifndef MK_N_LAUNCHES_X
#define MK_N_LAUNCHES 1
#endif
extern "C" void kernel_launch(void* const* d_in, const int* in_sizes, int n_in, void* d_out, int out_size, void* d_ws, size_t ws_size, hipStream_t stream) {
    static int grid = 0;
    if (grid == 0) {
        if (n_in != 24 || out_size != mk::M * mk::D || ws_size < mk::WS_END) { fprintf(stderr, "kernel_launch: unexpected shapes (n_in %d out %d ws %zu)\n", n_in, out_size, ws_size); grid = -1; return; }
        int dev = 0, cus = 0, per_cu = 0;
        (void)hipGetDevice(&dev); (void)hipDeviceGetAttribute(&cus, hipDeviceAttributeMultiprocessorCount, dev);
        (void)hipFuncSetAttribute((const void*)mk::fwd_kernel, hipFuncAttributeMaxDynamicSharedMemorySize, mk::LDS_BYTES);
        (void)hipOccupancyMaxActiveBlocksPerMultiprocessor(&per_cu, (const void*)mk::fwd_kernel, 512, mk::LDS_BYTES);
        if (per_cu < 1) per_cu = 1;
        (void)hipGetLastError();
        grid = cus * per_cu;
    }
    if (grid < 0) return;
    if (hipMemsetAsync((char*)d_ws + mk::WS_CTL, 0, mk::CTL_BYTES, stream) != hipSuccess) { fprintf(stderr, "kernel_launch: memset of the barrier words failed\n"); return; }
    mk::Params p{};
    for (int i = 0; i < 24; ++i) p.in[i] = (const float*)d_in[i];
    p.out = (float*)d_out; p.ws = (unsigned char*)d_ws;
#if MK_N_LAUNCHES == 1
    p.ph_lo = 0; p.ph_hi = 11;
    void* args[] = {&p};
    hipError_t e = hipLaunchCooperativeKernel((const void*)mk::fwd_kernel, dim3(grid), dim3(512), args, mk::LDS_BYTES, stream);
    if (e != hipSuccess) fprintf(stderr, "cooperative launch failed: %s (grid %d)\n", hipGetErrorString(e), grid);
#else
    for (int ph = 0; ph < 11; ++ph) { p.ph_lo = ph; p.ph_hi = ph + 1; hipLaunchKernelGGL(mk::fwd_kernel, dim3(grid), dim3(512), mk::LDS_BYTES, stream, p); }
#endif
}
```

```cpp
#include <hip/hip_runtime.h>
#include <hip/hip_cooperative_groups.h>
#include <cstdio>
#include <cstdint>
namespace cg = cooperative_groups;
#ifndef PROBE_ATT
#define PROBE_ATT 1
#endif
#ifndef MK_N_LAUNCHES
#define MK_N_LAUNCHES 1
#endif
namespace pg8 {
#define PG8_LAS __attribute__((address_space(3)))
typedef unsigned short bf16_t;
typedef short bf16x8 __attribute__((ext_vector_type(8)));
typedef float f32x4 __attribute__((ext_vector_type(4)));
typedef unsigned u32x4 __attribute__((ext_vector_type(4)));
constexpr int BM = 256, BK = 64, HALF = 128, HTB = HALF * BK * 2  , STAGE_BYTES = 8 * HTB, NXCD = 8, WGM = 8;

__host__ __device__ __forceinline__ int lds_byte(int r, int c) { const int st = (r >> 4) * 2 + (c >> 5), rr = r & 15, cc = c & 31, ob = rr * 64 + cc * 2; return st * 1024 + (ob ^ (((ob >> 9) & 1) << 5)); }
__host__ __device__ __forceinline__ void stage_rc(int b, int& R, int& C) { const int st = b / 1024, sb = b % 1024, swz = sb ^ (((sb >> 9) & 1) << 5); R = (st >> 1) * 16 + swz / 64; C = (st & 1) * 32 + (swz % 64) / 2; }
__host__ __device__ __forceinline__ int perm32(int rho) { const int n = rho >> 4, i = rho & 15; return 8 * (i >> 2) + 4 * n + (i & 3); }

struct Unit { int pm, pn; };
struct Gemm { const bf16_t* A; const bf16_t* Bt; int M, N, K; };

struct StaticOrder {
    int nM, nN, nwg, G, c, nI, rev;
    __host__ __device__ void init(int M, int N, int G_, int c_, int rev_ = 0) { nM = M / BM; nN = N / BM; nwg = nM * nN; G = G_; c = c_; nI = (nwg + G - 1) / G; rev = (rev_ && (nwg % G) == 0) ? 1 : 0; }
    __host__ __device__ bool next(int i, Unit& u) const {
        if (i >= nI) return false;
        const long L = (long)(rev ? nI - 1 - i : i) * G + c; if (L >= nwg) return false;
        int wgid = (int)L; { const int q = nwg / NXCD, r = nwg % NXCD, xcd = wgid % NXCD, off = wgid / NXCD; wgid = (xcd < r ? xcd * (q + 1) : r * (q + 1) + (xcd - r) * q) + off; }
        const int nig = WGM * nN, gid = wgid / nig, fm = gid * WGM, gsz = (nM - fm) < WGM ? (nM - fm) : WGM;
        u.pm = fm + ((wgid % nig) % gsz); u.pn = (wgid % nig) / gsz; return true;
    }
    __device__ __forceinline__ void a_ready(const Unit&) const {}
    __device__ __forceinline__ void done(const Unit&) const {}
};

__device__ __forceinline__ unsigned cvt_pk_bf16(float lo, float hi) { unsigned r; asm volatile("v_cvt_pk_bf16_f32 %0, %1, %2" : "=v"(r) : "v"(lo), "v"(hi)); return r; }
typedef float f32x2 __attribute__((ext_vector_type(2)));
typedef unsigned u32x2 __attribute__((ext_vector_type(2)));
__device__ __forceinline__ float bf_lo(unsigned w) { return __uint_as_float(w << 16); }
__device__ __forceinline__ float bf_hi(unsigned w) { return __uint_as_float(w & 0xffff0000u); }
__device__ __forceinline__ float row_rstd(const float* ssq, int row) {
    const f32x4* p = (const f32x4*)(ssq + (size_t)row * 16);
    const f32x4 a = p[0], b = p[1], c = p[2], d = p[3];
    const float s = ((a[0] + a[1]) + (a[2] + a[3])) + ((b[0] + b[1]) + (b[2] + b[3])) + ((c[0] + c[1]) + (c[2] + c[3])) + ((d[0] + d[1]) + (d[2] + d[3]));
    return __builtin_amdgcn_rsqf(s * (1.0f / 1024.0f) + 1e-6f);
}
__device__ __forceinline__ void rows_rstd(const float* ssq, int row0, int fq, float (&rs)[2][4]) {
    f32x4 pr[2][4];
#pragma unroll
    for (int ai = 0; ai < 2; ++ai)
#pragma unroll
        for (int m = 0; m < 4; ++m) pr[ai][m] = *(const f32x4*)(ssq + (size_t)(row0 + ai * HALF + m * 16) * 16 + 4 * fq);
#pragma unroll
    for (int ai = 0; ai < 2; ++ai)
#pragma unroll
        for (int m = 0; m < 4; ++m) { float t = (pr[ai][m][0] + pr[ai][m][1]) + (pr[ai][m][2] + pr[ai][m][3]); t += __shfl_xor(t, 16); t += __shfl_xor(t, 32); rs[ai][m] = __builtin_amdgcn_rsqf(t * (1.0f / 1024.0f) + 1e-6f); }
}
__device__ __forceinline__ float fast_sigmoid(float x) { return __builtin_amdgcn_rcpf(1.0f + __expf(-x)); }

constexpr int QKW = 1664;
constexpr int VT_PITCH = 131072 + 128;
constexpr float C2Q = 0.125f * 1.4426950408889634f;

struct EpiQKV {
    static constexpr bool PERM = true, AFTER_DRAIN = false;
    bf16_t* QK; bf16_t* VT; const float* ssq; const float* aq; const float* ak; const float* bq; const float* bk; PG8_LAS unsigned char* xlds;
    __device__ __forceinline__ void operator()(const f32x4 (&acc)[2][2][4][2], const Unit& u, int wr, int wc, int fr, int fq) const {
        const int L = u.pn * 256 + wc * 64;
        int kind; const float* gain = nullptr; float scale = 1.f; int ccol = 0, vrow = 0;
        if (L < 512) { kind = 0; gain = aq; scale = C2Q; ccol = L; }
        else if (L < 640) { kind = 0; gain = ak; ccol = L; }
        else if (L < 768) { kind = 1; vrow = L - 640; }
        else if (L < 1280) { kind = 0; gain = bq; scale = C2Q; ccol = L - 128; }
        else if (L < 1792) { kind = 0; gain = bk; ccol = L - 128; }
        else { kind = 1; vrow = L - 1792 + 128; }
        if (kind == 0) {
            f32x4 gv[2][2];
#pragma unroll
            for (int bj = 0; bj < 2; ++bj)
#pragma unroll
                for (int n = 0; n < 2; ++n) gv[bj][n] = *(const f32x4*)(gain + 32 * bj + 8 * fq + 4 * n);
            float rsv[2][4]; rows_rstd(ssq, u.pm * BM + wr * 64 + fr, fq, rsv);
#pragma unroll
            for (int ai = 0; ai < 2; ++ai)
#pragma unroll
                for (int m = 0; m < 4; ++m) {
                    const int row = u.pm * BM + ai * HALF + wr * 64 + m * 16 + fr;
                    const float rs = rsv[ai][m];
                    float ss = 0.f;
#pragma unroll
                    for (int bj = 0; bj < 2; ++bj)
#pragma unroll
                        for (int n = 0; n < 2; ++n) { const f32x4 v = acc[ai][bj][m][n] * rs; ss += (v[0] * v[0] + v[1] * v[1]) + (v[2] * v[2] + v[3] * v[3]); }
                    ss += __shfl_xor(ss, 16); ss += __shfl_xor(ss, 32);
                    const float f = rs * __builtin_amdgcn_rsqf(ss * (1.0f / 64.0f) + 1e-6f) * scale;
                    bf16_t* rowp = QK + ((size_t)((row >> 6) * 26 + (ccol >> 6)) * 64 + (row & 63)) * 64 + 8 * fq;
#pragma unroll
                    for (int bj = 0; bj < 2; ++bj) {
                        const f32x4 v0 = acc[ai][bj][m][0] * f * gv[bj][0], v1 = acc[ai][bj][m][1] * f * gv[bj][1];
                        u32x4 w; w.x = cvt_pk_bf16(v0[0], v0[1]); w.y = cvt_pk_bf16(v0[2], v0[3]); w.z = cvt_pk_bf16(v1[0], v1[1]); w.w = cvt_pk_bf16(v1[2], v1[3]);
                        *(u32x4*)(rowp + 32 * bj) = w;
                    }
                }
        } else {
            PG8_LAS unsigned char* xl = xlds + (wr * 4 + wc) * 2048;
            const int lane = fq * 16 + fr;
            float rsv[2][4]; rows_rstd(ssq, u.pm * BM + wr * 64 + fr, fq, rsv);
#pragma unroll
            for (int ai = 0; ai < 2; ++ai) {
                float rs[4];
#pragma unroll
                for (int m = 0; m < 4; ++m) rs[m] = rsv[ai][m];
                const size_t tb = (size_t)(u.pm * 4 + ai * 2 + wr) * 640;
#pragma unroll
                for (int bj = 0; bj < 2; ++bj)
#pragma unroll
                    for (int n = 0; n < 2; ++n) {
#pragma unroll
                        for (int m = 0; m < 4; ++m) {
                            const f32x4 v = acc[ai][bj][m][n] * rs[m];
                            const unsigned w0 = cvt_pk_bf16(v[0], v[1]), w1 = cvt_pk_bf16(v[2], v[3]);
                            PG8_LAS bf16_t* q = (PG8_LAS bf16_t*)(xl + (4 * fq) * 128 + (16 * m + fr) * 2);
                            q[0] = (bf16_t)(w0 & 0xffffu); q[64] = (bf16_t)(w0 >> 16); q[128] = (bf16_t)(w1 & 0xffffu); q[192] = (bf16_t)(w1 >> 16);
                        }
                        asm volatile("s_waitcnt lgkmcnt(0)" ::: "memory");
                        const int c16 = lane >> 2, part = lane & 3;
                        const u32x4 a = *(const PG8_LAS u32x4*)(xl + c16 * 128 + part * 32), b = *(const PG8_LAS u32x4*)(xl + c16 * 128 + part * 32 + 16);
                        bf16_t* gp = VT + (tb + vrow + 32 * bj + 8 * (c16 >> 2) + 4 * n + (c16 & 3)) * 64 + part * 16;
                        *(u32x4*)gp = a; *(u32x4*)(gp + 8) = b;
                        asm volatile("s_waitcnt lgkmcnt(0)" ::: "memory");
                    }
            }
        }
    }
};

template <bool FINAL> struct EpiRes {
    static constexpr bool PERM = true, AFTER_DRAIN = false;
    bf16_t* X; float* out; float* ssq;
    __device__ __forceinline__ void operator()(const f32x4 (&acc)[2][2][4][2], const Unit& u, int wr, int wc, int fr, int fq) const {
        const int col0 = u.pn * BM + wc * 32 + 8 * fq;
        u32x4 xin[2][4][2];
#pragma unroll
        for (int ai = 0; ai < 2; ++ai)
#pragma unroll
            for (int m = 0; m < 4; ++m)
#pragma unroll
                for (int bj = 0; bj < 2; ++bj) xin[ai][m][bj] = *(const u32x4*)(X + (size_t)(u.pm * BM + ai * HALF + wr * 64 + m * 16 + fr) * 1024 + col0 + bj * HALF);
#pragma unroll
        for (int ai = 0; ai < 2; ++ai)
#pragma unroll
            for (int m = 0; m < 4; ++m) {
                const int row = u.pm * BM + ai * HALF + wr * 64 + m * 16 + fr;
                float ss = 0.f;
#pragma unroll
                for (int bj = 0; bj < 2; ++bj) {
                    bf16_t* xp = X + (size_t)row * 1024 + col0 + bj * HALF;
                    const u32x4 xv = xin[ai][m][bj];
                    f32x4 y0 = acc[ai][bj][m][0], y1 = acc[ai][bj][m][1];
                    y0[0] += bf_lo(xv.x); y0[1] += bf_hi(xv.x); y0[2] += bf_lo(xv.y); y0[3] += bf_hi(xv.y);
                    y1[0] += bf_lo(xv.z); y1[1] += bf_hi(xv.z); y1[2] += bf_lo(xv.w); y1[3] += bf_hi(xv.w);
                    if (FINAL) {
                        float* op = out + (size_t)row * 1024 + col0 + bj * HALF;
                        __builtin_nontemporal_store(y0, (f32x4*)op); __builtin_nontemporal_store(y1, (f32x4*)(op + 4));
                    } else {
                        u32x4 w; w.x = cvt_pk_bf16(y0[0], y0[1]); w.y = cvt_pk_bf16(y0[2], y0[3]); w.z = cvt_pk_bf16(y1[0], y1[1]); w.w = cvt_pk_bf16(y1[2], y1[3]);
                        *(u32x4*)xp = w;
                        ss += (y0[0] * y0[0] + y0[1] * y0[1]) + (y0[2] * y0[2] + y0[3] * y0[3]) + (y1[0] * y1[0] + y1[1] * y1[1]) + (y1[2] * y1[2] + y1[3] * y1[3]);
                    }
                }
                if (!FINAL) {
                    ss += __shfl_xor(ss, 16); ss += __shfl_xor(ss, 32);
                    if (fq == 0) ssq[(size_t)row * 16 + u.pn * 4 + wc] = ss;
                }
            }
    }
};

struct EpiGlu {
    static constexpr bool PERM = true, AFTER_DRAIN = false;
    bf16_t* H; const float* ssq;
    __device__ __forceinline__ void operator()(const f32x4 (&acc)[2][2][4][2], const Unit& u, int wr, int wc, int fr, int fq) const {
        const int col0 = u.pn * HALF + wc * 32 + 8 * fq;
        float rsv[2][4]; rows_rstd(ssq, u.pm * BM + wr * 64 + fr, fq, rsv);
#pragma unroll
        for (int ai = 0; ai < 2; ++ai)
#pragma unroll
            for (int m = 0; m < 4; ++m) {
                const int row = u.pm * BM + ai * HALF + wr * 64 + m * 16 + fr;
                const float rs = rsv[ai][m];
                float h[8];
#pragma unroll
                for (int n = 0; n < 2; ++n)
#pragma unroll
                    for (int i = 0; i < 4; ++i) { const float g = acc[ai][0][m][n][i] * rs, up = acc[ai][1][m][n][i] * rs; h[4 * n + i] = g * up * fast_sigmoid(g); }
                u32x4 w; w.x = cvt_pk_bf16(h[0], h[1]); w.y = cvt_pk_bf16(h[2], h[3]); w.z = cvt_pk_bf16(h[4], h[5]); w.w = cvt_pk_bf16(h[6], h[7]);
                *(u32x4*)(H + (size_t)row * 2816 + col0) = w;
            }
    }
};

struct EpiConvIn {
    static constexpr bool PERM = true, AFTER_DRAIN = false;
    bf16_t* O; const float* ssq;
    __device__ __forceinline__ void operator()(const f32x4 (&acc)[2][2][4][2], const Unit& u, int wr, int wc, int fr, int fq) const {
        float rsv[2][4]; rows_rstd(ssq, u.pm * BM + wr * 64 + fr, fq, rsv);
#pragma unroll
        for (int ai = 0; ai < 2; ++ai)
#pragma unroll
            for (int m = 0; m < 4; ++m) {
                const int row = u.pm * BM + ai * HALF + wr * 64 + m * 16 + fr;
                const float rs = rsv[ai][m];
                bf16_t* rp = O + (size_t)row * 1536 + wc * 32 + 8 * fq;
                if (u.pn < 2) {
#pragma unroll
                    for (int bj = 0; bj < 2; ++bj) {
                        const f32x4 v0 = acc[ai][bj][m][0] * rs, v1 = acc[ai][bj][m][1] * rs;
                        u32x4 w; w.x = cvt_pk_bf16(v0[0], v0[1]); w.y = cvt_pk_bf16(v0[2], v0[3]); w.z = cvt_pk_bf16(v1[0], v1[1]); w.w = cvt_pk_bf16(v1[2], v1[3]);
                        *(u32x4*)(rp + u.pn * BM + bj * HALF) = w;
                    }
                } else {
                    float h[8];
                    const bool glu = u.pn >= 6;
#pragma unroll
                    for (int n = 0; n < 2; ++n)
#pragma unroll
                        for (int i = 0; i < 4; ++i) { const float a = acc[ai][0][m][n][i] * rs, b = acc[ai][1][m][n][i] * rs; h[4 * n + i] = glu ? a * fast_sigmoid(b) : a * b; }
                    u32x4 w; w.x = cvt_pk_bf16(h[0], h[1]); w.y = cvt_pk_bf16(h[2], h[3]); w.z = cvt_pk_bf16(h[4], h[5]); w.w = cvt_pk_bf16(h[6], h[7]);
                    *(u32x4*)(rp + 512 + (u.pn - 2) * HALF) = w;
                }
            }
    }
};

struct EpiPlain {
    static constexpr bool PERM = true, AFTER_DRAIN = false;
    bf16_t* O; int ldc; const float* ssq;
    __device__ __forceinline__ void operator()(const f32x4 (&acc)[2][2][4][2], const Unit& u, int wr, int wc, int fr, int fq) const {
        const int col0 = u.pn * BM + wc * 32 + 8 * fq;
#pragma unroll
        for (int ai = 0; ai < 2; ++ai)
#pragma unroll
            for (int m = 0; m < 4; ++m) {
                const int row = u.pm * BM + ai * HALF + wr * 64 + m * 16 + fr;
                const float rs = row_rstd(ssq, row);
#pragma unroll
                for (int bj = 0; bj < 2; ++bj) {
                    const f32x4 v0 = acc[ai][bj][m][0] * rs, v1 = acc[ai][bj][m][1] * rs;
                    u32x4 w; w.x = cvt_pk_bf16(v0[0], v0[1]); w.y = cvt_pk_bf16(v0[2], v0[3]); w.z = cvt_pk_bf16(v1[0], v1[1]); w.w = cvt_pk_bf16(v1[2], v1[3]);
                    *(u32x4*)(O + (size_t)row * ldc + col0 + bj * HALF) = w;
                }
            }
    }
};

template <class Epi, class Sched, bool ALIGN_EPI = false, bool SP2 = false>
__device__ __forceinline__ void gemm_phase(PG8_LAS unsigned char* lds, const Gemm g, const Sched& S, const Epi& E) {
    const int tid = threadIdx.x, wid = __builtin_amdgcn_readfirstlane(tid >> 6), lane = tid & 63, wr = wid >> 2, wc = wid & 3, fr = lane & 15, fq = lane >> 4;
    const int K = g.K, nt = K / BK;
    unsigned voffA[2], voffB[2];
#pragma unroll
    for (int i = 0; i < 2; ++i) { int R, C; stage_rc(tid * 16 + i * 8192, R, C); const int Rb = Epi::PERM ? ((R & ~31) + perm32(R & 31)) : R;
        voffA[i] = (unsigned)(R * K + C) * 2u; voffB[i] = (unsigned)(Rb * K + C) * 2u; }
    const size_t kstep = (size_t)(BK * 2);
    const size_t hstep = (size_t)HALF * K * 2;
    const size_t tstep = 2 * hstep;
    const unsigned ldsw = (unsigned)wid * 1024u;
    const int aoff = lds_byte(wr * 64 + fr, fq * 8), boff = lds_byte(wc * 32 + fr, fq * 8);
#define PG8_SA(b, h) (((b) * 2 + (h)) * HTB)
#define PG8_SB(b, h) ((4 + (b) * 2 + (h)) * HTB)
#define PG8_STAGE(bufoff, gbase, voff) do { _Pragma("unroll") for (int _i = 0; _i < 2; ++_i) \
        __builtin_amdgcn_global_load_lds((const unsigned*)((const char*)(gbase) + (voff)[_i]), (PG8_LAS unsigned*)(lds + (bufoff) + ldsw + _i * 8192), 16, 0, 0); } while (0)
#define PG8_LDA(dst, b, h) do { _Pragma("unroll") for (int m = 0; m < 4; ++m) _Pragma("unroll") for (int k = 0; k < 2; ++k) dst[m][k] = *(const PG8_LAS bf16x8*)(lds + PG8_SA(b, h) + aoff + m * 2048 + k * 1024); } while (0)
#define PG8_LDB(dst, b, h) do { _Pragma("unroll") for (int n = 0; n < 2; ++n) _Pragma("unroll") for (int k = 0; k < 2; ++k) dst[n][k] = *(const PG8_LAS bf16x8*)(lds + PG8_SB(b, h) + boff + n * 2048 + k * 1024); } while (0)
#define PG8_MMA(ai, bj, At, Bt) do { __builtin_amdgcn_s_setprio(1); _Pragma("unroll") for (int m = 0; m < 4; ++m) _Pragma("unroll") for (int n = 0; n < 2; ++n) _Pragma("unroll") for (int k = 0; k < 2; ++k) \
        acc[ai][bj][m][n] = __builtin_amdgcn_mfma_f32_16x16x32_bf16(Bt[n][k], At[m][k], acc[ai][bj][m][n], 0, 0, 0); __builtin_amdgcn_s_setprio(0); } while (0)
#define PG8_WAIT_V(n) asm volatile("s_waitcnt vmcnt(" #n ")" ::: "memory")
#define PG8_WAIT_L(n) asm volatile("s_waitcnt lgkmcnt(" #n ")" ::: "memory")
#define PG8_BAR __builtin_amdgcn_s_barrier()
#define PG8_SCHED __builtin_amdgcn_sched_barrier(0)
    Unit cur, nxt; int ui = 0;
    if (!S.next(0, cur)) return;
    f32x4 acc[2][2][4][2];
#pragma unroll
    for (int a = 0; a < 2; ++a)
#pragma unroll
        for (int b = 0; b < 2; ++b)
#pragma unroll
            for (int m = 0; m < 4; ++m)
#pragma unroll
                for (int n = 0; n < 2; ++n) acc[a][b][m][n] = (f32x4){0.f, 0.f, 0.f, 0.f};
    bf16x8 At[4][2], B0[2][2], B1[2][2];
    const char* cA = (const char*)g.A + (size_t)cur.pm * tstep; const char* cB = (const char*)g.Bt + (size_t)cur.pn * tstep;
    S.a_ready(cur);
    if constexpr (SP2) {
        PG8_STAGE(PG8_SB(0, 0), cB, voffB); PG8_STAGE(PG8_SB(0, 1), cB + hstep, voffB); PG8_STAGE(PG8_SA(0, 0), cA, voffA); PG8_STAGE(PG8_SA(0, 1), cA + hstep, voffA);
        if (wr == 1) PG8_BAR;
        PG8_WAIT_V(2); PG8_BAR;
        PG8_STAGE(PG8_SB(1, 0), cB + kstep, voffB); PG8_STAGE(PG8_SA(1, 0), cA + kstep, voffA); PG8_STAGE(PG8_SB(1, 1), cB + hstep + kstep, voffB);
        PG8_WAIT_V(6); PG8_BAR;
    } else {
        PG8_STAGE(PG8_SB(0, 0), cB, voffB); PG8_STAGE(PG8_SA(0, 0), cA, voffA); PG8_STAGE(PG8_SB(0, 1), cB + hstep, voffB); PG8_STAGE(PG8_SA(0, 1), cA + hstep, voffA);
        if (wr == 1) PG8_BAR;
        PG8_WAIT_V(4); PG8_BAR;
        PG8_STAGE(PG8_SB(1, 0), cB + kstep, voffB); PG8_STAGE(PG8_SA(1, 0), cA + kstep, voffA); PG8_STAGE(PG8_SB(1, 1), cB + hstep + kstep, voffB);
        PG8_WAIT_V(6); PG8_BAR;
    }
    for (;;) {
        const bool has_next = S.next(ui + 1, nxt);
        const char* nA = has_next ? (const char*)g.A + (size_t)nxt.pm * tstep : cA; const char* nB = has_next ? (const char*)g.Bt + (size_t)nxt.pn * tstep : cB;
        for (int t = 0; t < nt; t += 2) {
            const bool last = (t == nt - 2);
            const char* a1 = cA + (size_t)(t + 1) * kstep;
            const char* a2 = last ? nA : cA + (size_t)(t + 2) * kstep; const char* b2 = last ? nB : cB + (size_t)(t + 2) * kstep;
            const char* a3 = a2 + kstep; const char* b3 = b2 + kstep;
            if (last && has_next) S.a_ready(nxt);
            if constexpr (SP2) {
            PG8_LDB(B0, 0, 0); PG8_LDB(B1, 0, 1); PG8_SCHED; PG8_LDA(At, 0, 0); PG8_STAGE(PG8_SA(1, 1), a1 + hstep, voffA);
            PG8_WAIT_V(8); PG8_WAIT_L(0); PG8_BAR; PG8_MMA(0, 0, At, B0); PG8_MMA(0, 1, At, B1); PG8_BAR; PG8_SCHED;
            PG8_LDA(At, 0, 1); PG8_STAGE(PG8_SB(0, 0), b2, voffB); PG8_STAGE(PG8_SB(0, 1), b2 + hstep, voffB); PG8_STAGE(PG8_SA(0, 0), a2, voffA);
            PG8_WAIT_V(8); PG8_WAIT_L(0); PG8_BAR; PG8_MMA(1, 0, At, B0); PG8_MMA(1, 1, At, B1); PG8_BAR; PG8_SCHED;
            PG8_LDB(B0, 1, 0); PG8_LDB(B1, 1, 1); PG8_SCHED; PG8_LDA(At, 1, 0); PG8_STAGE(PG8_SA(0, 1), a2 + hstep, voffA);
            PG8_WAIT_V(8); PG8_WAIT_L(0); PG8_BAR; PG8_MMA(0, 0, At, B0); PG8_MMA(0, 1, At, B1); PG8_BAR; PG8_SCHED;
            PG8_LDA(At, 1, 1); PG8_STAGE(PG8_SB(1, 0), b3, voffB); PG8_STAGE(PG8_SB(1, 1), b3 + hstep, voffB); PG8_STAGE(PG8_SA(1, 0), a3, voffA);
            PG8_WAIT_V(8); PG8_WAIT_L(0); PG8_BAR; PG8_MMA(1, 0, At, B0); PG8_MMA(1, 1, At, B1); PG8_BAR; PG8_SCHED;
            } else {
            PG8_LDB(B0, 0, 0); PG8_SCHED; PG8_LDA(At, 0, 0); PG8_STAGE(PG8_SA(1, 1), a1 + hstep, voffA);
            PG8_WAIT_L(8); PG8_BAR; PG8_WAIT_L(0); PG8_MMA(0, 0, At, B0); PG8_BAR; PG8_SCHED;
            PG8_LDB(B1, 0, 1); PG8_STAGE(PG8_SB(0, 0), b2, voffB);
            PG8_BAR; PG8_WAIT_L(0); PG8_MMA(0, 1, At, B1); PG8_BAR;
            PG8_LDA(At, 0, 1); PG8_STAGE(PG8_SA(0, 0), a2, voffA);
            PG8_BAR; PG8_WAIT_L(0); PG8_MMA(1, 0, At, B0); PG8_BAR; PG8_SCHED;
            PG8_STAGE(PG8_SB(0, 1), b2 + hstep, voffB);
            PG8_WAIT_V(6); PG8_BAR; PG8_MMA(1, 1, At, B1); PG8_BAR;
            PG8_LDB(B0, 1, 0); PG8_SCHED; PG8_LDA(At, 1, 0); PG8_STAGE(PG8_SA(0, 1), a2 + hstep, voffA);
            PG8_WAIT_L(8); PG8_BAR; PG8_WAIT_L(0); PG8_MMA(0, 0, At, B0); PG8_BAR; PG8_SCHED;
            PG8_LDB(B1, 1, 1); PG8_STAGE(PG8_SB(1, 0), b3, voffB);
            PG8_BAR; PG8_WAIT_L(0); PG8_MMA(0, 1, At, B1); PG8_BAR;
            PG8_LDA(At, 1, 1); PG8_STAGE(PG8_SA(1, 0), a3, voffA);
            PG8_BAR; PG8_WAIT_L(0); PG8_MMA(1, 0, At, B0); PG8_BAR; PG8_SCHED;
            PG8_STAGE(PG8_SB(1, 1), b3 + hstep, voffB);
            PG8_WAIT_V(6); PG8_BAR; PG8_MMA(1, 1, At, B1); PG8_BAR;
            }
        }
        if constexpr (ALIGN_EPI) { if (wr == 0) PG8_BAR; }
        if constexpr (!Epi::AFTER_DRAIN) { E(acc, cur, wr, wc, fr, fq); S.done(cur); }
        if (!has_next) break;
#pragma unroll
        for (int a = 0; a < 2; ++a)
#pragma unroll
            for (int b = 0; b < 2; ++b)
#pragma unroll
                for (int m = 0; m < 4; ++m)
#pragma unroll
                    for (int n = 0; n < 2; ++n) acc[a][b][m][n] = (f32x4){0.f, 0.f, 0.f, 0.f};
        cur = nxt; cA = nA; cB = nB; ++ui;
        if constexpr (ALIGN_EPI) { if (wr == 1) PG8_BAR; }
    }
    PG8_WAIT_V(0);
    if constexpr (!ALIGN_EPI) { if (wr == 0) PG8_BAR; }
    PG8_BAR;
    if constexpr (Epi::AFTER_DRAIN) { E.fused(acc, cur, wr, wc, fr, fq, lds, wid, lane); S.done(cur); }
#undef PG8_SA
#undef PG8_SB
#undef PG8_STAGE
#undef PG8_LDA
#undef PG8_LDB
#undef PG8_MMA
#undef PG8_WAIT_V
#undef PG8_WAIT_L
#undef PG8_BAR
#undef PG8_SCHED
}
}
namespace att {
using pg8::bf16_t; using pg8::bf16x8; using pg8::f32x4; using pg8::u32x4; using pg8::u32x2; using pg8::cvt_pk_bf16; using pg8::QKW; using pg8::VT_PITCH;
typedef float f32x16 __attribute__((ext_vector_type(16)));
#define ALAS __attribute__((address_space(3)))
constexpr int OFF_K0 = 0, OFF_K1 = 8192, OFF_V = 16384, STAGE = 32768, NSTG = 4, OFF_LUT = NSTG * STAGE;
constexpr int LUTW = 448, LUTC = 224;
constexpr int OFF_SUB = OFF_LUT + 12 * LUTW * 4;
constexpr int ATT_LDS = OFF_SUB + 512;
__device__ __forceinline__ int pi32(int r) { return (r & ~12) | ((r & 4) << 1) | ((r & 8) >> 1); }
__device__ __forceinline__ int t5_bucket(int rel) {
    const int n = rel < 0 ? -rel : rel;
    int b = n < 8 ? n : (n < 12 ? 8 : n < 16 ? 9 : n < 23 ? 10 : n < 32 ? 11 : n < 46 ? 12 : n < 64 ? 13 : n < 91 ? 14 : 15);
    return b + (rel > 0 ? 16 : 0);
}

__device__ __forceinline__ void glds16(const void* gsrc, unsigned lds_dst) { unsigned keep;
    asm volatile("s_mov_b32 %0, m0\n\ts_mov_b32 m0, %2\n\ts_nop 0\n\tglobal_load_lds_dwordx4 %1, off\n\ts_mov_b32 m0, %0" : "=&s"(keep) : "v"(gsrc), "s"(lds_dst) : "memory"); }
typedef float f32x2_t __attribute__((ext_vector_type(2))); typedef __bf16 bf16x2_t __attribute__((ext_vector_type(2)));
__device__ __forceinline__ unsigned cvtpk_s(float lo, float hi) { f32x2_t v = {lo, hi}; bf16x2_t b = __builtin_convertvector(v, bf16x2_t); return __builtin_bit_cast(unsigned, b); }
template <int N> __device__ __forceinline__ void wait_bar() { asm volatile("s_waitcnt vmcnt(%0) lgkmcnt(0)\n\ts_barrier" :: "n"(N) : "memory"); }

template <bool WIN>
__device__ __forceinline__ void attn_unit(ALAS unsigned char* lds, const bf16_t* __restrict__ QK, const bf16_t* __restrict__ VT, bf16_t* __restrict__ Y,
                                          const float* __restrict__ rel_bias, const float* __restrict__ sinkp, const float* __restrict__ subln, float lam,
                                          int seq_base, int S, int q0, int hsel) {
    constexpr float LOG2E = 1.4426950408889634f;
    constexpr int NDB = WIN ? 2 : 4;
    const int tid = threadIdx.x, lane = tid & 63, l31 = lane & 31, hi = lane >> 5;
    const int wid = __builtin_amdgcn_readfirstlane(tid >> 6), half = wid >> 2, wq = wid & 3;
    const int qw = q0 + 32 * wq;
    int qcol, kcol0, kcol1, vrow0, bhead;
    if (WIN) { qcol = (2 * hsel + half) * 64; kcol0 = 512 + (hsel >> 1) * 64; kcol1 = kcol0; vrow0 = (hsel >> 1) * 64; bhead = 2 * hsel; }
    else { qcol = 640 + (2 * hsel + half) * 64; kcol0 = 1152 + (2 * hsel) * 64; kcol1 = kcol0 + 64; vrow0 = 128 + hsel * 128; bhead = 8 + hsel; }
    const ALAS float* lut = (const ALAS float*)(lds + OFF_LUT) + (WIN ? (bhead + half) : bhead) * LUTW;

    const int t_lo = WIN ? (q0 >= 128 ? (q0 - 128) / 64 : 0) : 0;
    const int t_hi = WIN ? ((q0 + 256) / 64 < S / 64 ? (q0 + 256) / 64 : S / 64) : S / 64;
    const int NT = t_hi - t_lo;
    const unsigned ldsb = (unsigned)(uintptr_t)lds;
    const int drow = 8 * wid + (lane >> 3), dch = (lane & 7) ^ ((4 * wid + (lane >> 4)) & 7);
    const bf16_t* kg = QK + ((size_t)((seq_base >> 6) + t_lo) * 26 * 64 + drow) * 64 + dch * 8 + kcol0 * 64;
    const bf16_t* vg = VT + ((size_t)((seq_base >> 6) + t_lo) * 640 + vrow0 + drow) * 64 + dch * 8;
    const unsigned dk = ldsb + wid * 1024;
#define AT_DMA(tr) do { const unsigned sb_ = (unsigned)__builtin_amdgcn_readfirstlane(dk + (((tr) & (NSTG - 1)) * STAGE)); const size_t ko_ = (size_t)(tr) * 26 * 4096, vo_ = (size_t)(tr) * 640 * 64; \
        glds16(kg + ko_, sb_ + OFF_K0); if (!WIN) glds16(kg + ko_ + 4096, sb_ + OFF_K1); glds16(vg + vo_, sb_ + OFF_V); if (!WIN) glds16(vg + vo_ + 64 * 64, sb_ + OFF_V + 8192); } while (0)
    constexpr int NPW = WIN ? 2 : 4;
    bf16x8 qfr[4];
    { const int qrow = seq_base + qw + l31; const bf16_t* qp = QK + ((size_t)((qrow >> 6) * 26 + (qcol >> 6)) * 64 + (qrow & 63)) * 64 + hi * 8;
#pragma unroll
      for (int ds = 0; ds < 4; ++ds) qfr[ds] = *(const bf16x8*)(qp + ds * 16); }
#define qf(ds) qfr[ds]
    AT_DMA(0); if (NT > 1) AT_DMA(1); if (NT > 2) AT_DMA(2);
    constexpr float THR = 8.0f;
    float m_ref = WIN ? sinkp[2 * hsel + half] * LOG2E : 0.f;
    float l_run = (WIN && hi == 0) ? 1.f : 0.f;
    float cbase = 0.f;
    f32x16 cvec;
#pragma unroll
    for (int r = 0; r < 16; ++r) cvec[r] = cbase - m_ref;
    f32x16 o[NDB];
#pragma unroll
    for (int db = 0; db < NDB; ++db)
#pragma unroll
        for (int r = 0; r < 16; ++r) o[db][r] = 0.f;
    const int krow = pi32(l31), fK = (krow >> 1) & 7, fV = (l31 >> 1) & 7;
    int kx[4], vx[4];
#pragma unroll
    for (int c = 0; c < 4; ++c) { kx[c] = (WIN ? OFF_K0 : (half ? OFF_K1 : OFF_K0)) + krow * 128 + (((2 * c + hi) ^ fK) << 4); vx[c] = OFF_V + l31 * 128 + (((2 * c + hi) ^ fV) << 4); }
    const int qabs = qw + l31;
    const float cfar_lo = __uint_as_float(__builtin_amdgcn_readfirstlane(__float_as_uint(lut[0]))), cfar_hi = __uint_as_float(__builtin_amdgcn_readfirstlane(__float_as_uint(lut[LUTW - 1])));
    asm volatile("" : "+v"(qfr[0]), "+v"(qfr[1]), "+v"(qfr[2]), "+v"(qfr[3]));
#pragma clang loop unroll(disable)
    for (int tr = 0; tr < NT; ++tr) {
        if (tr + 2 < NT) wait_bar<2 * NPW>(); else if (tr + 1 < NT) wait_bar<NPW>(); else wait_bar<0>();
        if (tr + 3 < NT) AT_DMA(tr + 3);
        const int k0 = (t_lo + tr) * 64;
        const bool skip = WIN && (k0 > qw + 31 + 128 || k0 + 63 < qw - 128);
        if (!skip) {
            const bool near = WIN || ((k0 - (qw + 31)) < 128 && (qw - (k0 + 63)) < 128);
            const float cinit = near ? 0.f : (k0 > qw ? cfar_hi : cfar_lo);
            if (__builtin_expect(cinit != cbase, 0)) { cbase = cinit; asm volatile("" ::: "memory");
#pragma unroll
                for (int r = 0; r < 16; ++r) cvec[r] = cbase - m_ref; }
            f32x16 s0, s1;
            const ALAS unsigned char* sb = lds + (tr & (NSTG - 1)) * STAGE;
            {
                bf16x8 ka[8];
#pragma unroll
                for (int ds = 0; ds < 4; ++ds) { ka[2 * ds] = *(const ALAS bf16x8*)(sb + kx[ds]); ka[2 * ds + 1] = *(const ALAS bf16x8*)(sb + kx[ds] + 4096); }
                __builtin_amdgcn_sched_barrier(0);
                s0 = __builtin_amdgcn_mfma_f32_32x32x16_bf16(ka[0], qf(0), cvec, 0, 0, 0);
                s1 = __builtin_amdgcn_mfma_f32_32x32x16_bf16(ka[1], qf(0), cvec, 0, 0, 0);
#pragma unroll
                for (int ds = 1; ds < 4; ++ds) {
                    s0 = __builtin_amdgcn_mfma_f32_32x32x16_bf16(ka[2 * ds], qf(ds), s0, 0, 0, 0);
                    s1 = __builtin_amdgcn_mfma_f32_32x32x16_bf16(ka[2 * ds + 1], qf(ds), s1, 0, 0, 0);
                }
            }
            bf16x8 va[2 * NDB], vc[2 * NDB];
#pragma unroll
            for (int kk = 0; kk < 2; ++kk)
#pragma unroll
                for (int db = 0; db < NDB; ++db) va[kk * NDB + db] = *(const ALAS bf16x8*)(sb + vx[kk] + db * 4096);
            __builtin_amdgcn_sched_barrier(0);
            if (near) {
                const ALAS float* lb = lut + (k0 + 8 * hi - qabs + LUTC);
#pragma unroll
                for (int r = 0; r < 16; ++r) { s0[r] += lb[16 * (r >> 3) + (r & 7)]; s1[r] += lb[32 + 16 * (r >> 3) + (r & 7)];
                    if ((r & 7) == 7) __builtin_amdgcn_sched_barrier(0); }
            }
#define MX3(a, b, c) __builtin_fmaxf(__builtin_fmaxf((a), (b)), (c))
            float mxa = MX3(s0[0], s0[1], s1[0]), mxb = MX3(s0[2], s0[3], s1[1]);
            mxa = MX3(mxa, s1[2], s1[3]);
#pragma unroll
            for (int r = 4; r < 16; r += 4) { mxa = MX3(mxa, s0[r], s0[r + 1]); mxb = MX3(mxb, s0[r + 2], s0[r + 3]); mxa = MX3(mxa, s1[r], s1[r + 1]); mxb = MX3(mxb, s1[r + 2], s1[r + 3]); }
#undef MX3
            float mx = fmaxf(mxa, mxb);
            if (__any(mx > THR)) {
                mx = fmaxf(mx, __shfl_xor(mx, 32));
                const float dl = fmaxf(mx, 0.f);
                m_ref += dl;
                const float f = __builtin_amdgcn_exp2f(-dl);
                l_run *= f;
#pragma unroll
                for (int db = 0; db < NDB; ++db)
#pragma unroll
                    for (int r = 0; r < 16; ++r) o[db][r] *= f;
#pragma unroll
                for (int r = 0; r < 16; ++r) { s0[r] -= dl; s1[r] -= dl; cvec[r] = cbase - m_ref; }
            }
            float ls0 = 0.f, ls1 = 0.f;
#define AT_EXP(SS, B, PF) do { \
                const float e0 = __builtin_amdgcn_exp2f(SS[B + 0]), e1 = __builtin_amdgcn_exp2f(SS[B + 1]), e2 = __builtin_amdgcn_exp2f(SS[B + 2]), e3 = __builtin_amdgcn_exp2f(SS[B + 3]); \
                const float e4 = __builtin_amdgcn_exp2f(SS[B + 4]), e5 = __builtin_amdgcn_exp2f(SS[B + 5]), e6 = __builtin_amdgcn_exp2f(SS[B + 6]), e7 = __builtin_amdgcn_exp2f(SS[B + 7]); \
                ls0 += e0; ls1 += e4; ls0 += e1; ls1 += e5; ls0 += e2; ls1 += e6; ls0 += e3; ls1 += e7; \
                PF.u.x = cvtpk_s(e0, e1); PF.u.y = cvtpk_s(e2, e3); PF.u.z = cvtpk_s(e4, e5); PF.u.w = cvtpk_s(e6, e7); } while (0)
            union PFU { u32x4 u; bf16x8 b; };
            PFU p0, p1, p2, p3;
            AT_EXP(s0, 0, p0);
#pragma unroll
            for (int kk = 0; kk < 2; ++kk)
#pragma unroll
                for (int db = 0; db < NDB; ++db) vc[kk * NDB + db] = *(const ALAS bf16x8*)(sb + vx[kk + 2] + db * 4096);
            __builtin_amdgcn_sched_barrier(0);
#pragma unroll
            for (int db = 0; db < NDB; ++db) o[db] = __builtin_amdgcn_mfma_f32_32x32x16_bf16(va[db], p0.b, o[db], 0, 0, 0);
            AT_EXP(s0, 8, p1);
            __builtin_amdgcn_sched_barrier(0);
#pragma unroll
            for (int db = 0; db < NDB; ++db) o[db] = __builtin_amdgcn_mfma_f32_32x32x16_bf16(va[NDB + db], p1.b, o[db], 0, 0, 0);
            AT_EXP(s1, 0, p2);
            __builtin_amdgcn_sched_barrier(0);
#pragma unroll
            for (int db = 0; db < NDB; ++db) o[db] = __builtin_amdgcn_mfma_f32_32x32x16_bf16(vc[db], p2.b, o[db], 0, 0, 0);
            AT_EXP(s1, 8, p3);
            __builtin_amdgcn_sched_barrier(0);
#pragma unroll
            for (int db = 0; db < NDB; ++db) o[db] = __builtin_amdgcn_mfma_f32_32x32x16_bf16(vc[NDB + db], p3.b, o[db], 0, 0, 0);
            __builtin_amdgcn_sched_barrier(0);
#undef AT_EXP
            l_run += ls0 + ls1;
        }
    }
    asm volatile("s_waitcnt lgkmcnt(0)\n\ts_barrier" ::: "memory");
#undef qf
#undef AT_DMA
    const float l_tot = l_run + __shfl_xor(l_run, 32);
    const float inv = 1.0f / l_tot;
    const size_t orow = (size_t)(seq_base + qw + l31) * 1024;
    if (WIN) {
        bf16_t* yp = Y + orow + (2 * hsel + half) * 64 + 8 * hi;
#pragma unroll
        for (int db = 0; db < NDB; ++db)
#pragma unroll
            for (int p = 0; p < 2; ++p) {
                u32x2 w0, w1;
                w0.x = cvt_pk_bf16(o[db][8 * p] * inv, o[db][8 * p + 1] * inv); w0.y = cvt_pk_bf16(o[db][8 * p + 2] * inv, o[db][8 * p + 3] * inv);
                w1.x = cvt_pk_bf16(o[db][8 * p + 4] * inv, o[db][8 * p + 5] * inv); w1.y = cvt_pk_bf16(o[db][8 * p + 6] * inv, o[db][8 * p + 7] * inv);
                const u32x2 snd = hi ? w0 : w1, mine = hi ? w1 : w0;
                u32x2 rcv; rcv.x = (unsigned)__shfl_xor((int)snd.x, 32); rcv.y = (unsigned)__shfl_xor((int)snd.y, 32);
                u32x4 ow; if (hi) { ow.x = rcv.x; ow.y = rcv.y; ow.z = mine.x; ow.w = mine.y; } else { ow.x = mine.x; ow.y = mine.y; ow.z = rcv.x; ow.w = rcv.y; }
                *(u32x4*)(yp + 32 * db + 16 * p) = ow;
            }
    } else {
        ALAS f32x4* xch = (ALAS f32x4*)lds + (size_t)wq * 1024 + l31;
        if (half == 1) {
#pragma unroll
            for (int db = 0; db < NDB; ++db)
#pragma unroll
                for (int g = 0; g < 4; ++g) { f32x4 v; v[0] = o[db][4 * g] * inv; v[1] = o[db][4 * g + 1] * inv; v[2] = o[db][4 * g + 2] * inv; v[3] = o[db][4 * g + 3] * inv;
                    xch[(8 * db + 2 * g + hi) * 32] = v; }
        }
        __syncthreads();
        if (half == 0) {
            float ss = 0.f;
#pragma unroll
            for (int db = 0; db < NDB; ++db)
#pragma unroll
                for (int g = 0; g < 4; ++g) { const f32x4 v = xch[(8 * db + 2 * g + hi) * 32];
#pragma unroll
                    for (int i = 0; i < 4; ++i) { const float x = o[db][4 * g + i] * inv - lam * v[i]; o[db][4 * g + i] = x; ss += x * x; } }
            ss += __shfl_xor(ss, 32);
            const float rn = __builtin_amdgcn_rsqf(ss * (1.0f / 128.0f) + 1e-6f) * 0.8f;
            bf16_t* yp = Y + orow + 512 + hsel * 128 + 8 * hi;
#pragma unroll
            for (int db = 0; db < NDB; ++db)
#pragma unroll
                for (int p = 0; p < 2; ++p) {
                    const f32x4 ga = *(const ALAS f32x4*)(lds + OFF_SUB + (32 * db + 16 * p + 4 * hi) * 4), gb = *(const ALAS f32x4*)(lds + OFF_SUB + (32 * db + 16 * p + 8 + 4 * hi) * 4);
                    u32x2 w0, w1;
                    w0.x = cvt_pk_bf16(o[db][8 * p] * rn * ga[0], o[db][8 * p + 1] * rn * ga[1]); w0.y = cvt_pk_bf16(o[db][8 * p + 2] * rn * ga[2], o[db][8 * p + 3] * rn * ga[3]);
                    w1.x = cvt_pk_bf16(o[db][8 * p + 4] * rn * gb[0], o[db][8 * p + 5] * rn * gb[1]); w1.y = cvt_pk_bf16(o[db][8 * p + 6] * rn * gb[2], o[db][8 * p + 7] * rn * gb[3]);
                    const u32x2 snd = hi ? w0 : w1, mine = hi ? w1 : w0;
                    u32x2 rcv; rcv.x = (unsigned)__shfl_xor((int)snd.x, 32); rcv.y = (unsigned)__shfl_xor((int)snd.y, 32);
                    u32x4 ow; if (hi) { ow.x = rcv.x; ow.y = rcv.y; ow.z = mine.x; ow.w = mine.y; } else { ow.x = mine.x; ow.y = mine.y; ow.z = rcv.x; ow.w = rcv.y; }
                    *(u32x4*)(yp + 32 * db + 16 * p) = ow;
                }
        }
        __syncthreads();
    }
}

__device__ __forceinline__ void attn_phase(ALAS unsigned char* lds, const bf16_t* QK, const bf16_t* VT, bf16_t* Y, const float* rel_bias, const float* sinkp, const float* subln, const float* blam) {
    float lam;
    { const int lane = threadIdx.x & 63; float a = blam[lane] * blam[64 + lane], b = blam[128 + lane] * blam[192 + lane];
#pragma unroll
      for (int o = 1; o < 64; o <<= 1) { a += __shfl_xor(a, o); b += __shfl_xor(b, o); }
      lam = __expf(a) - __expf(b) + 0.2f; }
    { constexpr float LOG2E = 1.4426950408889634f; ALAS float* lutw = (ALAS float*)(lds + OFF_LUT);
      for (int i = threadIdx.x; i < 12 * LUTW; i += 512) { const int hh = i / LUTW, ri = i - hh * LUTW, rel = ri - LUTC;
        lutw[i] = (hh < 8 && (rel < -128 || rel > 128)) ? -1e30f : rel_bias[t5_bucket(rel) * 12 + hh] * LOG2E; }
      if (threadIdx.x < 128) ((ALAS float*)(lds + OFF_SUB))[threadIdx.x] = subln[threadIdx.x];
      __syncthreads(); }
    const int G = gridDim.x, bx = blockIdx.x;
    if (__builtin_amdgcn_readfirstlane((int)threadIdx.x) >= 256) __builtin_amdgcn_s_setprio(1);
    if (G == 256) {
        const int x = bx & 7, j = bx >> 3;
        for (int r = 0; r < 8; ++r) { const int bh = x + 8 * (r >> 1), qb = j + 32 * (r & 1);
            attn_unit<false>(lds, QK, VT, Y, rel_bias, sinkp, subln, lam, (bh >> 2) * 8192, 8192, qb * 128, bh & 3); }
        for (int r = 0; r < 8; ++r) { const int bh = x + 8 * ((j >> 4) + 2 * r), qb = j & 15;
            attn_unit<false>(lds, QK, VT, Y, rel_bias, sinkp, subln, lam, 65536 + (bh >> 2) * 2048, 2048, qb * 128, bh & 3); }
    } else {
    for (int u = bx; u < 2048; u += G) { const int qb = u & 63, bh = u >> 6; attn_unit<false>(lds, QK, VT, Y, rel_bias, sinkp, subln, lam, (bh >> 2) * 8192, 8192, qb * 128, bh & 3); }
    for (int u = bx; u < 2048; u += G) { const int qb = u & 15, bh = u >> 4; attn_unit<false>(lds, QK, VT, Y, rel_bias, sinkp, subln, lam, 65536 + (bh >> 2) * 2048, 2048, qb * 128, bh & 3); }
    }
    for (int u = bx; u < 4096; u += G) { const int hp = u & 3, qb = u >> 2;
        const int row0 = qb * 128; int seq_base, S;
        if (row0 < 65536) { seq_base = row0 & ~8191; S = 8192; } else { seq_base = row0 & ~2047; S = 2048; }
        attn_unit<true>(lds, QK, VT, Y, rel_bias, sinkp, subln, lam, seq_base, S, row0 - seq_base, hp); }
    __builtin_amdgcn_s_setprio(0);
}
}

namespace cv {
using pg8::bf16_t; using pg8::f32x4; using pg8::u32x4; using pg8::cvt_pk_bf16; using pg8::bf_lo; using pg8::bf_hi; using pg8::fast_sigmoid;
#define CLAS __attribute__((address_space(3)))
constexpr int T = 32, HALO = 15, ROWS = T + 2 * HALO;
constexpr int OFF_U0 = 0, OFF_U1 = 64 * 1024;
constexpr int CONV_LDS = OFF_U1 + T * 512 * 4;
__device__ __forceinline__ void conv_unit(CLAS unsigned char* lds, const bf16_t* __restrict__ PC, bf16_t* __restrict__ YC, const float* __restrict__ w3, const float* __restrict__ w31,
                                          const float* __restrict__ dwb, const float* __restrict__ lng, const float* __restrict__ lnb, int seq_base, int S, int t0) {
    const int tid = threadIdx.x;
    {
        u32x4 w8[8];
#pragma unroll
        for (int it = 0; it < 8; ++it) { const int idx = tid + 512 * it, j = idx >> 6, v = idx & 63, tok = t0 - HALO + j;
            w8[it] = (u32x4){0u, 0u, 0u, 0u};
            if (idx < ROWS * 64 && tok >= 0 && tok < S) w8[it] = *(const u32x4*)(PC + (size_t)(seq_base + tok) * 1536 + 1024 + v * 8); }
#pragma unroll
        for (int it = 0; it < 8; ++it) { const int idx = tid + 512 * it, j = idx >> 6, v = idx & 63;
            if (idx < ROWS * 64) *(CLAS u32x4*)(lds + OFF_U0 + j * 1024 + v * 16) = w8[it]; }
    }
    __syncthreads();
    const int cp = tid & 255, th = tid >> 8;
    {
        const float wa0 = w3[2 * cp], wa1 = w3[512 + 2 * cp], wa2 = w3[1024 + 2 * cp];
        const float wb0 = w3[2 * cp + 1], wb1 = w3[512 + 2 * cp + 1], wb2 = w3[1024 + 2 * cp + 1];
        const int tb = t0 + 16 * th;
        unsigned pw[18], gw[16];
#pragma unroll
        for (int i = 0; i < 18; ++i) { const int tok = tb - 1 + i; pw[i] = 0u; if (tok >= 0 && tok < S) pw[i] = *(const unsigned*)(PC + (size_t)(seq_base + tok) * 1536 + 512 + 2 * cp); }
#pragma unroll
        for (int i = 0; i < 16; ++i) gw[i] = *(const unsigned*)(PC + (size_t)(seq_base + tb + i) * 1536 + 2 * cp);
#pragma unroll
        for (int i = 0; i < 16; ++i) {
            const float ya = bf_lo(gw[i]) * (wa0 * bf_lo(pw[i]) + wa1 * bf_lo(pw[i + 1]) + wa2 * bf_lo(pw[i + 2]));
            const float yb = bf_hi(gw[i]) * (wb0 * bf_hi(pw[i]) + wb1 * bf_hi(pw[i + 1]) + wb2 * bf_hi(pw[i + 2]));
            *(unsigned*)(YC + (size_t)(seq_base + tb + i) * 1024 + 2 * cp) = cvt_pk_bf16(ya, yb);
        }
    }
    {
        float wa[31], wb[31];
#pragma unroll
        for (int j = 0; j < 31; ++j) { wa[j] = w31[j * 512 + 2 * cp]; wb[j] = w31[j * 512 + 2 * cp + 1]; }
        const float ba = dwb[2 * cp], bb = dwb[2 * cp + 1];
        for (int g4 = 0; g4 < 4; ++g4) {
            const int tt = 16 * th + 4 * g4;
            float aa[4], ab[4];
#pragma unroll
            for (int k = 0; k < 4; ++k) { aa[k] = ba; ab[k] = bb; }
            const CLAS unsigned char* up = lds + OFF_U0 + tt * 1024 + cp * 4;
#pragma unroll
            for (int rr = 0; rr < 34; ++rr) {
                const unsigned w = *(const CLAS unsigned*)(up + rr * 1024);
                const float xa = bf_lo(w), xb = bf_hi(w);
#pragma unroll
                for (int k = 0; k < 4; ++k) { const int j = rr - k; if (j >= 0 && j < 31) { aa[k] += wa[j] * xa; ab[k] += wb[j] * xb; } }
            }
#pragma unroll
            for (int k = 0; k < 4; ++k) { typedef float f32x2 __attribute__((ext_vector_type(2))); *(CLAS f32x2*)(lds + OFF_U1 + (tt + k) * 2048 + cp * 8) = (f32x2){aa[k], ab[k]}; }
        }
    }
    __syncthreads();
    {
        const int lane = tid & 63, wid = tid >> 6;
        const f32x4 g0 = *(const f32x4*)(lng + 8 * lane), g1 = *(const f32x4*)(lng + 8 * lane + 4), b0 = *(const f32x4*)(lnb + 8 * lane), b1 = *(const f32x4*)(lnb + 8 * lane + 4);
        for (int k = 0; k < 4; ++k) {
            const int tt = 4 * wid + k;
            const f32x4 x0 = *(const CLAS f32x4*)(lds + OFF_U1 + tt * 2048 + lane * 32), x1 = *(const CLAS f32x4*)(lds + OFF_U1 + tt * 2048 + lane * 32 + 16);
            float s = ((x0[0] + x0[1]) + (x0[2] + x0[3])) + ((x1[0] + x1[1]) + (x1[2] + x1[3]));
#pragma unroll
            for (int o = 1; o < 64; o <<= 1) s += __shfl_xor(s, o);
            const float mean = s * (1.0f / 512.0f);
            const f32x4 d0 = x0 - mean, d1 = x1 - mean;
            float q = ((d0[0] * d0[0] + d0[1] * d0[1]) + (d0[2] * d0[2] + d0[3] * d0[3])) + ((d1[0] * d1[0] + d1[1] * d1[1]) + (d1[2] * d1[2] + d1[3] * d1[3]));
#pragma unroll
            for (int o = 1; o < 64; o <<= 1) q += __shfl_xor(q, o);
            const float rstd = __builtin_amdgcn_rsqf(q * (1.0f / 512.0f) + 1e-6f);
            f32x4 y0 = d0 * rstd * g0 + b0, y1 = d1 * rstd * g1 + b1;
#pragma unroll
            for (int i = 0; i < 4; ++i) { y0[i] = y0[i] * fast_sigmoid(y0[i]); y1[i] = y1[i] * fast_sigmoid(y1[i]); }
            u32x4 w; w.x = cvt_pk_bf16(y0[0], y0[1]); w.y = cvt_pk_bf16(y0[2], y0[3]); w.z = cvt_pk_bf16(y1[0], y1[1]); w.w = cvt_pk_bf16(y1[2], y1[3]);
            *(u32x4*)(YC + (size_t)(seq_base + t0 + tt) * 1024 + 512 + 8 * lane) = w;
        }
    }
    __syncthreads();
}
__device__ __forceinline__ void conv_phase(CLAS unsigned char* lds, const bf16_t* PC, bf16_t* YC, const float* w3, const float* w31, const float* dwb, const float* lng, const float* lnb) {
    for (int u = blockIdx.x; u < 131072 / T; u += gridDim.x) {
        const int row0 = u * T; int seq_base, S;
        if (row0 < 65536) { seq_base = row0 & ~8191; S = 8192; } else { seq_base = row0 & ~2047; S = 2048; }
        conv_unit(lds, PC, YC, w3, w31, dwb, lng, lnb, seq_base, S, row0 - seq_base);
    }
}
}

namespace mk {
using pg8::bf16_t; using pg8::f32x4; using pg8::u32x4; using pg8::u32x2; using pg8::cvt_pk_bf16;
#define MLAS __attribute__((address_space(3)))
constexpr int M = 131072, D = 1024, FF = 2816, NQKV = 2304, NCI = 2560;
constexpr size_t MiB = 1u << 20;
constexpr size_t WS_X = 0;
constexpr size_t WS_BIG = 256 * MiB;
constexpr size_t WS_VT = WS_BIG + (size_t)M * pg8::QKW * 2;
constexpr size_t WS_W = 960 * MiB;
constexpr size_t WS_WQKV = WS_W, WS_WO = WS_WQKV + (size_t)NQKV * D * 2, WS_WGU0 = WS_WO + (size_t)D * D * 2, WS_WGU1 = WS_WGU0 + (size_t)2 * FF * D * 2,
                 WS_WD0 = WS_WGU1 + (size_t)2 * FF * D * 2, WS_WD1 = WS_WD0 + (size_t)D * FF * 2, WS_WCI = WS_WD1 + (size_t)D * FF * 2, WS_WCO = WS_WCI + (size_t)NCI * D * 2;
constexpr size_t WS_SSQ = 1008 * MiB;
constexpr size_t WS_CTL = 1016 * MiB, CTL_BYTES = 16384;
constexpr size_t WS_END = WS_CTL + 65536;
static_assert(WS_VT + (size_t)640 * pg8::VT_PITCH * 2 <= WS_W && WS_BIG + (size_t)M * FF * 2 <= WS_W && WS_WCO + (size_t)D * D * 2 <= WS_SSQ, "ws map");
constexpr int MISC_OFF = 155648, LDS_BYTES = MISC_OFF + 256;
static_assert(att::ATT_LDS <= MISC_OFF && cv::CONV_LDS <= MISC_OFF && pg8::STAGE_BYTES + 16384 <= MISC_OFF, "lds map");

#define XB_TMO      128
#define XB_XCNT(j)  (256  + 64 * (j))
#define XB_XSUB(j)  (1280 + 64 * (j))
#define XB_XGEN(j)  (2304 + 64 * (j))
#define XB_TOP      3328
#define XB_TOPGEN   3392
#define XCD_BAR_WORDS 3456
#define XB_SPIN_CAP (1u << 18)

__device__ __forceinline__ unsigned xb_ld(unsigned* p)              { return __hip_atomic_load(p, __ATOMIC_RELAXED, __HIP_MEMORY_SCOPE_AGENT); }
__device__ __forceinline__ unsigned xb_add(unsigned* p, unsigned v) { return __hip_atomic_fetch_add(p, v, __ATOMIC_RELAXED, __HIP_MEMORY_SCOPE_AGENT); }
__device__ __forceinline__ unsigned xb_xcc_id() { return (unsigned)__builtin_amdgcn_s_getreg((3 << 11) | 20) & 0xFu; }
#define XB_SPIN(cond, bar) do { unsigned _sp = 0; while (cond) { __builtin_amdgcn_s_sleep(1); \
    if ((++_sp & 255u) == 0u) { if (xb_ld(&(bar)[XB_TMO])) break; if (_sp > XB_SPIN_CAP) { atomicAdd(&(bar)[XB_TMO], 1u); break; } } } } while (0)

struct XcdBarrier {
    unsigned* bar; unsigned x;
    volatile MLAS unsigned* st;
};

__device__ __forceinline__ XcdBarrier xcd_barrier_post(unsigned* bar, volatile MLAS unsigned* st) {
    XcdBarrier b; b.bar = bar; b.x = xb_xcc_id(); b.st = st;
    if (threadIdx.x == 0) (void)xb_add(&bar[XB_XCNT(b.x)], 1u);
    return b;
}
__device__ __forceinline__ void xcd_barrier_complete(unsigned* bar, unsigned x, unsigned& nloc, unsigned& nx) {
    const unsigned G = gridDim.x * gridDim.y * gridDim.z;
    unsigned sum, cnt, mine, sp = 0u;
    for (;;) {
        sum = 0u; cnt = 0u; mine = 0u;
#pragma unroll
        for (unsigned j = 0; j < 16; ++j) { const unsigned c = xb_ld(&bar[XB_XCNT(j)]); sum += c; cnt += (c > 0u) ? 1u : 0u; mine = (j == x) ? c : mine; }
        if (sum == G) break;
        __builtin_amdgcn_s_sleep(1);
        if ((++sp & 255u) == 0u) { if (xb_ld(&bar[XB_TMO])) break; if (sp > XB_SPIN_CAP) { atomicAdd(&bar[XB_TMO], 1u); break; } }
    }
    nloc = mine > 0u ? mine : 1u; nx = cnt > 0u ? cnt : 1u;
}

__device__ __forceinline__ void xcd_barrier(const XcdBarrier& b) {
    asm volatile("s_waitcnt vmcnt(0)" ::: "memory");
    __syncthreads();
    if (threadIdx.x == 0) {
        unsigned* bar = b.bar;
        __builtin_amdgcn_s_waitcnt(0);
        unsigned nloc = b.st[0], nx = b.st[1];
        if (nloc == 0u) { xcd_barrier_complete(bar, b.x, nloc, nx); b.st[0] = nloc; b.st[1] = nx; }
        const unsigned old = xb_add(&bar[XB_XSUB(b.x)], 1u);
        const unsigned gen = old / nloc;
        if (old + 1u == (gen + 1u) * nloc) {
            __builtin_amdgcn_fence(__ATOMIC_RELEASE, "agent");
            asm volatile("s_waitcnt vmcnt(0)" ::: "memory");
            const unsigned og = xb_add(&bar[XB_TOP], 1u);
            const unsigned tg = og / nx;
            if (og + 1u == (tg + 1u) * nx) xb_add(&bar[XB_TOPGEN], 1u);
            else XB_SPIN(xb_ld(&bar[XB_TOPGEN]) == tg, bar);
            __builtin_amdgcn_fence(__ATOMIC_ACQUIRE, "agent");
            xb_add(&bar[XB_XGEN(b.x)], 1u);
            asm volatile("s_waitcnt vmcnt(0)" ::: "memory");
        } else {
            XB_SPIN(xb_ld(&bar[XB_XGEN(b.x)]) == gen, bar);
            __builtin_amdgcn_fence(__ATOMIC_ACQUIRE, "agent");
            asm volatile("s_waitcnt vmcnt(0)" ::: "memory");
        }
    }
    __syncthreads();
}

static_assert(XCD_BAR_WORDS * 4 <= CTL_BYTES, "barrier words");
struct Params { const float* in[24]; float* out; unsigned char* ws; int ph_lo, ph_hi; };

__device__ __forceinline__ void tr_item(const float* __restrict__ W, int ldw, int srccol0, const float* __restrict__ gain, bf16_t* __restrict__ WT, int K, int destrow0, int k0, MLAS float* scr, int lane) {
    float wv[32];
#pragma unroll
    for (int i = 0; i < 32; ++i) { const int kk = 2 * i + (lane >> 5); wv[i] = __builtin_nontemporal_load(W + (size_t)(k0 + kk) * ldw + srccol0 + (lane & 31)); }
    const float g0 = gain ? gain[k0 + (lane & 31) * 2] : 1.0f, g1 = gain ? gain[k0 + (lane & 31) * 2 + 1] : 1.0f;
#pragma unroll
    for (int i = 0; i < 32; ++i) { const int kk = 2 * i + (lane >> 5); const float ga = __shfl(g0, i), gb = __shfl(g1, i); scr[kk * 33 + (lane & 31)] = wv[i] * ((lane >> 5) ? gb : ga); }
    asm volatile("s_waitcnt lgkmcnt(0)" ::: "memory");
    const int c = lane & 7;
#pragma unroll
    for (int j = 0; j < 4; ++j) { const int n = (lane >> 3) + 8 * j; const MLAS float* s = scr + (8 * c) * 33 + n;
        u32x4 o; o.x = cvt_pk_bf16(s[0 * 33], s[1 * 33]); o.y = cvt_pk_bf16(s[2 * 33], s[3 * 33]); o.z = cvt_pk_bf16(s[4 * 33], s[5 * 33]); o.w = cvt_pk_bf16(s[6 * 33], s[7 * 33]);
        *(u32x4*)(WT + (size_t)(destrow0 + n) * K + k0 + 8 * c) = o; }
    asm volatile("s_waitcnt lgkmcnt(0)" ::: "memory");
}

__device__ __forceinline__ void prologue(const Params& p, MLAS unsigned char* lds) {
    const int tid = threadIdx.x, lane = tid & 63, wave = tid >> 6;
    MLAS float* scr = (MLAS float*)(lds + wave * 16384);
    const int gw = blockIdx.x * 8 + wave, NGW = gridDim.x * 8;
    unsigned char* ws = p.ws;
    constexpr int I_QKV = (NQKV / 32) * (D / 64), I_O = (D / 32) * (D / 64), I_GU = (2 * FF / 32) * (D / 64), I_D = (D / 32) * (FF / 64), I_CI = (NCI / 32) * (D / 64);
    constexpr int NIT = I_QKV + I_O + 2 * I_GU + 2 * I_D + I_CI + I_O;
    for (int it = gw; it < NIT; it += NGW) {
        int r = it;
        if (r < I_QKV) { const int kb = r / (NQKV / 32), nb = r % (NQKV / 32); const int n0 = nb * 32, pn = n0 >> 8, within = n0 & 255, bj = within >> 7, wc = (within & 127) >> 5;
            tr_item(p.in[8], NQKV, 256 * pn + 64 * wc + 32 * bj, p.in[3], (bf16_t*)(ws + WS_WQKV), D, n0, kb * 64, scr, lane); continue; }
        r -= I_QKV;
        if (r < I_O) { const int kb = r / (D / 32), nb = r % (D / 32); tr_item(p.in[9], D, nb * 32, nullptr, (bf16_t*)(ws + WS_WO), D, nb * 32, kb * 64, scr, lane); continue; }
        r -= I_O;
        if (r < 2 * I_GU) { const int l = r / I_GU; r -= l * I_GU; const int kb = r / (2 * FF / 32), nb = r % (2 * FF / 32); const int n0 = nb * 32, pn = n0 >> 8, within = n0 & 255, bj = within >> 7, j = within & 127;
            const float* src = (bj ? p.in[6] : p.in[5]) + (size_t)l * D * FF;
            tr_item(src, FF, 128 * pn + j, p.in[4] + l * D, (bf16_t*)(ws + (l ? WS_WGU1 : WS_WGU0)), D, n0, kb * 64, scr, lane); continue; }
        r -= 2 * I_GU;
        if (r < 2 * I_D) { const int l = r / I_D; r -= l * I_D; const int kb = r / (D / 32), nb = r % (D / 32);
            tr_item(p.in[7] + (size_t)l * FF * D, D, nb * 32, nullptr, (bf16_t*)(ws + (l ? WS_WD1 : WS_WD0)), FF, nb * 32, kb * 64, scr, lane); continue; }
        r -= 2 * I_D;
        if (r < I_CI) { const int kb = r / (NCI / 32), nb = r % (NCI / 32); const int n0 = nb * 32, pn = n0 >> 8, within = n0 & 255, bj = within >> 7, j = within & 127;
            const int src = pn < 2 ? n0 : (pn < 6 ? (bj ? 1024 : 512) + 128 * (pn - 2) + j : (bj ? 2048 : 1536) + 128 * (pn - 6) + j);
            tr_item(p.in[17], NCI, src, p.in[3] + D, (bf16_t*)(ws + WS_WCI), D, n0, kb * 64, scr, lane); continue; }
        r -= I_CI;
        { const int kb = r / (D / 32), nb = r % (D / 32); tr_item(p.in[18], D, nb * 32, nullptr, (bf16_t*)(ws + WS_WCO), D, nb * 32, kb * 64, scr, lane); }
    }
    bf16_t* X = (bf16_t*)(ws + WS_X); float* ssq = (float*)(ws + WS_SSQ);
    for (int m0 = gw; m0 < M; m0 += 4 * NGW) {
        f32x4 v[4][4];
#pragma unroll
        for (int r = 0; r < 4; ++r) { const int m = m0 + r * NGW; if (m < M) { const float* xrow = (m < 65536) ? p.in[0] + (size_t)m * D : p.in[1] + (size_t)(m - 65536) * D; const f32x4* xr = (const f32x4*)xrow + lane;
#pragma unroll
            for (int j = 0; j < 4; ++j) v[r][j] = __builtin_nontemporal_load(xr + 64 * j); } }
#pragma unroll
        for (int r = 0; r < 4; ++r) { const int m = m0 + r * NGW; if (m < M) {
            float s = 0.f;
#pragma unroll
            for (int j = 0; j < 4; ++j) s += (v[r][j][0] * v[r][j][0] + v[r][j][1] * v[r][j][1]) + (v[r][j][2] * v[r][j][2] + v[r][j][3] * v[r][j][3]);
#pragma unroll
            for (int o = 1; o < 64; o <<= 1) s += __shfl_xor(s, o);
            u32x2* o8 = (u32x2*)(X + (size_t)m * D) + lane;
#pragma unroll
            for (int j = 0; j < 4; ++j) { u32x2 w; w.x = cvt_pk_bf16(v[r][j][0], v[r][j][1]); w.y = cvt_pk_bf16(v[r][j][2], v[r][j][3]); o8[64 * j] = w; }
            if (lane < 16) ssq[(size_t)m * 16 + lane] = (lane == 0) ? s : 0.f; } }
    }
}

__global__ void __launch_bounds__(512, 2) fwd_kernel(Params p) {
    extern __shared__ __attribute__((aligned(16))) unsigned char lds_raw[];
    MLAS unsigned char* lds = (MLAS unsigned char*)lds_raw;
    cg::grid_group grid = cg::this_grid();
    unsigned char* ws = p.ws;
    bf16_t* X = (bf16_t*)(ws + WS_X); bf16_t* BIG = (bf16_t*)(ws + WS_BIG); bf16_t* VT = (bf16_t*)(ws + WS_VT); float* ssq = (float*)(ws + WS_SSQ);
    bf16_t* Y = (bf16_t*)p.out;
    const int lo = p.ph_lo, hi = p.ph_hi, G = gridDim.x, bx = blockIdx.x;
    volatile MLAS unsigned* misc = (volatile MLAS unsigned*)(lds + MISC_OFF);
    if (threadIdx.x < 2) misc[threadIdx.x] = 0u;
    __syncthreads();
    const XcdBarrier xbar = xcd_barrier_post((unsigned*)(ws + WS_CTL), misc);
#ifndef PH_MASK
#define PH_MASK 0x7ff
#endif
#define IN(k) (((PH_MASK >> (k)) & 1) && lo <= (k) && (k) < hi)
#define SEAM(k) do { if (IN(k) && IN((k) + 1)) { if ((k) == 0) grid.sync(); else xcd_barrier(xbar); } } while (0)
    if (IN(0)) { prologue(p, lds); __syncthreads(); }
    SEAM(0);
    if (IN(1)) { pg8::Gemm g{X, (const bf16_t*)(ws + WS_WQKV), M, NQKV, D}; pg8::StaticOrder S; S.init(M, NQKV, G, bx, 1);
        pg8::EpiQKV E{BIG, VT, ssq, p.in[10], p.in[11], p.in[13], p.in[14], lds + pg8::STAGE_BYTES};
        pg8::gemm_phase<pg8::EpiQKV, pg8::StaticOrder, true, true>(lds, g, S, E); }
    SEAM(1);
    if (IN(2)) { for (int rep = 0; rep < PROBE_ATT; ++rep) att::attn_phase(lds, BIG, VT, Y, p.in[2], p.in[12], p.in[16], p.in[15]); }
    SEAM(2);
    if (IN(3)) { pg8::Gemm g{Y, (const bf16_t*)(ws + WS_WO), M, D, D}; pg8::StaticOrder S; S.init(M, D, G, bx, 1);
        pg8::EpiRes<false> E{X, nullptr, ssq};
        pg8::gemm_phase<pg8::EpiRes<false>, pg8::StaticOrder, true, true>(lds, g, S, E); }
    SEAM(3);
    if (IN(4)) { pg8::Gemm g{X, (const bf16_t*)(ws + WS_WGU0), M, 2 * FF, D}; pg8::StaticOrder S; S.init(M, 2 * FF, G, bx);
        pg8::EpiGlu E{BIG, ssq};
        pg8::gemm_phase<pg8::EpiGlu, pg8::StaticOrder, true, true>(lds, g, S, E); }
    SEAM(4);
    if (IN(5)) { pg8::Gemm g{BIG, (const bf16_t*)(ws + WS_WD0), M, D, FF}; pg8::StaticOrder S; S.init(M, D, G, bx, 1);
        pg8::EpiRes<false> E{X, nullptr, ssq};
        pg8::gemm_phase<pg8::EpiRes<false>, pg8::StaticOrder, true, true>(lds, g, S, E); }
    SEAM(5);
    if (IN(6)) { pg8::Gemm g{X, (const bf16_t*)(ws + WS_WCI), M, NCI, D}; pg8::StaticOrder S; S.init(M, NCI, G, bx);
        pg8::EpiConvIn E{BIG, ssq};
        pg8::gemm_phase<pg8::EpiConvIn, pg8::StaticOrder, true, true>(lds, g, S, E); }
    SEAM(6);
    if (IN(7)) { cv::conv_phase(lds, BIG, Y, p.in[19], p.in[20], p.in[21], p.in[22], p.in[23]); }
    SEAM(7);
    if (IN(8)) { pg8::Gemm g{Y, (const bf16_t*)(ws + WS_WCO), M, D, D}; pg8::StaticOrder S; S.init(M, D, G, bx, 1);
        pg8::EpiRes<false> E{X, nullptr, ssq};
        pg8::gemm_phase<pg8::EpiRes<false>, pg8::StaticOrder, true, true>(lds, g, S, E); }
    SEAM(8);
    if (IN(9)) { pg8::Gemm g{X, (const bf16_t*)(ws + WS_WGU1), M, 2 * FF, D}; pg8::StaticOrder S; S.init(M, 2 * FF, G, bx);
        pg8::EpiGlu E{BIG, ssq};
        pg8::gemm_phase<pg8::EpiGlu, pg8::StaticOrder, true, true>(lds, g, S, E); }
    SEAM(9);
    if (IN(10)) { pg8::Gemm g{BIG, (const bf16_t*)(ws + WS_WD1), M, D, FF}; pg8::StaticOrder S; S.init(M, D, G, bx, 1);
        pg8::EpiRes<true> E{X, p.out, ssq};
        pg8::gemm_phase<pg8::EpiRes<true>, pg8::StaticOrder, true, true>(lds, g, S, E); }
#undef IN
#undef SEAM
}
}

#ifndef MK_N_LAUNCHES_X
#define MK_N_LAUNCHES 1
#endif
extern "C" void kernel_launch(void* const* d_in, const int* in_sizes, int n_in, void* d_out, int out_size, void* d_ws, size_t ws_size, hipStream_t stream) {
    static int grid = 0;
    if (grid == 0) {
        if (n_in != 24 || out_size != mk::M * mk::D || ws_size < mk::WS_END) { fprintf(stderr, "kernel_launch: unexpected shapes (n_in %d out %d ws %zu)\n", n_in, out_size, ws_size); grid = -1; return; }
        int dev = 0, cus = 0, per_cu = 0;
        (void)hipGetDevice(&dev); (void)hipDeviceGetAttribute(&cus, hipDeviceAttributeMultiprocessorCount, dev);
        (void)hipFuncSetAttribute((const void*)mk::fwd_kernel, hipFuncAttributeMaxDynamicSharedMemorySize, mk::LDS_BYTES);
        (void)hipOccupancyMaxActiveBlocksPerMultiprocessor(&per_cu, (const void*)mk::fwd_kernel, 512, mk::LDS_BYTES);
        if (per_cu < 1) per_cu = 1;
        (void)hipGetLastError();
        grid = cus * per_cu;
    }
    if (grid < 0) return;
    if (hipMemsetAsync((char*)d_ws + mk::WS_CTL, 0, mk::CTL_BYTES, stream) != hipSuccess) { fprintf(stderr, "kernel_launch: memset of the barrier words failed\n"); return; }
    mk::Params p{};
    for (int i = 0; i < 24; ++i) p.in[i] = (const float*)d_in[i];
    p.out = (float*)d_out; p.ws = (unsigned char*)d_ws;
#if MK_N_LAUNCHES == 1
    p.ph_lo = 0; p.ph_hi = 11;
    void* args[] = {&p};
    hipError_t e = hipLaunchCooperativeKernel((const void*)mk::fwd_kernel, dim3(grid), dim3(512), args, mk::LDS_BYTES, stream);
    if (e != hipSuccess) fprintf(stderr, "cooperative launch failed: %s (grid %d)\n", hipGetErrorString(e), grid);
#else
    for (int ph = 0; ph < 11; ++ph) { p.ph_lo = ph; p.ph_hi = ph + 1; hipLaunchKernelGGL(mk::fwd_kernel, dim3(grid), dim3(512), mk::LDS_BYTES, stream, p); }
#endif
}
```

```cpp
#include <hip/hip_runtime.h>
#include <hip/hip_cooperative_groups.h>
#include <cstdio>
#include <cstdint>
namespace cg = cooperative_groups;
#ifndef PROBE_ATT
#define PROBE_ATT 1
#endif
#ifndef MK_N_LAUNCHES
#define MK_N_LAUNCHES 1
#endif
namespace pg8 {
#define PG8_LAS __attribute__((address_space(3)))
typedef unsigned short bf16_t;
typedef short bf16x8 __attribute__((ext_vector_type(8)));
typedef float f32x4 __attribute__((ext_vector_type(4)));
typedef unsigned u32x4 __attribute__((ext_vector_type(4)));
constexpr int BM = 256, BK = 64, HALF = 128, HTB = HALF * BK * 2  , STAGE_BYTES = 8 * HTB, NXCD = 8, WGM = 8;

__host__ __device__ __forceinline__ int lds_byte(int r, int c) { const int st = (r >> 4) * 2 + (c >> 5), rr = r & 15, cc = c & 31, ob = rr * 64 + cc * 2; return st * 1024 + (ob ^ (((ob >> 9) & 1) << 5)); }
__host__ __device__ __forceinline__ void stage_rc(int b, int& R, int& C) { const int st = b / 1024, sb = b % 1024, swz = sb ^ (((sb >> 9) & 1) << 5); R = (st >> 1) * 16 + swz / 64; C = (st & 1) * 32 + (swz % 64) / 2; }
__host__ __device__ __forceinline__ int perm32(int rho) { const int n = rho >> 4, i = rho & 15; return 8 * (i >> 2) + 4 * n + (i & 3); }

struct Unit { int pm, pn; };
struct Gemm { const bf16_t* A; const bf16_t* Bt; int M, N, K; };

struct StaticOrder {
    int nM, nN, nwg, G, c, nI, rev;
    __host__ __device__ void init(int M, int N, int G_, int c_, int rev_ = 0) { nM = M / BM; nN = N / BM; nwg = nM * nN; G = G_; c = c_; nI = (nwg + G - 1) / G; rev = (rev_ && (nwg % G) == 0) ? 1 : 0; }
    __host__ __device__ bool next(int i, Unit& u) const {
        if (i >= nI) return false;
        const long L = (long)(rev ? nI - 1 - i : i) * G + c; if (L >= nwg) return false;
        int wgid = (int)L; { const int q = nwg / NXCD, r = nwg % NXCD, xcd = wgid % NXCD, off = wgid / NXCD; wgid = (xcd < r ? xcd * (q + 1) : r * (q + 1) + (xcd - r) * q) + off; }
        const int nig = WGM * nN, gid = wgid / nig, fm = gid * WGM, gsz = (nM - fm) < WGM ? (nM - fm) : WGM;
        u.pm = fm + ((wgid % nig) % gsz); u.pn = (wgid % nig) / gsz; return true;
    }
    __device__ __forceinline__ void a_ready(const Unit&) const {}
    __device__ __forceinline__ void done(const Unit&) const {}
};

__device__ __forceinline__ unsigned cvt_pk_bf16(float lo, float hi) { unsigned r; asm volatile("v_cvt_pk_bf16_f32 %0, %1, %2" : "=v"(r) : "v"(lo), "v"(hi)); return r; }
typedef float f32x2 __attribute__((ext_vector_type(2)));
typedef unsigned u32x2 __attribute__((ext_vector_type(2)));
__device__ __forceinline__ float bf_lo(unsigned w) { return __uint_as_float(w << 16); }
__device__ __forceinline__ float bf_hi(unsigned w) { return __uint_as_float(w & 0xffff0000u); }
__device__ __forceinline__ float row_rstd(const float* ssq, int row) {
    const f32x4* p = (const f32x4*)(ssq + (size_t)row * 16);
    const f32x4 a = p[0], b = p[1], c = p[2], d = p[3];
    const float s = ((a[0] + a[1]) + (a[2] + a[3])) + ((b[0] + b[1]) + (b[2] + b[3])) + ((c[0] + c[1]) + (c[2] + c[3])) + ((d[0] + d[1]) + (d[2] + d[3]));
    return __builtin_amdgcn_rsqf(s * (1.0f / 1024.0f) + 1e-6f);
}
__device__ __forceinline__ void rows_rstd(const float* ssq, int row0, int fq, float (&rs)[2][4]) {
    f32x4 pr[2][4];
#pragma unroll
    for (int ai = 0; ai < 2; ++ai)
#pragma unroll
        for (int m = 0; m < 4; ++m) pr[ai][m] = *(const f32x4*)(ssq + (size_t)(row0 + ai * HALF + m * 16) * 16 + 4 * fq);
#pragma unroll
    for (int ai = 0; ai < 2; ++ai)
#pragma unroll
        for (int m = 0; m < 4; ++m) { float t = (pr[ai][m][0] + pr[ai][m][1]) + (pr[ai][m][2] + pr[ai][m][3]); t += __shfl_xor(t, 16); t += __shfl_xor(t, 32); rs[ai][m] = __builtin_amdgcn_rsqf(t * (1.0f / 1024.0f) + 1e-6f); }
}
__device__ __forceinline__ float fast_sigmoid(float x) { return __builtin_amdgcn_rcpf(1.0f + __expf(-x)); }

constexpr int QKW = 1664;
constexpr int VT_PITCH = 131072 + 128;
constexpr float C2Q = 0.125f * 1.4426950408889634f;

struct EpiQKV {
    static constexpr bool PERM = true, AFTER_DRAIN = false;
    bf16_t* QK; bf16_t* VT; const float* ssq; const float* aq; const float* ak; const float* bq; const float* bk; PG8_LAS unsigned char* xlds;
    __device__ __forceinline__ void operator()(const f32x4 (&acc)[2][2][4][2], const Unit& u, int wr, int wc, int fr, int fq) const {
        const int L = u.pn * 256 + wc * 64;
        int kind; const float* gain = nullptr; float scale = 1.f; int ccol = 0, vrow = 0;
        if (L < 512) { kind = 0; gain = aq; scale = C2Q; ccol = L; }
        else if (L < 640) { kind = 0; gain = ak; ccol = L; }
        else if (L < 768) { kind = 1; vrow = L - 640; }
        else if (L < 1280) { kind = 0; gain = bq; scale = C2Q; ccol = L - 128; }
        else if (L < 1792) { kind = 0; gain = bk; ccol = L - 128; }
        else { kind = 1; vrow = L - 1792 + 128; }
        if (kind == 0) {
            f32x4 gv[2][2];
#pragma unroll
            for (int bj = 0; bj < 2; ++bj)
#pragma unroll
                for (int n = 0; n < 2; ++n) gv[bj][n] = *(const f32x4*)(gain + 32 * bj + 8 * fq + 4 * n);
            float rsv[2][4]; rows_rstd(ssq, u.pm * BM + wr * 64 + fr, fq, rsv);
#pragma unroll
            for (int ai = 0; ai < 2; ++ai)
#pragma unroll
                for (int m = 0; m < 4; ++m) {
                    const int row = u.pm * BM + ai * HALF + wr * 64 + m * 16 + fr;
                    const float rs = rsv[ai][m];
                    float ss = 0.f;
#pragma unroll
                    for (int bj = 0; bj < 2; ++bj)
#pragma unroll
                        for (int n = 0; n < 2; ++n) { const f32x4 v = acc[ai][bj][m][n] * rs; ss += (v[0] * v[0] + v[1] * v[1]) + (v[2] * v[2] + v[3] * v[3]); }
                    ss += __shfl_xor(ss, 16); ss += __shfl_xor(ss, 32);
                    const float f = rs * __builtin_amdgcn_rsqf(ss * (1.0f / 64.0f) + 1e-6f) * scale;
                    bf16_t* rowp = QK + ((size_t)((row >> 6) * 26 + (ccol >> 6)) * 64 + (row & 63)) * 64 + 8 * fq;
#pragma unroll
                    for (int bj = 0; bj < 2; ++bj) {
                        const f32x4 v0 = acc[ai][bj][m][0] * f * gv[bj][0], v1 = acc[ai][bj][m][1] * f * gv[bj][1];
                        u32x4 w; w.x = cvt_pk_bf16(v0[0], v0[1]); w.y = cvt_pk_bf16(v0[2], v0[3]); w.z = cvt_pk_bf16(v1[0], v1[1]); w.w = cvt_pk_bf16(v1[2], v1[3]);
                        *(u32x4*)(rowp + 32 * bj) = w;
                    }
                }
        } else {
            PG8_LAS unsigned char* xl = xlds + (wr * 4 + wc) * 2048;
            const int lane = fq * 16 + fr;
            float rsv[2][4]; rows_rstd(ssq, u.pm * BM + wr * 64 + fr, fq, rsv);
#pragma unroll
            for (int ai = 0; ai < 2; ++ai) {
                float rs[4];
#pragma unroll
                for (int m = 0; m < 4; ++m) rs[m] = rsv[ai][m];
                const size_t tb = (size_t)(u.pm * 4 + ai * 2 + wr) * 640;
#pragma unroll
                for (int bj = 0; bj < 2; ++bj)
#pragma unroll
                    for (int n = 0; n < 2; ++n) {
#pragma unroll
                        for (int m = 0; m < 4; ++m) {
                            const f32x4 v = acc[ai][bj][m][n] * rs[m];
                            const unsigned w0 = cvt_pk_bf16(v[0], v[1]), w1 = cvt_pk_bf16(v[2], v[3]);
                            PG8_LAS bf16_t* q = (PG8_LAS bf16_t*)(xl + (4 * fq) * 128 + (16 * m + fr) * 2);
                            q[0] = (bf16_t)(w0 & 0xffffu); q[64] = (bf16_t)(w0 >> 16); q[128] = (bf16_t)(w1 & 0xffffu); q[192] = (bf16_t)(w1 >> 16);
                        }
                        asm volatile("s_waitcnt lgkmcnt(0)" ::: "memory");
                        const int c16 = lane >> 2, part = lane & 3;
                        const u32x4 a = *(const PG8_LAS u32x4*)(xl + c16 * 128 + part * 32), b = *(const PG8_LAS u32x4*)(xl + c16 * 128 + part * 32 + 16);
                        bf16_t* gp = VT + (tb + vrow + 32 * bj + 8 * (c16 >> 2) + 4 * n + (c16 & 3)) * 64 + part * 16;
                        *(u32x4*)gp = a; *(u32x4*)(gp + 8) = b;
                        asm volatile("s_waitcnt lgkmcnt(0)" ::: "memory");
                    }
            }
        }
    }
};

template <bool FINAL> struct EpiRes {
    static constexpr bool PERM = true, AFTER_DRAIN = false;
    bf16_t* X; float* out; float* ssq;
    __device__ __forceinline__ void operator()(const f32x4 (&acc)[2][2][4][2], const Unit& u, int wr, int wc, int fr, int fq) const {
        const int col0 = u.pn * BM + wc * 32 + 8 * fq;
        u32x4 xin[2][4][2];
#pragma unroll
        for (int ai = 0; ai < 2; ++ai)
#pragma unroll
            for (int m = 0; m < 4; ++m)
#pragma unroll
                for (int bj = 0; bj < 2; ++bj) xin[ai][m][bj] = *(const u32x4*)(X + (size_t)(u.pm * BM + ai * HALF + wr * 64 + m * 16 + fr) * 1024 + col0 + bj * HALF);
#pragma unroll
        for (int ai = 0; ai < 2; ++ai)
#pragma unroll
            for (int m = 0; m < 4; ++m) {
                const int row = u.pm * BM + ai * HALF + wr * 64 + m * 16 + fr;
                float ss = 0.f;
#pragma unroll
                for (int bj = 0; bj < 2; ++bj) {
                    bf16_t* xp = X + (size_t)row * 1024 + col0 + bj * HALF;
                    const u32x4 xv = xin[ai][m][bj];
                    f32x4 y0 = acc[ai][bj][m][0], y1 = acc[ai][bj][m][1];
                    y0[0] += bf_lo(xv.x); y0[1] += bf_hi(xv.x); y0[2] += bf_lo(xv.y); y0[3] += bf_hi(xv.y);
                    y1[0] += bf_lo(xv.z); y1[1] += bf_hi(xv.z); y1[2] += bf_lo(xv.w); y1[3] += bf_hi(xv.w);
                    if (FINAL) {
                        float* op = out + (size_t)row * 1024 + col0 + bj * HALF;
                        __builtin_nontemporal_store(y0, (f32x4*)op); __builtin_nontemporal_store(y1, (f32x4*)(op + 4));
                    } else {
                        u32x4 w; w.x = cvt_pk_bf16(y0[0], y0[1]); w.y = cvt_pk_bf16(y0[2], y0[3]); w.z = cvt_pk_bf16(y1[0], y1[1]); w.w = cvt_pk_bf16(y1[2], y1[3]);
                        *(u32x4*)xp = w;
                        ss += (y0[0] * y0[0] + y0[1] * y0[1]) + (y0[2] * y0[2] + y0[3] * y0[3]) + (y1[0] * y1[0] + y1[1] * y1[1]) + (y1[2] * y1[2] + y1[3] * y1[3]);
                    }
                }
                if (!FINAL) {
                    ss += __shfl_xor(ss, 16); ss += __shfl_xor(ss, 32);
                    if (fq == 0) ssq[(size_t)row * 16 + u.pn * 4 + wc] = ss;
                }
            }
    }
};

struct EpiGlu {
    static constexpr bool PERM = true, AFTER_DRAIN = false;
    bf16_t* H; const float* ssq;
    __device__ __forceinline__ void operator()(const f32x4 (&acc)[2][2][4][2], const Unit& u, int wr, int wc, int fr, int fq) const {
        const int col0 = u.pn * HALF + wc * 32 + 8 * fq;
        float rsv[2][4]; rows_rstd(ssq, u.pm * BM + wr * 64 + fr, fq, rsv);
#pragma unroll
        for (int ai = 0; ai < 2; ++ai)
#pragma unroll
            for (int m = 0; m < 4; ++m) {
                const int row = u.pm * BM + ai * HALF + wr * 64 + m * 16 + fr;
                const float rs = rsv[ai][m];
                float h[8];
#pragma unroll
                for (int n = 0; n < 2; ++n)
#pragma unroll
                    for (int i = 0; i < 4; ++i) { const float g = acc[ai][0][m][n][i] * rs, up = acc[ai][1][m][n][i] * rs; h[4 * n + i] = g * up * fast_sigmoid(g); }
                u32x4 w; w.x = cvt_pk_bf16(h[0], h[1]); w.y = cvt_pk_bf16(h[2], h[3]); w.z = cvt_pk_bf16(h[4], h[5]); w.w = cvt_pk_bf16(h[6], h[7]);
                *(u32x4*)(H + (size_t)row * 2816 + col0) = w;
            }
    }
};

struct EpiConvIn {
    static constexpr bool PERM = true, AFTER_DRAIN = false;
    bf16_t* O; const float* ssq;
    __device__ __forceinline__ void operator()(const f32x4 (&acc)[2][2][4][2], const Unit& u, int wr, int wc, int fr, int fq) const {
        float rsv[2][4]; rows_rstd(ssq, u.pm * BM + wr * 64 + fr, fq, rsv);
#pragma unroll
        for (int ai = 0; ai < 2; ++ai)
#pragma unroll
            for (int m = 0; m < 4; ++m) {
                const int row = u.pm * BM + ai * HALF + wr * 64 + m * 16 + fr;
                const float rs = rsv[ai][m];
                bf16_t* rp = O + (size_t)row * 1536 + wc * 32 + 8 * fq;
                if (u.pn < 2) {
#pragma unroll
                    for (int bj = 0; bj < 2; ++bj) {
                        const f32x4 v0 = acc[ai][bj][m][0] * rs, v1 = acc[ai][bj][m][1] * rs;
                        u32x4 w; w.x = cvt_pk_bf16(v0[0], v0[1]); w.y = cvt_pk_bf16(v0[2], v0[3]); w.z = cvt_pk_bf16(v1[0], v1[1]); w.w = cvt_pk_bf16(v1[2], v1[3]);
                        *(u32x4*)(rp + u.pn * BM + bj * HALF) = w;
                    }
                } else {
                    float h[8];
                    const bool glu = u.pn >= 6;
#pragma unroll
                    for (int n = 0; n < 2; ++n)
#pragma unroll
                        for (int i = 0; i < 4; ++i) { const float a = acc[ai][0][m][n][i] * rs, b = acc[ai][1][m][n][i] * rs; h[4 * n + i] = glu ? a * fast_sigmoid(b) : a * b; }
                    u32x4 w; w.x = cvt_pk_bf16(h[0], h[1]); w.y = cvt_pk_bf16(h[2], h[3]); w.z = cvt_pk_bf16(h[4], h[5]); w.w = cvt_pk_bf16(h[6], h[7]);
                    *(u32x4*)(rp + 512 + (u.pn - 2) * HALF) = w;
                }
            }
    }
};

struct EpiPlain {
    static constexpr bool PERM = true, AFTER_DRAIN = false;
    bf16_t* O; int ldc; const float* ssq;
    __device__ __forceinline__ void operator()(const f32x4 (&acc)[2][2][4][2], const Unit& u, int wr, int wc, int fr, int fq) const {
        const int col0 = u.pn * BM + wc * 32 + 8 * fq;
#pragma unroll
        for (int ai = 0; ai < 2; ++ai)
#pragma unroll
            for (int m = 0; m < 4; ++m) {
                const int row = u.pm * BM + ai * HALF + wr * 64 + m * 16 + fr;
                const float rs = row_rstd(ssq, row);
#pragma unroll
                for (int bj = 0; bj < 2; ++bj) {
                    const f32x4 v0 = acc[ai][bj][m][0] * rs, v1 = acc[ai][bj][m][1] * rs;
                    u32x4 w; w.x = cvt_pk_bf16(v0[0], v0[1]); w.y = cvt_pk_bf16(v0[2], v0[3]); w.z = cvt_pk_bf16(v1[0], v1[1]); w.w = cvt_pk_bf16(v1[2], v1[3]);
                    *(u32x4*)(O + (size_t)row * ldc + col0 + bj * HALF) = w;
                }
            }
    }
};

template <class Epi, class Sched, bool ALIGN_EPI = false, bool SP2 = false>
__device__ __forceinline__ void gemm_phase(PG8_LAS unsigned char* lds, const Gemm g, const Sched& S, const Epi& E) {
    const int tid = threadIdx.x, wid = __builtin_amdgcn_readfirstlane(tid >> 6), lane = tid & 63, wr = wid >> 2, wc = wid & 3, fr = lane & 15, fq = lane >> 4;
    const int K = g.K, nt = K / BK;
    unsigned voffA[2], voffB[2];
#pragma unroll
    for (int i = 0; i < 2; ++i) { int R, C; stage_rc(tid * 16 + i * 8192, R, C); const int Rb = Epi::PERM ? ((R & ~31) + perm32(R & 31)) : R;
        voffA[i] = (unsigned)(R * K + C) * 2u; voffB[i] = (unsigned)(Rb * K + C) * 2u; }
    const size_t kstep = (size_t)(BK * 2);
    const size_t hstep = (size_t)HALF * K * 2;
    const size_t tstep = 2 * hstep;
    const unsigned ldsw = (unsigned)wid * 1024u;
    const int aoff = lds_byte(wr * 64 + fr, fq * 8), boff = lds_byte(wc * 32 + fr, fq * 8);
#define PG8_SA(b, h) (((b) * 2 + (h)) * HTB)
#define PG8_SB(b, h) ((4 + (b) * 2 + (h)) * HTB)
#define PG8_STAGE(bufoff, gbase, voff) do { _Pragma("unroll") for (int _i = 0; _i < 2; ++_i) \
        __builtin_amdgcn_global_load_lds((const unsigned*)((const char*)(gbase) + (voff)[_i]), (PG8_LAS unsigned*)(lds + (bufoff) + ldsw + _i * 8192), 16, 0, 0); } while (0)
#define PG8_LDA(dst, b, h) do { _Pragma("unroll") for (int m = 0; m < 4; ++m) _Pragma("unroll") for (int k = 0; k < 2; ++k) dst[m][k] = *(const PG8_LAS bf16x8*)(lds + PG8_SA(b, h) + aoff + m * 2048 + k * 1024); } while (0)
#define PG8_LDB(dst, b, h) do { _Pragma("unroll") for (int n = 0; n < 2; ++n) _Pragma("unroll") for (int k = 0; k < 2; ++k) dst[n][k] = *(const PG8_LAS bf16x8*)(lds + PG8_SB(b, h) + boff + n * 2048 + k * 1024); } while (0)
#define PG8_MMA(ai, bj, At, Bt) do { __builtin_amdgcn_s_setprio(1); _Pragma("unroll") for (int m = 0; m < 4; ++m) _Pragma("unroll") for (int n = 0; n < 2; ++n) _Pragma("unroll") for (int k = 0; k < 2; ++k) \
        acc[ai][bj][m][n] = __builtin_amdgcn_mfma_f32_16x16x32_bf16(Bt[n][k], At[m][k], acc[ai][bj][m][n], 0, 0, 0); __builtin_amdgcn_s_setprio(0); } while (0)
#define PG8_WAIT_V(n) asm volatile("s_waitcnt vmcnt(" #n ")" ::: "memory")
#define PG8_WAIT_L(n) asm volatile("s_waitcnt lgkmcnt(" #n ")" ::: "memory")
#define PG8_BAR __builtin_amdgcn_s_barrier()
#define PG8_SCHED __builtin_amdgcn_sched_barrier(0)
    Unit cur, nxt; int ui = 0;
    if (!S.next(0, cur)) return;
    f32x4 acc[2][2][4][2];
#pragma unroll
    for (int a = 0; a < 2; ++a)
#pragma unroll
        for (int b = 0; b < 2; ++b)
#pragma unroll
            for (int m = 0; m < 4; ++m)
#pragma unroll
                for (int n = 0; n < 2; ++n) acc[a][b][m][n] = (f32x4){0.f, 0.f, 0.f, 0.f};
    bf16x8 At[4][2], B0[2][2], B1[2][2];
    const char* cA = (const char*)g.A + (size_t)cur.pm * tstep; const char* cB = (const char*)g.Bt + (size_t)cur.pn * tstep;
    S.a_ready(cur);
    if constexpr (SP2) {
        PG8_STAGE(PG8_SB(0, 0), cB, voffB); PG8_STAGE(PG8_SB(0, 1), cB + hstep, voffB); PG8_STAGE(PG8_SA(0, 0), cA, voffA); PG8_STAGE(PG8_SA(0, 1), cA + hstep, voffA);
        if (wr == 1) PG8_BAR;
        PG8_WAIT_V(2); PG8_BAR;
        PG8_STAGE(PG8_SB(1, 0), cB + kstep, voffB); PG8_STAGE(PG8_SA(1, 0), cA + kstep, voffA); PG8_STAGE(PG8_SB(1, 1), cB + hstep + kstep, voffB);
        PG8_WAIT_V(6); PG8_BAR;
    } else {
        PG8_STAGE(PG8_SB(0, 0), cB, voffB); PG8_STAGE(PG8_SA(0, 0), cA, voffA); PG8_STAGE(PG8_SB(0, 1), cB + hstep, voffB); PG8_STAGE(PG8_SA(0, 1), cA + hstep, voffA);
        if (wr == 1) PG8_BAR;
        PG8_WAIT_V(4); PG8_BAR;
        PG8_STAGE(PG8_SB(1, 0), cB + kstep, voffB); PG8_STAGE(PG8_SA(1, 0), cA + kstep, voffA); PG8_STAGE(PG8_SB(1, 1), cB + hstep + kstep, voffB);
        PG8_WAIT_V(6); PG8_BAR;
    }
    for (;;) {
        const bool has_next = S.next(ui + 1, nxt);
        const char* nA = has_next ? (const char*)g.A + (size_t)nxt.pm * tstep : cA; const char* nB = has_next ? (const char*)g.Bt + (size_t)nxt.pn * tstep : cB;
        for (int t = 0; t < nt; t += 2) {
            const bool last = (t == nt - 2);
            const char* a1 = cA + (size_t)(t + 1) * kstep;
            const char* a2 = last ? nA : cA + (size_t)(t + 2) * kstep; const char* b2 = last ? nB : cB + (size_t)(t + 2) * kstep;
            const char* a3 = a2 + kstep; const char* b3 = b2 + kstep;
            if (last && has_next) S.a_ready(nxt);
            if constexpr (SP2) {
            PG8_LDB(B0, 0, 0); PG8_LDB(B1, 0, 1); PG8_SCHED; PG8_LDA(At, 0, 0); PG8_STAGE(PG8_SA(1, 1), a1 + hstep, voffA);
            PG8_WAIT_V(8); PG8_WAIT_L(0); PG8_BAR; PG8_MMA(0, 0, At, B0); PG8_MMA(0, 1, At, B1); PG8_BAR; PG8_SCHED;
            PG8_LDA(At, 0, 1); PG8_STAGE(PG8_SB(0, 0), b2, voffB); PG8_STAGE(PG8_SB(0, 1), b2 + hstep, voffB); PG8_STAGE(PG8_SA(0, 0), a2, voffA);
            PG8_WAIT_V(8); PG8_WAIT_L(0); PG8_BAR; PG8_MMA(1, 0, At, B0); PG8_MMA(1, 1, At, B1); PG8_BAR; PG8_SCHED;
            PG8_LDB(B0, 1, 0); PG8_LDB(B1, 1, 1); PG8_SCHED; PG8_LDA(At, 1, 0); PG8_STAGE(PG8_SA(0, 1), a2 + hstep, voffA);
            PG8_WAIT_V(8); PG8_WAIT_L(0); PG8_BAR; PG8_MMA(0, 0, At, B0); PG8_MMA(0, 1, At, B1); PG8_BAR; PG8_SCHED;
            PG8_LDA(At, 1, 1); PG8_STAGE(PG8_SB(1, 0), b3, voffB); PG8_STAGE(PG8_SB(1, 1), b3 + hstep, voffB); PG8_STAGE(PG8_SA(1, 0), a3, voffA);
            PG8_WAIT_V(8); PG8_WAIT_L(0); PG8_BAR; PG8_MMA(1, 0, At, B0); PG8_MMA(1, 1, At, B1); PG8_BAR; PG8_SCHED;
            } else {
            PG8_LDB(B0, 0, 0); PG8_SCHED; PG8_LDA(At, 0, 0); PG8_STAGE(PG8_SA(1, 1), a1 + hstep, voffA);
            PG8_WAIT_L(8); PG8_BAR; PG8_WAIT_L(0); PG8_MMA(0, 0, At, B0); PG8_BAR; PG8_SCHED;
            PG8_LDB(B1, 0, 1); PG8_STAGE(PG8_SB(0, 0), b2, voffB);
            PG8_BAR; PG8_WAIT_L(0); PG8_MMA(0, 1, At, B1); PG8_BAR;
            PG8_LDA(At, 0, 1); PG8_STAGE(PG8_SA(0, 0), a2, voffA);
            PG8_BAR; PG8_WAIT_L(0); PG8_MMA(1, 0, At, B0); PG8_BAR; PG8_SCHED;
            PG8_STAGE(PG8_SB(0, 1), b2 + hstep, voffB);
            PG8_WAIT_V(6); PG8_BAR; PG8_MMA(1, 1, At, B1); PG8_BAR;
            PG8_LDB(B0, 1, 0); PG8_SCHED; PG8_LDA(At, 1, 0); PG8_STAGE(PG8_SA(0, 1), a2 + hstep, voffA);
            PG8_WAIT_L(8); PG8_BAR; PG8_WAIT_L(0); PG8_MMA(0, 0, At, B0); PG8_BAR; PG8_SCHED;
            PG8_LDB(B1, 1, 1); PG8_STAGE(PG8_SB(1, 0), b3, voffB);
            PG8_BAR; PG8_WAIT_L(0); PG8_MMA(0, 1, At, B1); PG8_BAR;
            PG8_LDA(At, 1, 1); PG8_STAGE(PG8_SA(1, 0), a3, voffA);
            PG8_BAR; PG8_WAIT_L(0); PG8_MMA(1, 0, At, B0); PG8_BAR; PG8_SCHED;
            PG8_STAGE(PG8_SB(1, 1), b3 + hstep, voffB);
            PG8_WAIT_V(6); PG8_BAR; PG8_MMA(1, 1, At, B1); PG8_BAR;
            }
        }
        if constexpr (ALIGN_EPI) { if (wr == 0) PG8_BAR; }
        if constexpr (!Epi::AFTER_DRAIN) { E(acc, cur, wr, wc, fr, fq); S.done(cur); }
        if (!has_next) break;
#pragma unroll
        for (int a = 0; a < 2; ++a)
#pragma unroll
            for (int b = 0; b < 2; ++b)
#pragma unroll
                for (int m = 0; m < 4; ++m)
#pragma unroll
                    for (int n = 0; n < 2; ++n) acc[a][b][m][n] = (f32x4){0.f, 0.f, 0.f, 0.f};
        cur = nxt; cA = nA; cB = nB; ++ui;
        if constexpr (ALIGN_EPI) { if (wr == 1) PG8_BAR; }
    }
    PG8_WAIT_V(0);
    if constexpr (!ALIGN_EPI) { if (wr == 0) PG8_BAR; }
    PG8_BAR;
    if constexpr (Epi::AFTER_DRAIN) { E.fused(acc, cur, wr, wc, fr, fq, lds, wid, lane); S.done(cur); }
#undef PG8_SA
#undef PG8_SB
#undef PG8_STAGE
#undef PG8_LDA
#undef PG8_LDB
#undef PG8_MMA
#undef PG8_WAIT_V
#undef PG8_WAIT_L
#undef PG8_BAR
#undef PG8_SCHED
}
}
namespace att {
using pg8::bf16_t; using pg8::bf16x8; using pg8::f32x4; using pg8::u32x4; using pg8::u32x2; using pg8::cvt_pk_bf16; using pg8::QKW; using pg8::VT_PITCH;
typedef float f32x16 __attribute__((ext_vector_type(16)));
#define ALAS __attribute__((address_space(3)))
constexpr int OFF_K0 = 0, OFF_K1 = 8192, OFF_V = 16384, STAGE = 32768, NSTG = 4, OFF_LUT = NSTG * STAGE;
constexpr int LUTW = 448, LUTC = 224;
constexpr int OFF_SUB = OFF_LUT + 12 * LUTW * 4;
constexpr int ATT_LDS = OFF_SUB + 512;
__device__ __forceinline__ int pi32(int r) { return (r & ~12) | ((r & 4) << 1) | ((r & 8) >> 1); }
__device__ __forceinline__ int t5_bucket(int rel) {
    const int n = rel < 0 ? -rel : rel;
    int b = n < 8 ? n : (n < 12 ? 8 : n < 16 ? 9 : n < 23 ? 10 : n < 32 ? 11 : n < 46 ? 12 : n < 64 ? 13 : n < 91 ? 14 : 15);
    return b + (rel > 0 ? 16 : 0);
}

__device__ __forceinline__ void glds16(const void* gsrc, unsigned lds_dst) { unsigned keep;
    asm volatile("s_mov_b32 %0, m0\n\ts_mov_b32 m0, %2\n\ts_nop 0\n\tglobal_load_lds_dwordx4 %1, off\n\ts_mov_b32 m0, %0" : "=&s"(keep) : "v"(gsrc), "s"(lds_dst) : "memory"); }
typedef float f32x2_t __attribute__((ext_vector_type(2))); typedef __bf16 bf16x2_t __attribute__((ext_vector_type(2)));
__device__ __forceinline__ unsigned cvtpk_s(float lo, float hi) { f32x2_t v = {lo, hi}; bf16x2_t b = __builtin_convertvector(v, bf16x2_t); return __builtin_bit_cast(unsigned, b); }
template <int N> __device__ __forceinline__ void wait_bar() { asm volatile("s_waitcnt vmcnt(%0) lgkmcnt(0)\n\ts_barrier" :: "n"(N) : "memory"); }

template <bool WIN>
__device__ __forceinline__ void attn_unit(ALAS unsigned char* lds, const bf16_t* __restrict__ QK, const bf16_t* __restrict__ VT, bf16_t* __restrict__ Y,
                                          const float* __restrict__ rel_bias, const float* __restrict__ sinkp, const float* __restrict__ subln, float lam,
                                          int seq_base, int S, int q0, int hsel) {
    constexpr float LOG2E = 1.4426950408889634f;
    constexpr int NDB = WIN ? 2 : 4;
    const int tid = threadIdx.x, lane = tid & 63, l31 = lane & 31, hi = lane >> 5;
    const int wid = __builtin_amdgcn_readfirstlane(tid >> 6), half = wid >> 2, wq = wid & 3;
    const int qw = q0 + 32 * wq;
    int qcol, kcol0, kcol1, vrow0, bhead;
    if (WIN) { qcol = (2 * hsel + half) * 64; kcol0 = 512 + (hsel >> 1) * 64; kcol1 = kcol0; vrow0 = (hsel >> 1) * 64; bhead = 2 * hsel; }
    else { qcol = 640 + (2 * hsel + half) * 64; kcol0 = 1152 + (2 * hsel) * 64; kcol1 = kcol0 + 64; vrow0 = 128 + hsel * 128; bhead = 8 + hsel; }
    const ALAS float* lut = (const ALAS float*)(lds + OFF_LUT) + (WIN ? (bhead + half) : bhead) * LUTW;

    const int t_lo = WIN ? (q0 >= 128 ? (q0 - 128) / 64 : 0) : 0;
    const int t_hi = WIN ? ((q0 + 256) / 64 < S / 64 ? (q0 + 256) / 64 : S / 64) : S / 64;
    const int NT = t_hi - t_lo;
    const unsigned ldsb = (unsigned)(uintptr_t)lds;
    const int drow = 8 * wid + (lane >> 3), dch = (lane & 7) ^ ((4 * wid + (lane >> 4)) & 7);
    const bf16_t* kg = QK + ((size_t)((seq_base >> 6) + t_lo) * 26 * 64 + drow) * 64 + dch * 8 + kcol0 * 64;
    const bf16_t* vg = VT + ((size_t)((seq_base >> 6) + t_lo) * 640 + vrow0 + drow) * 64 + dch * 8;
    const unsigned dk = ldsb + wid * 1024;
#define AT_DMA(tr) do { const unsigned sb_ = (unsigned)__builtin_amdgcn_readfirstlane(dk + (((tr) & (NSTG - 1)) * STAGE)); const size_t ko_ = (size_t)(tr) * 26 * 4096, vo_ = (size_t)(tr) * 640 * 64; \
        glds16(kg + ko_, sb_ + OFF_K0); if (!WIN) glds16(kg + ko_ + 4096, sb_ + OFF_K1); glds16(vg + vo_, sb_ + OFF_V); if (!WIN) glds16(vg + vo_ + 64 * 64, sb_ + OFF_V + 8192); } while (0)
    constexpr int NPW = WIN ? 2 : 4;
    bf16x8 qfr[4];
    { const int qrow = seq_base + qw + l31; const bf16_t* qp = QK + ((size_t)((qrow >> 6) * 26 + (qcol >> 6)) * 64 + (qrow & 63)) * 64 + hi * 8;
#pragma unroll
      for (int ds = 0; ds < 4; ++ds) qfr[ds] = *(const bf16x8*)(qp + ds * 16); }
#define qf(ds) qfr[ds]
    AT_DMA(0); if (NT > 1) AT_DMA(1); if (NT > 2) AT_DMA(2);
    constexpr float THR = 8.0f;
    float m_ref = WIN ? sinkp[2 * hsel + half] * LOG2E : 0.f;
    float l_run = (WIN && hi == 0) ? 1.f : 0.f;
    float cbase = 0.f;
    f32x16 cvec;
#pragma unroll
    for (int r = 0; r < 16; ++r) cvec[r] = cbase - m_ref;
    f32x16 o[NDB];
#pragma unroll
    for (int db = 0; db < NDB; ++db)
#pragma unroll
        for (int r = 0; r < 16; ++r) o[db][r] = 0.f;
    const int krow = pi32(l31), fK = (krow >> 1) & 7, fV = (l31 >> 1) & 7;
    int kx[4], vx[4];
#pragma unroll
    for (int c = 0; c < 4; ++c) { kx[c] = (WIN ? OFF_K0 : (half ? OFF_K1 : OFF_K0)) + krow * 128 + (((2 * c + hi) ^ fK) << 4); vx[c] = OFF_V + l31 * 128 + (((2 * c + hi) ^ fV) << 4); }
    const int qabs = qw + l31;
    const float cfar_lo = __uint_as_float(__builtin_amdgcn_readfirstlane(__float_as_uint(lut[0]))), cfar_hi = __uint_as_float(__builtin_amdgcn_readfirstlane(__float_as_uint(lut[LUTW - 1])));
    asm volatile("" : "+v"(qfr[0]), "+v"(qfr[1]), "+v"(qfr[2]), "+v"(qfr[3]));
#pragma clang loop unroll(disable)
    for (int tr = 0; tr < NT; ++tr) {
        if (tr + 2 < NT) wait_bar<2 * NPW>(); else if (tr + 1 < NT) wait_bar<NPW>(); else wait_bar<0>();
        if (tr + 3 < NT) AT_DMA(tr + 3);
        const int k0 = (t_lo + tr) * 64;
        const bool skip = WIN && (k0 > qw + 31 + 128 || k0 + 63 < qw - 128);
        if (!skip) {
            const bool near = WIN || ((k0 - (qw + 31)) < 128 && (qw - (k0 + 63)) < 128);
            const float cinit = near ? 0.f : (k0 > qw ? cfar_hi : cfar_lo);
            if (__builtin_expect(cinit != cbase, 0)) { cbase = cinit; asm volatile("" ::: "memory");
#pragma unroll
                for (int r = 0; r < 16; ++r) cvec[r] = cbase - m_ref; }
            f32x16 s0, s1;
            const ALAS unsigned char* sb = lds + (tr & (NSTG - 1)) * STAGE;
            {
                bf16x8 ka[8];
#pragma unroll
                for (int ds = 0; ds < 4; ++ds) { ka[2 * ds] = *(const ALAS bf16x8*)(sb + kx[ds]); ka[2 * ds + 1] = *(const ALAS bf16x8*)(sb + kx[ds] + 4096); }
                __builtin_amdgcn_sched_barrier(0);
                s0 = __builtin_amdgcn_mfma_f32_32x32x16_bf16(ka[0], qf(0), cvec, 0, 0, 0);
                s1 = __builtin_amdgcn_mfma_f32_32x32x16_bf16(ka[1], qf(0), cvec, 0, 0, 0);
#pragma unroll
                for (int ds = 1; ds < 4; ++ds) {
                    s0 = __builtin_amdgcn_mfma_f32_32x32x16_bf16(ka[2 * ds], qf(ds), s0, 0, 0, 0);
                    s1 = __builtin_amdgcn_mfma_f32_32x32x16_bf16(ka[2 * ds + 1], qf(ds), s1, 0, 0, 0);
                }
            }
            bf16x8 va[2 * NDB], vc[2 * NDB];
#pragma unroll
            for (int kk = 0; kk < 2; ++kk)
#pragma unroll
                for (int db = 0; db < NDB; ++db) va[kk * NDB + db] = *(const ALAS bf16x8*)(sb + vx[kk] + db * 4096);
            __builtin_amdgcn_sched_barrier(0);
            if (near) {
                const ALAS float* lb = lut + (k0 + 8 * hi - qabs + LUTC);
#pragma unroll
                for (int r = 0; r < 16; ++r) { s0[r] += lb[16 * (r >> 3) + (r & 7)]; s1[r] += lb[32 + 16 * (r >> 3) + (r & 7)];
                    if ((r & 7) == 7) __builtin_amdgcn_sched_barrier(0); }
            }
#define MX3(a, b, c) __builtin_fmaxf(__builtin_fmaxf((a), (b)), (c))
            float mxa = MX3(s0[0], s0[1], s1[0]), mxb = MX3(s0[2], s0[3], s1[1]);
            mxa = MX3(mxa, s1[2], s1[3]);
#pragma unroll
            for (int r = 4; r < 16; r += 4) { mxa = MX3(mxa, s0[r], s0[r + 1]); mxb = MX3(mxb, s0[r + 2], s0[r + 3]); mxa = MX3(mxa, s1[r], s1[r + 1]); mxb = MX3(mxb, s1[r + 2], s1[r + 3]); }
#undef MX3
            float mx = fmaxf(mxa, mxb);
            if (__any(mx > THR)) {
                mx = fmaxf(mx, __shfl_xor(mx, 32));
                const float dl = fmaxf(mx, 0.f);
                m_ref += dl;
                const float f = __builtin_amdgcn_exp2f(-dl);
                l_run *= f;
#pragma unroll
                for (int db = 0; db < NDB; ++db)
#pragma unroll
                    for (int r = 0; r < 16; ++r) o[db][r] *= f;
#pragma unroll
                for (int r = 0; r < 16; ++r) { s0[r] -= dl; s1[r] -= dl; cvec[r] = cbase - m_ref; }
            }
            float ls0 = 0.f, ls1 = 0.f;
#define AT_EXP(SS, B, PF) do { \
                const float e0 = __builtin_amdgcn_exp2f(SS[B + 0]), e1 = __builtin_amdgcn_exp2f(SS[B + 1]), e2 = __builtin_amdgcn_exp2f(SS[B + 2]), e3 = __builtin_amdgcn_exp2f(SS[B + 3]); \
                const float e4 = __builtin_amdgcn_exp2f(SS[B + 4]), e5 = __builtin_amdgcn_exp2f(SS[B + 5]), e6 = __builtin_amdgcn_exp2f(SS[B + 6]), e7 = __builtin_amdgcn_exp2f(SS[B + 7]); \
                ls0 += e0; ls1 += e4; ls0 += e1; ls1 += e5; ls0 += e2; ls1 += e6; ls0 += e3; ls1 += e7; \
                PF.u.x = cvtpk_s(e0, e1); PF.u.y = cvtpk_s(e2, e3); PF.u.z = cvtpk_s(e4, e5); PF.u.w = cvtpk_s(e6, e7); } while (0)
            union PFU { u32x4 u; bf16x8 b; };
            PFU p0, p1, p2, p3;
            AT_EXP(s0, 0, p0);
#pragma unroll
            for (int kk = 0; kk < 2; ++kk)
#pragma unroll
                for (int db = 0; db < NDB; ++db) vc[kk * NDB + db] = *(const ALAS bf16x8*)(sb + vx[kk + 2] + db * 4096);
            __builtin_amdgcn_sched_barrier(0);
#pragma unroll
            for (int db = 0; db < NDB; ++db) o[db] = __builtin_amdgcn_mfma_f32_32x32x16_bf16(va[db], p0.b, o[db], 0, 0, 0);
            AT_EXP(s0, 8, p1);
            __builtin_amdgcn_sched_barrier(0);
#pragma unroll
            for (int db = 0; db < NDB; ++db) o[db] = __builtin_amdgcn_mfma_f32_32x32x16_bf16(va[NDB + db], p1.b, o[db], 0, 0, 0);
            AT_EXP(s1, 0, p2);
            __builtin_amdgcn_sched_barrier(0);
#pragma unroll
            for (int db = 0; db < NDB; ++db) o[db] = __builtin_amdgcn_mfma_f32_32x32x16_bf16(vc[db], p2.b, o[db], 0, 0, 0);
            AT_EXP(s1, 8, p3);
            __builtin_amdgcn_sched_barrier(0);
#pragma unroll
            for (int db = 0; db < NDB; ++db) o[db] = __builtin_amdgcn_mfma_f32_32x32x16_bf16(vc[NDB + db], p3.b, o[db], 0, 0, 0);
            __builtin_amdgcn_sched_barrier(0);
#undef AT_EXP
            l_run += ls0 + ls1;
        }
    }
    asm volatile("s_waitcnt lgkmcnt(0)\n\ts_barrier" ::: "memory");
#undef qf
#undef AT_DMA
    const float l_tot = l_run + __shfl_xor(l_run, 32);
    const float inv = 1.0f / l_tot;
    const size_t orow = (size_t)(seq_base + qw + l31) * 1024;
    if (WIN) {
        bf16_t* yp = Y + orow + (2 * hsel + half) * 64 + 8 * hi;
#pragma unroll
        for (int db = 0; db < NDB; ++db)
#pragma unroll
            for (int p = 0; p < 2; ++p) {
                u32x2 w0, w1;
                w0.x = cvt_pk_bf16(o[db][8 * p] * inv, o[db][8 * p + 1] * inv); w0.y = cvt_pk_bf16(o[db][8 * p + 2] * inv, o[db][8 * p + 3] * inv);
                w1.x = cvt_pk_bf16(o[db][8 * p + 4] * inv, o[db][8 * p + 5] * inv); w1.y = cvt_pk_bf16(o[db][8 * p + 6] * inv, o[db][8 * p + 7] * inv);
                const u32x2 snd = hi ? w0 : w1, mine = hi ? w1 : w0;
                u32x2 rcv; rcv.x = (unsigned)__shfl_xor((int)snd.x, 32); rcv.y = (unsigned)__shfl_xor((int)snd.y, 32);
                u32x4 ow; if (hi) { ow.x = rcv.x; ow.y = rcv.y; ow.z = mine.x; ow.w = mine.y; } else { ow.x = mine.x; ow.y = mine.y; ow.z = rcv.x; ow.w = rcv.y; }
                *(u32x4*)(yp + 32 * db + 16 * p) = ow;
            }
    } else {
        ALAS f32x4* xch = (ALAS f32x4*)lds + (size_t)wq * 1024 + l31;
        if (half == 1) {
#pragma unroll
            for (int db = 0; db < NDB; ++db)
#pragma unroll
                for (int g = 0; g < 4; ++g) { f32x4 v; v[0] = o[db][4 * g] * inv; v[1] = o[db][4 * g + 1] * inv; v[2] = o[db][4 * g + 2] * inv; v[3] = o[db][4 * g + 3] * inv;
                    xch[(8 * db + 2 * g + hi) * 32] = v; }
        }
        __syncthreads();
        if (half == 0) {
            float ss = 0.f;
#pragma unroll
            for (int db = 0; db < NDB; ++db)
#pragma unroll
                for (int g = 0; g < 4; ++g) { const f32x4 v = xch[(8 * db + 2 * g + hi) * 32];
#pragma unroll
                    for (int i = 0; i < 4; ++i) { const float x = o[db][4 * g + i] * inv - lam * v[i]; o[db][4 * g + i] = x; ss += x * x; } }
            ss += __shfl_xor(ss, 32);
            const float rn = __builtin_amdgcn_rsqf(ss * (1.0f / 128.0f) + 1e-6f) * 0.8f;
            bf16_t* yp = Y + orow + 512 + hsel * 128 + 8 * hi;
#pragma unroll
            for (int db = 0; db < NDB; ++db)
#pragma unroll
                for (int p = 0; p < 2; ++p) {
                    const f32x4 ga = *(const ALAS f32x4*)(lds + OFF_SUB + (32 * db + 16 * p + 4 * hi) * 4), gb = *(const ALAS f32x4*)(lds + OFF_SUB + (32 * db + 16 * p + 8 + 4 * hi) * 4);
                    u32x2 w0, w1;
                    w0.x = cvt_pk_bf16(o[db][8 * p] * rn * ga[0], o[db][8 * p + 1] * rn * ga[1]); w0.y = cvt_pk_bf16(o[db][8 * p + 2] * rn * ga[2], o[db][8 * p + 3] * rn * ga[3]);
                    w1.x = cvt_pk_bf16(o[db][8 * p + 4] * rn * gb[0], o[db][8 * p + 5] * rn * gb[1]); w1.y = cvt_pk_bf16(o[db][8 * p + 6] * rn * gb[2], o[db][8 * p + 7] * rn * gb[3]);
                    const u32x2 snd = hi ? w0 : w1, mine = hi ? w1 : w0;
                    u32x2 rcv; rcv.x = (unsigned)__shfl_xor((int)snd.x, 32); rcv.y = (unsigned)__shfl_xor((int)snd.y, 32);
                    u32x4 ow; if (hi) { ow.x = rcv.x; ow.y = rcv.y; ow.z = mine.x; ow.w = mine.y; } else { ow.x = mine.x; ow.y = mine.y; ow.z = rcv.x; ow.w = rcv.y; }
                    *(u32x4*)(yp + 32 * db + 16 * p) = ow;
                }
        }
        __syncthreads();
    }
}

__device__ __forceinline__ void attn_phase(ALAS unsigned char* lds, const bf16_t* QK, const bf16_t* VT, bf16_t* Y, const float* rel_bias, const float* sinkp, const float* subln, const float* blam) {
    float lam;
    { const int lane = threadIdx.x & 63; float a = blam[lane] * blam[64 + lane], b = blam[128 + lane] * blam[192 + lane];
#pragma unroll
      for (int o = 1; o < 64; o <<= 1) { a += __shfl_xor(a, o); b += __shfl_xor(b, o); }
      lam = __expf(a) - __expf(b) + 0.2f; }
    { constexpr float LOG2E = 1.4426950408889634f; ALAS float* lutw = (ALAS float*)(lds + OFF_LUT);
      for (int i = threadIdx.x; i < 12 * LUTW; i += 512) { const int hh = i / LUTW, ri = i - hh * LUTW, rel = ri - LUTC;
        lutw[i] = (hh < 8 && (rel < -128 || rel > 128)) ? -1e30f : rel_bias[t5_bucket(rel) * 12 + hh] * LOG2E; }
      if (threadIdx.x < 128) ((ALAS float*)(lds + OFF_SUB))[threadIdx.x] = subln[threadIdx.x];
      __syncthreads(); }
    const int G = gridDim.x, bx = blockIdx.x;
    if (__builtin_amdgcn_readfirstlane((int)threadIdx.x) >= 256) __builtin_amdgcn_s_setprio(1);
    if (G == 256) {
        const int x = bx & 7, j = bx >> 3;
        for (int r = 0; r < 8; ++r) { const int bh = x + 8 * (r >> 1), qb = j + 32 * (r & 1);
            attn_unit<false>(lds, QK, VT, Y, rel_bias, sinkp, subln, lam, (bh >> 2) * 8192, 8192, qb * 128, bh & 3); }
        for (int r = 0; r < 8; ++r) { const int bh = x + 8 * ((j >> 4) + 2 * r), qb = j & 15;
            attn_unit<false>(lds, QK, VT, Y, rel_bias, sinkp, subln, lam, 65536 + (bh >> 2) * 2048, 2048, qb * 128, bh & 3); }
    } else {
    for (int u = bx; u < 2048; u += G) { const int qb = u & 63, bh = u >> 6; attn_unit<false>(lds, QK, VT, Y, rel_bias, sinkp, subln, lam, (bh >> 2) * 8192, 8192, qb * 128, bh & 3); }
    for (int u = bx; u < 2048; u += G) { const int qb = u & 15, bh = u >> 4; attn_unit<false>(lds, QK, VT, Y, rel_bias, sinkp, subln, lam, 65536 + (bh >> 2) * 2048, 2048, qb * 128, bh & 3); }
    }
    for (int u = bx; u < 4096; u += G) { const int hp = u & 3, qb = u >> 2;
        const int row0 = qb * 128; int seq_base, S;
        if (row0 < 65536) { seq_base = row0 & ~8191; S = 8192; } else { seq_base = row0 & ~2047; S = 2048; }
        attn_unit<true>(lds, QK, VT, Y, rel_bias, sinkp, subln, lam, seq_base, S, row0 - seq_base, hp); }
    __builtin_amdgcn_s_setprio(0);
}
}

namespace cv {
using pg8::bf16_t; using pg8::f32x4; using pg8::u32x4; using pg8::cvt_pk_bf16; using pg8::bf_lo; using pg8::bf_hi; using pg8::fast_sigmoid;
#define CLAS __attribute__((address_space(3)))
constexpr int T = 32, HALO = 15, ROWS = T + 2 * HALO;
constexpr int OFF_U0 = 0, OFF_U1 = 64 * 1024;
constexpr int CONV_LDS = OFF_U1 + T * 512 * 4;
__device__ __forceinline__ void conv_unit(CLAS unsigned char* lds, const bf16_t* __restrict__ PC, bf16_t* __restrict__ YC, const float* __restrict__ w3, const float* __restrict__ w31,
                                          const float* __restrict__ dwb, const float* __restrict__ lng, const float* __restrict__ lnb, int seq_base, int S, int t0) {
    const int tid = threadIdx.x;
    {
        u32x4 w8[8];
#pragma unroll
        for (int it = 0; it < 8; ++it) { const int idx = tid + 512 * it, j = idx >> 6, v = idx & 63, tok = t0 - HALO + j;
            w8[it] = (u32x4){0u, 0u, 0u, 0u};
            if (idx < ROWS * 64 && tok >= 0 && tok < S) w8[it] = *(const u32x4*)(PC + (size_t)(seq_base + tok) * 1536 + 1024 + v * 8); }
#pragma unroll
        for (int it = 0; it < 8; ++it) { const int idx = tid + 512 * it, j = idx >> 6, v = idx & 63;
            if (idx < ROWS * 64) *(CLAS u32x4*)(lds + OFF_U0 + j * 1024 + v * 16) = w8[it]; }
    }
    __syncthreads();
    const int cp = tid & 255, th = tid >> 8;
    {
        const float wa0 = w3[2 * cp], wa1 = w3[512 + 2 * cp], wa2 = w3[1024 + 2 * cp];
        const float wb0 = w3[2 * cp + 1], wb1 = w3[512 + 2 * cp + 1], wb2 = w3[1024 + 2 * cp + 1];
        const int tb = t0 + 16 * th;
        unsigned pw[18], gw[16];
#pragma unroll
        for (int i = 0; i < 18; ++i) { const int tok = tb - 1 + i; pw[i] = 0u; if (tok >= 0 && tok < S) pw[i] = *(const unsigned*)(PC + (size_t)(seq_base + tok) * 1536 + 512 + 2 * cp); }
#pragma unroll
        for (int i = 0; i < 16; ++i) gw[i] = *(const unsigned*)(PC + (size_t)(seq_base + tb + i) * 1536 + 2 * cp);
#pragma unroll
        for (int i = 0; i < 16; ++i) {
            const float ya = bf_lo(gw[i]) * (wa0 * bf_lo(pw[i]) + wa1 * bf_lo(pw[i + 1]) + wa2 * bf_lo(pw[i + 2]));
            const float yb = bf_hi(gw[i]) * (wb0 * bf_hi(pw[i]) + wb1 * bf_hi(pw[i + 1]) + wb2 * bf_hi(pw[i + 2]));
            *(unsigned*)(YC + (size_t)(seq_base + tb + i) * 1024 + 2 * cp) = cvt_pk_bf16(ya, yb);
        }
    }
    {
        float wa[31], wb[31];
#pragma unroll
        for (int j = 0; j < 31; ++j) { wa[j] = w31[j * 512 + 2 * cp]; wb[j] = w31[j * 512 + 2 * cp + 1]; }
        const float ba = dwb[2 * cp], bb = dwb[2 * cp + 1];
        for (int g4 = 0; g4 < 4; ++g4) {
            const int tt = 16 * th + 4 * g4;
            float aa[4], ab[4];
#pragma unroll
            for (int k = 0; k < 4; ++k) { aa[k] = ba; ab[k] = bb; }
            const CLAS unsigned char* up = lds + OFF_U0 + tt * 1024 + cp * 4;
#pragma unroll
            for (int rr = 0; rr < 34; ++rr) {
                const unsigned w = *(const CLAS unsigned*)(up + rr * 1024);
                const float xa = bf_lo(w), xb = bf_hi(w);
#pragma unroll
                for (int k = 0; k < 4; ++k) { const int j = rr - k; if (j >= 0 && j < 31) { aa[k] += wa[j] * xa; ab[k] += wb[j] * xb; } }
            }
#pragma unroll
            for (int k = 0; k < 4; ++k) { typedef float f32x2 __attribute__((ext_vector_type(2))); *(CLAS f32x2*)(lds + OFF_U1 + (tt + k) * 2048 + cp * 8) = (f32x2){aa[k], ab[k]}; }
        }
    }
    __syncthreads();
    {
        const int lane = tid & 63, wid = tid >> 6;
        const f32x4 g0 = *(const f32x4*)(lng + 8 * lane), g1 = *(const f32x4*)(lng + 8 * lane + 4), b0 = *(const f32x4*)(lnb + 8 * lane), b1 = *(const f32x4*)(lnb + 8 * lane + 4);
        for (int k = 0; k < 4; ++k) {
            const int tt = 4 * wid + k;
            const f32x4 x0 = *(const CLAS f32x4*)(lds + OFF_U1 + tt * 2048 + lane * 32), x1 = *(const CLAS f32x4*)(lds + OFF_U1 + tt * 2048 + lane * 32 + 16);
            float s = ((x0[0] + x0[1]) + (x0[2] + x0[3])) + ((x1[0] + x1[1]) + (x1[2] + x1[3]));
#pragma unroll
            for (int o = 1; o < 64; o <<= 1) s += __shfl_xor(s, o);
            const float mean = s * (1.0f / 512.0f);
            const f32x4 d0 = x0 - mean, d1 = x1 - mean;
            float q = ((d0[0] * d0[0] + d0[1] * d0[1]) + (d0[2] * d0[2] + d0[3] * d0[3])) + ((d1[0] * d1[0] + d1[1] * d1[1]) + (d1[2] * d1[2] + d1[3] * d1[3]));
#pragma unroll
            for (int o = 1; o < 64; o <<= 1) q += __shfl_xor(q, o);
            const float rstd = __builtin_amdgcn_rsqf(q * (1.0f / 512.0f) + 1e-6f);
            f32x4 y0 = d0 * rstd * g0 + b0, y1 = d1 * rstd * g1 + b1;
#pragma unroll
            for (int i = 0; i < 4; ++i) { y0[i] = y0[i] * fast_sigmoid(y0[i]); y1[i] = y1[i] * fast_sigmoid(y1[i]); }
            u32x4 w; w.x = cvt_pk_bf16(y0[0], y0[1]); w.y = cvt_pk_bf16(y0[2], y0[3]); w.z = cvt_pk_bf16(y1[0], y1[1]); w.w = cvt_pk_bf16(y1[2], y1[3]);
            *(u32x4*)(YC + (size_t)(seq_base + t0 + tt) * 1024 + 512 + 8 * lane) = w;
        }
    }
    __syncthreads();
}
__device__ __forceinline__ void conv_phase(CLAS unsigned char* lds, const bf16_t* PC, bf16_t* YC, const float* w3, const float* w31, const float* dwb, const float* lng, const float* lnb) {
    const int nU = 131072 / T, gd = (int)gridDim.x; const bool revc = (nU % gd) == 0;
    for (int k = 0, u0 = blockIdx.x; u0 < nU; u0 += gd, ++k) {
        const int u = revc ? (nU - gd + (int)blockIdx.x - k * gd) : u0;
        const int row0 = u * T; int seq_base, S;
        if (row0 < 65536) { seq_base = row0 & ~8191; S = 8192; } else { seq_base = row0 & ~2047; S = 2048; }
        conv_unit(lds, PC, YC, w3, w31, dwb, lng, lnb, seq_base, S, row0 - seq_base);
    }
}
}

namespace mk {
using pg8::bf16_t; using pg8::f32x4; using pg8::u32x4; using pg8::u32x2; using pg8::cvt_pk_bf16;
#define MLAS __attribute__((address_space(3)))
constexpr int M = 131072, D = 1024, FF = 2816, NQKV = 2304, NCI = 2560;
constexpr size_t MiB = 1u << 20;
constexpr size_t WS_X = 0;
constexpr size_t WS_BIG = 256 * MiB;
constexpr size_t WS_VT = WS_BIG + (size_t)M * pg8::QKW * 2;
constexpr size_t WS_W = 960 * MiB;
constexpr size_t WS_WQKV = WS_W, WS_WO = WS_WQKV + (size_t)NQKV * D * 2, WS_WGU0 = WS_WO + (size_t)D * D * 2, WS_WGU1 = WS_WGU0 + (size_t)2 * FF * D * 2,
                 WS_WD0 = WS_WGU1 + (size_t)2 * FF * D * 2, WS_WD1 = WS_WD0 + (size_t)D * FF * 2, WS_WCI = WS_WD1 + (size_t)D * FF * 2, WS_WCO = WS_WCI + (size_t)NCI * D * 2;
constexpr size_t WS_SSQ = 1008 * MiB;
constexpr size_t WS_CTL = 1016 * MiB, CTL_BYTES = 16384;
constexpr size_t WS_END = WS_CTL + 65536;
static_assert(WS_VT + (size_t)640 * pg8::VT_PITCH * 2 <= WS_W && WS_BIG + (size_t)M * FF * 2 <= WS_W && WS_WCO + (size_t)D * D * 2 <= WS_SSQ, "ws map");
constexpr int MISC_OFF = 155648, LDS_BYTES = MISC_OFF + 256;
static_assert(att::ATT_LDS <= MISC_OFF && cv::CONV_LDS <= MISC_OFF && pg8::STAGE_BYTES + 16384 <= MISC_OFF, "lds map");

#define XB_TMO      128
#define XB_XCNT(j)  (256  + 64 * (j))
#define XB_XSUB(j)  (1280 + 64 * (j))
#define XB_XGEN(j)  (2304 + 64 * (j))
#define XB_TOP      3328
#define XB_TOPGEN   3392
#define XCD_BAR_WORDS 3456
#define XB_SPIN_CAP (1u << 18)

__device__ __forceinline__ unsigned xb_ld(unsigned* p)              { return __hip_atomic_load(p, __ATOMIC_RELAXED, __HIP_MEMORY_SCOPE_AGENT); }
__device__ __forceinline__ unsigned xb_add(unsigned* p, unsigned v) { return __hip_atomic_fetch_add(p, v, __ATOMIC_RELAXED, __HIP_MEMORY_SCOPE_AGENT); }
__device__ __forceinline__ unsigned xb_xcc_id() { return (unsigned)__builtin_amdgcn_s_getreg((3 << 11) | 20) & 0xFu; }
#define XB_SPIN(cond, bar) do { unsigned _sp = 0; while (cond) { __builtin_amdgcn_s_sleep(1); \
    if ((++_sp & 255u) == 0u) { if (xb_ld(&(bar)[XB_TMO])) break; if (_sp > XB_SPIN_CAP) { atomicAdd(&(bar)[XB_TMO], 1u); break; } } } } while (0)

struct XcdBarrier {
    unsigned* bar; unsigned x;
    volatile MLAS unsigned* st;
};

__device__ __forceinline__ XcdBarrier xcd_barrier_post(unsigned* bar, volatile MLAS unsigned* st) {
    XcdBarrier b; b.bar = bar; b.x = xb_xcc_id(); b.st = st;
    if (threadIdx.x == 0) (void)xb_add(&bar[XB_XCNT(b.x)], 1u);
    return b;
}
__device__ __forceinline__ void xcd_barrier_complete(unsigned* bar, unsigned x, unsigned& nloc, unsigned& nx) {
    const unsigned G = gridDim.x * gridDim.y * gridDim.z;
    unsigned sum, cnt, mine, sp = 0u;
    for (;;) {
        sum = 0u; cnt = 0u; mine = 0u;
#pragma unroll
        for (unsigned j = 0; j < 16; ++j) { const unsigned c = xb_ld(&bar[XB_XCNT(j)]); sum += c; cnt += (c > 0u) ? 1u : 0u; mine = (j == x) ? c : mine; }
        if (sum == G) break;
        __builtin_amdgcn_s_sleep(1);
        if ((++sp & 255u) == 0u) { if (xb_ld(&bar[XB_TMO])) break; if (sp > XB_SPIN_CAP) { atomicAdd(&bar[XB_TMO], 1u); break; } }
    }
    nloc = mine > 0u ? mine : 1u; nx = cnt > 0u ? cnt : 1u;
}

__device__ __forceinline__ void xcd_barrier(const XcdBarrier& b) {
    asm volatile("s_waitcnt vmcnt(0)" ::: "memory");
    __syncthreads();
    if (threadIdx.x == 0) {
        unsigned* bar = b.bar;
        __builtin_amdgcn_s_waitcnt(0);
        unsigned nloc = b.st[0], nx = b.st[1];
        if (nloc == 0u) { xcd_barrier_complete(bar, b.x, nloc, nx); b.st[0] = nloc; b.st[1] = nx; }
        const unsigned old = xb_add(&bar[XB_XSUB(b.x)], 1u);
        const unsigned gen = old / nloc;
        if (old + 1u == (gen + 1u) * nloc) {
            __builtin_amdgcn_fence(__ATOMIC_RELEASE, "agent");
            asm volatile("s_waitcnt vmcnt(0)" ::: "memory");
            const unsigned og = xb_add(&bar[XB_TOP], 1u);
            const unsigned tg = og / nx;
            if (og + 1u == (tg + 1u) * nx) xb_add(&bar[XB_TOPGEN], 1u);
            else XB_SPIN(xb_ld(&bar[XB_TOPGEN]) == tg, bar);
            __builtin_amdgcn_fence(__ATOMIC_ACQUIRE, "agent");
            xb_add(&bar[XB_XGEN(b.x)], 1u);
            asm volatile("s_waitcnt vmcnt(0)" ::: "memory");
        } else {
            XB_SPIN(xb_ld(&bar[XB_XGEN(b.x)]) == gen, bar);
            __builtin_amdgcn_fence(__ATOMIC_ACQUIRE, "agent");
            asm volatile("s_waitcnt vmcnt(0)" ::: "memory");
        }
    }
    __syncthreads();
}

static_assert(XCD_BAR_WORDS * 4 <= CTL_BYTES, "barrier words");
struct Params { const float* in[24]; float* out; unsigned char* ws; int ph_lo, ph_hi; };

__device__ __forceinline__ void tr_item(const float* __restrict__ W, int ldw, int srccol0, const float* __restrict__ gain, bf16_t* __restrict__ WT, int K, int destrow0, int k0, MLAS float* scr, int lane) {
    float wv[32];
#pragma unroll
    for (int i = 0; i < 32; ++i) { const int kk = 2 * i + (lane >> 5); wv[i] = __builtin_nontemporal_load(W + (size_t)(k0 + kk) * ldw + srccol0 + (lane & 31)); }
    const float g0 = gain ? gain[k0 + (lane & 31) * 2] : 1.0f, g1 = gain ? gain[k0 + (lane & 31) * 2 + 1] : 1.0f;
#pragma unroll
    for (int i = 0; i < 32; ++i) { const int kk = 2 * i + (lane >> 5); const float ga = __shfl(g0, i), gb = __shfl(g1, i); scr[kk * 33 + (lane & 31)] = wv[i] * ((lane >> 5) ? gb : ga); }
    asm volatile("s_waitcnt lgkmcnt(0)" ::: "memory");
    const int c = lane & 7;
#pragma unroll
    for (int j = 0; j < 4; ++j) { const int n = (lane >> 3) + 8 * j; const MLAS float* s = scr + (8 * c) * 33 + n;
        u32x4 o; o.x = cvt_pk_bf16(s[0 * 33], s[1 * 33]); o.y = cvt_pk_bf16(s[2 * 33], s[3 * 33]); o.z = cvt_pk_bf16(s[4 * 33], s[5 * 33]); o.w = cvt_pk_bf16(s[6 * 33], s[7 * 33]);
        *(u32x4*)(WT + (size_t)(destrow0 + n) * K + k0 + 8 * c) = o; }
    asm volatile("s_waitcnt lgkmcnt(0)" ::: "memory");
}

__device__ __forceinline__ void prologue(const Params& p, MLAS unsigned char* lds) {
    const int tid = threadIdx.x, lane = tid & 63, wave = tid >> 6;
    MLAS float* scr = (MLAS float*)(lds + wave * 16384);
    const int gw = blockIdx.x * 8 + wave, NGW = gridDim.x * 8;
    unsigned char* ws = p.ws;
    constexpr int I_QKV = (NQKV / 32) * (D / 64), I_O = (D / 32) * (D / 64), I_GU = (2 * FF / 32) * (D / 64), I_D = (D / 32) * (FF / 64), I_CI = (NCI / 32) * (D / 64);
    constexpr int NIT = I_QKV + I_O + 2 * I_GU + 2 * I_D + I_CI + I_O;
    for (int it = gw; it < NIT; it += NGW) {
        int r = it;
        if (r < I_QKV) { const int kb = r / (NQKV / 32), nb = r % (NQKV / 32); const int n0 = nb * 32, pn = n0 >> 8, within = n0 & 255, bj = within >> 7, wc = (within & 127) >> 5;
            tr_item(p.in[8], NQKV, 256 * pn + 64 * wc + 32 * bj, p.in[3], (bf16_t*)(ws + WS_WQKV), D, n0, kb * 64, scr, lane); continue; }
        r -= I_QKV;
        if (r < I_O) { const int kb = r / (D / 32), nb = r % (D / 32); tr_item(p.in[9], D, nb * 32, nullptr, (bf16_t*)(ws + WS_WO), D, nb * 32, kb * 64, scr, lane); continue; }
        r -= I_O;
        if (r < 2 * I_GU) { const int l = r / I_GU; r -= l * I_GU; const int kb = r / (2 * FF / 32), nb = r % (2 * FF / 32); const int n0 = nb * 32, pn = n0 >> 8, within = n0 & 255, bj = within >> 7, j = within & 127;
            const float* src = (bj ? p.in[6] : p.in[5]) + (size_t)l * D * FF;
            tr_item(src, FF, 128 * pn + j, p.in[4] + l * D, (bf16_t*)(ws + (l ? WS_WGU1 : WS_WGU0)), D, n0, kb * 64, scr, lane); continue; }
        r -= 2 * I_GU;
        if (r < 2 * I_D) { const int l = r / I_D; r -= l * I_D; const int kb = r / (D / 32), nb = r % (D / 32);
            tr_item(p.in[7] + (size_t)l * FF * D, D, nb * 32, nullptr, (bf16_t*)(ws + (l ? WS_WD1 : WS_WD0)), FF, nb * 32, kb * 64, scr, lane); continue; }
        r -= 2 * I_D;
        if (r < I_CI) { const int kb = r / (NCI / 32), nb = r % (NCI / 32); const int n0 = nb * 32, pn = n0 >> 8, within = n0 & 255, bj = within >> 7, j = within & 127;
            const int src = pn < 2 ? n0 : (pn < 6 ? (bj ? 1024 : 512) + 128 * (pn - 2) + j : (bj ? 2048 : 1536) + 128 * (pn - 6) + j);
            tr_item(p.in[17], NCI, src, p.in[3] + D, (bf16_t*)(ws + WS_WCI), D, n0, kb * 64, scr, lane); continue; }
        r -= I_CI;
        { const int kb = r / (D / 32), nb = r % (D / 32); tr_item(p.in[18], D, nb * 32, nullptr, (bf16_t*)(ws + WS_WCO), D, nb * 32, kb * 64, scr, lane); }
    }
    bf16_t* X = (bf16_t*)(ws + WS_X); float* ssq = (float*)(ws + WS_SSQ);
    for (int m0 = gw; m0 < M; m0 += 4 * NGW) {
        f32x4 v[4][4];
#pragma unroll
        for (int r = 0; r < 4; ++r) { const int m = m0 + r * NGW; if (m < M) { const float* xrow = (m < 65536) ? p.in[0] + (size_t)m * D : p.in[1] + (size_t)(m - 65536) * D; const f32x4* xr = (const f32x4*)xrow + lane;
#pragma unroll
            for (int j = 0; j < 4; ++j) v[r][j] = __builtin_nontemporal_load(xr + 64 * j); } }
#pragma unroll
        for (int r = 0; r < 4; ++r) { const int m = m0 + r * NGW; if (m < M) {
            float s = 0.f;
#pragma unroll
            for (int j = 0; j < 4; ++j) s += (v[r][j][0] * v[r][j][0] + v[r][j][1] * v[r][j][1]) + (v[r][j][2] * v[r][j][2] + v[r][j][3] * v[r][j][3]);
#pragma unroll
            for (int o = 1; o < 64; o <<= 1) s += __shfl_xor(s, o);
            u32x2* o8 = (u32x2*)(X + (size_t)m * D) + lane;
#pragma unroll
            for (int j = 0; j < 4; ++j) { u32x2 w; w.x = cvt_pk_bf16(v[r][j][0], v[r][j][1]); w.y = cvt_pk_bf16(v[r][j][2], v[r][j][3]); o8[64 * j] = w; }
            if (lane < 16) ssq[(size_t)m * 16 + lane] = (lane == 0) ? s : 0.f; } }
    }
}

__global__ void __launch_bounds__(512, 2) fwd_kernel(Params p) {
    extern __shared__ __attribute__((aligned(16))) unsigned char lds_raw[];
    MLAS unsigned char* lds = (MLAS unsigned char*)lds_raw;
    cg::grid_group grid = cg::this_grid();
    unsigned char* ws = p.ws;
    bf16_t* X = (bf16_t*)(ws + WS_X); bf16_t* BIG = (bf16_t*)(ws + WS_BIG); bf16_t* VT = (bf16_t*)(ws + WS_VT); float* ssq = (float*)(ws + WS_SSQ);
    bf16_t* Y = (bf16_t*)p.out;
    const int lo = p.ph_lo, hi = p.ph_hi, G = gridDim.x, bx = blockIdx.x;
    volatile MLAS unsigned* misc = (volatile MLAS unsigned*)(lds + MISC_OFF);
    if (threadIdx.x < 2) misc[threadIdx.x] = 0u;
    __syncthreads();
    const XcdBarrier xbar = xcd_barrier_post((unsigned*)(ws + WS_CTL), misc);
#ifndef PH_MASK
#define PH_MASK 0x7ff
#endif
#define IN(k) (((PH_MASK >> (k)) & 1) && lo <= (k) && (k) < hi)
#define SEAM(k) do { if (IN(k) && IN((k) + 1)) { if ((k) == 0) grid.sync(); else xcd_barrier(xbar); } } while (0)
    if (IN(0)) { prologue(p, lds); __syncthreads(); }
    SEAM(0);
    if (IN(1)) { pg8::Gemm g{X, (const bf16_t*)(ws + WS_WQKV), M, NQKV, D}; pg8::StaticOrder S; S.init(M, NQKV, G, bx, 1);
        pg8::EpiQKV E{BIG, VT, ssq, p.in[10], p.in[11], p.in[13], p.in[14], lds + pg8::STAGE_BYTES};
        pg8::gemm_phase<pg8::EpiQKV, pg8::StaticOrder, true, true>(lds, g, S, E); }
    SEAM(1);
    if (IN(2)) { for (int rep = 0; rep < PROBE_ATT; ++rep) att::attn_phase(lds, BIG, VT, Y, p.in[2], p.in[12], p.in[16], p.in[15]); }
    SEAM(2);
    if (IN(3)) { pg8::Gemm g{Y, (const bf16_t*)(ws + WS_WO), M, D, D}; pg8::StaticOrder S; S.init(M, D, G, bx, 1);
        pg8::EpiRes<false> E{X, nullptr, ssq};
        pg8::gemm_phase<pg8::EpiRes<false>, pg8::StaticOrder, true, true>(lds, g, S, E); }
    SEAM(3);
    if (IN(4)) { pg8::Gemm g{X, (const bf16_t*)(ws + WS_WGU0), M, 2 * FF, D}; pg8::StaticOrder S; S.init(M, 2 * FF, G, bx);
        pg8::EpiGlu E{BIG, ssq};
        pg8::gemm_phase<pg8::EpiGlu, pg8::StaticOrder, true, true>(lds, g, S, E); }
    SEAM(4);
    if (IN(5)) { pg8::Gemm g{BIG, (const bf16_t*)(ws + WS_WD0), M, D, FF}; pg8::StaticOrder S; S.init(M, D, G, bx, 1);
        pg8::EpiRes<false> E{X, nullptr, ssq};
        pg8::gemm_phase<pg8::EpiRes<false>, pg8::StaticOrder, true, true>(lds, g, S, E); }
    SEAM(5);
    if (IN(6)) { pg8::Gemm g{X, (const bf16_t*)(ws + WS_WCI), M, NCI, D}; pg8::StaticOrder S; S.init(M, NCI, G, bx);
        pg8::EpiConvIn E{BIG, ssq};
        pg8::gemm_phase<pg8::EpiConvIn, pg8::StaticOrder, true, true>(lds, g, S, E); }
    SEAM(6);
    if (IN(7)) { cv::conv_phase(lds, BIG, Y, p.in[19], p.in[20], p.in[21], p.in[22], p.in[23]); }
    SEAM(7);
    if (IN(8)) { pg8::Gemm g{Y, (const bf16_t*)(ws + WS_WCO), M, D, D}; pg8::StaticOrder S; S.init(M, D, G, bx);
        pg8::EpiRes<false> E{X, nullptr, ssq};
        pg8::gemm_phase<pg8::EpiRes<false>, pg8::StaticOrder, true, true>(lds, g, S, E); }
    SEAM(8);
    if (IN(9)) { pg8::Gemm g{X, (const bf16_t*)(ws + WS_WGU1), M, 2 * FF, D}; pg8::StaticOrder S; S.init(M, 2 * FF, G, bx, 1);
        pg8::EpiGlu E{BIG, ssq};
        pg8::gemm_phase<pg8::EpiGlu, pg8::StaticOrder, true, true>(lds, g, S, E); }
    SEAM(9);
    if (IN(10)) { pg8::Gemm g{BIG, (const bf16_t*)(ws + WS_WD1), M, D, FF}; pg8::StaticOrder S; S.init(M, D, G, bx);
        pg8::EpiRes<true> E{X, p.out, ssq};
        pg8::gemm_phase<pg8::EpiRes<true>, pg8::StaticOrder, true, true>(lds, g, S, E); }
#undef IN
#undef SEAM
}
}

#ifndef MK_N_LAUNCHES_X
#define MK_N_LAUNCHES 1
#endif
extern "C" void kernel_launch(void* const* d_in, const int* in_sizes, int n_in, void* d_out, int out_size, void* d_ws, size_t ws_size, hipStream_t stream) {
    static int grid = 0;
    if (grid == 0) {
        if (n_in != 24 || out_size != mk::M * mk::D || ws_size < mk::WS_END) { fprintf(stderr, "kernel_launch: unexpected shapes (n_in %d out %d ws %zu)\n", n_in, out_size, ws_size); grid = -1; return; }
        int dev = 0, cus = 0, per_cu = 0;
        (void)hipGetDevice(&dev); (void)hipDeviceGetAttribute(&cus, hipDeviceAttributeMultiprocessorCount, dev);
        (void)hipFuncSetAttribute((const void*)mk::fwd_kernel, hipFuncAttributeMaxDynamicSharedMemorySize, mk::LDS_BYTES);
        (void)hipOccupancyMaxActiveBlocksPerMultiprocessor(&per_cu, (const void*)mk::fwd_kernel, 512, mk::LDS_BYTES);
        if (per_cu < 1) per_cu = 1;
        (void)hipGetLastError();
        grid = cus * per_cu;
    }
    if (grid < 0) return;
    if (hipMemsetAsync((char*)d_ws + mk::WS_CTL, 0, mk::CTL_BYTES, stream) != hipSuccess) { fprintf(stderr, "kernel_launch: memset of the barrier words failed\n"); return; }
    mk::Params p{};
    for (int i = 0; i < 24; ++i) p.in[i] = (const float*)d_in[i];
    p.out = (float*)d_out; p.ws = (unsigned char*)d_ws;
#if MK_N_LAUNCHES == 1
    p.ph_lo = 0; p.ph_hi = 11;
    void* args[] = {&p};
    hipError_t e = hipLaunchCooperativeKernel((const void*)mk::fwd_kernel, dim3(grid), dim3(512), args, mk::LDS_BYTES, stream);
    if (e != hipSuccess) fprintf(stderr, "cooperative launch failed: %s (grid %d)\n", hipGetErrorString(e), grid);
#else
    for (int ph = 0; ph < 11; ++ph) { p.ph_lo = ph; p.ph_hi = ph + 1; hipLaunchKernelGGL(mk::fwd_kernel, dim3(grid), dim3(512), mk::LDS_BYTES, stream, p); }
#endif
}
```
